# Optimizing an MI355X kernel written in HIP

```python
import math
import jax, jax.numpy as jnp
from jax import lax
import numpy as np

D_MODEL = 1024
BATCH = 4
SEQ = 4096
DEPTH = 2

CHUNK = 64
HEAD_DIM = 64
MIX_WIDTH = D_MODEL
N_HEADS_TOTAL = MIX_WIDTH // HEAD_DIM
SWA_HEADS = N_HEADS_TOTAL // 2
SWA_KV_HEADS = SWA_HEADS // 4
FOX_HEADS = N_HEADS_TOTAL // 4
MLSTM_HEADS = N_HEADS_TOTAL - SWA_HEADS - FOX_HEADS
SWA_Q = SWA_HEADS * HEAD_DIM
SWA_KV = SWA_KV_HEADS * HEAD_DIM
FOX_W = FOX_HEADS * HEAD_DIM
MLSTM_W = MLSTM_HEADS * HEAD_DIM
IN_WIDTH = SWA_Q + 2 * SWA_KV + 3 * FOX_W + FOX_HEADS + 4 * MLSTM_W + 2 * MLSTM_HEADS
WINDOW = 128
WIN_CHUNKS = WINDOW // CHUNK
QBLK = 128
D_FF = 4 * D_MODEL
ROPE_THETA = 10000.0
EPS = 1e-6

kernel_name = "hybrid_swa_fox_mlstm_parallel_heads"


def _rms(x, gain):
    xf = x.astype(jnp.float32)
    y = xf * lax.rsqrt(jnp.mean(xf * xf, axis=-1, keepdims=True) + EPS)
    return (y * gain.astype(jnp.float32)).astype(x.dtype)


def _rope(x, pos):
    half = HEAD_DIM // 2
    inv = ROPE_THETA ** (-jnp.arange(half, dtype=jnp.float32) / half)
    ang = pos.astype(jnp.float32)[:, None] * inv[None, :]
    cos = jnp.cos(ang)[None, :, None, :]
    sin = jnp.sin(ang)[None, :, None, :]
    xf = x.astype(jnp.float32)
    x1, x2 = xf[..., :half], xf[..., half:]
    return jnp.concatenate([x1 * cos - x2 * sin, x2 * cos + x1 * sin], axis=-1).astype(x.dtype)


def _split_in_proj(z):
    sizes = (SWA_Q, SWA_KV, SWA_KV, FOX_W, FOX_W, FOX_W, FOX_HEADS,
             MLSTM_W, MLSTM_W, MLSTM_W, MLSTM_HEADS, MLSTM_HEADS, MLSTM_W)
    idx = np.cumsum(sizes)[:-1].tolist()
    return jnp.split(z, idx, axis=-1)


def _swa_attention(q, k, v, sinks):
    B, S = q.shape[0], q.shape[1]
    nb = S // QBLK
    G = SWA_HEADS // SWA_KV_HEADS
    qb = q.reshape(B, nb, QBLK, SWA_KV_HEADS, G, HEAD_DIM)

    def band(t):
        tb = t.reshape(B, nb, QBLK, SWA_KV_HEADS, HEAD_DIM)
        prev = jnp.concatenate([jnp.zeros_like(tb[:, :1]), tb[:, :-1]], axis=1)
        return jnp.concatenate([prev, tb], axis=2)

    kb, vb = band(k), band(v)
    s = jnp.einsum('bnqhgd,bnkhd->bnhgqk', qb, kb).astype(jnp.float32) / math.sqrt(HEAD_DIM)
    qpos = jnp.arange(nb)[:, None] * QBLK + jnp.arange(QBLK)[None, :]
    kpos = jnp.arange(nb)[:, None] * QBLK - QBLK + jnp.arange(2 * QBLK)[None, :]
    qc = (qpos // CHUNK)[:, :, None]
    kc = (kpos // CHUNK)[:, None, :]
    allowed = (kpos[:, None, :] >= 0) & (kc <= qc) & (kc >= qc - WIN_CHUNKS)
    s = jnp.where(allowed[None, :, None, None], s, -jnp.inf)
    sink = sinks.astype(jnp.float32).reshape(SWA_KV_HEADS, G)[None, None, :, :, None, None]
    m = jnp.maximum(jnp.max(s, axis=-1, keepdims=True), sink)
    p = jnp.exp(s - m)
    p = p / (jnp.sum(p, axis=-1, keepdims=True) + jnp.exp(sink - m))
    o = jnp.einsum('bnhgqk,bnkhd->bnqhgd', p.astype(v.dtype), vb)
    return o.reshape(B, S, SWA_Q)


def _fox_attention(q, k, v, log_f):
    B, S, H, D = q.shape
    nb = S // QBLK
    FT = jnp.cumsum(log_f, axis=1).transpose(0, 2, 1)
    qb = q.reshape(B, nb, QBLK, H, D).transpose(1, 0, 2, 3, 4)
    Fb = FT.reshape(B, H, nb, QBLK).transpose(2, 0, 1, 3)
    kpos = jnp.arange(S)

    def block(args):
        qi, Fi, n = args
        s = jnp.einsum('bqhd,bkhd->bhqk', qi, k).astype(jnp.float32) / math.sqrt(D)
        s = s + Fi[..., None] - FT[:, :, None, :]
        qpos = n * QBLK + jnp.arange(QBLK)
        s = jnp.where((kpos[None, :] <= qpos[:, None])[None, None], s, -jnp.inf)
        p = jax.nn.softmax(s, axis=-1).astype(v.dtype)
        return jnp.einsum('bhqk,bkhd->bqhd', p, v)

    o = lax.map(block, (qb, Fb, jnp.arange(nb)))
    return o.transpose(1, 0, 2, 3, 4).reshape(B, S, H * D)


def _mlstm(q, k, v, i_pre, f_pre):
    B, S, H, D = q.shape
    nc, L = S // CHUNK, CHUNK

    def chunks(t):
        return t.astype(jnp.float32).reshape(B, nc, L, H, D).transpose(0, 3, 1, 2, 4)

    qc, kc, vc = chunks(q), chunks(k) / math.sqrt(D), chunks(v)
    ig = i_pre.reshape(B, nc, L, H).transpose(0, 3, 1, 2)
    lf = jax.nn.log_sigmoid(f_pre).reshape(B, nc, L, H).transpose(0, 3, 1, 2)
    b = jnp.cumsum(lf, axis=-1)
    g = b[..., -1]
    causal = jnp.tril(jnp.ones((L, L), dtype=bool))
    Dm = jnp.where(causal, b[..., :, None] - b[..., None, :] + ig[..., None, :], -jnp.inf)
    a = g[..., None] - b + ig
    a_max = jnp.max(a, axis=-1)
    wa = jnp.exp(a - a_max[..., None])
    C_loc = jnp.einsum('bhcl,bhclv,bhclk->bhcvk', wa, vc, kc)
    n_loc = jnp.einsum('bhcl,bhclk->bhck', wa, kc)

    def step(carry, inp):
        C, n, m = carry
        Cl, nl, gl, aml = inp
        m_new = jnp.maximum(gl + m, aml)
        s_old = jnp.exp(gl + m - m_new)
        s_loc = jnp.exp(aml - m_new)
        C_new = s_old[..., None, None] * C + s_loc[..., None, None] * Cl
        n_new = s_old[..., None] * n + s_loc[..., None] * nl
        return (C_new, n_new, m_new), (C, n, m)

    init = (jnp.zeros((B, H, D, D), jnp.float32), jnp.zeros((B, H, D), jnp.float32),
            jnp.zeros((B, H), jnp.float32))
    xs = (C_loc.transpose(2, 0, 1, 3, 4), n_loc.transpose(2, 0, 1, 3),
          g.transpose(2, 0, 1), a_max.transpose(2, 0, 1))
    _, (C_prev, n_prev, m_prev) = lax.scan(step, init, xs)
    C_prev = C_prev.transpose(1, 2, 0, 3, 4)
    n_prev = n_prev.transpose(1, 2, 0, 3)
    m_prev = m_prev.transpose(1, 2, 0)

    inter = b + m_prev[..., None]
    m_t = jnp.maximum(inter, jnp.max(Dm, axis=-1))
    w_inter = jnp.exp(inter - m_t)
    Sm = jnp.einsum('bhcld,bhcsd->bhcls', qc, kc) * jnp.exp(Dm - m_t[..., None])
    num = (w_inter[..., None] * jnp.einsum('bhcvk,bhclk->bhclv', C_prev, qc)
           + jnp.einsum('bhcls,bhcsv->bhclv', Sm, vc))
    den = w_inter * jnp.einsum('bhck,bhclk->bhcl', n_prev, qc) + jnp.sum(Sm, axis=-1)
    h = num / jnp.maximum(jnp.abs(den), jnp.exp(-m_t))[..., None]
    return h.transpose(0, 2, 3, 1, 4).reshape(B, S, H, D)


def _layer(x, norm1, w_in, swa_q_norm, swa_k_norm, swa_sinks, fox_q_norm, fox_k_norm,
           fox_f_bias, mlstm_i_bias, mlstm_f_bias, mlstm_out_norm, w_out, norm2, w_ff1, w_ff2):
    B, S, _ = x.shape
    h = _rms(x, norm1)
    z = h @ w_in
    (aq, ak, av, bq, bk, bv, bf, cq, ck, cv, ci, cf, co) = _split_in_proj(z)
    pos = jnp.arange(S)

    aq = _rope(_rms(aq.reshape(B, S, SWA_HEADS, HEAD_DIM), swa_q_norm), pos)
    ak = _rope(_rms(ak.reshape(B, S, SWA_KV_HEADS, HEAD_DIM), swa_k_norm), pos)
    ya = _swa_attention(aq, ak, av.reshape(B, S, SWA_KV_HEADS, HEAD_DIM), swa_sinks)

    bq = _rms(bq.reshape(B, S, FOX_HEADS, HEAD_DIM), fox_q_norm)
    bk = _rms(bk.reshape(B, S, FOX_HEADS, HEAD_DIM), fox_k_norm)
    log_f = jax.nn.log_sigmoid(bf.astype(jnp.float32) + fox_f_bias.astype(jnp.float32))
    yb = _fox_attention(bq, bk, bv.reshape(B, S, FOX_HEADS, HEAD_DIM), log_f)

    hc = _mlstm(cq.reshape(B, S, MLSTM_HEADS, HEAD_DIM), ck.reshape(B, S, MLSTM_HEADS, HEAD_DIM),
                cv.reshape(B, S, MLSTM_HEADS, HEAD_DIM),
                ci.astype(jnp.float32) + mlstm_i_bias.astype(jnp.float32),
                cf.astype(jnp.float32) + mlstm_f_bias.astype(jnp.float32))
    hc = _rms(hc, mlstm_out_norm)
    og = jax.nn.sigmoid(co.astype(jnp.float32)).reshape(B, S, MLSTM_HEADS, HEAD_DIM)
    yc = (og * hc).reshape(B, S, MLSTM_W).astype(x.dtype)

    x = x + jnp.concatenate([ya, yb, yc], axis=-1) @ w_out
    u = _rms(x, norm2) @ w_ff1
    return x + jnp.square(jax.nn.relu(u)) @ w_ff2


def setup_inputs(seed: int = 0) -> dict:
    key = jax.random.key(seed)
    ks = jax.random.split(key, 17)
    f32 = jnp.float32

    def gain(k, shape):
        return 1.0 + 0.02 * jax.random.normal(k, shape, f32)

    return {
        "x": jax.random.normal(ks[0], (BATCH, SEQ, D_MODEL), f32),
        "norm1": gain(ks[1], (DEPTH, D_MODEL)),
        "w_in": jax.random.normal(ks[2], (DEPTH, D_MODEL, IN_WIDTH), f32) * D_MODEL ** -0.5,
        "swa_q_norm": gain(ks[3], (DEPTH, HEAD_DIM)),
        "swa_k_norm": gain(ks[4], (DEPTH, HEAD_DIM)),
        "swa_sinks": jax.random.normal(ks[5], (DEPTH, SWA_HEADS), f32),
        "fox_q_norm": gain(ks[6], (DEPTH, HEAD_DIM)),
        "fox_k_norm": gain(ks[7], (DEPTH, HEAD_DIM)),
        "fox_f_bias": jax.random.uniform(ks[8], (DEPTH, FOX_HEADS), f32, 2.0, 6.0),
        "mlstm_i_bias": 0.1 * jax.random.normal(ks[9], (DEPTH, MLSTM_HEADS), f32),
        "mlstm_f_bias": jax.random.uniform(ks[10], (DEPTH, MLSTM_HEADS), f32, 3.0, 6.0),
        "mlstm_out_norm": gain(ks[11], (DEPTH, MLSTM_HEADS, HEAD_DIM)),
        "w_out": jax.random.normal(ks[12], (DEPTH, MIX_WIDTH, D_MODEL), f32) * MIX_WIDTH ** -0.5,
        "norm2": gain(ks[13], (DEPTH, D_MODEL)),
        "w_ff1": jax.random.normal(ks[14], (DEPTH, D_MODEL, D_FF), f32) * D_MODEL ** -0.5,
        "w_ff2": jax.random.normal(ks[15], (DEPTH, D_FF, D_MODEL), f32) * D_FF ** -0.5,
    }


def reference(x, norm1, w_in, swa_q_norm, swa_k_norm, swa_sinks, fox_q_norm, fox_k_norm,
              fox_f_bias, mlstm_i_bias, mlstm_f_bias, mlstm_out_norm, w_out, norm2, w_ff1, w_ff2):
    for l in range(DEPTH):
        x = _layer(x, norm1[l], w_in[l], swa_q_norm[l], swa_k_norm[l], swa_sinks[l],
                   fox_q_norm[l], fox_k_norm[l], fox_f_bias[l], mlstm_i_bias[l], mlstm_f_bias[l],
                   mlstm_out_norm[l], w_out[l], norm2[l], w_ff1[l], w_ff2[l])
    return x
```

```cpp
#include <hip/hip_runtime.h>
#include <hip/hip_cooperative_groups.h>
#include <cstdio>
#include <cstdint>
#include <cmath>
namespace cg = cooperative_groups;
namespace pg8 {
#define PG8_LAS __attribute__((address_space(3)))
typedef unsigned short bf16_t;
typedef short bf16x8 __attribute__((ext_vector_type(8)));
typedef float f32x4 __attribute__((ext_vector_type(4)));
typedef unsigned u32x4 __attribute__((ext_vector_type(4)));
constexpr int BM = 256, BK = 64, HALF = 128, HTB = HALF * BK * 2  , STAGE_BYTES = 8 * HTB, NXCD = 8, WGM = 8;

__host__ __device__ __forceinline__ int lds_byte(int r, int c) { const int st = (r >> 4) * 2 + (c >> 5), rr = r & 15, cc = c & 31, ob = rr * 64 + cc * 2; return st * 1024 + (ob ^ (((ob >> 9) & 1) << 5)); }
__host__ __device__ __forceinline__ void stage_rc(int b, int& R, int& C) { const int st = b / 1024, sb = b % 1024, swz = sb ^ (((sb >> 9) & 1) << 5); R = (st >> 1) * 16 + swz / 64; C = (st & 1) * 32 + (swz % 64) / 2; }
__host__ __device__ __forceinline__ int perm32(int rho) { const int n = rho >> 4, i = rho & 15; return 8 * (i >> 2) + 4 * n + (i & 3); }

struct Unit { int pm, pn; };
struct Gemm { const bf16_t* A; const bf16_t* Bt; int M, N, K; };

struct StaticOrder {
    int nM, nN, nwg, G, c;
    __host__ __device__ void init(int M, int N, int G_, int c_) { nM = M / BM; nN = N / BM; nwg = nM * nN; G = G_; c = c_; }
    __host__ __device__ bool next(int i, Unit& u) const {
        const long L = (long)i * G + c; if (L >= nwg) return false;
        int wgid = (int)L; { const int q = nwg / NXCD, r = nwg % NXCD, xcd = wgid % NXCD, off = wgid / NXCD; wgid = (xcd < r ? xcd * (q + 1) : r * (q + 1) + (xcd - r) * q) + off; }
        const int nig = WGM * nN, gid = wgid / nig, fm = gid * WGM, gsz = (nM - fm) < WGM ? (nM - fm) : WGM;
        u.pm = fm + ((wgid % nig) % gsz); u.pn = (wgid % nig) / gsz; return true;
    }
    __device__ __forceinline__ void a_ready(const Unit&) const {}
    __device__ __forceinline__ void done(const Unit&) const {}
};

__device__ __forceinline__ unsigned cvt_pk_bf16(float lo, float hi) { unsigned r; asm volatile("v_cvt_pk_bf16_f32 %0, %1, %2" : "=v"(r) : "v"(lo), "v"(hi)); return r; }
constexpr float EPS = 1e-6f;
constexpr float LOG2E = 1.4426950408889634f;
constexpr float C2 = 0.125f * LOG2E;
constexpr int ZP = 2560;

__device__ __forceinline__ float row_rstd(const float* ssq, int row, int fq) {
    const float* sp = ssq + (size_t)row * 32 + fq * 8;
    const f32x4 s0 = *(const f32x4*)sp, s1 = *(const f32x4*)(sp + 4);
    float t = ((s0[0] + s0[1]) + (s0[2] + s0[3])) + ((s1[0] + s1[1]) + (s1[2] + s1[3]));
    t += __shfl_xor(t, 16); t += __shfl_xor(t, 32);
    return rsqrtf(t * (1.0f / 1024.0f) + EPS);
}

struct EpiIn {
    static constexpr bool PERM = true, AFTER_DRAIN = false;
    bf16_t* Z; float* G; const float* ssq; const float* ropec; const float* ropes; const float* gqa; const float* gka; const float* gqb; const float* gkb;
    unsigned char* KT; unsigned char* VT;
    __device__ __forceinline__ void operator()(const f32x4 (&acc)[2][2][4][2], const Unit& u, int wr, int wc, int fr, int fq) const {
        const int pn = u.pn;
        int type = 0; const float* gsel = gqa; bool rp = false; float sc = 1.f;
        if (pn < 2) { type = 1; gsel = gqa; rp = true; sc = C2; }
        else if (pn == 2) { if (wc < 2) { type = 1; gsel = gka; rp = true; } }
        else if (pn == 3) { type = 1; gsel = gqb; sc = C2; }
        else if (pn == 4) { type = 1; gsel = gkb; }
        else if (pn == 7) { sc = 0.125f; }
        else if (pn == 9) { type = 2; }
        else if (pn == 10) { type = 3; }
        if (type == 3 && wc != 0) return;
        const int dcol = 8 * fq;
        unsigned char* tp = nullptr;
        if (pn == 4 || pn == 5) { const size_t tb0 = (size_t)((((u.pm * BM) >> 12) * 4 + wc) * 64 + (((u.pm * BM) & 4095) >> 6) + wr) * 8192;
            tp = pn == 4 ? KT + tb0 + fq * 1024 + fr * 16 : VT + tb0 + (fr * 4 + fq) * 16; }
        float gn[2][8];
#pragma unroll
        for (int bj = 0; bj < 2; ++bj)
#pragma unroll
            for (int i = 0; i < 8; ++i) gn[bj][i] = (type == 1) ? gsel[32 * bj + dcol + i] : 1.f;
#pragma unroll
        for (int ai = 0; ai < 2; ++ai)
#pragma unroll
            for (int m = 0; m < 4; ++m) {
                const int row = u.pm * BM + ai * HALF + wr * 64 + m * 16 + fr;
                const float rstd = row_rstd(ssq, row, fq);
                float v[2][8];
#pragma unroll
                for (int bj = 0; bj < 2; ++bj)
#pragma unroll
                    for (int n = 0; n < 2; ++n)
#pragma unroll
                        for (int e = 0; e < 4; ++e) v[bj][4 * n + e] = acc[ai][bj][m][n][e] * rstd;
                if (type == 1) {
                    float ss = 0.f;
#pragma unroll
                    for (int bj = 0; bj < 2; ++bj)
#pragma unroll
                        for (int i = 0; i < 8; ++i) ss += v[bj][i] * v[bj][i];
                    ss += __shfl_xor(ss, 16); ss += __shfl_xor(ss, 32);
                    const float hr = rsqrtf(ss * (1.0f / 64.0f) + EPS);
#pragma unroll
                    for (int bj = 0; bj < 2; ++bj)
#pragma unroll
                        for (int i = 0; i < 8; ++i) v[bj][i] *= hr * gn[bj][i];
                    if (rp) {
                        const int pos = row & 4095;
                        const f32x4 c0 = *(const f32x4*)(ropec + pos * 32 + dcol), c1 = *(const f32x4*)(ropec + pos * 32 + dcol + 4);
                        const f32x4 s0 = *(const f32x4*)(ropes + pos * 32 + dcol), s1 = *(const f32x4*)(ropes + pos * 32 + dcol + 4);
#pragma unroll
                        for (int i = 0; i < 8; ++i) {
                            const float c = i < 4 ? c0[i & 3] : c1[i & 3], s = i < 4 ? s0[i & 3] : s1[i & 3];
                            const float x1 = v[0][i], x2 = v[1][i];
                            v[0][i] = x1 * c - x2 * s; v[1][i] = x2 * c + x1 * s;
                        }
                    }
#pragma unroll
                    for (int bj = 0; bj < 2; ++bj)
#pragma unroll
                        for (int i = 0; i < 8; ++i) v[bj][i] *= sc;
                } else if (type == 2) {
#pragma unroll
                    for (int bj = 0; bj < 2; ++bj)
#pragma unroll
                        for (int i = 0; i < 8; ++i) v[bj][i] = 1.0f / (1.0f + __expf(-v[bj][i]));
                } else if (type == 0) {
#pragma unroll
                    for (int bj = 0; bj < 2; ++bj)
#pragma unroll
                        for (int i = 0; i < 8; ++i) v[bj][i] *= sc;
                }
                if (type == 3) {
                    float* gp = G + (size_t)row * 16;
                    if (fq == 0) { *(f32x4*)gp = (f32x4){v[0][0], v[0][1], v[0][2], v[0][3]}; *(f32x4*)(gp + 4) = (f32x4){v[0][4], v[0][5], v[0][6], v[0][7]}; }
                    else if (fq == 1) { *(f32x4*)(gp + 8) = (f32x4){v[0][0], v[0][1], v[0][2], v[0][3]}; }
                } else {
#pragma unroll
                    for (int bj = 0; bj < 2; ++bj) {
                        u32x4 w; w.x = cvt_pk_bf16(v[bj][0], v[bj][1]); w.y = cvt_pk_bf16(v[bj][2], v[bj][3]); w.z = cvt_pk_bf16(v[bj][4], v[bj][5]); w.w = cvt_pk_bf16(v[bj][6], v[bj][7]);
                        if (pn == 4) *(u32x4*)(tp + ai * 16384 + bj * 4096 + m * 256) = w;
                        else if (pn == 5) *(u32x4*)(tp + ai * 16384 + bj * 4096 + m * 1024) = w;
                        else
                        *(u32x4*)(Z + (size_t)row * ZP + 256 * pn + 64 * wc + 32 * bj + dcol) = w;
                    }
                }
                if (m & 1) asm volatile("" ::: "memory");
            }
    }
};

struct EpiRes {
    static constexpr bool PERM = true, AFTER_DRAIN = false;
    bf16_t* XB; float* ssq; float* out;
    __device__ __forceinline__ void operator()(const f32x4 (&acc)[2][2][4][2], const Unit& u, int wr, int wc, int fr, int fq) const {
#pragma unroll
        for (int bj = 0; bj < 2; ++bj) {
            const int col0 = u.pn * BM + bj * HALF + wc * 32 + 8 * fq;
#pragma unroll
            for (int ai = 0; ai < 2; ++ai)
#pragma unroll
                for (int m = 0; m < 4; ++m) {
                    const int row = u.pm * BM + ai * HALF + wr * 64 + m * 16 + fr;
                    const size_t off = (size_t)row * 1024 + col0;
                    const u32x4 bw = *(const u32x4*)(XB + off);
                    f32x4 x0 = acc[ai][bj][m][0], x1 = acc[ai][bj][m][1];
                    x0[0] += __builtin_bit_cast(float, bw.x << 16); x0[1] += __builtin_bit_cast(float, bw.x & 0xffff0000u);
                    x0[2] += __builtin_bit_cast(float, bw.y << 16); x0[3] += __builtin_bit_cast(float, bw.y & 0xffff0000u);
                    x1[0] += __builtin_bit_cast(float, bw.z << 16); x1[1] += __builtin_bit_cast(float, bw.z & 0xffff0000u);
                    x1[2] += __builtin_bit_cast(float, bw.w << 16); x1[3] += __builtin_bit_cast(float, bw.w & 0xffff0000u);
                    if (out) { *(f32x4*)(out + off) = x0; *(f32x4*)(out + off + 4) = x1; }
                    else {
                        float ss = ((x0[0] * x0[0] + x0[1] * x0[1]) + (x0[2] * x0[2] + x0[3] * x0[3])) + ((x1[0] * x1[0] + x1[1] * x1[1]) + (x1[2] * x1[2] + x1[3] * x1[3]));
                        ss += __shfl_xor(ss, 16); ss += __shfl_xor(ss, 32);
                        if (fq == 0) ssq[(size_t)row * 32 + u.pn * 8 + bj * 4 + wc] = ss;
                        u32x4 w; w.x = cvt_pk_bf16(x0[0], x0[1]); w.y = cvt_pk_bf16(x0[2], x0[3]); w.z = cvt_pk_bf16(x1[0], x1[1]); w.w = cvt_pk_bf16(x1[2], x1[3]);
                        *(u32x4*)(XB + off) = w;
                    }
                }
        }
    }
};

struct EpiFF1 {
    static constexpr bool PERM = true, AFTER_DRAIN = false;
    bf16_t* H; const float* ssq;
    __device__ __forceinline__ void operator()(const f32x4 (&acc)[2][2][4][2], const Unit& u, int wr, int wc, int fr, int fq) const {
#pragma unroll
        for (int ai = 0; ai < 2; ++ai)
#pragma unroll
            for (int m = 0; m < 4; ++m) {
                const int row = u.pm * BM + ai * HALF + wr * 64 + m * 16 + fr;
                const float rstd = row_rstd(ssq, row, fq);
#pragma unroll
                for (int bj = 0; bj < 2; ++bj) {
                    const int col0 = u.pn * BM + bj * HALF + wc * 32 + 8 * fq;
                    f32x4 a = acc[ai][bj][m][0] * rstd, b = acc[ai][bj][m][1] * rstd;
#pragma unroll
                    for (int e = 0; e < 4; ++e) { a[e] = fmaxf(a[e], 0.f); a[e] *= a[e]; b[e] = fmaxf(b[e], 0.f); b[e] *= b[e]; }
                    u32x4 w; w.x = cvt_pk_bf16(a[0], a[1]); w.y = cvt_pk_bf16(a[2], a[3]); w.z = cvt_pk_bf16(b[0], b[1]); w.w = cvt_pk_bf16(b[2], b[3]);
                    *(u32x4*)(H + (size_t)row * 4096 + col0) = w;
                }
                if (m & 1) asm volatile("" ::: "memory");
            }
    }
};

template <class Epi, class Sched, bool ALIGN_EPI = false, bool SP2 = false>
__device__ __forceinline__ void gemm_phase(PG8_LAS unsigned char* lds, const Gemm g, const Sched& S, const Epi& E) {
    int tid_ = threadIdx.x; asm volatile("" : "+v"(tid_));
    const int tid = tid_, wid = __builtin_amdgcn_readfirstlane(tid >> 6), lane = tid & 63, wr = wid >> 2, wc = wid & 3, fr = lane & 15, fq = lane >> 4;
    const int K = g.K, nt = K / BK;
    unsigned voffA[2], voffB[2];
#pragma unroll
    for (int i = 0; i < 2; ++i) { int R, C; stage_rc(tid * 16 + i * 8192, R, C); const int Rb = Epi::PERM ? ((R & ~31) + perm32(R & 31)) : R;
        voffA[i] = (unsigned)(R * K + C) * 2u; voffB[i] = (unsigned)(Rb * K + C) * 2u; }
    const size_t kstep = (size_t)(BK * 2);
    const size_t hstep = (size_t)HALF * K * 2;
    const size_t tstep = 2 * hstep;
    const unsigned ldsw = (unsigned)wid * 1024u;
    const int aoff = lds_byte(wr * 64 + fr, fq * 8), boff = lds_byte(wc * 32 + fr, fq * 8);
#define PG8_SA(b, h) (((b) * 2 + (h)) * HTB)
#define PG8_SB(b, h) ((4 + (b) * 2 + (h)) * HTB)
#define PG8_STAGE(bufoff, gbase, voff) do { _Pragma("unroll") for (int _i = 0; _i < 2; ++_i) \
        __builtin_amdgcn_global_load_lds((const unsigned*)((const char*)(gbase) + (voff)[_i]), (PG8_LAS unsigned*)(lds + (bufoff) + ldsw + _i * 8192), 16, 0, 0); } while (0)
#define PG8_LDA(dst, b, h) do { _Pragma("unroll") for (int m = 0; m < 4; ++m) _Pragma("unroll") for (int k = 0; k < 2; ++k) dst[m][k] = *(const PG8_LAS bf16x8*)(lds + PG8_SA(b, h) + aoff + m * 2048 + k * 1024); } while (0)
#define PG8_LDB(dst, b, h) do { _Pragma("unroll") for (int n = 0; n < 2; ++n) _Pragma("unroll") for (int k = 0; k < 2; ++k) dst[n][k] = *(const PG8_LAS bf16x8*)(lds + PG8_SB(b, h) + boff + n * 2048 + k * 1024); } while (0)
#define PG8_MMA(ai, bj, At, Bt) do { __builtin_amdgcn_s_setprio(1); _Pragma("unroll") for (int m = 0; m < 4; ++m) _Pragma("unroll") for (int n = 0; n < 2; ++n) _Pragma("unroll") for (int k = 0; k < 2; ++k) \
        acc[ai][bj][m][n] = __builtin_amdgcn_mfma_f32_16x16x32_bf16(Bt[n][k], At[m][k], acc[ai][bj][m][n], 0, 0, 0); __builtin_amdgcn_s_setprio(0); } while (0)
#define PG8_WAIT_V(n) asm volatile("s_waitcnt vmcnt(" #n ")" ::: "memory")
#define PG8_WAIT_L(n) asm volatile("s_waitcnt lgkmcnt(" #n ")" ::: "memory")
#define PG8_BAR __builtin_amdgcn_s_barrier()
#define PG8_SCHED __builtin_amdgcn_sched_barrier(0)
    Unit cur, nxt; int ui = 0;
    if (!S.next(0, cur)) return;
    f32x4 acc[2][2][4][2];
#pragma unroll
    for (int a = 0; a < 2; ++a)
#pragma unroll
        for (int b = 0; b < 2; ++b)
#pragma unroll
            for (int m = 0; m < 4; ++m)
#pragma unroll
                for (int n = 0; n < 2; ++n) acc[a][b][m][n] = (f32x4){0.f, 0.f, 0.f, 0.f};
    bf16x8 At[4][2], B0[2][2], B1[2][2];
    const char* cA = (const char*)g.A + (size_t)cur.pm * tstep; const char* cB = (const char*)g.Bt + (size_t)cur.pn * tstep;
    S.a_ready(cur);
    if constexpr (SP2) {
        PG8_STAGE(PG8_SB(0, 0), cB, voffB); PG8_STAGE(PG8_SB(0, 1), cB + hstep, voffB); PG8_STAGE(PG8_SA(0, 0), cA, voffA); PG8_STAGE(PG8_SA(0, 1), cA + hstep, voffA);
        if (wr == 1) PG8_BAR;
        PG8_WAIT_V(2); PG8_BAR;
        PG8_STAGE(PG8_SB(1, 0), cB + kstep, voffB); PG8_STAGE(PG8_SA(1, 0), cA + kstep, voffA); PG8_STAGE(PG8_SB(1, 1), cB + hstep + kstep, voffB);
        PG8_WAIT_V(6); PG8_BAR;
    } else {
        PG8_STAGE(PG8_SB(0, 0), cB, voffB); PG8_STAGE(PG8_SA(0, 0), cA, voffA); PG8_STAGE(PG8_SB(0, 1), cB + hstep, voffB); PG8_STAGE(PG8_SA(0, 1), cA + hstep, voffA);
        if (wr == 1) PG8_BAR;
        PG8_WAIT_V(4); PG8_BAR;
        PG8_STAGE(PG8_SB(1, 0), cB + kstep, voffB); PG8_STAGE(PG8_SA(1, 0), cA + kstep, voffA); PG8_STAGE(PG8_SB(1, 1), cB + hstep + kstep, voffB);
        PG8_WAIT_V(6); PG8_BAR;
    }
    for (;;) {
        const bool has_next = S.next(ui + 1, nxt);
        const char* nA = has_next ? (const char*)g.A + (size_t)nxt.pm * tstep : cA; const char* nB = has_next ? (const char*)g.Bt + (size_t)nxt.pn * tstep : cB;
        for (int t = 0; t < nt; t += 2) {
            const bool last = (t == nt - 2);
            const char* a1 = cA + (size_t)(t + 1) * kstep;
            const char* a2 = last ? nA : cA + (size_t)(t + 2) * kstep; const char* b2 = last ? nB : cB + (size_t)(t + 2) * kstep;
            const char* a3 = a2 + kstep; const char* b3 = b2 + kstep;
            if (last && has_next) S.a_ready(nxt);
            if constexpr (SP2) {
            PG8_LDB(B0, 0, 0); PG8_LDB(B1, 0, 1); PG8_SCHED; PG8_LDA(At, 0, 0); PG8_STAGE(PG8_SA(1, 1), a1 + hstep, voffA);
            PG8_WAIT_V(8); PG8_WAIT_L(0); PG8_BAR; PG8_MMA(0, 0, At, B0); PG8_MMA(0, 1, At, B1); PG8_BAR; PG8_SCHED;
            PG8_LDA(At, 0, 1); PG8_STAGE(PG8_SB(0, 0), b2, voffB); PG8_STAGE(PG8_SB(0, 1), b2 + hstep, voffB); PG8_STAGE(PG8_SA(0, 0), a2, voffA);
            PG8_WAIT_V(8); PG8_WAIT_L(0); PG8_BAR; PG8_MMA(1, 0, At, B0); PG8_MMA(1, 1, At, B1); PG8_BAR; PG8_SCHED;
            PG8_LDB(B0, 1, 0); PG8_LDB(B1, 1, 1); PG8_SCHED; PG8_LDA(At, 1, 0); PG8_STAGE(PG8_SA(0, 1), a2 + hstep, voffA);
            PG8_WAIT_V(8); PG8_WAIT_L(0); PG8_BAR; PG8_MMA(0, 0, At, B0); PG8_MMA(0, 1, At, B1); PG8_BAR; PG8_SCHED;
            PG8_LDA(At, 1, 1); PG8_STAGE(PG8_SB(1, 0), b3, voffB); PG8_STAGE(PG8_SB(1, 1), b3 + hstep, voffB); PG8_STAGE(PG8_SA(1, 0), a3, voffA);
            PG8_WAIT_V(8); PG8_WAIT_L(0); PG8_BAR; PG8_MMA(1, 0, At, B0); PG8_MMA(1, 1, At, B1); PG8_BAR; PG8_SCHED;
            } else {
            PG8_LDB(B0, 0, 0); PG8_SCHED; PG8_LDA(At, 0, 0); PG8_STAGE(PG8_SA(1, 1), a1 + hstep, voffA);
            PG8_WAIT_L(8); PG8_BAR; PG8_WAIT_L(0); PG8_MMA(0, 0, At, B0); PG8_BAR; PG8_SCHED;
            PG8_LDB(B1, 0, 1); PG8_STAGE(PG8_SB(0, 0), b2, voffB);
            PG8_BAR; PG8_WAIT_L(0); PG8_MMA(0, 1, At, B1); PG8_BAR;
            PG8_LDA(At, 0, 1); PG8_STAGE(PG8_SA(0, 0), a2, voffA);
            PG8_BAR; PG8_WAIT_L(0); PG8_MMA(1, 0, At, B0); PG8_BAR; PG8_SCHED;
            PG8_STAGE(PG8_SB(0, 1), b2 + hstep, voffB);
            PG8_WAIT_V(6); PG8_BAR; PG8_MMA(1, 1, At, B1); PG8_BAR;
            PG8_LDB(B0, 1, 0); PG8_SCHED; PG8_LDA(At, 1, 0); PG8_STAGE(PG8_SA(0, 1), a2 + hstep, voffA);
            PG8_WAIT_L(8); PG8_BAR; PG8_WAIT_L(0); PG8_MMA(0, 0, At, B0); PG8_BAR; PG8_SCHED;
            PG8_LDB(B1, 1, 1); PG8_STAGE(PG8_SB(1, 0), b3, voffB);
            PG8_BAR; PG8_WAIT_L(0); PG8_MMA(0, 1, At, B1); PG8_BAR;
            PG8_LDA(At, 1, 1); PG8_STAGE(PG8_SA(1, 0), a3, voffA);
            PG8_BAR; PG8_WAIT_L(0); PG8_MMA(1, 0, At, B0); PG8_BAR; PG8_SCHED;
            PG8_STAGE(PG8_SB(1, 1), b3 + hstep, voffB);
            PG8_WAIT_V(6); PG8_BAR; PG8_MMA(1, 1, At, B1); PG8_BAR;
            }
        }
        if constexpr (ALIGN_EPI) { if (wr == 0) PG8_BAR; }
        if constexpr (!Epi::AFTER_DRAIN) { E(acc, cur, wr, wc, fr, fq); S.done(cur); }
        if (!has_next) break;
#pragma unroll
        for (int a = 0; a < 2; ++a)
#pragma unroll
            for (int b = 0; b < 2; ++b)
#pragma unroll
                for (int m = 0; m < 4; ++m)
#pragma unroll
                    for (int n = 0; n < 2; ++n) acc[a][b][m][n] = (f32x4){0.f, 0.f, 0.f, 0.f};
        cur = nxt; cA = nA; cB = nB; ++ui;
        if constexpr (ALIGN_EPI) { if (wr == 1) PG8_BAR; }
    }
    PG8_WAIT_V(0);
    if constexpr (!ALIGN_EPI) { if (wr == 0) PG8_BAR; }
    PG8_BAR;
    if constexpr (Epi::AFTER_DRAIN) { E.fused(acc, cur, wr, wc, fr, fq, lds, wid, lane); S.done(cur); }
#undef PG8_SA
#undef PG8_SB
#undef PG8_STAGE
#undef PG8_LDA
#undef PG8_LDB
#undef PG8_MMA
#undef PG8_WAIT_V
#undef PG8_WAIT_L
#undef PG8_BAR
#undef PG8_SCHED
}
}
#define LAS __attribute__((address_space(3)))
typedef unsigned short bf16_t;
typedef short bf16x8 __attribute__((ext_vector_type(8)));
typedef short s16x4 __attribute__((ext_vector_type(4)));
typedef float f32x4 __attribute__((ext_vector_type(4)));
typedef float f32x16 __attribute__((ext_vector_type(16)));
typedef unsigned u32x4 __attribute__((ext_vector_type(4)));
typedef unsigned u32x2 __attribute__((ext_vector_type(2)));
using pg8::ZP; using pg8::LOG2E; using pg8::EPS;
__device__ __forceinline__ int crow(int r, int hi) { return (r & 3) + 8 * (r >> 2) + 4 * hi; }
__device__ __forceinline__ unsigned cvtpk(float lo, float hi) { unsigned r; asm volatile("v_cvt_pk_bf16_f32 %0, %1, %2" : "=v"(r) : "v"(lo), "v"(hi)); return r; }
__device__ __forceinline__ unsigned f2bf(float f) { unsigned u = __builtin_bit_cast(unsigned, f); return (u + 0x7fffu + ((u >> 16) & 1u)) >> 16; }
__device__ __forceinline__ float bf2f(unsigned short h) { return __builtin_bit_cast(float, (unsigned)h << 16); }
__device__ __forceinline__ float ex2(float x) { return __builtin_amdgcn_exp2f(x); }
#define VM_WAIT0() asm volatile("s_waitcnt vmcnt(0)" ::: "memory")
#define LGKM_WAIT0() asm volatile("s_waitcnt lgkmcnt(0)" ::: "memory")

__device__ __forceinline__ void dma_k(LAS unsigned char* slot, const bf16_t* src, int pitch, int w, int lane) {
    const bf16_t* s = src + (size_t)lane * pitch + w * 8;
    __builtin_amdgcn_global_load_lds((const unsigned*)s, (LAS unsigned*)(slot + w * 1024), 16, 0, 0);
}
__device__ __forceinline__ void dma_v(LAS unsigned char* slot, const bf16_t* src, int pitch, int w, int lane) {
    const bf16_t* s = src + (size_t)(16 * (w & 3) + (lane >> 2)) * pitch + (w >> 2) * 32 + (lane & 3) * 8;
    __builtin_amdgcn_global_load_lds((const unsigned*)s, (LAS unsigned*)(slot + w * 1024), 16, 0, 0);
}
__device__ __forceinline__ void dma_lin(LAS unsigned char* slot, const unsigned char* src, int w, int lane) {
    __builtin_amdgcn_global_load_lds((const unsigned*)(src + w * 1024 + lane * 16), (LAS unsigned*)(slot + w * 1024), 16, 0, 0);
}
__device__ __forceinline__ void qkt(f32x16& p0, f32x16& p1, const LAS unsigned char* Kslot, const bf16x8* qr, int r32, int hi, f32x16 z0 = f32x16{}, f32x16 z1 = f32x16{}) {
    const LAS unsigned char* kb = Kslot + hi * 1024 + r32 * 16;
#pragma unroll
    for (int d0 = 0; d0 < 4; ++d0) {
        const bf16x8 b0 = *(const LAS bf16x8*)(kb + d0 * 2048);
        const bf16x8 b1 = *(const LAS bf16x8*)(kb + d0 * 2048 + 512);
        z0 = __builtin_amdgcn_mfma_f32_32x32x16_bf16(b0, qr[d0], z0, 0, 0, 0);
        z1 = __builtin_amdgcn_mfma_f32_32x32x16_bf16(b1, qr[d0], z1, 0, 0, 0);
    }
    p0 = z0; p1 = z1;
}
__device__ __forceinline__ int vt_lane_off(int lane) { const int hi = lane >> 5; return ((lane >> 4) & 1) * 32 + (lane & 3) * 8 + (4 * hi + ((lane & 15) >> 2)) * 64; }
__device__ __forceinline__ bf16x8 vfrag(int vb, int d0, int ks) {
    s16x4 lo, hh;
    asm volatile("ds_read_b64_tr_b16 %0, %1" : "=v"(lo) : "v"(vb + d0 * 4096 + ks * 1024) : "memory");
    asm volatile("ds_read_b64_tr_b16 %0, %1" : "=v"(hh) : "v"(vb + d0 * 4096 + ks * 1024 + 512) : "memory");
    asm volatile("s_waitcnt lgkmcnt(0)" : "+v"(lo), "+v"(hh) :: "memory");
    return (bf16x8){lo[0], lo[1], lo[2], lo[3], hh[0], hh[1], hh[2], hh[3]};
}
__device__ __forceinline__ void pv(f32x16* o, int vb, bf16x8 pa0, bf16x8 pa1, bf16x8 pa2, bf16x8 pa3) {
    s16x4 lo[8], hh[8];
#pragma unroll
    for (int i = 0; i < 8; ++i) {
        asm volatile("ds_read_b64_tr_b16 %0, %1 offset:%c2" : "=&v"(lo[i]) : "v"(vb), "i"((i >> 2) * 4096 + (i & 3) * 1024) : "memory");
        asm volatile("ds_read_b64_tr_b16 %0, %1 offset:%c2" : "=&v"(hh[i]) : "v"(vb), "i"((i >> 2) * 4096 + (i & 3) * 1024 + 512) : "memory");
    }
    asm volatile("s_waitcnt lgkmcnt(0)" : "+v"(lo[0]), "+v"(lo[1]), "+v"(lo[2]), "+v"(lo[3]), "+v"(lo[4]), "+v"(lo[5]), "+v"(lo[6]), "+v"(lo[7]),
                 "+v"(hh[0]), "+v"(hh[1]), "+v"(hh[2]), "+v"(hh[3]), "+v"(hh[4]), "+v"(hh[5]), "+v"(hh[6]), "+v"(hh[7]) :: "memory");
#define PVK(k) (bf16x8){lo[k][0], lo[k][1], lo[k][2], lo[k][3], hh[k][0], hh[k][1], hh[k][2], hh[k][3]}
    o[0] = __builtin_amdgcn_mfma_f32_32x32x16_bf16(pa0, PVK(0), o[0], 0, 0, 0);
    o[1] = __builtin_amdgcn_mfma_f32_32x32x16_bf16(pa0, PVK(4), o[1], 0, 0, 0);
    o[0] = __builtin_amdgcn_mfma_f32_32x32x16_bf16(pa1, PVK(1), o[0], 0, 0, 0);
    o[1] = __builtin_amdgcn_mfma_f32_32x32x16_bf16(pa1, PVK(5), o[1], 0, 0, 0);
    o[0] = __builtin_amdgcn_mfma_f32_32x32x16_bf16(pa2, PVK(2), o[0], 0, 0, 0);
    o[1] = __builtin_amdgcn_mfma_f32_32x32x16_bf16(pa2, PVK(6), o[1], 0, 0, 0);
    o[0] = __builtin_amdgcn_mfma_f32_32x32x16_bf16(pa3, PVK(3), o[0], 0, 0, 0);
    o[1] = __builtin_amdgcn_mfma_f32_32x32x16_bf16(pa3, PVK(7), o[1], 0, 0, 0);
#undef PVK
}
#define PACK8(P, B) __builtin_bit_cast(bf16x8, ((u32x4){cvtpk(P[B], P[B + 1]), cvtpk(P[B + 2], P[B + 3]), cvtpk(P[B + 4], P[B + 5]), cvtpk(P[B + 6], P[B + 7])}))
__device__ __forceinline__ void scale_rows(f32x16* o, float f, LAS float* wsf, int r32, int hi) {
    if (hi == 0) wsf[r32] = f;
    LGKM_WAIT0();
#pragma unroll
    for (int r = 0; r < 16; ++r) { const float fr = wsf[crow(r, hi)]; o[0][r] *= fr; o[1][r] *= fr; }
    LGKM_WAIT0();
}
__device__ __forceinline__ float max3f(float x, float y, float z) { return __builtin_fmaxf(__builtin_fmaxf(x, y), z); }
typedef float f32x8 __attribute__((ext_vector_type(8)));
typedef float f32x2 __attribute__((ext_vector_type(2)));
typedef short v4i16_t __attribute__((ext_vector_type(4)));
__device__ __forceinline__ s16x4 vtr(const LAS unsigned char* p) { return __builtin_bit_cast(s16x4, __builtin_amdgcn_ds_read_tr16_b64_v4i16((LAS v4i16_t*)p)); }
__device__ __forceinline__ float rowmax32(const f32x16& p0, const f32x16& p1) {
    float a = max3f(p0[0], p0[1], p1[0]), b = max3f(p0[2], p0[3], p1[1]); a = max3f(a, p1[2], p1[3]);
#pragma unroll
    for (int r = 4; r < 16; r += 4) { a = max3f(a, p0[r], p0[r + 1]); b = max3f(b, p0[r + 2], p0[r + 3]); a = max3f(a, p1[r], p1[r + 1]); b = max3f(b, p1[r + 2], p1[r + 3]); }
    const float m = fmaxf(a, b);
    auto rr = __builtin_amdgcn_permlane32_swap(__builtin_bit_cast(unsigned, m), __builtin_bit_cast(unsigned, m), false, false);
    return fmaxf(__builtin_bit_cast(float, (unsigned)rr[0]), __builtin_bit_cast(float, (unsigned)rr[1]));
}
template <int THR, bool HASF>
__device__ __forceinline__ void attn_step(f32x16& p0, f32x16& p1, f32x16& n0, f32x16& n1, const LAS unsigned char* Knext, const LAS float* Fnext, const LAS unsigned char* Vcur,
                                          const bf16x8* qr, float& mhat, float& l, f32x16* o, LAS float* wsf, int r32, int hi) {
    f32x16 c0 = f32x16{}, c1 = f32x16{};
    if (HASF) {
#pragma unroll
        for (int rr = 0; rr < 4; ++rr) { const f32x4 f0 = *(const LAS f32x4*)(Fnext + 8 * rr), f1 = *(const LAS f32x4*)(Fnext + 32 + 8 * rr);
#pragma unroll
            for (int e = 0; e < 4; ++e) { c0[4 * rr + e] = f0[e]; c1[4 * rr + e] = f1[e]; } }
    }
    bf16x8 kf[8];
    { const LAS unsigned char* kb = Knext + hi * 1024 + r32 * 16;
#pragma unroll
      for (int d0 = 0; d0 < 4; ++d0) { kf[2 * d0] = *(const LAS bf16x8*)(kb + d0 * 2048); kf[2 * d0 + 1] = *(const LAS bf16x8*)(kb + d0 * 2048 + 512); } }
    __builtin_amdgcn_sched_barrier(0);
    const float rm = rowmax32(p0, p1);
    if (__any(rm > mhat + (float)THR)) {
        const float mnew = fmaxf(mhat, rm), f = ex2(mhat - mnew);
        l *= f; mhat = mnew; scale_rows(o, f, wsf, r32, hi);
    }
#pragma unroll
    for (int d0 = 0; d0 < 4; ++d0) {
        c0 = __builtin_amdgcn_mfma_f32_32x32x16_bf16(kf[2 * d0], qr[d0], c0, 0, 0, 0);
        c1 = __builtin_amdgcn_mfma_f32_32x32x16_bf16(kf[2 * d0 + 1], qr[d0], c1, 0, 0, 0);
    }
    __builtin_amdgcn_sched_barrier(0);
    s16x4 vl[8], vh[8];
#pragma unroll
    for (int i = 0; i < 8; ++i) { vl[i] = vtr(Vcur + (i >> 2) * 4096 + (i & 3) * 1024); vh[i] = vtr(Vcur + (i >> 2) * 4096 + (i & 3) * 1024 + 512); }
    __builtin_amdgcn_sched_barrier(0);
    p0 = p0 - mhat; p1 = p1 - mhat;
#pragma unroll
    for (int r = 0; r < 16; ++r) { p0[r] = ex2(p0[r]); p1[r] = ex2(p1[r]); }
    const f32x16 t = p0 + p1;
    const f32x8 t8 = t.lo + t.hi; const f32x4 t4 = t8.lo + t8.hi; const f32x2 t2 = t4.lo + t4.hi;
    l += t2.x + t2.y;
    const bf16x8 pa0 = PACK8(p0, 0), pa1 = PACK8(p0, 8), pa2 = PACK8(p1, 0), pa3 = PACK8(p1, 8);
#define VFK(k) (bf16x8){vl[k][0], vl[k][1], vl[k][2], vl[k][3], vh[k][0], vh[k][1], vh[k][2], vh[k][3]}
    o[0] = __builtin_amdgcn_mfma_f32_32x32x16_bf16(pa0, VFK(0), o[0], 0, 0, 0);
    o[1] = __builtin_amdgcn_mfma_f32_32x32x16_bf16(pa0, VFK(4), o[1], 0, 0, 0);
    o[0] = __builtin_amdgcn_mfma_f32_32x32x16_bf16(pa1, VFK(1), o[0], 0, 0, 0);
    o[1] = __builtin_amdgcn_mfma_f32_32x32x16_bf16(pa1, VFK(5), o[1], 0, 0, 0);
    o[0] = __builtin_amdgcn_mfma_f32_32x32x16_bf16(pa2, VFK(2), o[0], 0, 0, 0);
    o[1] = __builtin_amdgcn_mfma_f32_32x32x16_bf16(pa2, VFK(6), o[1], 0, 0, 0);
    o[0] = __builtin_amdgcn_mfma_f32_32x32x16_bf16(pa3, VFK(3), o[0], 0, 0, 0);
    o[1] = __builtin_amdgcn_mfma_f32_32x32x16_bf16(pa3, VFK(7), o[1], 0, 0, 0);
#undef VFK
    n0 = c0; n1 = c1;
}
template <int THR>
__device__ __forceinline__ void softmax_pv(f32x16& p0, f32x16& p1, float& mhat, float& l, f32x16* o, int vb, LAS float* wsf, int r32, int hi) {
    float a = max3f(p0[0], p0[1], p1[0]), b = max3f(p0[2], p0[3], p1[1]); a = max3f(a, p1[2], p1[3]);
#pragma unroll
    for (int r = 4; r < 16; r += 4) { a = max3f(a, p0[r], p0[r + 1]); b = max3f(b, p0[r + 2], p0[r + 3]); a = max3f(a, p1[r], p1[r + 1]); b = max3f(b, p1[r + 2], p1[r + 3]); }
    float rm = fmaxf(a, b); rm = fmaxf(rm, __shfl_xor(rm, 32));
    if (__any(rm > mhat + (float)THR)) {
        const float mnew = fmaxf(mhat, rm), f = ex2(mhat - mnew);
        l *= f; mhat = mnew; scale_rows(o, f, wsf, r32, hi);
    }
    p0 = p0 - mhat; p1 = p1 - mhat;
#pragma unroll
    for (int r = 0; r < 16; ++r) { p0[r] = ex2(p0[r]); p1[r] = ex2(p1[r]); }
    const f32x16 t = p0 + p1;
    const f32x8 t8 = t.lo + t.hi; const f32x4 t4 = t8.lo + t8.hi; const f32x2 t2 = t4.lo + t4.hi;
    l += t2.x + t2.y;
    pv(o, vb, PACK8(p0, 0), PACK8(p0, 8), PACK8(p1, 0), PACK8(p1, 8));
}
__device__ __forceinline__ void store_o(const f32x16* o, float rinv, LAS float* wsf, LAS bf16_t* stg, bf16_t* Og, int pitch, int r32, int hi, int lane) {
    if (hi == 0) wsf[32 + r32] = rinv;
    LGKM_WAIT0();
#pragma unroll
    for (int r = 0; r < 16; ++r) { const int orow = crow(r, hi); const float rl = wsf[32 + orow];
#pragma unroll
        for (int d0 = 0; d0 < 2; ++d0) stg[orow * 64 + d0 * 32 + r32] = (bf16_t)f2bf(o[d0][r] * rl); }
    LGKM_WAIT0();
#pragma unroll
    for (int i = 0; i < 4; ++i) { const int row = i * 8 + (lane >> 3), ch = lane & 7; const u32x4 v = *(const LAS u32x4*)(stg + row * 64 + ch * 8); *(u32x4*)(Og + (size_t)row * pitch + ch * 8) = v; }
    LGKM_WAIT0();
}
__device__ __forceinline__ float log_sigmoid(float x) { return fminf(x, 0.f) - log1pf(__expf(-fabsf(x))); }

constexpr int MX_RING = 0, MX_F = 98304, MX_WSF = 114688, MX_WTOT = 116736, MX_STG_SWA = 65536, MX_STG_FOX = 40960;

struct MixCtx {
    const bf16_t* Z; const float* G; bf16_t* Y;
    const float* sinks; const float* fox_fb; const float* ml_ib; const float* ml_fb; const float* ml_norm;
    unsigned char* ws; const unsigned char* KT; const unsigned char* VT;
};

__device__ __forceinline__ void swa_item(const MixCtx& C, int item, LAS unsigned char* lds) {
    int tid_ = threadIdx.x; asm volatile("" : "+v"(tid_));
    const int tid = tid_, lane = tid & 63, w = __builtin_amdgcn_readfirstlane(tid >> 6), r32 = lane & 31, hi = lane >> 5;
    const int jp = item & 31, kvh = (item >> 5) & 1, b = item >> 6;
    const size_t rowbase = (size_t)b * 4096;
    const int cbase = jp >= 1 ? 2 * jp - 2 : 0, ntl = 2 * jp + 2 - cbase;
    const bf16_t* Kb = C.Z + rowbase * ZP + 512 + 64 * kvh; const bf16_t* Vb = C.Z + rowbase * ZP + 640 + 64 * kvh;
    for (int j = 0; j < ntl; ++j) { dma_k(lds + MX_RING + j * 16384, Kb + (size_t)(cbase + j) * 64 * ZP, ZP, w, lane); dma_v(lds + MX_RING + j * 16384 + 8192, Vb + (size_t)(cbase + j) * 64 * ZP, ZP, w, lane); }
    const int hq = 4 * kvh + (w >> 1);
    bf16x8 qra[4], qrb[4];
    { const bf16_t* Qa = C.Z + (rowbase + 128 * jp + 32 * (w & 1) + r32) * ZP + 64 * hq;
#pragma unroll
      for (int d0 = 0; d0 < 4; ++d0) { qra[d0] = *(const bf16x8*)(Qa + 16 * d0 + 8 * hi); qrb[d0] = *(const bf16x8*)(Qa + (size_t)64 * ZP + 16 * d0 + 8 * hi); } }
    LAS float* wsf = (LAS float*)(lds + MX_WSF) + w * 64; LAS bf16_t* stg = (LAS bf16_t*)(lds + MX_STG_SWA + w * 4096);
    const float sink = C.sinks[hq] * LOG2E;
    VM_WAIT0(); __syncthreads();
    const int vlo = vt_lane_off(lane);
#pragma unroll
    for (int cc = 0; cc < 2; ++cc) {
        const int c = 2 * jp + cc, c0 = c >= 2 ? c - 2 : 0, nt = c - c0 + 1, s0 = c0 - cbase, qw0 = 64 * c + 32 * (w & 1);
        const bf16x8* qr = cc == 0 ? qra : qrb;
        float mhat = sink, l = hi == 0 ? 1.f : 0.f; f32x16 o[2]; o[0] = f32x16{}; o[1] = f32x16{};
        f32x16 p0, p1; qkt(p0, p1, lds + MX_RING + s0 * 16384, qr, r32, hi);
        for (int j = 0; j < nt; ++j) {
            f32x16 n0 = p0, n1 = p1;
            if (j + 1 < nt) qkt(n0, n1, lds + MX_RING + (s0 + j + 1) * 16384, qr, r32, hi);
            softmax_pv<8>(p0, p1, mhat, l, o, (int)(uintptr_t)(lds + MX_RING + (s0 + j) * 16384 + 8192) + vlo, wsf, r32, hi);
            p0 = n0; p1 = n1;
        }
        l += __shfl_xor(l, 32);
        store_o(o, 1.0f / l, wsf, stg, C.Y + (rowbase + qw0) * 1024 + 64 * hq, 1024, r32, hi, lane);
    }
    __syncthreads();
}

__device__ __forceinline__ void fx0_item(const MixCtx& C, float* NF, unsigned* cntF, int bh, LAS unsigned char* lds) {
    int tid_ = threadIdx.x; asm volatile("" : "+v"(tid_));
    const int tid = tid_, lane = tid & 63, w = __builtin_amdgcn_readfirstlane(tid >> 6);
    const int b = bh >> 2, h = bh & 3; const size_t rowbase = (size_t)b * 4096;
    LAS float* wtot = (LAS float*)(lds + MX_WTOT);
    const float fb = C.fox_fb[h]; const int t0 = tid * 8; float v[8]; float run = 0.f;
#pragma unroll
    for (int i = 0; i < 8; ++i) { run += log_sigmoid(C.G[(rowbase + t0 + i) * 16 + h] + fb) * LOG2E; v[i] = run; }
    float inc = run;
#pragma unroll
    for (int o_ = 1; o_ < 64; o_ <<= 1) { const float y = __shfl_up(inc, o_); if (lane >= o_) inc += y; }
    if (lane == 63) wtot[w] = inc;
    __syncthreads();
    float off = inc - run;
    for (int j = 0; j < w; ++j) off += wtot[j];
    *(f32x4*)(NF + bh * 4096 + t0) = (f32x4){-(v[0] + off), -(v[1] + off), -(v[2] + off), -(v[3] + off)};
    *(f32x4*)(NF + bh * 4096 + t0 + 4) = (f32x4){-(v[4] + off), -(v[5] + off), -(v[6] + off), -(v[7] + off)};
    asm volatile("s_waitcnt vmcnt(0)" ::: "memory"); __syncthreads();
    if (tid == 0) { __builtin_amdgcn_fence(__ATOMIC_RELEASE, "agent"); asm volatile("s_waitcnt vmcnt(0)" ::: "memory"); __hip_atomic_fetch_add(cntF + bh, 1u, __ATOMIC_RELAXED, __HIP_MEMORY_SCOPE_AGENT); }
    __syncthreads();
}
__device__ __forceinline__ void fox_block(const MixCtx& C, const float* NF, unsigned* cntF, int bh, int qb, LAS unsigned char* lds, bool first) {
    int tid_ = threadIdx.x; asm volatile("" : "+v"(tid_));
    const int tid = tid_, lane = tid & 63, w = __builtin_amdgcn_readfirstlane(tid >> 6), r32 = lane & 31, hi = lane >> 5;
    const int b = bh >> 2, h = bh & 3; const size_t rowbase = (size_t)b * 4096; const int q0 = qb * 128, nkeys = q0 + 128, nst = qb + 1;
    const unsigned char* Kt = C.KT + (size_t)bh * 64 * 8192; const unsigned char* Vt = C.VT + (size_t)bh * 64 * 8192;
#define FOX_STAGE(st_) do { LAS unsigned char* sb_ = lds + MX_RING + ((st_) % 3) * 32768; \
        dma_lin(sb_, Kt + (size_t)(2 * (st_)) * 8192, w, lane); dma_lin(sb_ + 8192, Kt + (size_t)(2 * (st_) + 1) * 8192, w, lane); \
        dma_lin(sb_ + 16384, Vt + (size_t)(2 * (st_)) * 8192, w, lane); dma_lin(sb_ + 24576, Vt + (size_t)(2 * (st_) + 1) * 8192, w, lane); } while (0)
    if (first) {
        if (tid == 0) { while (__hip_atomic_load(cntF + bh, __ATOMIC_RELAXED, __HIP_MEMORY_SCOPE_AGENT) < 1u) __builtin_amdgcn_s_sleep(2); }
        __syncthreads();
    }
    FOX_STAGE(0); if (nst > 1) FOX_STAGE(1);
    LAS float* F2 = (LAS float*)(lds + MX_F);
    LAS float* wsf = (LAS float*)(lds + MX_WSF) + w * 64; LAS bf16_t* stg = (LAS bf16_t*)(lds + MX_STG_FOX + w * 4096);
    {
        const int t0 = tid * 8;
        if (first && t0 < nkeys) { const unsigned long long* np = (const unsigned long long*)(NF + bh * 4096 + t0); unsigned long long q[4];
#pragma unroll
            for (int i = 0; i < 4; ++i) q[i] = __hip_atomic_load(np + i, __ATOMIC_RELAXED, __HIP_MEMORY_SCOPE_AGENT);
#pragma unroll
            for (int i = 0; i < 4; ++i) *(LAS unsigned long long*)(F2 + t0 + 2 * i) = q[i]; }
    }
    const int g = w >> 2, qw0 = q0 + 32 * (w & 3);
    const bf16_t* Qb = C.Z + (rowbase + qw0 + r32) * ZP + 768 + 64 * h;
    bf16x8 qr[4];
#pragma unroll
    for (int d0 = 0; d0 < 4; ++d0) qr[d0] = *(const bf16x8*)(Qb + 16 * d0 + 8 * hi);
    float mhat = -1e30f, l = 0.f; f32x16 o[2]; o[0] = f32x16{}; o[1] = f32x16{};
    VM_WAIT0(); __syncthreads();
    const int vlo = vt_lane_off(lane), qpos = qw0 + r32;
#define FOX_SCORE(st_, P0, P1) do { const int kb_ = 64 * (2 * (st_) + g); const LAS unsigned char* sk_ = lds + MX_RING + ((st_) % 3) * 32768 + g * 8192; f32x16 c0_, c1_; \
        _Pragma("unroll") for (int rr = 0; rr < 4; ++rr) { const f32x4 f0 = *(const LAS f32x4*)(F2 + kb_ + 8 * rr + 4 * hi), f1 = *(const LAS f32x4*)(F2 + kb_ + 32 + 8 * rr + 4 * hi); \
            _Pragma("unroll") for (int e = 0; e < 4; ++e) { c0_[4 * rr + e] = f0[e]; c1_[4 * rr + e] = f1[e]; } } \
        qkt(P0, P1, sk_, qr, r32, hi, c0_, c1_); } while (0)
    f32x16 p0, p1, n0, n1; FOX_SCORE(0, p0, p1);
#define FOX_STEP(PA0, PA1, PB0, PB1, st_) do { if ((st_) + 2 < nst) FOX_STAGE((st_) + 2); \
        attn_step<24, true>(PA0, PA1, PB0, PB1, lds + MX_RING + (((st_) + 1) % 3) * 32768 + g * 8192, F2 + 64 * (2 * ((st_) + 1) + g) + 4 * hi, \
                           lds + MX_RING + ((st_) % 3) * 32768 + 16384 + g * 8192 + vlo, qr, mhat, l, o, wsf, r32, hi); \
        VM_WAIT0(); __syncthreads(); } while (0)
#define FOX_LAST(PA0, PA1) do { const int st = nst - 1, kbase = 64 * (2 * st + g); \
        if (kbase <= qw0 + 31) { \
            if (kbase + 63 > qw0) { _Pragma("unroll") for (int r = 0; r < 16; ++r) { const int kv = kbase + crow(r, hi); if (kv > qpos) PA0[r] = -INFINITY; if (kv + 32 > qpos) PA1[r] = -INFINITY; } } \
            softmax_pv<24>(PA0, PA1, mhat, l, o, (int)(uintptr_t)(lds + MX_RING + (st % 3) * 32768 + 16384 + g * 8192) + vlo, wsf, r32, hi); } } while (0)
    int st2 = 0;
    for (; st2 + 2 < nst; st2 += 2) { FOX_STEP(p0, p1, n0, n1, st2); FOX_STEP(n0, n1, p0, p1, st2 + 1); }
    if (st2 + 1 < nst) { FOX_STEP(p0, p1, n0, n1, st2); FOX_LAST(n0, n1); } else { FOX_LAST(p0, p1); }
#undef FOX_STEP
#undef FOX_LAST
    __syncthreads();
#undef FOX_SCORE
#undef FOX_STAGE
    l += __shfl_xor(l, 32);
    LAS float* mo = (LAS float*)(lds + MX_RING); LAS float* ml = (LAS float*)(lds + MX_RING + 32768);
    const int wq = w & 3;
    if (g == 1) {
#pragma unroll
        for (int d0 = 0; d0 < 2; ++d0)
#pragma unroll
            for (int r = 0; r < 16; ++r) mo[((wq * 2 + d0) * 16 + r) * 64 + lane] = o[d0][r];
        ml[(wq * 2 + 0) * 64 + lane] = mhat; ml[(wq * 2 + 1) * 64 + lane] = l;
    }
    __syncthreads();
    if (g == 0) {
        const float m1 = ml[(wq * 2 + 0) * 64 + lane], l1 = ml[(wq * 2 + 1) * 64 + lane];
        const float mn = fmaxf(mhat, m1), f0 = ex2(mhat - mn), f1 = ex2(m1 - mn), lt = l * f0 + l1 * f1;
        if (hi == 0) { wsf[r32] = f0; wsf[32 + r32] = f1; }
        LGKM_WAIT0();
#pragma unroll
        for (int r = 0; r < 16; ++r) { const float a0 = wsf[crow(r, hi)], a1 = wsf[32 + crow(r, hi)];
#pragma unroll
            for (int d0 = 0; d0 < 2; ++d0) o[d0][r] = o[d0][r] * a0 + mo[((wq * 2 + d0) * 16 + r) * 64 + lane] * a1; }
        LGKM_WAIT0();
        store_o(o, 1.0f / lt, wsf, stg, C.Y + (rowbase + qw0) * 1024 + 512 + 64 * h, 1024, r32, hi, lane);
    }
    __syncthreads();
}
__device__ __forceinline__ void fox_item(const MixCtx& C, const float* NF, unsigned* cntF, int bh, int i, LAS unsigned char* lds) {
    fox_block(C, NF, cntF, bh, 31 - i, lds, true);
    fox_block(C, NF, cntF, bh, i, lds, false);
}
constexpr int ML_WSF = 98304, ML_STG = 100352, ML_SM = 133120;
struct MlScratch { float* E; float* B; float* PM; float* CL; float* NL; bf16_t* CP; float* NP; float* GC; float* EM; float* MP; unsigned* cnt1; unsigned* cnt2; };
__device__ __forceinline__ void wait_count(unsigned* p, unsigned want, int tid) {
    if (tid == 0) { while (__hip_atomic_load(p, __ATOMIC_RELAXED, __HIP_MEMORY_SCOPE_AGENT) < want) __builtin_amdgcn_s_sleep(2);
        __builtin_amdgcn_fence(__ATOMIC_ACQUIRE, "agent"); asm volatile("s_waitcnt vmcnt(0)" ::: "memory"); }
    __syncthreads();
}
__device__ __forceinline__ void post_count(unsigned* p, int tid) {
    asm volatile("s_waitcnt vmcnt(0)" ::: "memory"); __syncthreads();
    if (tid == 0) { __builtin_amdgcn_fence(__ATOMIC_RELEASE, "agent"); asm volatile("s_waitcnt vmcnt(0)" ::: "memory");
        __hip_atomic_fetch_add(p, 1u, __ATOMIC_RELAXED, __HIP_MEMORY_SCOPE_AGENT); }
}
#define ML_COMMON \
    int tid_ = threadIdx.x; asm volatile("" : "+v"(tid_)); \
    const int tid = tid_, lane = tid & 63, w = __builtin_amdgcn_readfirstlane(tid >> 6), r32 = lane & 31, hi = lane >> 5; \
    const int b = bh >> 2, h = bh & 3; const size_t rowbase = (size_t)b * 4096; \
    float* E = S.E + bh * 4096; float* B = S.B + bh * 4096; float* PM = S.PM + bh * 4096; \
    float* CL = S.CL + (size_t)bh * 64 * 4096; float* NL = S.NL + bh * 4096; bf16_t* CP = S.CP + (size_t)bh * 64 * 4096; float* NP = S.NP + bh * 4096; \
    float* GC = S.GC + bh * 64; float* EM = S.EM + bh * 64; float* MP = S.MP + bh * 64; \
    (void)r32; (void)hi; (void)E; (void)B; (void)PM; (void)CL; (void)NL; (void)CP; (void)NP; (void)GC; (void)EM; (void)MP; (void)rowbase; (void)h;

__device__ __forceinline__ void ml1_item(const MixCtx& C, const MlScratch& S, int bh, int rd, LAS unsigned char* lds) {
    ML_COMMON
    LAS float* le = (LAS float*)(lds + ML_SM); LAS float* lem = le + 512;
    const bf16_t* Kg = C.Z + rowbase * ZP + 1792 + 64 * h; const bf16_t* Vg = C.Z + rowbase * ZP + 2048 + 64 * h;
    const int srow = 16 * (w & 3) + (lane >> 2), scol = (w >> 2) * 32 + (lane & 3) * 8;
    u32x4 kvr[8];
#pragma unroll
    for (int p = 0; p < 8; ++p) kvr[p] = *(const u32x4*)(Kg + (size_t)((8 * rd + p) * 64 + srow) * ZP + scol);
    {
        const int cc = 8 * rd + w, t = cc * 64 + lane;
        const float* gp = C.G + (rowbase + t) * 16;
        const float ig = gp[4 + h] + C.ml_ib[h];
        float bsum = log_sigmoid(gp[8 + h] + C.ml_fb[h]);
#pragma unroll
        for (int o_ = 1; o_ < 64; o_ <<= 1) { const float y = __shfl_up(bsum, o_); if (lane >= o_) bsum += y; }
        const float e = ig - bsum; float pm = e;
#pragma unroll
        for (int o_ = 1; o_ < 64; o_ <<= 1) { const float y = __shfl_up(pm, o_); if (lane >= o_) pm = fmaxf(pm, y); }
        E[t] = e; B[t] = bsum; PM[t] = pm; le[w * 64 + lane] = e;
        if (lane == 63) { GC[cc] = bsum; EM[cc] = pm; lem[w] = pm; }
    }
    __syncthreads();
    const int vlo = vt_lane_off(lane);
    const bf16x8 ones = (bf16x8){0x3F80, 0x3F80, 0x3F80, 0x3F80, 0x3F80, 0x3F80, 0x3F80, 0x3F80};
#pragma unroll
    for (int p = 0; p < 8; ++p) {
        const int cc = 8 * rd + p; LAS unsigned char* sl = lds + p * 16384;
        const float wa = __expf(le[p * 64 + srow] - lem[p]);
        u32x4 w2;
#pragma unroll
        for (int j = 0; j < 4; ++j) { const float lo = __builtin_bit_cast(float, kvr[p][j] << 16), hh = __builtin_bit_cast(float, kvr[p][j] & 0xffff0000u); w2[j] = cvtpk(lo * wa, hh * wa); }
        *(LAS u32x4*)(sl + w * 1024 + lane * 16) = w2;
        dma_v(sl + 8192, Vg + (size_t)cc * 64 * ZP, ZP, w, lane);
    }
    VM_WAIT0(); __syncthreads();
    {
        const int cc = 8 * rd + w; LAS unsigned char* sl = lds + w * 16384;
        const int ka = (int)(uintptr_t)sl + vlo, va = ka + 8192;
        float* cl = CL + (size_t)cc * 4096;
#pragma unroll
        for (int half = 0; half < 2; ++half) {
            f32x16 a0 = {}, a1 = {}, na = {};
#pragma unroll
            for (int ks = 0; ks < 4; ++ks) {
                const bf16x8 A = vfrag(ka, half, ks), B0 = vfrag(va, 0, ks), B1 = vfrag(va, 1, ks);
                a0 = __builtin_amdgcn_mfma_f32_32x32x16_bf16(A, B0, a0, 0, 0, 0);
                a1 = __builtin_amdgcn_mfma_f32_32x32x16_bf16(A, B1, a1, 0, 0, 0);
                na = __builtin_amdgcn_mfma_f32_32x32x16_bf16(A, ones, na, 0, 0, 0);
            }
#pragma unroll
            for (int r = 0; r < 16; ++r) { const int k = 32 * half + crow(r, hi); cl[k * 64 + r32] = a0[r]; cl[k * 64 + 32 + r32] = a1[r]; }
            if (r32 == 0) {
#pragma unroll
                for (int r = 0; r < 16; ++r) NL[cc * 64 + 32 * half + crow(r, hi)] = na[r];
            }
        }
    }
    post_count(S.cnt1 + bh, tid);
    __syncthreads();
}

__device__ __forceinline__ void ml2_item(const MixCtx& C, const MlScratch& S, int bh, int slice, LAS unsigned char* lds) {
    ML_COMMON
    LAS float* lg = (LAS float*)(lds + ML_SM); LAS float* lem = lg + 64; LAS float* lso = lg + 128; LAS float* lsl = lg + 192;
    wait_count(S.cnt1 + bh, 8u, tid);
    if (tid < 64) { lg[tid] = GC[tid]; lem[tid] = EM[tid]; }
    __syncthreads();
    if (tid == 0) { float mcur = 0.f; for (int c = 0; c < 64; ++c) { const float g = lg[c], em = lem[c], mx = fmaxf(mcur, em); if (slice == 0) MP[c] = mcur; lso[c] = __expf(mcur - mx); lsl[c] = __expf(em - mx); mcur = g + mx; } }
    __syncthreads();
    const int idx = slice * 2048 + tid * 4; const bool don = (slice == 0) && (tid < 64);
    f32x4 Cs = (f32x4){0.f, 0.f, 0.f, 0.f}; float ns = 0.f;
    for (int c0 = 0; c0 < 64; c0 += 16) {
        f32x4 lv[16]; float ln[16];
#pragma unroll
        for (int j = 0; j < 16; ++j) { lv[j] = *(const f32x4*)(CL + (size_t)(c0 + j) * 4096 + idx); ln[j] = don ? NL[(c0 + j) * 64 + tid] : 0.f; }
#pragma unroll
        for (int j = 0; j < 16; ++j) {
            const int c = c0 + j;
            u32x2 pk; pk.x = cvtpk(Cs[0], Cs[1]); pk.y = cvtpk(Cs[2], Cs[3]);
            *(u32x2*)(CP + (size_t)c * 4096 + idx) = pk;
            if (don) NP[c * 64 + tid] = ns;
            const float so = lso[c], sl = lsl[c];
            Cs = Cs * so + lv[j] * sl; ns = so * ns + sl * ln[j];
        }
    }
    post_count(S.cnt2 + bh, tid);
    __syncthreads();
}

__device__ __forceinline__ void ml3_item(const MixCtx& C, const MlScratch& S, int bh, int rd, LAS unsigned char* lds) {
    ML_COMMON
    wait_count(S.cnt2 + bh, 2u, tid);
    const int pair = w >> 1, half = w & 1;
    const bf16_t* Kg = C.Z + rowbase * ZP + 1792 + 64 * h; const bf16_t* Vg = C.Z + rowbase * ZP + 2048 + 64 * h; const bf16_t* Qg = C.Z + rowbase * ZP + 1536 + 64 * h;
    const int vlo = vt_lane_off(lane);
    LAS float* wsf = (LAS float*)(lds + ML_WSF) + w * 64; LAS bf16_t* stg = (LAS bf16_t*)(lds + ML_STG + w * 4096);
#pragma unroll
        for (int p = 0; p < 4; ++p) {
            const int cc = 4 * rd + p; LAS unsigned char* sl = lds + p * 24576;
            dma_k(sl, Kg + (size_t)cc * 64 * ZP, ZP, w, lane); dma_v(sl + 8192, Vg + (size_t)cc * 64 * ZP, ZP, w, lane); dma_v(sl + 16384, CP + (size_t)cc * 4096, 64, w, lane);
        }
        const int cc = 4 * rd + pair, lrow = 32 * half + r32, t = cc * 64 + lrow;
        const bf16_t* qp = Qg + (size_t)t * ZP;
        bf16x8 qr[4], qp2[4];
#pragma unroll
        for (int d0 = 0; d0 < 4; ++d0) qr[d0] = *(const bf16x8*)(qp + 16 * d0 + 8 * hi);
#pragma unroll
        for (int ks = 0; ks < 4; ++ks) { const u32x2 a = *(const u32x2*)(qp + 16 * ks + 4 * hi), b2 = *(const u32x2*)(qp + 16 * ks + 8 + 4 * hi); qp2[ks] = __builtin_bit_cast(bf16x8, ((u32x4){a.x, a.y, b2.x, b2.y})); }
        const float mprev = MP[cc], mm = fmaxf(mprev, PM[t]), winter = __expf(mprev - mm), bl = B[t];
        float nd = 0.f;
#pragma unroll
        for (int d0 = 0; d0 < 4; ++d0) { const float* np = NP + cc * 64 + 16 * d0 + 8 * hi; const f32x4 n0 = *(const f32x4*)np, n1 = *(const f32x4*)(np + 4);
            const u32x4 qq = __builtin_bit_cast(u32x4, qr[d0]);
#pragma unroll
            for (int j = 0; j < 4; ++j) { const float lo = __builtin_bit_cast(float, qq[j] << 16), hh = __builtin_bit_cast(float, qq[j] & 0xffff0000u);
                const float na_ = j < 2 ? n0[2 * j] : n1[2 * j - 4], nb_ = j < 2 ? n0[2 * j + 1] : n1[2 * j - 3]; nd += lo * na_ + hh * nb_; } }
        nd += __shfl_xor(nd, 32);
        VM_WAIT0(); __syncthreads();
        {
            LAS unsigned char* sl = lds + pair * 24576; const int base = (int)(uintptr_t)sl + vlo;
            f32x16 o[2]; o[0] = f32x16{}; o[1] = f32x16{};
            pv(o, base + 16384, qp2[0], qp2[1], qp2[2], qp2[3]);
            scale_rows(o, winter, wsf, r32, hi);
            f32x16 p0, p1; qkt(p0, p1, sl, qr, r32, hi);
            float rs = 0.f;
#pragma unroll
            for (int rr = 0; rr < 4; ++rr) { const f32x4 e0 = *(const f32x4*)(E + cc * 64 + 8 * rr + 4 * hi), e1 = *(const f32x4*)(E + cc * 64 + 32 + 8 * rr + 4 * hi);
#pragma unroll
                for (int e = 0; e < 4; ++e) { const int r = 4 * rr + e, s = 8 * rr + 4 * hi + e;
                    const float w0 = (s <= lrow) ? __expf(e0[e] - mm) : 0.f, w1 = (s + 32 <= lrow) ? __expf(e1[e] - mm) : 0.f;
                    p0[r] *= w0; p1[r] *= w1; rs += p0[r] + p1[r]; } }
            rs += __shfl_xor(rs, 32);
            pv(o, base + 8192, PACK8(p0, 0), PACK8(p0, 8), PACK8(p1, 0), PACK8(p1, 8));
            const float den = winter * nd + rs, dn = fmaxf(fabsf(den), __expf(-(bl + mm)));
            const float rinv = 1.0f / dn;
            if (hi == 0) wsf[32 + r32] = rinv;
            LGKM_WAIT0();
#pragma unroll
            for (int r = 0; r < 16; ++r) { const int orow = crow(r, hi); const float rl = wsf[32 + orow];
#pragma unroll
                for (int d0 = 0; d0 < 2; ++d0) stg[orow * 64 + d0 * 32 + r32] = (bf16_t)f2bf(o[d0][r] * rl); }
            LGKM_WAIT0();
#pragma unroll
            for (int i = 0; i < 4; ++i) {
                const int row = i * 8 + (lane >> 3), ch = lane & 7; const u32x4 v = *(const LAS u32x4*)(stg + row * 64 + ch * 8);
                float x[8]; float ss = 0.f;
#pragma unroll
                for (int j = 0; j < 4; ++j) { x[2 * j] = __builtin_bit_cast(float, v[j] << 16); x[2 * j + 1] = __builtin_bit_cast(float, v[j] & 0xffff0000u); ss += x[2 * j] * x[2 * j] + x[2 * j + 1] * x[2 * j + 1]; }
                ss += __shfl_xor(ss, 1); ss += __shfl_xor(ss, 2); ss += __shfl_xor(ss, 4);
                const float rn = rsqrtf(ss * (1.0f / 64.0f) + EPS);
                const size_t tok = rowbase + cc * 64 + 32 * half + row;
                const u32x4 og = *(const u32x4*)(C.Z + tok * ZP + 2304 + 64 * h + ch * 8);
                const f32x4 g0 = *(const f32x4*)(C.ml_norm + h * 64 + ch * 8), g1 = *(const f32x4*)(C.ml_norm + h * 64 + ch * 8 + 4);
                float y[8];
#pragma unroll
                for (int j = 0; j < 4; ++j) { const float o0 = __builtin_bit_cast(float, og[j] << 16), o1 = __builtin_bit_cast(float, og[j] & 0xffff0000u);
                    const float ga = j < 2 ? g0[2 * j] : g1[2 * j - 4], gb = j < 2 ? g0[2 * j + 1] : g1[2 * j - 3];
                    y[2 * j] = x[2 * j] * rn * ga * o0; y[2 * j + 1] = x[2 * j + 1] * rn * gb * o1; }
                u32x4 pk; pk.x = cvtpk(y[0], y[1]); pk.y = cvtpk(y[2], y[3]); pk.z = cvtpk(y[4], y[5]); pk.w = cvtpk(y[6], y[7]);
                *(u32x4*)(C.Y + tok * 1024 + 768 + 64 * h + ch * 8) = pk;
            }
            LGKM_WAIT0();
        }
        __syncthreads();
}
constexpr int MTOK = 16384, DMODEL = 1024, SEQL = 4096, DFF = 4096, NZT = 2816  , DEPTH = 2;
constexpr size_t MiB = 1u << 20;
constexpr size_t WS_CTL = 0, CTL_BYTES = 32768;
constexpr size_t WS_WIN = 2 * MiB, WIN_L = (size_t)NZT * DMODEL * 2;
constexpr size_t WS_WOUT = 13 * MiB, WOUT_L = (size_t)DMODEL * DMODEL * 2;
constexpr size_t WS_WFF1 = 17 * MiB, WFF_L = (size_t)DFF * DMODEL * 2;
constexpr size_t WS_WFF2 = 33 * MiB;
constexpr size_t WS_XG = 50 * MiB;
constexpr size_t WS_H = 84 * MiB;
constexpr size_t WS_Z = 84 * MiB, WS_Y = 164 * MiB;
constexpr size_t WS_KT = 196 * MiB, WS_VT = 204 * MiB;
constexpr size_t WS_SSQ = 212 * MiB, WS_ROPE = 214 * MiB, WS_G = 215 * MiB;
constexpr size_t WS_MLE = 216 * MiB, WS_MLB = WS_MLE + 262144, WS_MLPM = WS_MLB + 262144;
constexpr size_t WS_NL = 217 * MiB, WS_NP = WS_NL + 262144, WS_GC = WS_NP + 262144, WS_EM = WS_GC + 4096, WS_MP = WS_EM + 4096;
constexpr size_t WS_CL = 218 * MiB, WS_CP = 234 * MiB, WS_NFX = 242 * MiB, WS_END = 243 * MiB;
constexpr int LDS_BYTES = 147456;
constexpr int N_FOX = 256, N_SWA = 256, N_ML1 = 128, N_ML2 = 32, N_ML3 = 256, N_ML = N_ML1 + N_ML2 + N_ML3, N_FX0 = 16, N_ITEMS = N_FX0 + N_ML + N_FOX + N_SWA;

struct Params { const float* in[16]; float* out; unsigned char* ws; int ph_lo, ph_hi; };

__device__ __forceinline__ int win_src(int n) {
    const int pn = n >> 8, P = n & 255, L = 64 * ((P >> 5) & 3) + 32 * (P >> 7) + (P & 31), z = 256 * pn + L;
    if (z < 1536) return z;
    if (z < 2304) return z + 4;
    if (z < 2560) return z + 12;
    const int i = z - 2560;
    if (i < 4) return 1536 + i;
    if (i < 8) return 2308 + (i - 4);
    if (i < 12) return 2312 + (i - 8);
    return -1;
}
template <bool WIN>
__device__ __forceinline__ void tr_item(const float* W, const float* kgain, int K, int Nsrc, bf16_t* WT, int nblk, int item, LAS float* scr, int lane) {
    const int kb = item / nblk, nb = item % nblk, k0 = 64 * kb, n0 = 32 * nb;
    if (WIN && n0 >= 2560) {
        const int n = n0 + (lane & 31); const int src = win_src(n);
#pragma unroll 8
        for (int i = 0; i < 32; ++i) { const int kk = 2 * i + (lane >> 5); scr[kk * 33 + (lane & 31)] = src >= 0 ? W[(size_t)(k0 + kk) * Nsrc + src] * (kgain ? kgain[k0 + kk] : 1.f) : 0.f; }
    } else {
        const int n4 = (lane & 7) * 4; const int src = WIN ? win_src(n0 + n4) : n0 + n4;
        f32x4 v[8];
#pragma unroll
        for (int i = 0; i < 8; ++i) v[i] = *(const f32x4*)(W + (size_t)(k0 + 8 * i + (lane >> 3)) * Nsrc + src);
#pragma unroll
        for (int i = 0; i < 8; ++i) { const int kk = 8 * i + (lane >> 3); const float g = kgain ? kgain[k0 + kk] : 1.f; LAS float* d = scr + kk * 33 + n4;
            d[0] = v[i][0] * g; d[1] = v[i][1] * g; d[2] = v[i][2] * g; d[3] = v[i][3] * g; }
    }
    LGKM_WAIT0(); asm volatile("" ::: "memory");
    const int c = lane & 7;
#pragma unroll
    for (int j = 0; j < 4; ++j) { const int nn = (lane >> 3) + 8 * j; const LAS float* s = scr + (8 * c) * 33 + nn;
        u32x4 o; o.x = cvtpk(s[0 * 33], s[1 * 33]); o.y = cvtpk(s[2 * 33], s[3 * 33]); o.z = cvtpk(s[4 * 33], s[5 * 33]); o.w = cvtpk(s[6 * 33], s[7 * 33]);
        *(u32x4*)(WT + (size_t)(n0 + nn) * K + k0 + 8 * c) = o; }
    LGKM_WAIT0(); asm volatile("" ::: "memory");
}

#define RLX_AGENT __ATOMIC_RELAXED, __HIP_MEMORY_SCOPE_AGENT
#define XB_TMO      128
#define XB_XCNT(j)  (256  + 64 * (j))
#define XB_XSUB(j)  (1280 + 64 * (j))
#define XB_XGEN(j)  (2304 + 64 * (j))
#define XB_TOP      3328
#define XB_TOPGEN   3392
#define XCD_BAR_WORDS 3456
#define XB_SPIN_CAP (1u << 18)

__device__ __forceinline__ unsigned xb_ld(unsigned* p)              { return __hip_atomic_load(p, __ATOMIC_RELAXED, __HIP_MEMORY_SCOPE_AGENT); }
__device__ __forceinline__ unsigned xb_add(unsigned* p, unsigned v) { return __hip_atomic_fetch_add(p, v, __ATOMIC_RELAXED, __HIP_MEMORY_SCOPE_AGENT); }
__device__ __forceinline__ unsigned xb_xcc_id() { return (unsigned)__builtin_amdgcn_s_getreg((3 << 11) | 20) & 0xFu; }
#define XB_SPIN(cond, bar) do { unsigned _sp = 0; while (cond) { __builtin_amdgcn_s_sleep(1); \
    if ((++_sp & 255u) == 0u) { if (xb_ld(&(bar)[XB_TMO])) break; if (_sp > XB_SPIN_CAP) { atomicAdd(&(bar)[XB_TMO], 1u); break; } } } } while (0)

struct XcdBarrier {
    unsigned* bar; unsigned x;
    volatile LAS unsigned* st;
};

__device__ __forceinline__ XcdBarrier xcd_barrier_post(unsigned* bar, volatile LAS unsigned* st) {
    XcdBarrier b; b.bar = bar; b.x = xb_xcc_id(); b.st = st;
    if (threadIdx.x == 0) (void)xb_add(&bar[XB_XCNT(b.x)], 1u);
    return b;
}
__device__ __forceinline__ void xcd_barrier_complete(unsigned* bar, unsigned x, unsigned& nloc, unsigned& nx) {
    const unsigned G = gridDim.x * gridDim.y * gridDim.z;
    unsigned sum, cnt, mine, sp = 0u;
    for (;;) {
        sum = 0u; cnt = 0u; mine = 0u;
#pragma unroll
        for (unsigned j = 0; j < 16; ++j) { const unsigned c = xb_ld(&bar[XB_XCNT(j)]); sum += c; cnt += (c > 0u) ? 1u : 0u; mine = (j == x) ? c : mine; }
        if (sum == G) break;
        __builtin_amdgcn_s_sleep(1);
        if ((++sp & 255u) == 0u) { if (xb_ld(&bar[XB_TMO])) break; if (sp > XB_SPIN_CAP) { atomicAdd(&bar[XB_TMO], 1u); break; } }
    }
    nloc = mine > 0u ? mine : 1u; nx = cnt > 0u ? cnt : 1u;
}

__device__ __forceinline__ void xcd_barrier(const XcdBarrier& b) {
    asm volatile("s_waitcnt vmcnt(0)" ::: "memory");
    __syncthreads();
    if (threadIdx.x == 0) {
        unsigned* bar = b.bar;
        __builtin_amdgcn_s_waitcnt(0);
        unsigned nloc = b.st[0], nx = b.st[1];
        if (nloc == 0u) { xcd_barrier_complete(bar, b.x, nloc, nx); b.st[0] = nloc; b.st[1] = nx; }
        const unsigned old = xb_add(&bar[XB_XSUB(b.x)], 1u);
        const unsigned gen = old / nloc;
        if (old + 1u == (gen + 1u) * nloc) {
            __builtin_amdgcn_fence(__ATOMIC_RELEASE, "agent");
            asm volatile("s_waitcnt vmcnt(0)" ::: "memory");
            const unsigned og = xb_add(&bar[XB_TOP], 1u);
            const unsigned tg = og / nx;
            if (og + 1u == (tg + 1u) * nx) xb_add(&bar[XB_TOPGEN], 1u);
            else XB_SPIN(xb_ld(&bar[XB_TOPGEN]) == tg, bar);
            __builtin_amdgcn_fence(__ATOMIC_ACQUIRE, "agent");
            xb_add(&bar[XB_XGEN(b.x)], 1u);
            asm volatile("s_waitcnt vmcnt(0)" ::: "memory");
        } else {
            XB_SPIN(xb_ld(&bar[XB_XGEN(b.x)]) == gen, bar);
            __builtin_amdgcn_fence(__ATOMIC_ACQUIRE, "agent");
            asm volatile("s_waitcnt vmcnt(0)" ::: "memory");
        }
    }
    __syncthreads();
}

__global__ void __launch_bounds__(512, 2) fwd_megakernel(Params p) {
    extern __shared__ __attribute__((aligned(16))) unsigned char lds_raw[];
    LAS unsigned char* lds = (LAS unsigned char*)lds_raw;
    cg::grid_group grid = cg::this_grid();
    const int tid = threadIdx.x, lane = tid & 63, wave = __builtin_amdgcn_readfirstlane(tid >> 6);
    const int G = gridDim.x, bx = blockIdx.x;
    unsigned char* ws = p.ws;
    const float* x_in = p.in[0];
    bf16_t* XG = (bf16_t*)(ws + WS_XG); bf16_t* Zb = (bf16_t*)(ws + WS_Z); bf16_t* Yb = (bf16_t*)(ws + WS_Y); bf16_t* Hb = (bf16_t*)(ws + WS_H);
    float* SSQ = (float*)(ws + WS_SSQ); float* ROPEC = (float*)(ws + WS_ROPE); float* ROPES = ROPEC + SEQL * 32; float* Gt = (float*)(ws + WS_G);
    unsigned* ctl = (unsigned*)(ws + WS_CTL);
    const int lo = p.ph_lo, hi_ph = p.ph_hi;
    volatile LAS unsigned* bst = (volatile LAS unsigned*)(lds + 143360 + 16);
    if (tid < 2) bst[tid] = 0u;
    __syncthreads();
    XcdBarrier bar = xcd_barrier_post(ctl + 1024, bst);
    if (lo < 0) grid.sync();
#define IN_PH(k) (lo <= (k) && (k) < hi_ph)
#define SEAM(k) do { if (IN_PH(k) && IN_PH((k) + 1)) xcd_barrier(bar); } while (0)

    if (IN_PH(0)) {
        LAS float* scr = (LAS float*)(lds + wave * 16384);
        const int gw = bx * 8 + wave, NGW = G * 8;
        constexpr int I_IN = (DMODEL / 64) * (NZT / 32), I_OUT = (DMODEL / 64) * (DMODEL / 32), I_F1 = (DMODEL / 64) * (DFF / 32), I_F2 = (DFF / 64) * (DMODEL / 32);
        constexpr int I_LAYER = I_IN + I_OUT + I_F1 + I_F2;
        for (int it = gw; it < DEPTH * I_LAYER; it += NGW) {
            const int l = it / I_LAYER; int r = it % I_LAYER;
            if (r < I_IN) { tr_item<true>(p.in[2] + (size_t)l * DMODEL * 2572, p.in[1] + l * DMODEL, DMODEL, 2572, (bf16_t*)(ws + WS_WIN + l * WIN_L), NZT / 32, r, scr, lane); continue; } r -= I_IN;
            if (r < I_OUT) { tr_item<false>(p.in[12] + (size_t)l * DMODEL * DMODEL, nullptr, DMODEL, DMODEL, (bf16_t*)(ws + WS_WOUT + l * WOUT_L), DMODEL / 32, r, scr, lane); continue; } r -= I_OUT;
            if (r < I_F1) { tr_item<false>(p.in[14] + (size_t)l * DMODEL * DFF, p.in[13] + l * DMODEL, DMODEL, DFF, (bf16_t*)(ws + WS_WFF1 + l * WFF_L), DFF / 32, r, scr, lane); continue; } r -= I_F1;
            tr_item<false>(p.in[15] + (size_t)l * DFF * DMODEL, nullptr, DFF, DMODEL, (bf16_t*)(ws + WS_WFF2 + l * WFF_L), DMODEL / 32, r, scr, lane);
        }
        for (int i = bx * 512 + tid; i < SEQL * 32; i += G * 512) {
            const int pos = i >> 5, j = i & 31;
            double inv = 1.0; for (int q = 0; q < j; ++q) inv *= 0.7498942093324558;
            const float ang = (float)pos * (float)inv;
            double rev = (double)ang * 0.15915494309189535; rev -= __builtin_rint(rev);
            ROPEC[i] = __builtin_amdgcn_cosf((float)rev); ROPES[i] = __builtin_amdgcn_sinf((float)rev);
        }
        for (int m = gw; m < MTOK; m += 2 * NGW) {
            const int m2 = m + NGW;
            const bool has2 = m2 < MTOK;
            const f32x4* xr = (const f32x4*)(x_in + (size_t)m * DMODEL) + lane;
            const f32x4* xr2 = (const f32x4*)(x_in + (size_t)(has2 ? m2 : m) * DMODEL) + lane;
            f32x4 va[4], vb[4];
#pragma unroll
            for (int j = 0; j < 4; ++j) { va[j] = xr[64 * j]; vb[j] = xr2[64 * j]; }
#pragma unroll
            for (int rr = 0; rr < 2; ++rr) {
                if (rr == 1 && !has2) break;
                const int mm = rr == 0 ? m : m2;
                unsigned long long* o8 = (unsigned long long*)(XG + (size_t)mm * DMODEL) + lane;
#pragma unroll
                for (int j = 0; j < 4; ++j) {
                    const f32x4 v = rr == 0 ? va[j] : vb[j];
                    float s = (v[0] * v[0] + v[1] * v[1]) + (v[2] * v[2] + v[3] * v[3]);
                    s += __shfl_xor(s, 1); s += __shfl_xor(s, 2); s += __shfl_xor(s, 4);
                    if ((lane & 7) == 0) SSQ[(size_t)mm * 32 + 8 * j + (lane >> 3)] = s;
                    o8[64 * j] = (unsigned long long)cvtpk(v[0], v[1]) | ((unsigned long long)cvtpk(v[2], v[3]) << 32);
                }
            }
        }
    }
    SEAM(0);

    for (int l = 0; l < DEPTH; ++l) {
        const int pb = 1 + 5 * l;
        if (IN_PH(pb)) {
            pg8::Gemm g{XG, (const bf16_t*)(ws + WS_WIN + l * WIN_L), MTOK, NZT, DMODEL}; pg8::StaticOrder S; S.init(MTOK, NZT, G, bx);
            pg8::EpiIn E{Zb, Gt, SSQ, ROPEC, ROPES, p.in[3] + l * 64, p.in[4] + l * 64, p.in[6] + l * 64, p.in[7] + l * 64, ws + WS_KT, ws + WS_VT};
            pg8::gemm_phase<pg8::EpiIn, pg8::StaticOrder, true, true>(lds, g, S, E);
        }
        SEAM(pb);
        if (IN_PH(pb + 1)) {
            MixCtx C{Zb, Gt, Yb, p.in[5] + l * 8, p.in[8] + l * 4, p.in[9] + l * 4, p.in[10] + l * 4, p.in[11] + l * 256, ws, ws + WS_KT, ws + WS_VT};
            MlScratch MS{(float*)(ws + WS_MLE), (float*)(ws + WS_MLB), (float*)(ws + WS_MLPM), (float*)(ws + WS_CL), (float*)(ws + WS_NL), (bf16_t*)(ws + WS_CP), (float*)(ws + WS_NP), (float*)(ws + WS_GC), (float*)(ws + WS_EM), (float*)(ws + WS_MP), ctl + 128 + 32 * l, ctl + 192 + 32 * l};
            LAS int* itm = (LAS int*)(lds + 143360);
            float* NF = (float*)(ws + WS_NFX); unsigned* cntF = ctl + 512 + 32 * l; unsigned* qctr = ctl + 64 * l;
            for (;;) {
                __syncthreads();
                if (tid == 0) *itm = (int)atomicAdd(qctr, 1u);
                __syncthreads();
                const int it = *itm;
                if (it >= N_ITEMS) break;
                constexpr int N_SWAA = 80, Q_ML1 = N_FX0, Q_ML2 = Q_ML1 + N_ML1, Q_SWAA = Q_ML2 + N_ML2, Q_FOX = Q_SWAA + N_SWAA, Q_ML3 = Q_FOX + N_FOX, Q_SWAB = Q_ML3 + N_ML3;
                static_assert(Q_SWAB + (N_SWA - N_SWAA) == N_ITEMS, "queue map");
                if (it < Q_ML1) fx0_item(C, NF, cntF, it, lds);
                else if (it < Q_ML2) { const int k = it - Q_ML1; ml1_item(C, MS, k >> 3, k & 7, lds); }
                else if (it < Q_SWAA) { const int k = it - Q_ML2; ml2_item(C, MS, k >> 1, k & 1, lds); }
                else if (it < Q_FOX) swa_item(C, it - Q_SWAA, lds);
                else if (it < Q_ML3) {
                    if (tid == 0) { const unsigned x = xb_xcc_id() & 7u; int sel = 0;
                        for (unsigned t = 0; t < 8u; ++t) { const unsigned q = (x + t) & 7u; const unsigned j = atomicAdd(ctl + 640 + 16 * l + q, 1u); if (j < 32u) { sel = (int)(q * 32u + j); break; } }
                        itm[1] = sel; }
                    __syncthreads();
                    const int k = itm[1];
                    fox_item(C, NF, cntF, k >> 4, k & 15, lds); }
                else if (it < Q_SWAB) { const int k = it - Q_ML3; ml3_item(C, MS, k >> 4, k & 15, lds); }
                else swa_item(C, it - Q_SWAB + N_SWAA, lds);
            }
        }
        SEAM(pb + 1);
        if (IN_PH(pb + 2)) {
            pg8::Gemm g{Yb, (const bf16_t*)(ws + WS_WOUT + l * WOUT_L), MTOK, DMODEL, DMODEL}; pg8::StaticOrder S; S.init(MTOK, DMODEL, G, bx);
            pg8::EpiRes E{XG, SSQ, nullptr};
            pg8::gemm_phase<pg8::EpiRes, pg8::StaticOrder, true, true>(lds, g, S, E);
        }
        SEAM(pb + 2);
        if (IN_PH(pb + 3)) {
            pg8::Gemm g{XG, (const bf16_t*)(ws + WS_WFF1 + l * WFF_L), MTOK, DFF, DMODEL}; pg8::StaticOrder S; S.init(MTOK, DFF, G, bx);
            pg8::EpiFF1 E{Hb, SSQ};
            pg8::gemm_phase<pg8::EpiFF1, pg8::StaticOrder, true, true>(lds, g, S, E);
        }
        SEAM(pb + 3);
        if (IN_PH(pb + 4)) {
            pg8::Gemm g{Hb, (const bf16_t*)(ws + WS_WFF2 + l * WFF_L), MTOK, DMODEL, DFF}; pg8::StaticOrder S; S.init(MTOK, DMODEL, G, bx);
            pg8::EpiRes E{XG, SSQ, l + 1 == DEPTH ? p.out : nullptr};
            pg8::gemm_phase<pg8::EpiRes, pg8::StaticOrder, true, true>(lds, g, S, E);
        }
        SEAM(pb + 4);
    }
#undef IN_PH
#undef SEAM
}

constexpr int N_PHASES = 1 + 5 * DEPTH;
#ifndef MK_MULTI
#define MK_MULTI 0
#endif
extern "C" void kernel_launch(void* const* d_in, const int* in_sizes, int n_in, void* d_out, int out_size, void* d_ws, size_t ws_size, hipStream_t stream) {
    static int grid = 0;
    if (grid == 0) {
        if (n_in != 16 || out_size != MTOK * DMODEL || ws_size < WS_END) { fprintf(stderr, "kernel_launch: unexpected shapes (n_in %d out %d ws %zu)\n", n_in, out_size, ws_size); grid = -1; return; }
        int dev = 0, cus = 0, per_cu = 0;
        hipGetDevice(&dev); hipDeviceGetAttribute(&cus, hipDeviceAttributeMultiprocessorCount, dev);
        if (hipFuncSetAttribute((const void*)fwd_megakernel, hipFuncAttributeMaxDynamicSharedMemorySize, LDS_BYTES) != hipSuccess) { fprintf(stderr, "kernel_launch: hipFuncSetAttribute failed\n"); grid = -1; return; }
        if (hipOccupancyMaxActiveBlocksPerMultiprocessor(&per_cu, (const void*)fwd_megakernel, 512, LDS_BYTES) != hipSuccess || per_cu < 1) { fprintf(stderr, "kernel_launch: occupancy query says %d\n", per_cu); per_cu = 1; }
        (void)hipGetLastError();
        grid = cus;
        if (grid != 256) fprintf(stderr, "kernel_launch: %d CUs (expected 256)\n", grid);
    }
    if (grid < 0) return;
    hipMemsetAsync((char*)d_ws + WS_CTL, 0, CTL_BYTES, stream);
    Params a{};
    for (int i = 0; i < 16; ++i) a.in[i] = (const float*)d_in[i];
    a.out = (float*)d_out; a.ws = (unsigned char*)d_ws;
#if MK_MULTI
    for (int ph = 0; ph < N_PHASES; ++ph) { a.ph_lo = ph; a.ph_hi = ph + 1; hipLaunchKernelGGL(fwd_megakernel, dim3(grid), dim3(512), LDS_BYTES, stream, a); }
#else
    a.ph_lo = 0; a.ph_hi = N_PHASES;
    void* args[] = {&a};
    hipError_t e = hipLaunchCooperativeKernel((const void*)fwd_megakernel, dim3(grid), dim3(512), args, LDS_BYTES, stream);
    if (e != hipSuccess) fprintf(stderr, "cooperative launch failed: %s (grid %d)\n", hipGetErrorString(e), grid);
#endif
}
```

```cpp
#include <hip/hip_runtime.h>
#include <hip/hip_cooperative_groups.h>
#include <cstdio>
#include <cstdint>
#include <cmath>
namespace cg = cooperative_groups;
namespace pg8 {
#define PG8_LAS __attribute__((address_space(3)))
typedef unsigned short bf16_t;
typedef short bf16x8 __attribute__((ext_vector_type(8)));
typedef float f32x4 __attribute__((ext_vector_type(4)));
typedef unsigned u32x4 __attribute__((ext_vector_type(4)));
constexpr int BM = 256, BK = 64, HALF = 128, HTB = HALF * BK * 2  , STAGE_BYTES = 8 * HTB, NXCD = 8, WGM = 8;

__host__ __device__ __forceinline__ int lds_byte(int r, int c) { const int st = (r >> 4) * 2 + (c >> 5), rr = r & 15, cc = c & 31, ob = rr * 64 + cc * 2; return st * 1024 + (ob ^ (((ob >> 9) & 1) << 5)); }
__host__ __device__ __forceinline__ void stage_rc(int b, int& R, int& C) { const int st = b / 1024, sb = b % 1024, swz = sb ^ (((sb >> 9) & 1) << 5); R = (st >> 1) * 16 + swz / 64; C = (st & 1) * 32 + (swz % 64) / 2; }
__host__ __device__ __forceinline__ int perm32(int rho) { const int n = rho >> 4, i = rho & 15; return 8 * (i >> 2) + 4 * n + (i & 3); }

struct Unit { int pm, pn; };
struct Gemm { const bf16_t* A; const bf16_t* Bt; int M, N, K; };

struct StaticOrder {
    int nM, nN, nwg, G, c;
    __host__ __device__ void init(int M, int N, int G_, int c_) { nM = M / BM; nN = N / BM; nwg = nM * nN; G = G_; c = c_; }
    __host__ __device__ bool next(int i, Unit& u) const {
        const long L = (long)i * G + c; if (L >= nwg) return false;
        int wgid = (int)L; { const int q = nwg / NXCD, r = nwg % NXCD, xcd = wgid % NXCD, off = wgid / NXCD; wgid = (xcd < r ? xcd * (q + 1) : r * (q + 1) + (xcd - r) * q) + off; }
        const int nig = WGM * nN, gid = wgid / nig, fm = gid * WGM, gsz = (nM - fm) < WGM ? (nM - fm) : WGM;
        u.pm = fm + ((wgid % nig) % gsz); u.pn = (wgid % nig) / gsz; return true;
    }
    __device__ __forceinline__ void a_ready(const Unit&) const {}
    __device__ __forceinline__ void done(const Unit&) const {}
};

__device__ __forceinline__ unsigned cvt_pk_bf16(float lo, float hi) { unsigned r; asm volatile("v_cvt_pk_bf16_f32 %0, %1, %2" : "=v"(r) : "v"(lo), "v"(hi)); return r; }
constexpr float EPS = 1e-6f;
constexpr float LOG2E = 1.4426950408889634f;
constexpr float C2 = 0.125f * LOG2E;
constexpr int ZP = 2560;

__device__ __forceinline__ float row_rstd(const float* ssq, int row, int fq) {
    const float* sp = ssq + (size_t)row * 32 + fq * 8;
    const f32x4 s0 = *(const f32x4*)sp, s1 = *(const f32x4*)(sp + 4);
    float t = ((s0[0] + s0[1]) + (s0[2] + s0[3])) + ((s1[0] + s1[1]) + (s1[2] + s1[3]));
    t += __shfl_xor(t, 16); t += __shfl_xor(t, 32);
    return rsqrtf(t * (1.0f / 1024.0f) + EPS);
}

struct EpiIn {
    static constexpr bool PERM = true, AFTER_DRAIN = false;
    bf16_t* Z; float* G; const float* ssq; const float* ropec; const float* ropes; const float* gqa; const float* gka; const float* gqb; const float* gkb;
    unsigned char* KT; unsigned char* VT;
    __device__ __forceinline__ void operator()(const f32x4 (&acc)[2][2][4][2], const Unit& u, int wr, int wc, int fr, int fq) const {
        const int pn = u.pn;
        int type = 0; const float* gsel = gqa; bool rp = false; float sc = 1.f;
        if (pn < 2) { type = 1; gsel = gqa; rp = true; sc = C2; }
        else if (pn == 2) { if (wc < 2) { type = 1; gsel = gka; rp = true; } }
        else if (pn == 3) { type = 1; gsel = gqb; sc = C2; }
        else if (pn == 4) { type = 1; gsel = gkb; }
        else if (pn == 7) { sc = 0.125f; }
        else if (pn == 9) { type = 2; }
        else if (pn == 10) { type = 3; }
        if (type == 3 && wc != 0) return;
        const int dcol = 8 * fq;
        unsigned char* tp = nullptr;
        if (pn == 4 || pn == 5) { const size_t tb0 = (size_t)((((u.pm * BM) >> 12) * 4 + wc) * 64 + (((u.pm * BM) & 4095) >> 6) + wr) * 8192;
            tp = pn == 4 ? KT + tb0 + fq * 1024 + fr * 16 : VT + tb0 + (fr * 4 + fq) * 16; }
        float gn[2][8];
#pragma unroll
        for (int bj = 0; bj < 2; ++bj)
#pragma unroll
            for (int i = 0; i < 8; ++i) gn[bj][i] = (type == 1) ? gsel[32 * bj + dcol + i] : 1.f;
#pragma unroll
        for (int ai = 0; ai < 2; ++ai)
#pragma unroll
            for (int m = 0; m < 4; ++m) {
                const int row = u.pm * BM + ai * HALF + wr * 64 + m * 16 + fr;
                const float rstd = row_rstd(ssq, row, fq);
                float v[2][8];
#pragma unroll
                for (int bj = 0; bj < 2; ++bj)
#pragma unroll
                    for (int n = 0; n < 2; ++n)
#pragma unroll
                        for (int e = 0; e < 4; ++e) v[bj][4 * n + e] = acc[ai][bj][m][n][e] * rstd;
                if (type == 1) {
                    float ss = 0.f;
#pragma unroll
                    for (int bj = 0; bj < 2; ++bj)
#pragma unroll
                        for (int i = 0; i < 8; ++i) ss += v[bj][i] * v[bj][i];
                    ss += __shfl_xor(ss, 16); ss += __shfl_xor(ss, 32);
                    const float hr = rsqrtf(ss * (1.0f / 64.0f) + EPS);
#pragma unroll
                    for (int bj = 0; bj < 2; ++bj)
#pragma unroll
                        for (int i = 0; i < 8; ++i) v[bj][i] *= hr * gn[bj][i];
                    if (rp) {
                        const int pos = row & 4095;
                        const f32x4 c0 = *(const f32x4*)(ropec + pos * 32 + dcol), c1 = *(const f32x4*)(ropec + pos * 32 + dcol + 4);
                        const f32x4 s0 = *(const f32x4*)(ropes + pos * 32 + dcol), s1 = *(const f32x4*)(ropes + pos * 32 + dcol + 4);
#pragma unroll
                        for (int i = 0; i < 8; ++i) {
                            const float c = i < 4 ? c0[i & 3] : c1[i & 3], s = i < 4 ? s0[i & 3] : s1[i & 3];
                            const float x1 = v[0][i], x2 = v[1][i];
                            v[0][i] = x1 * c - x2 * s; v[1][i] = x2 * c + x1 * s;
                        }
                    }
#pragma unroll
                    for (int bj = 0; bj < 2; ++bj)
#pragma unroll
                        for (int i = 0; i < 8; ++i) v[bj][i] *= sc;
                } else if (type == 2) {
#pragma unroll
                    for (int bj = 0; bj < 2; ++bj)
#pragma unroll
                        for (int i = 0; i < 8; ++i) v[bj][i] = 1.0f / (1.0f + __expf(-v[bj][i]));
                } else if (type == 0) {
#pragma unroll
                    for (int bj = 0; bj < 2; ++bj)
#pragma unroll
                        for (int i = 0; i < 8; ++i) v[bj][i] *= sc;
                }
                if (type == 3) {
                    float* gp = G + (size_t)row * 16;
                    if (fq == 0) { *(f32x4*)gp = (f32x4){v[0][0], v[0][1], v[0][2], v[0][3]}; *(f32x4*)(gp + 4) = (f32x4){v[0][4], v[0][5], v[0][6], v[0][7]}; }
                    else if (fq == 1) { *(f32x4*)(gp + 8) = (f32x4){v[0][0], v[0][1], v[0][2], v[0][3]}; }
                } else {
#pragma unroll
                    for (int bj = 0; bj < 2; ++bj) {
                        u32x4 w; w.x = cvt_pk_bf16(v[bj][0], v[bj][1]); w.y = cvt_pk_bf16(v[bj][2], v[bj][3]); w.z = cvt_pk_bf16(v[bj][4], v[bj][5]); w.w = cvt_pk_bf16(v[bj][6], v[bj][7]);
                        if (pn == 4) *(u32x4*)(tp + ai * 16384 + bj * 4096 + m * 256) = w;
                        else if (pn == 5) *(u32x4*)(tp + ai * 16384 + bj * 4096 + m * 1024) = w;
                        else
                        *(u32x4*)(Z + (size_t)row * ZP + 256 * pn + 64 * wc + 32 * bj + dcol) = w;
                    }
                }
                if (m & 1) asm volatile("" ::: "memory");
            }
    }
};

struct EpiRes {
    static constexpr bool PERM = true, AFTER_DRAIN = false;
    bf16_t* XB; float* ssq; float* out; const float* rsq;
    __device__ __forceinline__ void operator()(const f32x4 (&acc)[2][2][4][2], const Unit& u, int wr, int wc, int fr, int fq) const {
        float r2[8];
#pragma unroll
        for (int j = 0; j < 8; ++j) r2[j] = 1.f;
        if (rsq) {
#pragma unroll
            for (int j = 0; j < 8; ++j) { const float r = row_rstd(rsq, u.pm * BM + (j >> 2) * HALF + wr * 64 + (j & 3) * 16 + fr, fq); r2[j] = r * r; }
        }
#pragma unroll
        for (int bj = 0; bj < 2; ++bj) {
            const int col0 = u.pn * BM + bj * HALF + wc * 32 + 8 * fq;
#pragma unroll
            for (int ai = 0; ai < 2; ++ai)
#pragma unroll
                for (int m = 0; m < 4; ++m) {
                    const int row = u.pm * BM + ai * HALF + wr * 64 + m * 16 + fr;
                    const size_t off = (size_t)row * 1024 + col0;
                    const u32x4 bw = *(const u32x4*)(XB + off);
                    f32x4 x0 = acc[ai][bj][m][0] * r2[ai * 4 + m], x1 = acc[ai][bj][m][1] * r2[ai * 4 + m];
                    x0[0] += __builtin_bit_cast(float, bw.x << 16); x0[1] += __builtin_bit_cast(float, bw.x & 0xffff0000u);
                    x0[2] += __builtin_bit_cast(float, bw.y << 16); x0[3] += __builtin_bit_cast(float, bw.y & 0xffff0000u);
                    x1[0] += __builtin_bit_cast(float, bw.z << 16); x1[1] += __builtin_bit_cast(float, bw.z & 0xffff0000u);
                    x1[2] += __builtin_bit_cast(float, bw.w << 16); x1[3] += __builtin_bit_cast(float, bw.w & 0xffff0000u);
                    if (out) { *(f32x4*)(out + off) = x0; *(f32x4*)(out + off + 4) = x1; }
                    else {
                        float ss = ((x0[0] * x0[0] + x0[1] * x0[1]) + (x0[2] * x0[2] + x0[3] * x0[3])) + ((x1[0] * x1[0] + x1[1] * x1[1]) + (x1[2] * x1[2] + x1[3] * x1[3]));
                        ss += __shfl_xor(ss, 16); ss += __shfl_xor(ss, 32);
                        if (fq == 0) ssq[(size_t)row * 32 + u.pn * 8 + bj * 4 + wc] = ss;
                        u32x4 w; w.x = cvt_pk_bf16(x0[0], x0[1]); w.y = cvt_pk_bf16(x0[2], x0[3]); w.z = cvt_pk_bf16(x1[0], x1[1]); w.w = cvt_pk_bf16(x1[2], x1[3]);
                        *(u32x4*)(XB + off) = w;
                    }
                }
        }
    }
};

struct EpiFF1 {
    static constexpr bool PERM = true, AFTER_DRAIN = false;
    bf16_t* H;
    __device__ __forceinline__ void operator()(const f32x4 (&acc)[2][2][4][2], const Unit& u, int wr, int wc, int fr, int fq) const {
#pragma unroll
        for (int ai = 0; ai < 2; ++ai)
#pragma unroll
            for (int m = 0; m < 4; ++m) {
                const int row = u.pm * BM + ai * HALF + wr * 64 + m * 16 + fr;
#pragma unroll
                for (int bj = 0; bj < 2; ++bj) {
                    const int col0 = u.pn * BM + bj * HALF + wc * 32 + 8 * fq;
                    f32x4 a = acc[ai][bj][m][0], b = acc[ai][bj][m][1];
#pragma unroll
                    for (int e = 0; e < 4; ++e) { a[e] = fmaxf(a[e], 0.f); a[e] *= a[e]; b[e] = fmaxf(b[e], 0.f); b[e] *= b[e]; }
                    u32x4 w; w.x = cvt_pk_bf16(a[0], a[1]); w.y = cvt_pk_bf16(a[2], a[3]); w.z = cvt_pk_bf16(b[0], b[1]); w.w = cvt_pk_bf16(b[2], b[3]);
                    *(u32x4*)(H + (size_t)row * 4096 + col0) = w;
                }
            }
    }
};

template <class Epi, class Sched, bool ALIGN_EPI = false, bool SP2 = false>
__device__ __forceinline__ void gemm_phase(PG8_LAS unsigned char* lds, const Gemm g, const Sched& S, const Epi& E) {
    int tid_ = threadIdx.x; asm volatile("" : "+v"(tid_));
    const int tid = tid_, wid = __builtin_amdgcn_readfirstlane(tid >> 6), lane = tid & 63, wr = wid >> 2, wc = wid & 3, fr = lane & 15, fq = lane >> 4;
    const int K = g.K, nt = K / BK;
    unsigned voffA[2], voffB[2];
#pragma unroll
    for (int i = 0; i < 2; ++i) { int R, C; stage_rc(tid * 16 + i * 8192, R, C); const int Rb = Epi::PERM ? ((R & ~31) + perm32(R & 31)) : R;
        voffA[i] = (unsigned)(R * K + C) * 2u; voffB[i] = (unsigned)(Rb * K + C) * 2u; }
    const size_t kstep = (size_t)(BK * 2);
    const size_t hstep = (size_t)HALF * K * 2;
    const size_t tstep = 2 * hstep;
    const unsigned ldsw = (unsigned)wid * 1024u;
    const int aoff = lds_byte(wr * 64 + fr, fq * 8), boff = lds_byte(wc * 32 + fr, fq * 8);
#define PG8_SA(b, h) (((b) * 2 + (h)) * HTB)
#define PG8_SB(b, h) ((4 + (b) * 2 + (h)) * HTB)
#define PG8_STAGE(bufoff, gbase, voff) do { _Pragma("unroll") for (int _i = 0; _i < 2; ++_i) \
        __builtin_amdgcn_global_load_lds((const unsigned*)((const char*)(gbase) + (voff)[_i]), (PG8_LAS unsigned*)(lds + (bufoff) + ldsw + _i * 8192), 16, 0, 0); } while (0)
#define PG8_LDA(dst, b, h) do { _Pragma("unroll") for (int m = 0; m < 4; ++m) _Pragma("unroll") for (int k = 0; k < 2; ++k) dst[m][k] = *(const PG8_LAS bf16x8*)(lds + PG8_SA(b, h) + aoff + m * 2048 + k * 1024); } while (0)
#define PG8_LDB(dst, b, h) do { _Pragma("unroll") for (int n = 0; n < 2; ++n) _Pragma("unroll") for (int k = 0; k < 2; ++k) dst[n][k] = *(const PG8_LAS bf16x8*)(lds + PG8_SB(b, h) + boff + n * 2048 + k * 1024); } while (0)
#define PG8_MMA(ai, bj, At, Bt) do { __builtin_amdgcn_s_setprio(1); _Pragma("unroll") for (int m = 0; m < 4; ++m) _Pragma("unroll") for (int n = 0; n < 2; ++n) _Pragma("unroll") for (int k = 0; k < 2; ++k) \
        acc[ai][bj][m][n] = __builtin_amdgcn_mfma_f32_16x16x32_bf16(Bt[n][k], At[m][k], acc[ai][bj][m][n], 0, 0, 0); __builtin_amdgcn_s_setprio(0); } while (0)
#define PG8_WAIT_V(n) asm volatile("s_waitcnt vmcnt(" #n ")" ::: "memory")
#define PG8_WAIT_L(n) asm volatile("s_waitcnt lgkmcnt(" #n ")" ::: "memory")
#define PG8_BAR __builtin_amdgcn_s_barrier()
#define PG8_SCHED __builtin_amdgcn_sched_barrier(0)
    Unit cur, nxt; int ui = 0;
    if (!S.next(0, cur)) return;
    f32x4 acc[2][2][4][2];
#pragma unroll
    for (int a = 0; a < 2; ++a)
#pragma unroll
        for (int b = 0; b < 2; ++b)
#pragma unroll
            for (int m = 0; m < 4; ++m)
#pragma unroll
                for (int n = 0; n < 2; ++n) acc[a][b][m][n] = (f32x4){0.f, 0.f, 0.f, 0.f};
    bf16x8 At[4][2], B0[2][2], B1[2][2];
    const char* cA = (const char*)g.A + (size_t)cur.pm * tstep; const char* cB = (const char*)g.Bt + (size_t)cur.pn * tstep;
    S.a_ready(cur);
    if constexpr (SP2) {
        PG8_STAGE(PG8_SB(0, 0), cB, voffB); PG8_STAGE(PG8_SB(0, 1), cB + hstep, voffB); PG8_STAGE(PG8_SA(0, 0), cA, voffA); PG8_STAGE(PG8_SA(0, 1), cA + hstep, voffA);
        if (wr == 1) PG8_BAR;
        PG8_WAIT_V(2); PG8_BAR;
        PG8_STAGE(PG8_SB(1, 0), cB + kstep, voffB); PG8_STAGE(PG8_SA(1, 0), cA + kstep, voffA); PG8_STAGE(PG8_SB(1, 1), cB + hstep + kstep, voffB);
        PG8_WAIT_V(6); PG8_BAR;
    } else {
        PG8_STAGE(PG8_SB(0, 0), cB, voffB); PG8_STAGE(PG8_SA(0, 0), cA, voffA); PG8_STAGE(PG8_SB(0, 1), cB + hstep, voffB); PG8_STAGE(PG8_SA(0, 1), cA + hstep, voffA);
        if (wr == 1) PG8_BAR;
        PG8_WAIT_V(4); PG8_BAR;
        PG8_STAGE(PG8_SB(1, 0), cB + kstep, voffB); PG8_STAGE(PG8_SA(1, 0), cA + kstep, voffA); PG8_STAGE(PG8_SB(1, 1), cB + hstep + kstep, voffB);
        PG8_WAIT_V(6); PG8_BAR;
    }
    for (;;) {
        const bool has_next = S.next(ui + 1, nxt);
        const char* nA = has_next ? (const char*)g.A + (size_t)nxt.pm * tstep : cA; const char* nB = has_next ? (const char*)g.Bt + (size_t)nxt.pn * tstep : cB;
        for (int t = 0; t < nt; t += 2) {
            const bool last = (t == nt - 2);
            const char* a1 = cA + (size_t)(t + 1) * kstep;
            const char* a2 = last ? nA : cA + (size_t)(t + 2) * kstep; const char* b2 = last ? nB : cB + (size_t)(t + 2) * kstep;
            const char* a3 = a2 + kstep; const char* b3 = b2 + kstep;
            if (last && has_next) S.a_ready(nxt);
            if constexpr (SP2) {
            PG8_LDB(B0, 0, 0); PG8_LDB(B1, 0, 1); PG8_SCHED; PG8_LDA(At, 0, 0); PG8_STAGE(PG8_SA(1, 1), a1 + hstep, voffA);
            PG8_WAIT_V(8); PG8_WAIT_L(0); PG8_BAR; PG8_MMA(0, 0, At, B0); PG8_MMA(0, 1, At, B1); PG8_BAR; PG8_SCHED;
            PG8_LDA(At, 0, 1); PG8_STAGE(PG8_SB(0, 0), b2, voffB); PG8_STAGE(PG8_SB(0, 1), b2 + hstep, voffB); PG8_STAGE(PG8_SA(0, 0), a2, voffA);
            PG8_WAIT_V(8); PG8_WAIT_L(0); PG8_BAR; PG8_MMA(1, 0, At, B0); PG8_MMA(1, 1, At, B1); PG8_BAR; PG8_SCHED;
            PG8_LDB(B0, 1, 0); PG8_LDB(B1, 1, 1); PG8_SCHED; PG8_LDA(At, 1, 0); PG8_STAGE(PG8_SA(0, 1), a2 + hstep, voffA);
            PG8_WAIT_V(8); PG8_WAIT_L(0); PG8_BAR; PG8_MMA(0, 0, At, B0); PG8_MMA(0, 1, At, B1); PG8_BAR; PG8_SCHED;
            PG8_LDA(At, 1, 1); PG8_STAGE(PG8_SB(1, 0), b3, voffB); PG8_STAGE(PG8_SB(1, 1), b3 + hstep, voffB); PG8_STAGE(PG8_SA(1, 0), a3, voffA);
            PG8_WAIT_V(8); PG8_WAIT_L(0); PG8_BAR; PG8_MMA(1, 0, At, B0); PG8_MMA(1, 1, At, B1); PG8_BAR; PG8_SCHED;
            } else {
            PG8_LDB(B0, 0, 0); PG8_SCHED; PG8_LDA(At, 0, 0); PG8_STAGE(PG8_SA(1, 1), a1 + hstep, voffA);
            PG8_WAIT_L(8); PG8_BAR; PG8_WAIT_L(0); PG8_MMA(0, 0, At, B0); PG8_BAR; PG8_SCHED;
            PG8_LDB(B1, 0, 1); PG8_STAGE(PG8_SB(0, 0), b2, voffB);
            PG8_BAR; PG8_WAIT_L(0); PG8_MMA(0, 1, At, B1); PG8_BAR;
            PG8_LDA(At, 0, 1); PG8_STAGE(PG8_SA(0, 0), a2, voffA);
            PG8_BAR; PG8_WAIT_L(0); PG8_MMA(1, 0, At, B0); PG8_BAR; PG8_SCHED;
            PG8_STAGE(PG8_SB(0, 1), b2 + hstep, voffB);
            PG8_WAIT_V(6); PG8_BAR; PG8_MMA(1, 1, At, B1); PG8_BAR;
            PG8_LDB(B0, 1, 0); PG8_SCHED; PG8_LDA(At, 1, 0); PG8_STAGE(PG8_SA(0, 1), a2 + hstep, voffA);
            PG8_WAIT_L(8); PG8_BAR; PG8_WAIT_L(0); PG8_MMA(0, 0, At, B0); PG8_BAR; PG8_SCHED;
            PG8_LDB(B1, 1, 1); PG8_STAGE(PG8_SB(1, 0), b3, voffB);
            PG8_BAR; PG8_WAIT_L(0); PG8_MMA(0, 1, At, B1); PG8_BAR;
            PG8_LDA(At, 1, 1); PG8_STAGE(PG8_SA(1, 0), a3, voffA);
            PG8_BAR; PG8_WAIT_L(0); PG8_MMA(1, 0, At, B0); PG8_BAR; PG8_SCHED;
            PG8_STAGE(PG8_SB(1, 1), b3 + hstep, voffB);
            PG8_WAIT_V(6); PG8_BAR; PG8_MMA(1, 1, At, B1); PG8_BAR;
            }
        }
        if constexpr (ALIGN_EPI) { if (wr == 0) PG8_BAR; }
        if constexpr (!Epi::AFTER_DRAIN) { E(acc, cur, wr, wc, fr, fq); S.done(cur); }
        if (!has_next) break;
#pragma unroll
        for (int a = 0; a < 2; ++a)
#pragma unroll
            for (int b = 0; b < 2; ++b)
#pragma unroll
                for (int m = 0; m < 4; ++m)
#pragma unroll
                    for (int n = 0; n < 2; ++n) acc[a][b][m][n] = (f32x4){0.f, 0.f, 0.f, 0.f};
        cur = nxt; cA = nA; cB = nB; ++ui;
        if constexpr (ALIGN_EPI) { if (wr == 1) PG8_BAR; }
    }
    PG8_WAIT_V(0);
    if constexpr (!ALIGN_EPI) { if (wr == 0) PG8_BAR; }
    PG8_BAR;
    if constexpr (Epi::AFTER_DRAIN) { E.fused(acc, cur, wr, wc, fr, fq, lds, wid, lane); S.done(cur); }
#undef PG8_SA
#undef PG8_SB
#undef PG8_STAGE
#undef PG8_LDA
#undef PG8_LDB
#undef PG8_MMA
#undef PG8_WAIT_V
#undef PG8_WAIT_L
#undef PG8_BAR
#undef PG8_SCHED
}
}
#define LAS __attribute__((address_space(3)))
typedef unsigned short bf16_t;
typedef short bf16x8 __attribute__((ext_vector_type(8)));
typedef short s16x4 __attribute__((ext_vector_type(4)));
typedef float f32x4 __attribute__((ext_vector_type(4)));
typedef float f32x16 __attribute__((ext_vector_type(16)));
typedef unsigned u32x4 __attribute__((ext_vector_type(4)));
typedef unsigned u32x2 __attribute__((ext_vector_type(2)));
using pg8::ZP; using pg8::LOG2E; using pg8::EPS;
__device__ __forceinline__ int crow(int r, int hi) { return (r & 3) + 8 * (r >> 2) + 4 * hi; }
__device__ __forceinline__ unsigned cvtpk(float lo, float hi) { unsigned r; asm volatile("v_cvt_pk_bf16_f32 %0, %1, %2" : "=v"(r) : "v"(lo), "v"(hi)); return r; }
__device__ __forceinline__ unsigned f2bf(float f) { unsigned u = __builtin_bit_cast(unsigned, f); return (u + 0x7fffu + ((u >> 16) & 1u)) >> 16; }
__device__ __forceinline__ float bf2f(unsigned short h) { return __builtin_bit_cast(float, (unsigned)h << 16); }
__device__ __forceinline__ float ex2(float x) { return __builtin_amdgcn_exp2f(x); }
#define VM_WAIT0() asm volatile("s_waitcnt vmcnt(0)" ::: "memory")
#define LGKM_WAIT0() asm volatile("s_waitcnt lgkmcnt(0)" ::: "memory")

__device__ __forceinline__ void dma_k(LAS unsigned char* slot, const bf16_t* src, int pitch, int w, int lane) {
    const bf16_t* s = src + (size_t)lane * pitch + w * 8;
    __builtin_amdgcn_global_load_lds((const unsigned*)s, (LAS unsigned*)(slot + w * 1024), 16, 0, 0);
}
__device__ __forceinline__ void dma_v(LAS unsigned char* slot, const bf16_t* src, int pitch, int w, int lane) {
    const bf16_t* s = src + (size_t)(16 * (w & 3) + (lane >> 2)) * pitch + (w >> 2) * 32 + (lane & 3) * 8;
    __builtin_amdgcn_global_load_lds((const unsigned*)s, (LAS unsigned*)(slot + w * 1024), 16, 0, 0);
}
__device__ __forceinline__ void dma_lin(LAS unsigned char* slot, const unsigned char* src, int w, int lane) {
    __builtin_amdgcn_global_load_lds((const unsigned*)(src + w * 1024 + lane * 16), (LAS unsigned*)(slot + w * 1024), 16, 0, 0);
}
__device__ __forceinline__ void qkt(f32x16& p0, f32x16& p1, const LAS unsigned char* Kslot, const bf16x8* qr, int r32, int hi, f32x16 z0 = f32x16{}, f32x16 z1 = f32x16{}) {
    const LAS unsigned char* kb = Kslot + hi * 1024 + r32 * 16;
#pragma unroll
    for (int d0 = 0; d0 < 4; ++d0) {
        const bf16x8 b0 = *(const LAS bf16x8*)(kb + d0 * 2048);
        const bf16x8 b1 = *(const LAS bf16x8*)(kb + d0 * 2048 + 512);
        z0 = __builtin_amdgcn_mfma_f32_32x32x16_bf16(b0, qr[d0], z0, 0, 0, 0);
        z1 = __builtin_amdgcn_mfma_f32_32x32x16_bf16(b1, qr[d0], z1, 0, 0, 0);
    }
    p0 = z0; p1 = z1;
}
__device__ __forceinline__ int vt_lane_off(int lane) { const int hi = lane >> 5; return ((lane >> 4) & 1) * 32 + (lane & 3) * 8 + (4 * hi + ((lane & 15) >> 2)) * 64; }
__device__ __forceinline__ bf16x8 vfrag(int vb, int d0, int ks) {
    s16x4 lo, hh;
    asm volatile("ds_read_b64_tr_b16 %0, %1" : "=v"(lo) : "v"(vb + d0 * 4096 + ks * 1024) : "memory");
    asm volatile("ds_read_b64_tr_b16 %0, %1" : "=v"(hh) : "v"(vb + d0 * 4096 + ks * 1024 + 512) : "memory");
    asm volatile("s_waitcnt lgkmcnt(0)" : "+v"(lo), "+v"(hh) :: "memory");
    return (bf16x8){lo[0], lo[1], lo[2], lo[3], hh[0], hh[1], hh[2], hh[3]};
}
__device__ __forceinline__ void pv(f32x16* o, int vb, bf16x8 pa0, bf16x8 pa1, bf16x8 pa2, bf16x8 pa3) {
    s16x4 lo[8], hh[8];
#pragma unroll
    for (int i = 0; i < 8; ++i) {
        asm volatile("ds_read_b64_tr_b16 %0, %1 offset:%c2" : "=&v"(lo[i]) : "v"(vb), "i"((i >> 2) * 4096 + (i & 3) * 1024) : "memory");
        asm volatile("ds_read_b64_tr_b16 %0, %1 offset:%c2" : "=&v"(hh[i]) : "v"(vb), "i"((i >> 2) * 4096 + (i & 3) * 1024 + 512) : "memory");
    }
    asm volatile("s_waitcnt lgkmcnt(0)" : "+v"(lo[0]), "+v"(lo[1]), "+v"(lo[2]), "+v"(lo[3]), "+v"(lo[4]), "+v"(lo[5]), "+v"(lo[6]), "+v"(lo[7]),
                 "+v"(hh[0]), "+v"(hh[1]), "+v"(hh[2]), "+v"(hh[3]), "+v"(hh[4]), "+v"(hh[5]), "+v"(hh[6]), "+v"(hh[7]) :: "memory");
#define PVK(k) (bf16x8){lo[k][0], lo[k][1], lo[k][2], lo[k][3], hh[k][0], hh[k][1], hh[k][2], hh[k][3]}
    o[0] = __builtin_amdgcn_mfma_f32_32x32x16_bf16(pa0, PVK(0), o[0], 0, 0, 0);
    o[1] = __builtin_amdgcn_mfma_f32_32x32x16_bf16(pa0, PVK(4), o[1], 0, 0, 0);
    o[0] = __builtin_amdgcn_mfma_f32_32x32x16_bf16(pa1, PVK(1), o[0], 0, 0, 0);
    o[1] = __builtin_amdgcn_mfma_f32_32x32x16_bf16(pa1, PVK(5), o[1], 0, 0, 0);
    o[0] = __builtin_amdgcn_mfma_f32_32x32x16_bf16(pa2, PVK(2), o[0], 0, 0, 0);
    o[1] = __builtin_amdgcn_mfma_f32_32x32x16_bf16(pa2, PVK(6), o[1], 0, 0, 0);
    o[0] = __builtin_amdgcn_mfma_f32_32x32x16_bf16(pa3, PVK(3), o[0], 0, 0, 0);
    o[1] = __builtin_amdgcn_mfma_f32_32x32x16_bf16(pa3, PVK(7), o[1], 0, 0, 0);
#undef PVK
}
#define PACK8(P, B) __builtin_bit_cast(bf16x8, ((u32x4){cvtpk(P[B], P[B + 1]), cvtpk(P[B + 2], P[B + 3]), cvtpk(P[B + 4], P[B + 5]), cvtpk(P[B + 6], P[B + 7])}))
__device__ __forceinline__ void scale_rows(f32x16* o, float f, LAS float* wsf, int r32, int hi) {
    if (hi == 0) wsf[r32] = f;
    LGKM_WAIT0();
#pragma unroll
    for (int r = 0; r < 16; ++r) { const float fr = wsf[crow(r, hi)]; o[0][r] *= fr; o[1][r] *= fr; }
    LGKM_WAIT0();
}
__device__ __forceinline__ float max3f(float x, float y, float z) { return __builtin_fmaxf(__builtin_fmaxf(x, y), z); }
typedef float f32x8 __attribute__((ext_vector_type(8)));
typedef float f32x2 __attribute__((ext_vector_type(2)));
typedef short v4i16_t __attribute__((ext_vector_type(4)));
__device__ __forceinline__ s16x4 vtr(const LAS unsigned char* p) { return __builtin_bit_cast(s16x4, __builtin_amdgcn_ds_read_tr16_b64_v4i16((LAS v4i16_t*)p)); }
__device__ __forceinline__ float rowmax32(const f32x16& p0, const f32x16& p1) {
    float a = max3f(p0[0], p0[1], p1[0]), b = max3f(p0[2], p0[3], p1[1]); a = max3f(a, p1[2], p1[3]);
#pragma unroll
    for (int r = 4; r < 16; r += 4) { a = max3f(a, p0[r], p0[r + 1]); b = max3f(b, p0[r + 2], p0[r + 3]); a = max3f(a, p1[r], p1[r + 1]); b = max3f(b, p1[r + 2], p1[r + 3]); }
    const float m = fmaxf(a, b);
    auto rr = __builtin_amdgcn_permlane32_swap(__builtin_bit_cast(unsigned, m), __builtin_bit_cast(unsigned, m), false, false);
    return fmaxf(__builtin_bit_cast(float, (unsigned)rr[0]), __builtin_bit_cast(float, (unsigned)rr[1]));
}
template <int THR, bool HASF>
__device__ __forceinline__ void attn_step(f32x16& p0, f32x16& p1, f32x16& n0, f32x16& n1, const LAS unsigned char* Knext, const LAS float* Fnext, const LAS unsigned char* Vcur,
                                          const bf16x8* qr, float& mhat, float& l, f32x16* o, LAS float* wsf, int r32, int hi) {
    f32x16 c0 = f32x16{}, c1 = f32x16{};
    if (HASF) {
#pragma unroll
        for (int rr = 0; rr < 4; ++rr) { const f32x4 f0 = *(const LAS f32x4*)(Fnext + 8 * rr), f1 = *(const LAS f32x4*)(Fnext + 32 + 8 * rr);
#pragma unroll
            for (int e = 0; e < 4; ++e) { c0[4 * rr + e] = f0[e]; c1[4 * rr + e] = f1[e]; } }
    }
    bf16x8 kf[8];
    { const LAS unsigned char* kb = Knext + hi * 1024 + r32 * 16;
#pragma unroll
      for (int d0 = 0; d0 < 4; ++d0) { kf[2 * d0] = *(const LAS bf16x8*)(kb + d0 * 2048); kf[2 * d0 + 1] = *(const LAS bf16x8*)(kb + d0 * 2048 + 512); } }
    __builtin_amdgcn_sched_barrier(0);
    const float rm = rowmax32(p0, p1);
    if (__any(rm > mhat + (float)THR)) {
        const float mnew = fmaxf(mhat, rm), f = ex2(mhat - mnew);
        l *= f; mhat = mnew; scale_rows(o, f, wsf, r32, hi);
    }
#pragma unroll
    for (int d0 = 0; d0 < 4; ++d0) {
        c0 = __builtin_amdgcn_mfma_f32_32x32x16_bf16(kf[2 * d0], qr[d0], c0, 0, 0, 0);
        c1 = __builtin_amdgcn_mfma_f32_32x32x16_bf16(kf[2 * d0 + 1], qr[d0], c1, 0, 0, 0);
    }
    __builtin_amdgcn_sched_barrier(0);
    s16x4 vl[8], vh[8];
#pragma unroll
    for (int i = 0; i < 8; ++i) { vl[i] = vtr(Vcur + (i >> 2) * 4096 + (i & 3) * 1024); vh[i] = vtr(Vcur + (i >> 2) * 4096 + (i & 3) * 1024 + 512); }
    __builtin_amdgcn_sched_barrier(0);
    p0 = p0 - mhat; p1 = p1 - mhat;
#pragma unroll
    for (int r = 0; r < 16; ++r) { p0[r] = ex2(p0[r]); p1[r] = ex2(p1[r]); }
    const f32x16 t = p0 + p1;
    const f32x8 t8 = t.lo + t.hi; const f32x4 t4 = t8.lo + t8.hi; const f32x2 t2 = t4.lo + t4.hi;
    l += t2.x + t2.y;
    const bf16x8 pa0 = PACK8(p0, 0), pa1 = PACK8(p0, 8), pa2 = PACK8(p1, 0), pa3 = PACK8(p1, 8);
#define VFK(k) (bf16x8){vl[k][0], vl[k][1], vl[k][2], vl[k][3], vh[k][0], vh[k][1], vh[k][2], vh[k][3]}
    o[0] = __builtin_amdgcn_mfma_f32_32x32x16_bf16(pa0, VFK(0), o[0], 0, 0, 0);
    o[1] = __builtin_amdgcn_mfma_f32_32x32x16_bf16(pa0, VFK(4), o[1], 0, 0, 0);
    o[0] = __builtin_amdgcn_mfma_f32_32x32x16_bf16(pa1, VFK(1), o[0], 0, 0, 0);
    o[1] = __builtin_amdgcn_mfma_f32_32x32x16_bf16(pa1, VFK(5), o[1], 0, 0, 0);
    o[0] = __builtin_amdgcn_mfma_f32_32x32x16_bf16(pa2, VFK(2), o[0], 0, 0, 0);
    o[1] = __builtin_amdgcn_mfma_f32_32x32x16_bf16(pa2, VFK(6), o[1], 0, 0, 0);
    o[0] = __builtin_amdgcn_mfma_f32_32x32x16_bf16(pa3, VFK(3), o[0], 0, 0, 0);
    o[1] = __builtin_amdgcn_mfma_f32_32x32x16_bf16(pa3, VFK(7), o[1], 0, 0, 0);
#undef VFK
    n0 = c0; n1 = c1;
}
template <int THR>
__device__ __forceinline__ void softmax_pv(f32x16& p0, f32x16& p1, float& mhat, float& l, f32x16* o, int vb, LAS float* wsf, int r32, int hi) {
    float a = max3f(p0[0], p0[1], p1[0]), b = max3f(p0[2], p0[3], p1[1]); a = max3f(a, p1[2], p1[3]);
#pragma unroll
    for (int r = 4; r < 16; r += 4) { a = max3f(a, p0[r], p0[r + 1]); b = max3f(b, p0[r + 2], p0[r + 3]); a = max3f(a, p1[r], p1[r + 1]); b = max3f(b, p1[r + 2], p1[r + 3]); }
    float rm = fmaxf(a, b); rm = fmaxf(rm, __shfl_xor(rm, 32));
    if (__any(rm > mhat + (float)THR)) {
        const float mnew = fmaxf(mhat, rm), f = ex2(mhat - mnew);
        l *= f; mhat = mnew; scale_rows(o, f, wsf, r32, hi);
    }
    p0 = p0 - mhat; p1 = p1 - mhat;
#pragma unroll
    for (int r = 0; r < 16; ++r) { p0[r] = ex2(p0[r]); p1[r] = ex2(p1[r]); }
    const f32x16 t = p0 + p1;
    const f32x8 t8 = t.lo + t.hi; const f32x4 t4 = t8.lo + t8.hi; const f32x2 t2 = t4.lo + t4.hi;
    l += t2.x + t2.y;
    pv(o, vb, PACK8(p0, 0), PACK8(p0, 8), PACK8(p1, 0), PACK8(p1, 8));
}
__device__ __forceinline__ void store_o(const f32x16* o, float rinv, LAS float* wsf, LAS bf16_t* stg, bf16_t* Og, int pitch, int r32, int hi, int lane) {
    if (hi == 0) wsf[32 + r32] = rinv;
    LGKM_WAIT0();
#pragma unroll
    for (int r = 0; r < 16; ++r) { const int orow = crow(r, hi); const float rl = wsf[32 + orow];
#pragma unroll
        for (int d0 = 0; d0 < 2; ++d0) stg[orow * 64 + d0 * 32 + r32] = (bf16_t)f2bf(o[d0][r] * rl); }
    LGKM_WAIT0();
#pragma unroll
    for (int i = 0; i < 4; ++i) { const int row = i * 8 + (lane >> 3), ch = lane & 7; const u32x4 v = *(const LAS u32x4*)(stg + row * 64 + ch * 8); *(u32x4*)(Og + (size_t)row * pitch + ch * 8) = v; }
    LGKM_WAIT0();
}
__device__ __forceinline__ float log_sigmoid(float x) { return fminf(x, 0.f) - log1pf(__expf(-fabsf(x))); }

constexpr int MX_RING = 0, MX_F = 98304, MX_WSF = 114688, MX_WTOT = 116736, MX_STG_SWA = 65536, MX_STG_FOX = 40960;

struct MixCtx {
    const bf16_t* Z; const float* G; bf16_t* Y;
    const float* sinks; const float* fox_fb; const float* ml_ib; const float* ml_fb; const float* ml_norm;
    unsigned char* ws; const unsigned char* KT; const unsigned char* VT;
};

__device__ __forceinline__ void swa_item(const MixCtx& C, int item, LAS unsigned char* lds) {
    int tid_ = threadIdx.x; asm volatile("" : "+v"(tid_));
    const int tid = tid_, lane = tid & 63, w = __builtin_amdgcn_readfirstlane(tid >> 6), r32 = lane & 31, hi = lane >> 5;
    const int jp = item & 31, kvh = (item >> 5) & 1, b = item >> 6;
    const size_t rowbase = (size_t)b * 4096;
    const int cbase = jp >= 1 ? 2 * jp - 2 : 0, ntl = 2 * jp + 2 - cbase;
    const bf16_t* Kb = C.Z + rowbase * ZP + 512 + 64 * kvh; const bf16_t* Vb = C.Z + rowbase * ZP + 640 + 64 * kvh;
    for (int j = 0; j < ntl; ++j) { dma_k(lds + MX_RING + j * 16384, Kb + (size_t)(cbase + j) * 64 * ZP, ZP, w, lane); dma_v(lds + MX_RING + j * 16384 + 8192, Vb + (size_t)(cbase + j) * 64 * ZP, ZP, w, lane); }
    const int hq = 4 * kvh + (w >> 1);
    bf16x8 qra[4], qrb[4];
    { const bf16_t* Qa = C.Z + (rowbase + 128 * jp + 32 * (w & 1) + r32) * ZP + 64 * hq;
#pragma unroll
      for (int d0 = 0; d0 < 4; ++d0) { qra[d0] = *(const bf16x8*)(Qa + 16 * d0 + 8 * hi); qrb[d0] = *(const bf16x8*)(Qa + (size_t)64 * ZP + 16 * d0 + 8 * hi); } }
    LAS float* wsf = (LAS float*)(lds + MX_WSF) + w * 64; LAS bf16_t* stg = (LAS bf16_t*)(lds + MX_STG_SWA + w * 4096);
    const float sink = C.sinks[hq] * LOG2E;
    VM_WAIT0(); __syncthreads();
    const int vlo = vt_lane_off(lane);
#pragma unroll
    for (int cc = 0; cc < 2; ++cc) {
        const int c = 2 * jp + cc, c0 = c >= 2 ? c - 2 : 0, nt = c - c0 + 1, s0 = c0 - cbase, qw0 = 64 * c + 32 * (w & 1);
        const bf16x8* qr = cc == 0 ? qra : qrb;
        float mhat = sink, l = hi == 0 ? 1.f : 0.f; f32x16 o[2]; o[0] = f32x16{}; o[1] = f32x16{};
        f32x16 p0, p1; qkt(p0, p1, lds + MX_RING + s0 * 16384, qr, r32, hi);
        for (int j = 0; j < nt; ++j) {
            f32x16 n0 = p0, n1 = p1;
            if (j + 1 < nt) qkt(n0, n1, lds + MX_RING + (s0 + j + 1) * 16384, qr, r32, hi);
            softmax_pv<8>(p0, p1, mhat, l, o, (int)(uintptr_t)(lds + MX_RING + (s0 + j) * 16384 + 8192) + vlo, wsf, r32, hi);
            p0 = n0; p1 = n1;
        }
        l += __shfl_xor(l, 32);
        store_o(o, 1.0f / l, wsf, stg, C.Y + (rowbase + qw0) * 1024 + 64 * hq, 1024, r32, hi, lane);
    }
    __syncthreads();
}

__device__ __forceinline__ void fx0_item(const MixCtx& C, float* NF, unsigned* cntF, int bh, LAS unsigned char* lds) {
    int tid_ = threadIdx.x; asm volatile("" : "+v"(tid_));
    const int tid = tid_, lane = tid & 63, w = __builtin_amdgcn_readfirstlane(tid >> 6);
    const int b = bh >> 2, h = bh & 3; const size_t rowbase = (size_t)b * 4096;
    LAS float* wtot = (LAS float*)(lds + MX_WTOT);
    const float fb = C.fox_fb[h]; const int t0 = tid * 8; float v[8]; float run = 0.f;
#pragma unroll
    for (int i = 0; i < 8; ++i) { run += log_sigmoid(C.G[(rowbase + t0 + i) * 16 + h] + fb) * LOG2E; v[i] = run; }
    float inc = run;
#pragma unroll
    for (int o_ = 1; o_ < 64; o_ <<= 1) { const float y = __shfl_up(inc, o_); if (lane >= o_) inc += y; }
    if (lane == 63) wtot[w] = inc;
    __syncthreads();
    float off = inc - run;
    for (int j = 0; j < w; ++j) off += wtot[j];
    *(f32x4*)(NF + bh * 4096 + t0) = (f32x4){-(v[0] + off), -(v[1] + off), -(v[2] + off), -(v[3] + off)};
    *(f32x4*)(NF + bh * 4096 + t0 + 4) = (f32x4){-(v[4] + off), -(v[5] + off), -(v[6] + off), -(v[7] + off)};
    asm volatile("s_waitcnt vmcnt(0)" ::: "memory"); __syncthreads();
    if (tid == 0) { __builtin_amdgcn_fence(__ATOMIC_RELEASE, "agent"); asm volatile("s_waitcnt vmcnt(0)" ::: "memory"); __hip_atomic_fetch_add(cntF + bh, 1u, __ATOMIC_RELAXED, __HIP_MEMORY_SCOPE_AGENT); }
    __syncthreads();
}
__device__ __forceinline__ void fox_block(const MixCtx& C, const float* NF, unsigned* cntF, int bh, int qb, LAS unsigned char* lds, bool first) {
    int tid_ = threadIdx.x; asm volatile("" : "+v"(tid_));
    const int tid = tid_, lane = tid & 63, w = __builtin_amdgcn_readfirstlane(tid >> 6), r32 = lane & 31, hi = lane >> 5;
    const int b = bh >> 2, h = bh & 3; const size_t rowbase = (size_t)b * 4096; const int q0 = qb * 128, nkeys = q0 + 128, nst = qb + 1;
    const unsigned char* Kt = C.KT + (size_t)bh * 64 * 8192; const unsigned char* Vt = C.VT + (size_t)bh * 64 * 8192;
#define FOX_STAGE(st_) do { LAS unsigned char* sb_ = lds + MX_RING + ((st_) % 3) * 32768; \
        dma_lin(sb_, Kt + (size_t)(2 * (st_)) * 8192, w, lane); dma_lin(sb_ + 8192, Kt + (size_t)(2 * (st_) + 1) * 8192, w, lane); \
        dma_lin(sb_ + 16384, Vt + (size_t)(2 * (st_)) * 8192, w, lane); dma_lin(sb_ + 24576, Vt + (size_t)(2 * (st_) + 1) * 8192, w, lane); } while (0)
    if (first) {
        if (tid == 0) { while (__hip_atomic_load(cntF + bh, __ATOMIC_RELAXED, __HIP_MEMORY_SCOPE_AGENT) < 1u) __builtin_amdgcn_s_sleep(2); }
        __syncthreads();
    }
    FOX_STAGE(0); if (nst > 1) FOX_STAGE(1);
    LAS float* F2 = (LAS float*)(lds + MX_F);
    LAS float* wsf = (LAS float*)(lds + MX_WSF) + w * 64; LAS bf16_t* stg = (LAS bf16_t*)(lds + MX_STG_FOX + w * 4096);
    {
        const int t0 = tid * 8;
        if (first && t0 < nkeys) { const unsigned long long* np = (const unsigned long long*)(NF + bh * 4096 + t0); unsigned long long q[4];
#pragma unroll
            for (int i = 0; i < 4; ++i) q[i] = __hip_atomic_load(np + i, __ATOMIC_RELAXED, __HIP_MEMORY_SCOPE_AGENT);
#pragma unroll
            for (int i = 0; i < 4; ++i) *(LAS unsigned long long*)(F2 + t0 + 2 * i) = q[i]; }
    }
    const int g = w >> 2, qw0 = q0 + 32 * (w & 3);
    const bf16_t* Qb = C.Z + (rowbase + qw0 + r32) * ZP + 768 + 64 * h;
    bf16x8 qr[4];
#pragma unroll
    for (int d0 = 0; d0 < 4; ++d0) qr[d0] = *(const bf16x8*)(Qb + 16 * d0 + 8 * hi);
    float mhat = -1e30f, l = 0.f; f32x16 o[2]; o[0] = f32x16{}; o[1] = f32x16{};
    VM_WAIT0(); __syncthreads();
    const int vlo = vt_lane_off(lane), qpos = qw0 + r32;
#define FOX_SCORE(st_, P0, P1) do { const int kb_ = 64 * (2 * (st_) + g); const LAS unsigned char* sk_ = lds + MX_RING + ((st_) % 3) * 32768 + g * 8192; f32x16 c0_, c1_; \
        _Pragma("unroll") for (int rr = 0; rr < 4; ++rr) { const f32x4 f0 = *(const LAS f32x4*)(F2 + kb_ + 8 * rr + 4 * hi), f1 = *(const LAS f32x4*)(F2 + kb_ + 32 + 8 * rr + 4 * hi); \
            _Pragma("unroll") for (int e = 0; e < 4; ++e) { c0_[4 * rr + e] = f0[e]; c1_[4 * rr + e] = f1[e]; } } \
        qkt(P0, P1, sk_, qr, r32, hi, c0_, c1_); } while (0)
    f32x16 p0, p1, n0, n1; FOX_SCORE(0, p0, p1);
#define FOX_STEP(PA0, PA1, PB0, PB1, st_) do { if ((st_) + 2 < nst) FOX_STAGE((st_) + 2); \
        attn_step<24, true>(PA0, PA1, PB0, PB1, lds + MX_RING + (((st_) + 1) % 3) * 32768 + g * 8192, F2 + 64 * (2 * ((st_) + 1) + g) + 4 * hi, \
                           lds + MX_RING + ((st_) % 3) * 32768 + 16384 + g * 8192 + vlo, qr, mhat, l, o, wsf, r32, hi); \
        VM_WAIT0(); __syncthreads(); } while (0)
#define FOX_LAST(PA0, PA1) do { const int st = nst - 1, kbase = 64 * (2 * st + g); \
        if (kbase <= qw0 + 31) { \
            if (kbase + 63 > qw0) { _Pragma("unroll") for (int r = 0; r < 16; ++r) { const int kv = kbase + crow(r, hi); if (kv > qpos) PA0[r] = -INFINITY; if (kv + 32 > qpos) PA1[r] = -INFINITY; } } \
            softmax_pv<24>(PA0, PA1, mhat, l, o, (int)(uintptr_t)(lds + MX_RING + (st % 3) * 32768 + 16384 + g * 8192) + vlo, wsf, r32, hi); } } while (0)
    int st2 = 0;
    for (; st2 + 2 < nst; st2 += 2) { FOX_STEP(p0, p1, n0, n1, st2); FOX_STEP(n0, n1, p0, p1, st2 + 1); }
    if (st2 + 1 < nst) { FOX_STEP(p0, p1, n0, n1, st2); FOX_LAST(n0, n1); } else { FOX_LAST(p0, p1); }
#undef FOX_STEP
#undef FOX_LAST
    __syncthreads();
#undef FOX_SCORE
#undef FOX_STAGE
    l += __shfl_xor(l, 32);
    LAS float* mo = (LAS float*)(lds + MX_RING); LAS float* ml = (LAS float*)(lds + MX_RING + 32768);
    const int wq = w & 3;
    if (g == 1) {
#pragma unroll
        for (int d0 = 0; d0 < 2; ++d0)
#pragma unroll
            for (int r = 0; r < 16; ++r) mo[((wq * 2 + d0) * 16 + r) * 64 + lane] = o[d0][r];
        ml[(wq * 2 + 0) * 64 + lane] = mhat; ml[(wq * 2 + 1) * 64 + lane] = l;
    }
    __syncthreads();
    if (g == 0) {
        const float m1 = ml[(wq * 2 + 0) * 64 + lane], l1 = ml[(wq * 2 + 1) * 64 + lane];
        const float mn = fmaxf(mhat, m1), f0 = ex2(mhat - mn), f1 = ex2(m1 - mn), lt = l * f0 + l1 * f1;
        if (hi == 0) { wsf[r32] = f0; wsf[32 + r32] = f1; }
        LGKM_WAIT0();
#pragma unroll
        for (int r = 0; r < 16; ++r) { const float a0 = wsf[crow(r, hi)], a1 = wsf[32 + crow(r, hi)];
#pragma unroll
            for (int d0 = 0; d0 < 2; ++d0) o[d0][r] = o[d0][r] * a0 + mo[((wq * 2 + d0) * 16 + r) * 64 + lane] * a1; }
        LGKM_WAIT0();
        store_o(o, 1.0f / lt, wsf, stg, C.Y + (rowbase + qw0) * 1024 + 512 + 64 * h, 1024, r32, hi, lane);
    }
    __syncthreads();
}
__device__ __forceinline__ void fox_item(const MixCtx& C, const float* NF, unsigned* cntF, int bh, int i, LAS unsigned char* lds) {
    fox_block(C, NF, cntF, bh, 31 - i, lds, true);
    fox_block(C, NF, cntF, bh, i, lds, false);
}
constexpr int ML_WSF = 98304, ML_STG = 100352, ML_SM = 133120;
struct MlScratch { float* E; float* B; float* PM; float* CL; float* NL; bf16_t* CP; float* NP; float* GC; float* EM; float* MP; unsigned* cnt1; unsigned* cnt2; };
__device__ __forceinline__ void wait_count(unsigned* p, unsigned want, int tid) {
    if (tid == 0) { while (__hip_atomic_load(p, __ATOMIC_RELAXED, __HIP_MEMORY_SCOPE_AGENT) < want) __builtin_amdgcn_s_sleep(2);
        __builtin_amdgcn_fence(__ATOMIC_ACQUIRE, "agent"); asm volatile("s_waitcnt vmcnt(0)" ::: "memory"); }
    __syncthreads();
}
__device__ __forceinline__ void post_count(unsigned* p, int tid) {
    asm volatile("s_waitcnt vmcnt(0)" ::: "memory"); __syncthreads();
    if (tid == 0) { __builtin_amdgcn_fence(__ATOMIC_RELEASE, "agent"); asm volatile("s_waitcnt vmcnt(0)" ::: "memory");
        __hip_atomic_fetch_add(p, 1u, __ATOMIC_RELAXED, __HIP_MEMORY_SCOPE_AGENT); }
}
#define ML_COMMON \
    int tid_ = threadIdx.x; asm volatile("" : "+v"(tid_)); \
    const int tid = tid_, lane = tid & 63, w = __builtin_amdgcn_readfirstlane(tid >> 6), r32 = lane & 31, hi = lane >> 5; \
    const int b = bh >> 2, h = bh & 3; const size_t rowbase = (size_t)b * 4096; \
    float* E = S.E + bh * 4096; float* B = S.B + bh * 4096; float* PM = S.PM + bh * 4096; \
    float* CL = S.CL + (size_t)bh * 64 * 4096; float* NL = S.NL + bh * 4096; bf16_t* CP = S.CP + (size_t)bh * 64 * 4096; float* NP = S.NP + bh * 4096; \
    float* GC = S.GC + bh * 64; float* EM = S.EM + bh * 64; float* MP = S.MP + bh * 64; \
    (void)r32; (void)hi; (void)E; (void)B; (void)PM; (void)CL; (void)NL; (void)CP; (void)NP; (void)GC; (void)EM; (void)MP; (void)rowbase; (void)h;

__device__ __forceinline__ void ml1_item(const MixCtx& C, const MlScratch& S, int bh, int rd, LAS unsigned char* lds) {
    ML_COMMON
    LAS float* le = (LAS float*)(lds + ML_SM); LAS float* lem = le + 512;
    const bf16_t* Kg = C.Z + rowbase * ZP + 1792 + 64 * h; const bf16_t* Vg = C.Z + rowbase * ZP + 2048 + 64 * h;
    const int srow = 16 * (w & 3) + (lane >> 2), scol = (w >> 2) * 32 + (lane & 3) * 8;
    u32x4 kvr[8];
#pragma unroll
    for (int p = 0; p < 8; ++p) kvr[p] = *(const u32x4*)(Kg + (size_t)((8 * rd + p) * 64 + srow) * ZP + scol);
    {
        const int cc = 8 * rd + w, t = cc * 64 + lane;
        const float* gp = C.G + (rowbase + t) * 16;
        const float ig = gp[4 + h] + C.ml_ib[h];
        float bsum = log_sigmoid(gp[8 + h] + C.ml_fb[h]);
#pragma unroll
        for (int o_ = 1; o_ < 64; o_ <<= 1) { const float y = __shfl_up(bsum, o_); if (lane >= o_) bsum += y; }
        const float e = ig - bsum; float pm = e;
#pragma unroll
        for (int o_ = 1; o_ < 64; o_ <<= 1) { const float y = __shfl_up(pm, o_); if (lane >= o_) pm = fmaxf(pm, y); }
        E[t] = e; B[t] = bsum; PM[t] = pm; le[w * 64 + lane] = e;
        if (lane == 63) { GC[cc] = bsum; EM[cc] = pm; lem[w] = pm; }
    }
    __syncthreads();
    const int vlo = vt_lane_off(lane);
    const bf16x8 ones = (bf16x8){0x3F80, 0x3F80, 0x3F80, 0x3F80, 0x3F80, 0x3F80, 0x3F80, 0x3F80};
#pragma unroll
    for (int p = 0; p < 8; ++p) {
        const int cc = 8 * rd + p; LAS unsigned char* sl = lds + p * 16384;
        const float wa = __expf(le[p * 64 + srow] - lem[p]);
        u32x4 w2;
#pragma unroll
        for (int j = 0; j < 4; ++j) { const float lo = __builtin_bit_cast(float, kvr[p][j] << 16), hh = __builtin_bit_cast(float, kvr[p][j] & 0xffff0000u); w2[j] = cvtpk(lo * wa, hh * wa); }
        *(LAS u32x4*)(sl + w * 1024 + lane * 16) = w2;
        dma_v(sl + 8192, Vg + (size_t)cc * 64 * ZP, ZP, w, lane);
    }
    VM_WAIT0(); __syncthreads();
    {
        const int cc = 8 * rd + w; LAS unsigned char* sl = lds + w * 16384;
        const int ka = (int)(uintptr_t)sl + vlo, va = ka + 8192;
        float* cl = CL + (size_t)cc * 4096;
#pragma unroll
        for (int half = 0; half < 2; ++half) {
            f32x16 a0 = {}, a1 = {}, na = {};
#pragma unroll
            for (int ks = 0; ks < 4; ++ks) {
                const bf16x8 A = vfrag(ka, half, ks), B0 = vfrag(va, 0, ks), B1 = vfrag(va, 1, ks);
                a0 = __builtin_amdgcn_mfma_f32_32x32x16_bf16(A, B0, a0, 0, 0, 0);
                a1 = __builtin_amdgcn_mfma_f32_32x32x16_bf16(A, B1, a1, 0, 0, 0);
                na = __builtin_amdgcn_mfma_f32_32x32x16_bf16(A, ones, na, 0, 0, 0);
            }
#pragma unroll
            for (int r = 0; r < 16; ++r) { const int k = 32 * half + crow(r, hi); cl[k * 64 + r32] = a0[r]; cl[k * 64 + 32 + r32] = a1[r]; }
            if (r32 == 0) {
#pragma unroll
                for (int r = 0; r < 16; ++r) NL[cc * 64 + 32 * half + crow(r, hi)] = na[r];
            }
        }
    }
    post_count(S.cnt1 + bh, tid);
    __syncthreads();
}

__device__ __forceinline__ void ml2_item(const MixCtx& C, const MlScratch& S, int bh, int slice, LAS unsigned char* lds) {
    ML_COMMON
    LAS float* lg = (LAS float*)(lds + ML_SM); LAS float* lem = lg + 64; LAS float* lso = lg + 128; LAS float* lsl = lg + 192;
    wait_count(S.cnt1 + bh, 8u, tid);
    if (tid < 64) { lg[tid] = GC[tid]; lem[tid] = EM[tid]; }
    __syncthreads();
    if (tid == 0) { float mcur = 0.f; for (int c = 0; c < 64; ++c) { const float g = lg[c], em = lem[c], mx = fmaxf(mcur, em); if (slice == 0) MP[c] = mcur; lso[c] = __expf(mcur - mx); lsl[c] = __expf(em - mx); mcur = g + mx; } }
    __syncthreads();
    const int idx = slice * 2048 + tid * 4; const bool don = (slice == 0) && (tid < 64);
    f32x4 Cs = (f32x4){0.f, 0.f, 0.f, 0.f}; float ns = 0.f;
    for (int c0 = 0; c0 < 64; c0 += 16) {
        f32x4 lv[16]; float ln[16];
#pragma unroll
        for (int j = 0; j < 16; ++j) { lv[j] = *(const f32x4*)(CL + (size_t)(c0 + j) * 4096 + idx); ln[j] = don ? NL[(c0 + j) * 64 + tid] : 0.f; }
#pragma unroll
        for (int j = 0; j < 16; ++j) {
            const int c = c0 + j;
            u32x2 pk; pk.x = cvtpk(Cs[0], Cs[1]); pk.y = cvtpk(Cs[2], Cs[3]);
            *(u32x2*)(CP + (size_t)c * 4096 + idx) = pk;
            if (don) NP[c * 64 + tid] = ns;
            const float so = lso[c], sl = lsl[c];
            Cs = Cs * so + lv[j] * sl; ns = so * ns + sl * ln[j];
        }
    }
    post_count(S.cnt2 + bh, tid);
    __syncthreads();
}

__device__ __forceinline__ void ml3_item(const MixCtx& C, const MlScratch& S, int bh, int rd, LAS unsigned char* lds) {
    ML_COMMON
    wait_count(S.cnt2 + bh, 2u, tid);
    const int pair = w >> 1, half = w & 1;
    const bf16_t* Kg = C.Z + rowbase * ZP + 1792 + 64 * h; const bf16_t* Vg = C.Z + rowbase * ZP + 2048 + 64 * h; const bf16_t* Qg = C.Z + rowbase * ZP + 1536 + 64 * h;
    const int vlo = vt_lane_off(lane);
    LAS float* wsf = (LAS float*)(lds + ML_WSF) + w * 64; LAS bf16_t* stg = (LAS bf16_t*)(lds + ML_STG + w * 4096);
#pragma unroll
        for (int p = 0; p < 4; ++p) {
            const int cc = 4 * rd + p; LAS unsigned char* sl = lds + p * 24576;
            dma_k(sl, Kg + (size_t)cc * 64 * ZP, ZP, w, lane); dma_v(sl + 8192, Vg + (size_t)cc * 64 * ZP, ZP, w, lane); dma_v(sl + 16384, CP + (size_t)cc * 4096, 64, w, lane);
        }
        const int cc = 4 * rd + pair, lrow = 32 * half + r32, t = cc * 64 + lrow;
        const bf16_t* qp = Qg + (size_t)t * ZP;
        bf16x8 qr[4], qp2[4];
#pragma unroll
        for (int d0 = 0; d0 < 4; ++d0) qr[d0] = *(const bf16x8*)(qp + 16 * d0 + 8 * hi);
#pragma unroll
        for (int ks = 0; ks < 4; ++ks) { const u32x2 a = *(const u32x2*)(qp + 16 * ks + 4 * hi), b2 = *(const u32x2*)(qp + 16 * ks + 8 + 4 * hi); qp2[ks] = __builtin_bit_cast(bf16x8, ((u32x4){a.x, a.y, b2.x, b2.y})); }
        const float mprev = MP[cc], mm = fmaxf(mprev, PM[t]), winter = __expf(mprev - mm), bl = B[t];
        float nd = 0.f;
#pragma unroll
        for (int d0 = 0; d0 < 4; ++d0) { const float* np = NP + cc * 64 + 16 * d0 + 8 * hi; const f32x4 n0 = *(const f32x4*)np, n1 = *(const f32x4*)(np + 4);
            const u32x4 qq = __builtin_bit_cast(u32x4, qr[d0]);
#pragma unroll
            for (int j = 0; j < 4; ++j) { const float lo = __builtin_bit_cast(float, qq[j] << 16), hh = __builtin_bit_cast(float, qq[j] & 0xffff0000u);
                const float na_ = j < 2 ? n0[2 * j] : n1[2 * j - 4], nb_ = j < 2 ? n0[2 * j + 1] : n1[2 * j - 3]; nd += lo * na_ + hh * nb_; } }
        nd += __shfl_xor(nd, 32);
        VM_WAIT0(); __syncthreads();
        {
            LAS unsigned char* sl = lds + pair * 24576; const int base = (int)(uintptr_t)sl + vlo;
            f32x16 o[2]; o[0] = f32x16{}; o[1] = f32x16{};
            pv(o, base + 16384, qp2[0], qp2[1], qp2[2], qp2[3]);
            scale_rows(o, winter, wsf, r32, hi);
            f32x16 p0, p1; qkt(p0, p1, sl, qr, r32, hi);
            float rs = 0.f;
#pragma unroll
            for (int rr = 0; rr < 4; ++rr) { const f32x4 e0 = *(const f32x4*)(E + cc * 64 + 8 * rr + 4 * hi), e1 = *(const f32x4*)(E + cc * 64 + 32 + 8 * rr + 4 * hi);
#pragma unroll
                for (int e = 0; e < 4; ++e) { const int r = 4 * rr + e, s = 8 * rr + 4 * hi + e;
                    const float w0 = (s <= lrow) ? __expf(e0[e] - mm) : 0.f, w1 = (s + 32 <= lrow) ? __expf(e1[e] - mm) : 0.f;
                    p0[r] *= w0; p1[r] *= w1; rs += p0[r] + p1[r]; } }
            rs += __shfl_xor(rs, 32);
            pv(o, base + 8192, PACK8(p0, 0), PACK8(p0, 8), PACK8(p1, 0), PACK8(p1, 8));
            const float den = winter * nd + rs, dn = fmaxf(fabsf(den), __expf(-(bl + mm)));
            const float rinv = 1.0f / dn;
            if (hi == 0) wsf[32 + r32] = rinv;
            LGKM_WAIT0();
#pragma unroll
            for (int r = 0; r < 16; ++r) { const int orow = crow(r, hi); const float rl = wsf[32 + orow];
#pragma unroll
                for (int d0 = 0; d0 < 2; ++d0) stg[orow * 64 + d0 * 32 + r32] = (bf16_t)f2bf(o[d0][r] * rl); }
            LGKM_WAIT0();
#pragma unroll
            for (int i = 0; i < 4; ++i) {
                const int row = i * 8 + (lane >> 3), ch = lane & 7; const u32x4 v = *(const LAS u32x4*)(stg + row * 64 + ch * 8);
                float x[8]; float ss = 0.f;
#pragma unroll
                for (int j = 0; j < 4; ++j) { x[2 * j] = __builtin_bit_cast(float, v[j] << 16); x[2 * j + 1] = __builtin_bit_cast(float, v[j] & 0xffff0000u); ss += x[2 * j] * x[2 * j] + x[2 * j + 1] * x[2 * j + 1]; }
                ss += __shfl_xor(ss, 1); ss += __shfl_xor(ss, 2); ss += __shfl_xor(ss, 4);
                const float rn = rsqrtf(ss * (1.0f / 64.0f) + EPS);
                const size_t tok = rowbase + cc * 64 + 32 * half + row;
                const u32x4 og = *(const u32x4*)(C.Z + tok * ZP + 2304 + 64 * h + ch * 8);
                const f32x4 g0 = *(const f32x4*)(C.ml_norm + h * 64 + ch * 8), g1 = *(const f32x4*)(C.ml_norm + h * 64 + ch * 8 + 4);
                float y[8];
#pragma unroll
                for (int j = 0; j < 4; ++j) { const float o0 = __builtin_bit_cast(float, og[j] << 16), o1 = __builtin_bit_cast(float, og[j] & 0xffff0000u);
                    const float ga = j < 2 ? g0[2 * j] : g1[2 * j - 4], gb = j < 2 ? g0[2 * j + 1] : g1[2 * j - 3];
                    y[2 * j] = x[2 * j] * rn * ga * o0; y[2 * j + 1] = x[2 * j + 1] * rn * gb * o1; }
                u32x4 pk; pk.x = cvtpk(y[0], y[1]); pk.y = cvtpk(y[2], y[3]); pk.z = cvtpk(y[4], y[5]); pk.w = cvtpk(y[6], y[7]);
                *(u32x4*)(C.Y + tok * 1024 + 768 + 64 * h + ch * 8) = pk;
            }
            LGKM_WAIT0();
        }
        __syncthreads();
}
constexpr int MTOK = 16384, DMODEL = 1024, SEQL = 4096, DFF = 4096, NZT = 2816  , DEPTH = 2;
constexpr size_t MiB = 1u << 20;
constexpr size_t WS_CTL = 0, CTL_BYTES = 32768;
constexpr size_t WS_WIN = 2 * MiB, WIN_L = (size_t)NZT * DMODEL * 2;
constexpr size_t WS_WOUT = 13 * MiB, WOUT_L = (size_t)DMODEL * DMODEL * 2;
constexpr size_t WS_WFF1 = 17 * MiB, WFF_L = (size_t)DFF * DMODEL * 2;
constexpr size_t WS_WFF2 = 33 * MiB;
constexpr size_t WS_SSQ2 = 82 * MiB;
constexpr size_t WS_XG = 50 * MiB;
constexpr size_t WS_H = 84 * MiB;
constexpr size_t WS_Z = 84 * MiB, WS_Y = 164 * MiB;
constexpr size_t WS_KT = 196 * MiB, WS_VT = 204 * MiB;
constexpr size_t WS_SSQ = 212 * MiB, WS_ROPE = 214 * MiB, WS_G = 215 * MiB;
constexpr size_t WS_MLE = 216 * MiB, WS_MLB = WS_MLE + 262144, WS_MLPM = WS_MLB + 262144;
constexpr size_t WS_NL = 217 * MiB, WS_NP = WS_NL + 262144, WS_GC = WS_NP + 262144, WS_EM = WS_GC + 4096, WS_MP = WS_EM + 4096;
constexpr size_t WS_CL = 218 * MiB, WS_CP = 234 * MiB, WS_NFX = 242 * MiB, WS_END = 243 * MiB;
constexpr int LDS_BYTES = 147456;
constexpr int N_FOX = 256, N_SWA = 256, N_ML1 = 128, N_ML2 = 32, N_ML3 = 256, N_ML = N_ML1 + N_ML2 + N_ML3, N_FX0 = 16, N_ITEMS = N_FX0 + N_ML + N_FOX + N_SWA;

struct Params { const float* in[16]; float* out; unsigned char* ws; int ph_lo, ph_hi; };

__device__ __forceinline__ int win_src(int n) {
    const int pn = n >> 8, P = n & 255, L = 64 * ((P >> 5) & 3) + 32 * (P >> 7) + (P & 31), z = 256 * pn + L;
    if (z < 1536) return z;
    if (z < 2304) return z + 4;
    if (z < 2560) return z + 12;
    const int i = z - 2560;
    if (i < 4) return 1536 + i;
    if (i < 8) return 2308 + (i - 4);
    if (i < 12) return 2312 + (i - 8);
    return -1;
}
template <bool WIN>
__device__ __forceinline__ void tr_item(const float* W, const float* kgain, int K, int Nsrc, bf16_t* WT, int nblk, int item, LAS float* scr, int lane) {
    const int kb = item / nblk, nb = item % nblk, k0 = 64 * kb, n0 = 32 * nb;
    if (WIN && n0 >= 2560) {
        const int n = n0 + (lane & 31); const int src = win_src(n);
#pragma unroll 8
        for (int i = 0; i < 32; ++i) { const int kk = 2 * i + (lane >> 5); scr[kk * 33 + (lane & 31)] = src >= 0 ? W[(size_t)(k0 + kk) * Nsrc + src] * (kgain ? kgain[k0 + kk] : 1.f) : 0.f; }
    } else {
        const int n4 = (lane & 7) * 4; const int src = WIN ? win_src(n0 + n4) : n0 + n4;
        f32x4 v[8];
#pragma unroll
        for (int i = 0; i < 8; ++i) v[i] = *(const f32x4*)(W + (size_t)(k0 + 8 * i + (lane >> 3)) * Nsrc + src);
#pragma unroll
        for (int i = 0; i < 8; ++i) { const int kk = 8 * i + (lane >> 3); const float g = kgain ? kgain[k0 + kk] : 1.f; LAS float* d = scr + kk * 33 + n4;
            d[0] = v[i][0] * g; d[1] = v[i][1] * g; d[2] = v[i][2] * g; d[3] = v[i][3] * g; }
    }
    LGKM_WAIT0(); asm volatile("" ::: "memory");
    const int c = lane & 7;
#pragma unroll
    for (int j = 0; j < 4; ++j) { const int nn = (lane >> 3) + 8 * j; const LAS float* s = scr + (8 * c) * 33 + nn;
        u32x4 o; o.x = cvtpk(s[0 * 33], s[1 * 33]); o.y = cvtpk(s[2 * 33], s[3 * 33]); o.z = cvtpk(s[4 * 33], s[5 * 33]); o.w = cvtpk(s[6 * 33], s[7 * 33]);
        *(u32x4*)(WT + (size_t)(n0 + nn) * K + k0 + 8 * c) = o; }
    LGKM_WAIT0(); asm volatile("" ::: "memory");
}

#define RLX_AGENT __ATOMIC_RELAXED, __HIP_MEMORY_SCOPE_AGENT
#define XB_TMO      128
#define XB_XCNT(j)  (256  + 64 * (j))
#define XB_XSUB(j)  (1280 + 64 * (j))
#define XB_XGEN(j)  (2304 + 64 * (j))
#define XB_TOP      3328
#define XB_TOPGEN   3392
#define XCD_BAR_WORDS 3456
#define XB_SPIN_CAP (1u << 18)

__device__ __forceinline__ unsigned xb_ld(unsigned* p)              { return __hip_atomic_load(p, __ATOMIC_RELAXED, __HIP_MEMORY_SCOPE_AGENT); }
__device__ __forceinline__ unsigned xb_add(unsigned* p, unsigned v) { return __hip_atomic_fetch_add(p, v, __ATOMIC_RELAXED, __HIP_MEMORY_SCOPE_AGENT); }
__device__ __forceinline__ unsigned xb_xcc_id() { return (unsigned)__builtin_amdgcn_s_getreg((3 << 11) | 20) & 0xFu; }
#define XB_SPIN(cond, bar) do { unsigned _sp = 0; while (cond) { __builtin_amdgcn_s_sleep(1); \
    if ((++_sp & 255u) == 0u) { if (xb_ld(&(bar)[XB_TMO])) break; if (_sp > XB_SPIN_CAP) { atomicAdd(&(bar)[XB_TMO], 1u); break; } } } } while (0)

struct XcdBarrier {
    unsigned* bar; unsigned x;
    volatile LAS unsigned* st;
};

__device__ __forceinline__ XcdBarrier xcd_barrier_post(unsigned* bar, volatile LAS unsigned* st) {
    XcdBarrier b; b.bar = bar; b.x = xb_xcc_id(); b.st = st;
    if (threadIdx.x == 0) (void)xb_add(&bar[XB_XCNT(b.x)], 1u);
    return b;
}
__device__ __forceinline__ void xcd_barrier_complete(unsigned* bar, unsigned x, unsigned& nloc, unsigned& nx) {
    const unsigned G = gridDim.x * gridDim.y * gridDim.z;
    unsigned sum, cnt, mine, sp = 0u;
    for (;;) {
        sum = 0u; cnt = 0u; mine = 0u;
#pragma unroll
        for (unsigned j = 0; j < 16; ++j) { const unsigned c = xb_ld(&bar[XB_XCNT(j)]); sum += c; cnt += (c > 0u) ? 1u : 0u; mine = (j == x) ? c : mine; }
        if (sum == G) break;
        __builtin_amdgcn_s_sleep(1);
        if ((++sp & 255u) == 0u) { if (xb_ld(&bar[XB_TMO])) break; if (sp > XB_SPIN_CAP) { atomicAdd(&bar[XB_TMO], 1u); break; } }
    }
    nloc = mine > 0u ? mine : 1u; nx = cnt > 0u ? cnt : 1u;
}

__device__ __forceinline__ void xcd_barrier(const XcdBarrier& b) {
    asm volatile("s_waitcnt vmcnt(0)" ::: "memory");
    __syncthreads();
    if (threadIdx.x == 0) {
        unsigned* bar = b.bar;
        __builtin_amdgcn_s_waitcnt(0);
        unsigned nloc = b.st[0], nx = b.st[1];
        if (nloc == 0u) { xcd_barrier_complete(bar, b.x, nloc, nx); b.st[0] = nloc; b.st[1] = nx; }
        const unsigned old = xb_add(&bar[XB_XSUB(b.x)], 1u);
        const unsigned gen = old / nloc;
        if (old + 1u == (gen + 1u) * nloc) {
            __builtin_amdgcn_fence(__ATOMIC_RELEASE, "agent");
            asm volatile("s_waitcnt vmcnt(0)" ::: "memory");
            const unsigned og = xb_add(&bar[XB_TOP], 1u);
            const unsigned tg = og / nx;
            if (og + 1u == (tg + 1u) * nx) xb_add(&bar[XB_TOPGEN], 1u);
            else XB_SPIN(xb_ld(&bar[XB_TOPGEN]) == tg, bar);
            __builtin_amdgcn_fence(__ATOMIC_ACQUIRE, "agent");
            xb_add(&bar[XB_XGEN(b.x)], 1u);
            asm volatile("s_waitcnt vmcnt(0)" ::: "memory");
        } else {
            XB_SPIN(xb_ld(&bar[XB_XGEN(b.x)]) == gen, bar);
            __builtin_amdgcn_fence(__ATOMIC_ACQUIRE, "agent");
            asm volatile("s_waitcnt vmcnt(0)" ::: "memory");
        }
    }
    __syncthreads();
}

__global__ void __launch_bounds__(512, 2) fwd_megakernel(Params p) {
    extern __shared__ __attribute__((aligned(16))) unsigned char lds_raw[];
    LAS unsigned char* lds = (LAS unsigned char*)lds_raw;
    cg::grid_group grid = cg::this_grid();
    const int tid = threadIdx.x, lane = tid & 63, wave = __builtin_amdgcn_readfirstlane(tid >> 6);
    const int G = gridDim.x, bx = blockIdx.x;
    unsigned char* ws = p.ws;
    const float* x_in = p.in[0];
    bf16_t* XG = (bf16_t*)(ws + WS_XG); bf16_t* Zb = (bf16_t*)(ws + WS_Z); bf16_t* Yb = (bf16_t*)(ws + WS_Y); bf16_t* Hb = (bf16_t*)(ws + WS_H);
    float* SSQ = (float*)(ws + WS_SSQ); float* SSQ2 = (float*)(ws + WS_SSQ2); float* ROPEC = (float*)(ws + WS_ROPE); float* ROPES = ROPEC + SEQL * 32; float* Gt = (float*)(ws + WS_G);
    unsigned* ctl = (unsigned*)(ws + WS_CTL);
    const int lo = p.ph_lo, hi_ph = p.ph_hi;
    volatile LAS unsigned* bst = (volatile LAS unsigned*)(lds + 143360 + 16);
    if (tid < 2) bst[tid] = 0u;
    __syncthreads();
    XcdBarrier bar = xcd_barrier_post(ctl + 1024, bst);
    if (lo < 0) grid.sync();
#define IN_PH(k) (lo <= (k) && (k) < hi_ph)
#define SEAM(k) do { if (IN_PH(k) && IN_PH((k) + 1)) xcd_barrier(bar); } while (0)

    if (IN_PH(0)) {
        LAS float* scr = (LAS float*)(lds + wave * 16384);
        const int gw = bx * 8 + wave, NGW = G * 8;
        constexpr int I_IN = (DMODEL / 64) * (NZT / 32), I_OUT = (DMODEL / 64) * (DMODEL / 32), I_F1 = (DMODEL / 64) * (DFF / 32), I_F2 = (DFF / 64) * (DMODEL / 32);
        constexpr int I_LAYER = I_IN + I_OUT + I_F1 + I_F2;
        for (int it = gw; it < DEPTH * I_LAYER; it += NGW) {
            const int l = it / I_LAYER; int r = it % I_LAYER;
            if (r < I_IN) { tr_item<true>(p.in[2] + (size_t)l * DMODEL * 2572, p.in[1] + l * DMODEL, DMODEL, 2572, (bf16_t*)(ws + WS_WIN + l * WIN_L), NZT / 32, r, scr, lane); continue; } r -= I_IN;
            if (r < I_OUT) { tr_item<false>(p.in[12] + (size_t)l * DMODEL * DMODEL, nullptr, DMODEL, DMODEL, (bf16_t*)(ws + WS_WOUT + l * WOUT_L), DMODEL / 32, r, scr, lane); continue; } r -= I_OUT;
            if (r < I_F1) { tr_item<false>(p.in[14] + (size_t)l * DMODEL * DFF, p.in[13] + l * DMODEL, DMODEL, DFF, (bf16_t*)(ws + WS_WFF1 + l * WFF_L), DFF / 32, r, scr, lane); continue; } r -= I_F1;
            tr_item<false>(p.in[15] + (size_t)l * DFF * DMODEL, nullptr, DFF, DMODEL, (bf16_t*)(ws + WS_WFF2 + l * WFF_L), DMODEL / 32, r, scr, lane);
        }
        for (int i = bx * 512 + tid; i < SEQL * 32; i += G * 512) {
            const int pos = i >> 5, j = i & 31;
            double inv = 1.0; for (int q = 0; q < j; ++q) inv *= 0.7498942093324558;
            const float ang = (float)pos * (float)inv;
            double rev = (double)ang * 0.15915494309189535; rev -= __builtin_rint(rev);
            ROPEC[i] = __builtin_amdgcn_cosf((float)rev); ROPES[i] = __builtin_amdgcn_sinf((float)rev);
        }
        for (int m = gw; m < MTOK; m += 2 * NGW) {
            const int m2 = m + NGW;
            const bool has2 = m2 < MTOK;
            const f32x4* xr = (const f32x4*)(x_in + (size_t)m * DMODEL) + lane;
            const f32x4* xr2 = (const f32x4*)(x_in + (size_t)(has2 ? m2 : m) * DMODEL) + lane;
            f32x4 va[4], vb[4];
#pragma unroll
            for (int j = 0; j < 4; ++j) { va[j] = xr[64 * j]; vb[j] = xr2[64 * j]; }
#pragma unroll
            for (int rr = 0; rr < 2; ++rr) {
                if (rr == 1 && !has2) break;
                const int mm = rr == 0 ? m : m2;
                unsigned long long* o8 = (unsigned long long*)(XG + (size_t)mm * DMODEL) + lane;
#pragma unroll
                for (int j = 0; j < 4; ++j) {
                    const f32x4 v = rr == 0 ? va[j] : vb[j];
                    float s = (v[0] * v[0] + v[1] * v[1]) + (v[2] * v[2] + v[3] * v[3]);
                    s += __shfl_xor(s, 1); s += __shfl_xor(s, 2); s += __shfl_xor(s, 4);
                    if ((lane & 7) == 0) SSQ[(size_t)mm * 32 + 8 * j + (lane >> 3)] = s;
                    o8[64 * j] = (unsigned long long)cvtpk(v[0], v[1]) | ((unsigned long long)cvtpk(v[2], v[3]) << 32);
                }
            }
        }
    }
    SEAM(0);

    for (int l = 0; l < DEPTH; ++l) {
        const int pb = 1 + 5 * l;
        if (IN_PH(pb)) {
            pg8::Gemm g{XG, (const bf16_t*)(ws + WS_WIN + l * WIN_L), MTOK, NZT, DMODEL}; pg8::StaticOrder S; S.init(MTOK, NZT, G, bx);
            pg8::EpiIn E{Zb, Gt, SSQ, ROPEC, ROPES, p.in[3] + l * 64, p.in[4] + l * 64, p.in[6] + l * 64, p.in[7] + l * 64, ws + WS_KT, ws + WS_VT};
            pg8::gemm_phase<pg8::EpiIn, pg8::StaticOrder, true, true>(lds, g, S, E);
        }
        SEAM(pb);
        if (IN_PH(pb + 1)) {
            MixCtx C{Zb, Gt, Yb, p.in[5] + l * 8, p.in[8] + l * 4, p.in[9] + l * 4, p.in[10] + l * 4, p.in[11] + l * 256, ws, ws + WS_KT, ws + WS_VT};
            MlScratch MS{(float*)(ws + WS_MLE), (float*)(ws + WS_MLB), (float*)(ws + WS_MLPM), (float*)(ws + WS_CL), (float*)(ws + WS_NL), (bf16_t*)(ws + WS_CP), (float*)(ws + WS_NP), (float*)(ws + WS_GC), (float*)(ws + WS_EM), (float*)(ws + WS_MP), ctl + 128 + 32 * l, ctl + 192 + 32 * l};
            LAS int* itm = (LAS int*)(lds + 143360);
            float* NF = (float*)(ws + WS_NFX); unsigned* cntF = ctl + 512 + 32 * l; unsigned* qctr = ctl + 64 * l;
            for (;;) {
                __syncthreads();
                if (tid == 0) *itm = (int)atomicAdd(qctr, 1u);
                __syncthreads();
                const int it = *itm;
                if (it >= N_ITEMS) break;
                constexpr int Q_ML1 = N_FX0, Q_ML2 = Q_ML1 + N_ML1, Q_FOXA = Q_ML2 + N_ML2, N_FOXA = 256, Q_ML3 = Q_FOXA + N_FOXA, Q_FOXB = Q_ML3 + N_ML3, Q_SWA = Q_FOXB + (N_FOX - N_FOXA);
                static_assert(Q_SWA + N_SWA == N_ITEMS, "queue map");
                if (it < Q_ML1) fx0_item(C, NF, cntF, it, lds);
                else if (it < Q_ML2) { const int k = it - Q_ML1; ml1_item(C, MS, k >> 3, k & 7, lds); }
                else if (it < Q_FOXA) { const int k = it - Q_ML2; ml2_item(C, MS, k >> 1, k & 1, lds); }
                else if (it < Q_ML3) {
                    if (tid == 0) { const unsigned x = xb_xcc_id() & 7u; int sel = 0;
                        for (unsigned t = 0; t < 8u; ++t) { const unsigned q = (x + t) & 7u; const unsigned j = atomicAdd(ctl + 640 + 16 * l + q, 1u); if (j < 32u) { sel = (int)(q * 32u + j); break; } }
                        itm[1] = sel; }
                    __syncthreads();
                    const int k = itm[1];
                    fox_item(C, NF, cntF, k >> 4, k & 15, lds); }
                else if (it < Q_FOXB) { const int k = it - Q_ML3; ml3_item(C, MS, k >> 4, k & 15, lds); }
                else if (it < Q_SWA) { const int k = it - Q_FOXB + N_FOXA; fox_item(C, NF, cntF, k & 15, k >> 4, lds); }
                else swa_item(C, it - Q_SWA, lds);
            }
        }
        SEAM(pb + 1);
        if (IN_PH(pb + 2)) {
            pg8::Gemm g{Yb, (const bf16_t*)(ws + WS_WOUT + l * WOUT_L), MTOK, DMODEL, DMODEL}; pg8::StaticOrder S; S.init(MTOK, DMODEL, G, bx);
            pg8::EpiRes E{XG, SSQ2, nullptr, nullptr};
            pg8::gemm_phase<pg8::EpiRes, pg8::StaticOrder, true, true>(lds, g, S, E);
        }
        SEAM(pb + 2);
        if (IN_PH(pb + 3)) {
            pg8::Gemm g{XG, (const bf16_t*)(ws + WS_WFF1 + l * WFF_L), MTOK, DFF, DMODEL}; pg8::StaticOrder S; S.init(MTOK, DFF, G, bx);
            pg8::EpiFF1 E{Hb};
            pg8::gemm_phase<pg8::EpiFF1, pg8::StaticOrder, true, true>(lds, g, S, E);
        }
        SEAM(pb + 3);
        if (IN_PH(pb + 4)) {
            pg8::Gemm g{Hb, (const bf16_t*)(ws + WS_WFF2 + l * WFF_L), MTOK, DMODEL, DFF}; pg8::StaticOrder S; S.init(MTOK, DMODEL, G, bx);
            pg8::EpiRes E{XG, SSQ, l + 1 == DEPTH ? p.out : nullptr, SSQ2};
            pg8::gemm_phase<pg8::EpiRes, pg8::StaticOrder, true, true>(lds, g, S, E);
        }
        SEAM(pb + 4);
    }
#undef IN_PH
#undef SEAM
}

constexpr int N_PHASES = 1 + 5 * DEPTH;
#ifndef MK_MULTI
#define MK_MULTI 0
#endif
extern "C" void kernel_launch(void* const* d_in, const int* in_sizes, int n_in, void* d_out, int out_size, void* d_ws, size_t ws_size, hipStream_t stream) {
    static int grid = 0;
    if (grid == 0) {
        if (n_in != 16 || out_size != MTOK * DMODEL || ws_size < WS_END) { fprintf(stderr, "kernel_launch: unexpected shapes (n_in %d out %d ws %zu)\n", n_in, out_size, ws_size); grid = -1; return; }
        int dev = 0, cus = 0, per_cu = 0;
        hipGetDevice(&dev); hipDeviceGetAttribute(&cus, hipDeviceAttributeMultiprocessorCount, dev);
        if (hipFuncSetAttribute((const void*)fwd_megakernel, hipFuncAttributeMaxDynamicSharedMemorySize, LDS_BYTES) != hipSuccess) { fprintf(stderr, "kernel_launch: hipFuncSetAttribute failed\n"); grid = -1; return; }
        if (hipOccupancyMaxActiveBlocksPerMultiprocessor(&per_cu, (const void*)fwd_megakernel, 512, LDS_BYTES) != hipSuccess || per_cu < 1) { fprintf(stderr, "kernel_launch: occupancy query says %d\n", per_cu); per_cu = 1; }
        (void)hipGetLastError();
        grid = cus;
        if (grid != 256) fprintf(stderr, "kernel_launch: %d CUs (expected 256)\n", grid);
    }
    if (grid < 0) return;
    hipMemsetAsync((char*)d_ws + WS_CTL, 0, CTL_BYTES, stream);
    Params a{};
    for (int i = 0; i < 16; ++i) a.in[i] = (const float*)d_in[i];
    a.out = (float*)d_out; a.ws = (unsigned char*)d_ws;
#if MK_MULTI
    for (int ph = 0; ph < N_PHASES; ++ph) { a.ph_lo = ph; a.ph_hi = ph + 1; hipLaunchKernelGGL(fwd_megakernel, dim3(grid), dim3(512), LDS_BYTES, stream, a); }
#else
    a.ph_lo = 0; a.ph_hi = N_PHASES;
    void* args[] = {&a};
    hipError_t e = hipLaunchCooperativeKernel((const void*)fwd_megakernel, dim3(grid), dim3(512), args, LDS_BYTES, stream);
    if (e != hipSuccess) fprintf(stderr, "cooperative launch failed: %s (grid %d)\n", hipGetErrorString(e), grid);
#endif
}
```

```cpp
#include <hip/hip_runtime.h>
#include <hip/hip_cooperative_groups.h>
#include <cstdio>
#include <cstdint>
#include <cmath>
namespace cg = cooperative_groups;
namespace pg8 {
#define PG8_LAS __attribute__((address_space(3)))
typedef unsigned short bf16_t;
typedef short bf16x8 __attribute__((ext_vector_type(8)));
typedef float f32x4 __attribute__((ext_vector_type(4)));
typedef unsigned u32x4 __attribute__((ext_vector_type(4)));
constexpr int BM = 256, BK = 64, HALF = 128, HTB = HALF * BK * 2  , STAGE_BYTES = 8 * HTB, NXCD = 8, WGM = 8;

__host__ __device__ __forceinline__ int lds_byte(int r, int c) { const int st = (r >> 4) * 2 + (c >> 5), rr = r & 15, cc = c & 31, ob = rr * 64 + cc * 2; return st * 1024 + (ob ^ (((ob >> 9) & 1) << 5)); }
__host__ __device__ __forceinline__ void stage_rc(int b, int& R, int& C) { const int st = b / 1024, sb = b % 1024, swz = sb ^ (((sb >> 9) & 1) << 5); R = (st >> 1) * 16 + swz / 64; C = (st & 1) * 32 + (swz % 64) / 2; }
__host__ __device__ __forceinline__ int perm32(int rho) { const int n = rho >> 4, i = rho & 15; return 8 * (i >> 2) + 4 * n + (i & 3); }

struct Unit { int pm, pn; };
struct Gemm { const bf16_t* A; const bf16_t* Bt; int M, N, K; };

struct StaticOrder {
    int nM, nN, nwg, G, c;
    __host__ __device__ void init(int M, int N, int G_, int c_) { nM = M / BM; nN = N / BM; nwg = nM * nN; G = G_; c = c_; }
    __host__ __device__ bool next(int i, Unit& u) const {
        const long L = (long)i * G + c; if (L >= nwg) return false;
        int wgid = (int)L; { const int q = nwg / NXCD, r = nwg % NXCD, xcd = wgid % NXCD, off = wgid / NXCD; wgid = (xcd < r ? xcd * (q + 1) : r * (q + 1) + (xcd - r) * q) + off; }
        const int nig = WGM * nN, gid = wgid / nig, fm = gid * WGM, gsz = (nM - fm) < WGM ? (nM - fm) : WGM;
        u.pm = fm + ((wgid % nig) % gsz); u.pn = (wgid % nig) / gsz; return true;
    }
    __device__ __forceinline__ void a_ready(const Unit&) const {}
    __device__ __forceinline__ void done(const Unit&) const {}
};

__device__ __forceinline__ unsigned cvt_pk_bf16(float lo, float hi) { unsigned r; asm volatile("v_cvt_pk_bf16_f32 %0, %1, %2" : "=v"(r) : "v"(lo), "v"(hi)); return r; }
constexpr float EPS = 1e-6f;
constexpr float LOG2E = 1.4426950408889634f;
constexpr float C2 = 0.125f * LOG2E;
constexpr int ZP = 2560;

__device__ __forceinline__ float row_rstd(const float* ssq, int row, int fq) {
    const float* sp = ssq + (size_t)row * 32 + fq * 8;
    const f32x4 s0 = *(const f32x4*)sp, s1 = *(const f32x4*)(sp + 4);
    float t = ((s0[0] + s0[1]) + (s0[2] + s0[3])) + ((s1[0] + s1[1]) + (s1[2] + s1[3]));
    t += __shfl_xor(t, 16); t += __shfl_xor(t, 32);
    return rsqrtf(t * (1.0f / 1024.0f) + EPS);
}

struct EpiIn {
    static constexpr bool PERM = true, AFTER_DRAIN = false;
    bf16_t* Z; float* G; const float* ssq; const float* ropec; const float* ropes; const float* gqa; const float* gka; const float* gqb; const float* gkb;
    unsigned char* KT; unsigned char* VT;
    __device__ __forceinline__ void operator()(const f32x4 (&acc)[2][2][4][2], const Unit& u, int wr, int wc, int fr, int fq) const {
        const int pn = u.pn;
        int type = 0; const float* gsel = gqa; bool rp = false; float sc = 1.f;
        if (pn < 2) { type = 1; gsel = gqa; rp = true; sc = C2; }
        else if (pn == 2) { if (wc < 2) { type = 1; gsel = gka; rp = true; } }
        else if (pn == 3) { type = 1; gsel = gqb; sc = C2; }
        else if (pn == 4) { type = 1; gsel = gkb; }
        else if (pn == 7) { sc = 0.125f; }
        else if (pn == 9) { type = 2; }
        else if (pn == 10) { type = 3; }
        if (type == 3 && wc != 0) return;
        const int dcol = 8 * fq;
        unsigned char* tp = nullptr;
        if (pn == 4 || pn == 5) { const size_t tb0 = (size_t)((((u.pm * BM) >> 12) * 4 + wc) * 64 + (((u.pm * BM) & 4095) >> 6) + wr) * 8192;
            tp = pn == 4 ? KT + tb0 + fq * 1024 + fr * 16 : VT + tb0 + (fr * 4 + fq) * 16; }
        float gn[2][8];
#pragma unroll
        for (int bj = 0; bj < 2; ++bj)
#pragma unroll
            for (int i = 0; i < 8; ++i) gn[bj][i] = (type == 1) ? gsel[32 * bj + dcol + i] : 1.f;
#pragma unroll
        for (int ai = 0; ai < 2; ++ai)
#pragma unroll
            for (int m = 0; m < 4; ++m) {
                const int row = u.pm * BM + ai * HALF + wr * 64 + m * 16 + fr;
                const float rstd = row_rstd(ssq, row, fq);
                float v[2][8];
#pragma unroll
                for (int bj = 0; bj < 2; ++bj)
#pragma unroll
                    for (int n = 0; n < 2; ++n)
#pragma unroll
                        for (int e = 0; e < 4; ++e) v[bj][4 * n + e] = acc[ai][bj][m][n][e] * rstd;
                if (type == 1) {
                    float ss = 0.f;
#pragma unroll
                    for (int bj = 0; bj < 2; ++bj)
#pragma unroll
                        for (int i = 0; i < 8; ++i) ss += v[bj][i] * v[bj][i];
                    ss += __shfl_xor(ss, 16); ss += __shfl_xor(ss, 32);
                    const float hr = rsqrtf(ss * (1.0f / 64.0f) + EPS);
#pragma unroll
                    for (int bj = 0; bj < 2; ++bj)
#pragma unroll
                        for (int i = 0; i < 8; ++i) v[bj][i] *= hr * gn[bj][i];
                    if (rp) {
                        const int pos = row & 4095;
                        const f32x4 c0 = *(const f32x4*)(ropec + pos * 32 + dcol), c1 = *(const f32x4*)(ropec + pos * 32 + dcol + 4);
                        const f32x4 s0 = *(const f32x4*)(ropes + pos * 32 + dcol), s1 = *(const f32x4*)(ropes + pos * 32 + dcol + 4);
#pragma unroll
                        for (int i = 0; i < 8; ++i) {
                            const float c = i < 4 ? c0[i & 3] : c1[i & 3], s = i < 4 ? s0[i & 3] : s1[i & 3];
                            const float x1 = v[0][i], x2 = v[1][i];
                            v[0][i] = x1 * c - x2 * s; v[1][i] = x2 * c + x1 * s;
                        }
                    }
#pragma unroll
                    for (int bj = 0; bj < 2; ++bj)
#pragma unroll
                        for (int i = 0; i < 8; ++i) v[bj][i] *= sc;
                } else if (type == 2) {
#pragma unroll
                    for (int bj = 0; bj < 2; ++bj)
#pragma unroll
                        for (int i = 0; i < 8; ++i) v[bj][i] = 1.0f / (1.0f + __expf(-v[bj][i]));
                } else if (type == 0) {
#pragma unroll
                    for (int bj = 0; bj < 2; ++bj)
#pragma unroll
                        for (int i = 0; i < 8; ++i) v[bj][i] *= sc;
                }
                if (type == 3) {
                    float* gp = G + (size_t)row * 16;
                    if (fq == 0) { *(f32x4*)gp = (f32x4){v[0][0], v[0][1], v[0][2], v[0][3]}; *(f32x4*)(gp + 4) = (f32x4){v[0][4], v[0][5], v[0][6], v[0][7]}; }
                    else if (fq == 1) { *(f32x4*)(gp + 8) = (f32x4){v[0][0], v[0][1], v[0][2], v[0][3]}; }
                } else {
#pragma unroll
                    for (int bj = 0; bj < 2; ++bj) {
                        u32x4 w; w.x = cvt_pk_bf16(v[bj][0], v[bj][1]); w.y = cvt_pk_bf16(v[bj][2], v[bj][3]); w.z = cvt_pk_bf16(v[bj][4], v[bj][5]); w.w = cvt_pk_bf16(v[bj][6], v[bj][7]);
                        if (pn == 4) *(u32x4*)(tp + ai * 16384 + bj * 4096 + m * 256) = w;
                        else if (pn == 5) *(u32x4*)(tp + ai * 16384 + bj * 4096 + m * 1024) = w;
                        else
                        *(u32x4*)(Z + (size_t)row * ZP + 256 * pn + 64 * wc + 32 * bj + dcol) = w;
                    }
                }
                if (m & 1) asm volatile("" ::: "memory");
            }
    }
};

struct EpiRes {
    static constexpr bool PERM = true, AFTER_DRAIN = false;
    bf16_t* XB; float* ssq; float* out; const float* rsq;
    __device__ __forceinline__ void operator()(const f32x4 (&acc)[2][2][4][2], const Unit& u, int wr, int wc, int fr, int fq) const {
        float r2[8];
#pragma unroll
        for (int j = 0; j < 8; ++j) r2[j] = 1.f;
        if (rsq) {
#pragma unroll
            for (int j = 0; j < 8; ++j) { const float r = row_rstd(rsq, u.pm * BM + (j >> 2) * HALF + wr * 64 + (j & 3) * 16 + fr, fq); r2[j] = r * r; }
        }
#pragma unroll
        for (int bj = 0; bj < 2; ++bj) {
            const int col0 = u.pn * BM + bj * HALF + wc * 32 + 8 * fq;
#pragma unroll
            for (int ai = 0; ai < 2; ++ai)
#pragma unroll
                for (int m = 0; m < 4; ++m) {
                    const int row = u.pm * BM + ai * HALF + wr * 64 + m * 16 + fr;
                    const size_t off = (size_t)row * 1024 + col0;
                    const u32x4 bw = *(const u32x4*)(XB + off);
                    f32x4 x0 = acc[ai][bj][m][0] * r2[ai * 4 + m], x1 = acc[ai][bj][m][1] * r2[ai * 4 + m];
                    x0[0] += __builtin_bit_cast(float, bw.x << 16); x0[1] += __builtin_bit_cast(float, bw.x & 0xffff0000u);
                    x0[2] += __builtin_bit_cast(float, bw.y << 16); x0[3] += __builtin_bit_cast(float, bw.y & 0xffff0000u);
                    x1[0] += __builtin_bit_cast(float, bw.z << 16); x1[1] += __builtin_bit_cast(float, bw.z & 0xffff0000u);
                    x1[2] += __builtin_bit_cast(float, bw.w << 16); x1[3] += __builtin_bit_cast(float, bw.w & 0xffff0000u);
                    if (out) { *(f32x4*)(out + off) = x0; *(f32x4*)(out + off + 4) = x1; }
                    else {
                        float ss = ((x0[0] * x0[0] + x0[1] * x0[1]) + (x0[2] * x0[2] + x0[3] * x0[3])) + ((x1[0] * x1[0] + x1[1] * x1[1]) + (x1[2] * x1[2] + x1[3] * x1[3]));
                        ss += __shfl_xor(ss, 16); ss += __shfl_xor(ss, 32);
                        if (fq == 0) ssq[(size_t)row * 32 + u.pn * 8 + bj * 4 + wc] = ss;
                        u32x4 w; w.x = cvt_pk_bf16(x0[0], x0[1]); w.y = cvt_pk_bf16(x0[2], x0[3]); w.z = cvt_pk_bf16(x1[0], x1[1]); w.w = cvt_pk_bf16(x1[2], x1[3]);
                        *(u32x4*)(XB + off) = w;
                    }
                }
        }
    }
};

struct EpiFF1 {
    static constexpr bool PERM = true, AFTER_DRAIN = false;
    bf16_t* H;
    __device__ __forceinline__ void operator()(const f32x4 (&acc)[2][2][4][2], const Unit& u, int wr, int wc, int fr, int fq) const {
#pragma unroll
        for (int ai = 0; ai < 2; ++ai)
#pragma unroll
            for (int m = 0; m < 4; ++m) {
                const int row = u.pm * BM + ai * HALF + wr * 64 + m * 16 + fr;
#pragma unroll
                for (int bj = 0; bj < 2; ++bj) {
                    const int col0 = u.pn * BM + bj * HALF + wc * 32 + 8 * fq;
                    f32x4 a = acc[ai][bj][m][0], b = acc[ai][bj][m][1];
#pragma unroll
                    for (int e = 0; e < 4; ++e) { a[e] = fmaxf(a[e], 0.f); a[e] *= a[e]; b[e] = fmaxf(b[e], 0.f); b[e] *= b[e]; }
                    u32x4 w; w.x = cvt_pk_bf16(a[0], a[1]); w.y = cvt_pk_bf16(a[2], a[3]); w.z = cvt_pk_bf16(b[0], b[1]); w.w = cvt_pk_bf16(b[2], b[3]);
                    *(u32x4*)(H + (size_t)row * 4096 + col0) = w;
                }
            }
    }
};

template <class Epi, class Sched, bool ALIGN_EPI = false, bool SP2 = false>
__device__ __forceinline__ void gemm_phase(PG8_LAS unsigned char* lds, const Gemm g, const Sched& S, const Epi& E) {
    int tid_ = threadIdx.x; asm volatile("" : "+v"(tid_));
    const int tid = tid_, wid = __builtin_amdgcn_readfirstlane(tid >> 6), lane = tid & 63, wr = wid >> 2, wc = wid & 3, fr = lane & 15, fq = lane >> 4;
    const int K = g.K, nt = K / BK;
    unsigned voffA[2], voffB[2];
#pragma unroll
    for (int i = 0; i < 2; ++i) { int R, C; stage_rc(tid * 16 + i * 8192, R, C); const int Rb = Epi::PERM ? ((R & ~31) + perm32(R & 31)) : R;
        voffA[i] = (unsigned)(R * K + C) * 2u; voffB[i] = (unsigned)(Rb * K + C) * 2u; }
    const size_t kstep = (size_t)(BK * 2);
    const size_t hstep = (size_t)HALF * K * 2;
    const size_t tstep = 2 * hstep;
    const unsigned ldsw = (unsigned)wid * 1024u;
    const int aoff = lds_byte(wr * 64 + fr, fq * 8), boff = lds_byte(wc * 32 + fr, fq * 8);
#define PG8_SA(b, h) (((b) * 2 + (h)) * HTB)
#define PG8_SB(b, h) ((4 + (b) * 2 + (h)) * HTB)
#define PG8_STAGE(bufoff, gbase, voff) do { _Pragma("unroll") for (int _i = 0; _i < 2; ++_i) \
        __builtin_amdgcn_global_load_lds((const unsigned*)((const char*)(gbase) + (voff)[_i]), (PG8_LAS unsigned*)(lds + (bufoff) + ldsw + _i * 8192), 16, 0, 0); } while (0)
#define PG8_LDA(dst, b, h) do { _Pragma("unroll") for (int m = 0; m < 4; ++m) _Pragma("unroll") for (int k = 0; k < 2; ++k) dst[m][k] = *(const PG8_LAS bf16x8*)(lds + PG8_SA(b, h) + aoff + m * 2048 + k * 1024); } while (0)
#define PG8_LDB(dst, b, h) do { _Pragma("unroll") for (int n = 0; n < 2; ++n) _Pragma("unroll") for (int k = 0; k < 2; ++k) dst[n][k] = *(const PG8_LAS bf16x8*)(lds + PG8_SB(b, h) + boff + n * 2048 + k * 1024); } while (0)
#define PG8_MMA(ai, bj, At, Bt) do { __builtin_amdgcn_s_setprio(1); _Pragma("unroll") for (int m = 0; m < 4; ++m) _Pragma("unroll") for (int n = 0; n < 2; ++n) _Pragma("unroll") for (int k = 0; k < 2; ++k) \
        acc[ai][bj][m][n] = __builtin_amdgcn_mfma_f32_16x16x32_bf16(Bt[n][k], At[m][k], acc[ai][bj][m][n], 0, 0, 0); __builtin_amdgcn_s_setprio(0); } while (0)
#define PG8_WAIT_V(n) asm volatile("s_waitcnt vmcnt(" #n ")" ::: "memory")
#define PG8_WAIT_L(n) asm volatile("s_waitcnt lgkmcnt(" #n ")" ::: "memory")
#define PG8_BAR __builtin_amdgcn_s_barrier()
#define PG8_SCHED __builtin_amdgcn_sched_barrier(0)
    Unit cur, nxt; int ui = 0;
    if (!S.next(0, cur)) return;
    f32x4 acc[2][2][4][2];
#pragma unroll
    for (int a = 0; a < 2; ++a)
#pragma unroll
        for (int b = 0; b < 2; ++b)
#pragma unroll
            for (int m = 0; m < 4; ++m)
#pragma unroll
                for (int n = 0; n < 2; ++n) acc[a][b][m][n] = (f32x4){0.f, 0.f, 0.f, 0.f};
    bf16x8 At[4][2], B0[2][2], B1[2][2];
    const char* cA = (const char*)g.A + (size_t)cur.pm * tstep; const char* cB = (const char*)g.Bt + (size_t)cur.pn * tstep;
    S.a_ready(cur);
    if constexpr (SP2) {
        PG8_STAGE(PG8_SB(0, 0), cB, voffB); PG8_STAGE(PG8_SB(0, 1), cB + hstep, voffB); PG8_STAGE(PG8_SA(0, 0), cA, voffA); PG8_STAGE(PG8_SA(0, 1), cA + hstep, voffA);
        if (wr == 1) PG8_BAR;
        PG8_WAIT_V(2); PG8_BAR;
        PG8_STAGE(PG8_SB(1, 0), cB + kstep, voffB); PG8_STAGE(PG8_SA(1, 0), cA + kstep, voffA); PG8_STAGE(PG8_SB(1, 1), cB + hstep + kstep, voffB);
        PG8_WAIT_V(6); PG8_BAR;
    } else {
        PG8_STAGE(PG8_SB(0, 0), cB, voffB); PG8_STAGE(PG8_SA(0, 0), cA, voffA); PG8_STAGE(PG8_SB(0, 1), cB + hstep, voffB); PG8_STAGE(PG8_SA(0, 1), cA + hstep, voffA);
        if (wr == 1) PG8_BAR;
        PG8_WAIT_V(4); PG8_BAR;
        PG8_STAGE(PG8_SB(1, 0), cB + kstep, voffB); PG8_STAGE(PG8_SA(1, 0), cA + kstep, voffA); PG8_STAGE(PG8_SB(1, 1), cB + hstep + kstep, voffB);
        PG8_WAIT_V(6); PG8_BAR;
    }
    for (;;) {
        const bool has_next = S.next(ui + 1, nxt);
        const char* nA = has_next ? (const char*)g.A + (size_t)nxt.pm * tstep : cA; const char* nB = has_next ? (const char*)g.Bt + (size_t)nxt.pn * tstep : cB;
        for (int t = 0; t < nt; t += 2) {
            const bool last = (t == nt - 2);
            const char* a1 = cA + (size_t)(t + 1) * kstep;
            const char* a2 = last ? nA : cA + (size_t)(t + 2) * kstep; const char* b2 = last ? nB : cB + (size_t)(t + 2) * kstep;
            const char* a3 = a2 + kstep; const char* b3 = b2 + kstep;
            if (last && has_next) S.a_ready(nxt);
            if constexpr (SP2) {
            PG8_LDB(B0, 0, 0); PG8_LDB(B1, 0, 1); PG8_SCHED; PG8_LDA(At, 0, 0); PG8_STAGE(PG8_SA(1, 1), a1 + hstep, voffA);
            PG8_WAIT_V(8); PG8_WAIT_L(0); PG8_BAR; PG8_MMA(0, 0, At, B0); PG8_MMA(0, 1, At, B1); PG8_BAR; PG8_SCHED;
            PG8_LDA(At, 0, 1); PG8_STAGE(PG8_SB(0, 0), b2, voffB); PG8_STAGE(PG8_SB(0, 1), b2 + hstep, voffB); PG8_STAGE(PG8_SA(0, 0), a2, voffA);
            PG8_WAIT_V(8); PG8_WAIT_L(0); PG8_BAR; PG8_MMA(1, 0, At, B0); PG8_MMA(1, 1, At, B1); PG8_BAR; PG8_SCHED;
            PG8_LDB(B0, 1, 0); PG8_LDB(B1, 1, 1); PG8_SCHED; PG8_LDA(At, 1, 0); PG8_STAGE(PG8_SA(0, 1), a2 + hstep, voffA);
            PG8_WAIT_V(8); PG8_WAIT_L(0); PG8_BAR; PG8_MMA(0, 0, At, B0); PG8_MMA(0, 1, At, B1); PG8_BAR; PG8_SCHED;
            PG8_LDA(At, 1, 1); PG8_STAGE(PG8_SB(1, 0), b3, voffB); PG8_STAGE(PG8_SB(1, 1), b3 + hstep, voffB); PG8_STAGE(PG8_SA(1, 0), a3, voffA);
            PG8_WAIT_V(8); PG8_WAIT_L(0); PG8_BAR; PG8_MMA(1, 0, At, B0); PG8_MMA(1, 1, At, B1); PG8_BAR; PG8_SCHED;
            } else {
            PG8_LDB(B0, 0, 0); PG8_SCHED; PG8_LDA(At, 0, 0); PG8_STAGE(PG8_SA(1, 1), a1 + hstep, voffA);
            PG8_WAIT_L(8); PG8_BAR; PG8_WAIT_L(0); PG8_MMA(0, 0, At, B0); PG8_BAR; PG8_SCHED;
            PG8_LDB(B1, 0, 1); PG8_STAGE(PG8_SB(0, 0), b2, voffB);
            PG8_BAR; PG8_WAIT_L(0); PG8_MMA(0, 1, At, B1); PG8_BAR;
            PG8_LDA(At, 0, 1); PG8_STAGE(PG8_SA(0, 0), a2, voffA);
            PG8_BAR; PG8_WAIT_L(0); PG8_MMA(1, 0, At, B0); PG8_BAR; PG8_SCHED;
            PG8_STAGE(PG8_SB(0, 1), b2 + hstep, voffB);
            PG8_WAIT_V(6); PG8_BAR; PG8_MMA(1, 1, At, B1); PG8_BAR;
            PG8_LDB(B0, 1, 0); PG8_SCHED; PG8_LDA(At, 1, 0); PG8_STAGE(PG8_SA(0, 1), a2 + hstep, voffA);
            PG8_WAIT_L(8); PG8_BAR; PG8_WAIT_L(0); PG8_MMA(0, 0, At, B0); PG8_BAR; PG8_SCHED;
            PG8_LDB(B1, 1, 1); PG8_STAGE(PG8_SB(1, 0), b3, voffB);
            PG8_BAR; PG8_WAIT_L(0); PG8_MMA(0, 1, At, B1); PG8_BAR;
            PG8_LDA(At, 1, 1); PG8_STAGE(PG8_SA(1, 0), a3, voffA);
            PG8_BAR; PG8_WAIT_L(0); PG8_MMA(1, 0, At, B0); PG8_BAR; PG8_SCHED;
            PG8_STAGE(PG8_SB(1, 1), b3 + hstep, voffB);
            PG8_WAIT_V(6); PG8_BAR; PG8_MMA(1, 1, At, B1); PG8_BAR;
            }
        }
        if constexpr (ALIGN_EPI) { if (wr == 0) PG8_BAR; }
        if constexpr (!Epi::AFTER_DRAIN) { E(acc, cur, wr, wc, fr, fq); S.done(cur); }
        if (!has_next) break;
#pragma unroll
        for (int a = 0; a < 2; ++a)
#pragma unroll
            for (int b = 0; b < 2; ++b)
#pragma unroll
                for (int m = 0; m < 4; ++m)
#pragma unroll
                    for (int n = 0; n < 2; ++n) acc[a][b][m][n] = (f32x4){0.f, 0.f, 0.f, 0.f};
        cur = nxt; cA = nA; cB = nB; ++ui;
        if constexpr (ALIGN_EPI) { if (wr == 1) PG8_BAR; }
    }
    PG8_WAIT_V(0);
    if constexpr (!ALIGN_EPI) { if (wr == 0) PG8_BAR; }
    PG8_BAR;
    if constexpr (Epi::AFTER_DRAIN) { E.fused(acc, cur, wr, wc, fr, fq, lds, wid, lane); S.done(cur); }
#undef PG8_SA
#undef PG8_SB
#undef PG8_STAGE
#undef PG8_LDA
#undef PG8_LDB
#undef PG8_MMA
#undef PG8_WAIT_V
#undef PG8_WAIT_L
#undef PG8_BAR
#undef PG8_SCHED
}
}
#define LAS __attribute__((address_space(3)))
typedef unsigned short bf16_t;
typedef short bf16x8 __attribute__((ext_vector_type(8)));
typedef short s16x4 __attribute__((ext_vector_type(4)));
typedef float f32x4 __attribute__((ext_vector_type(4)));
typedef float f32x16 __attribute__((ext_vector_type(16)));
typedef unsigned u32x4 __attribute__((ext_vector_type(4)));
typedef unsigned u32x2 __attribute__((ext_vector_type(2)));
using pg8::ZP; using pg8::LOG2E; using pg8::EPS;
__device__ __forceinline__ int crow(int r, int hi) { return (r & 3) + 8 * (r >> 2) + 4 * hi; }
__device__ __forceinline__ unsigned cvtpk(float lo, float hi) { unsigned r; asm volatile("v_cvt_pk_bf16_f32 %0, %1, %2" : "=v"(r) : "v"(lo), "v"(hi)); return r; }
__device__ __forceinline__ unsigned f2bf(float f) { unsigned u = __builtin_bit_cast(unsigned, f); return (u + 0x7fffu + ((u >> 16) & 1u)) >> 16; }
__device__ __forceinline__ float bf2f(unsigned short h) { return __builtin_bit_cast(float, (unsigned)h << 16); }
__device__ __forceinline__ float ex2(float x) { return __builtin_amdgcn_exp2f(x); }
#define VM_WAIT0() asm volatile("s_waitcnt vmcnt(0)" ::: "memory")
#define LGKM_WAIT0() asm volatile("s_waitcnt lgkmcnt(0)" ::: "memory")

__device__ __forceinline__ void dma_k(LAS unsigned char* slot, const bf16_t* src, int pitch, int w, int lane) {
    const bf16_t* s = src + (size_t)lane * pitch + w * 8;
    __builtin_amdgcn_global_load_lds((const unsigned*)s, (LAS unsigned*)(slot + w * 1024), 16, 0, 0);
}
__device__ __forceinline__ void dma_v(LAS unsigned char* slot, const bf16_t* src, int pitch, int w, int lane) {
    const bf16_t* s = src + (size_t)(16 * (w & 3) + (lane >> 2)) * pitch + (w >> 2) * 32 + (lane & 3) * 8;
    __builtin_amdgcn_global_load_lds((const unsigned*)s, (LAS unsigned*)(slot + w * 1024), 16, 0, 0);
}
__device__ __forceinline__ void dma_lin(LAS unsigned char* slot, const unsigned char* src, int w, int lane) {
    __builtin_amdgcn_global_load_lds((const unsigned*)(src + w * 1024 + lane * 16), (LAS unsigned*)(slot + w * 1024), 16, 0, 0);
}
__device__ __forceinline__ void qkt(f32x16& p0, f32x16& p1, const LAS unsigned char* Kslot, const bf16x8* qr, int r32, int hi, f32x16 z0 = f32x16{}, f32x16 z1 = f32x16{}) {
    const LAS unsigned char* kb = Kslot + hi * 1024 + r32 * 16;
#pragma unroll
    for (int d0 = 0; d0 < 4; ++d0) {
        const bf16x8 b0 = *(const LAS bf16x8*)(kb + d0 * 2048);
        const bf16x8 b1 = *(const LAS bf16x8*)(kb + d0 * 2048 + 512);
        z0 = __builtin_amdgcn_mfma_f32_32x32x16_bf16(b0, qr[d0], z0, 0, 0, 0);
        z1 = __builtin_amdgcn_mfma_f32_32x32x16_bf16(b1, qr[d0], z1, 0, 0, 0);
    }
    p0 = z0; p1 = z1;
}
__device__ __forceinline__ int vt_lane_off(int lane) { const int hi = lane >> 5; return ((lane >> 4) & 1) * 32 + (lane & 3) * 8 + (4 * hi + ((lane & 15) >> 2)) * 64; }
__device__ __forceinline__ bf16x8 vfrag(int vb, int d0, int ks) {
    s16x4 lo, hh;
    asm volatile("ds_read_b64_tr_b16 %0, %1" : "=v"(lo) : "v"(vb + d0 * 4096 + ks * 1024) : "memory");
    asm volatile("ds_read_b64_tr_b16 %0, %1" : "=v"(hh) : "v"(vb + d0 * 4096 + ks * 1024 + 512) : "memory");
    asm volatile("s_waitcnt lgkmcnt(0)" : "+v"(lo), "+v"(hh) :: "memory");
    return (bf16x8){lo[0], lo[1], lo[2], lo[3], hh[0], hh[1], hh[2], hh[3]};
}
__device__ __forceinline__ void pv(f32x16* o, int vb, bf16x8 pa0, bf16x8 pa1, bf16x8 pa2, bf16x8 pa3) {
    s16x4 lo[8], hh[8];
#pragma unroll
    for (int i = 0; i < 8; ++i) {
        asm volatile("ds_read_b64_tr_b16 %0, %1 offset:%c2" : "=&v"(lo[i]) : "v"(vb), "i"((i >> 2) * 4096 + (i & 3) * 1024) : "memory");
        asm volatile("ds_read_b64_tr_b16 %0, %1 offset:%c2" : "=&v"(hh[i]) : "v"(vb), "i"((i >> 2) * 4096 + (i & 3) * 1024 + 512) : "memory");
    }
    asm volatile("s_waitcnt lgkmcnt(0)" : "+v"(lo[0]), "+v"(lo[1]), "+v"(lo[2]), "+v"(lo[3]), "+v"(lo[4]), "+v"(lo[5]), "+v"(lo[6]), "+v"(lo[7]),
                 "+v"(hh[0]), "+v"(hh[1]), "+v"(hh[2]), "+v"(hh[3]), "+v"(hh[4]), "+v"(hh[5]), "+v"(hh[6]), "+v"(hh[7]) :: "memory");
#define PVK(k) (bf16x8){lo[k][0], lo[k][1], lo[k][2], lo[k][3], hh[k][0], hh[k][1], hh[k][2], hh[k][3]}
    o[0] = __builtin_amdgcn_mfma_f32_32x32x16_bf16(pa0, PVK(0), o[0], 0, 0, 0);
    o[1] = __builtin_amdgcn_mfma_f32_32x32x16_bf16(pa0, PVK(4), o[1], 0, 0, 0);
    o[0] = __builtin_amdgcn_mfma_f32_32x32x16_bf16(pa1, PVK(1), o[0], 0, 0, 0);
    o[1] = __builtin_amdgcn_mfma_f32_32x32x16_bf16(pa1, PVK(5), o[1], 0, 0, 0);
    o[0] = __builtin_amdgcn_mfma_f32_32x32x16_bf16(pa2, PVK(2), o[0], 0, 0, 0);
    o[1] = __builtin_amdgcn_mfma_f32_32x32x16_bf16(pa2, PVK(6), o[1], 0, 0, 0);
    o[0] = __builtin_amdgcn_mfma_f32_32x32x16_bf16(pa3, PVK(3), o[0], 0, 0, 0);
    o[1] = __builtin_amdgcn_mfma_f32_32x32x16_bf16(pa3, PVK(7), o[1], 0, 0, 0);
#undef PVK
}
#define PACK8(P, B) __builtin_bit_cast(bf16x8, ((u32x4){cvtpk(P[B], P[B + 1]), cvtpk(P[B + 2], P[B + 3]), cvtpk(P[B + 4], P[B + 5]), cvtpk(P[B + 6], P[B + 7])}))
__device__ __forceinline__ void scale_rows(f32x16* o, float f, LAS float* wsf, int r32, int hi) {
    if (hi == 0) wsf[r32] = f;
    LGKM_WAIT0();
#pragma unroll
    for (int r = 0; r < 16; ++r) { const float fr = wsf[crow(r, hi)]; o[0][r] *= fr; o[1][r] *= fr; }
    LGKM_WAIT0();
}
__device__ __forceinline__ float max3f(float x, float y, float z) { return __builtin_fmaxf(__builtin_fmaxf(x, y), z); }
typedef float f32x8 __attribute__((ext_vector_type(8)));
typedef float f32x2 __attribute__((ext_vector_type(2)));
typedef short v4i16_t __attribute__((ext_vector_type(4)));
__device__ __forceinline__ s16x4 vtr(const LAS unsigned char* p) { return __builtin_bit_cast(s16x4, __builtin_amdgcn_ds_read_tr16_b64_v4i16((LAS v4i16_t*)p)); }
__device__ __forceinline__ float rowmax32(const f32x16& p0, const f32x16& p1) {
    float a = max3f(p0[0], p0[1], p1[0]), b = max3f(p0[2], p0[3], p1[1]); a = max3f(a, p1[2], p1[3]);
#pragma unroll
    for (int r = 4; r < 16; r += 4) { a = max3f(a, p0[r], p0[r + 1]); b = max3f(b, p0[r + 2], p0[r + 3]); a = max3f(a, p1[r], p1[r + 1]); b = max3f(b, p1[r + 2], p1[r + 3]); }
    const float m = fmaxf(a, b);
    auto rr = __builtin_amdgcn_permlane32_swap(__builtin_bit_cast(unsigned, m), __builtin_bit_cast(unsigned, m), false, false);
    return fmaxf(__builtin_bit_cast(float, (unsigned)rr[0]), __builtin_bit_cast(float, (unsigned)rr[1]));
}
template <int THR, bool HASF>
__device__ __forceinline__ void attn_step(f32x16& p0, f32x16& p1, f32x16& n0, f32x16& n1, const LAS unsigned char* Knext, const LAS float* Fnext, const LAS unsigned char* Vcur,
                                          const bf16x8* qr, float& mhat, float& l, f32x16* o, LAS float* wsf, int r32, int hi) {
    f32x16 c0 = f32x16{}, c1 = f32x16{};
    if (HASF) {
#pragma unroll
        for (int rr = 0; rr < 4; ++rr) { const f32x4 f0 = *(const LAS f32x4*)(Fnext + 8 * rr), f1 = *(const LAS f32x4*)(Fnext + 32 + 8 * rr);
#pragma unroll
            for (int e = 0; e < 4; ++e) { c0[4 * rr + e] = f0[e]; c1[4 * rr + e] = f1[e]; } }
    }
    bf16x8 kf[8];
    { const LAS unsigned char* kb = Knext + hi * 1024 + r32 * 16;
#pragma unroll
      for (int d0 = 0; d0 < 4; ++d0) { kf[2 * d0] = *(const LAS bf16x8*)(kb + d0 * 2048); kf[2 * d0 + 1] = *(const LAS bf16x8*)(kb + d0 * 2048 + 512); } }
    __builtin_amdgcn_sched_barrier(0);
    const float rm = rowmax32(p0, p1);
    if (__any(rm > mhat + (float)THR)) {
        const float mnew = fmaxf(mhat, rm), f = ex2(mhat - mnew);
        l *= f; mhat = mnew; scale_rows(o, f, wsf, r32, hi);
    }
#pragma unroll
    for (int d0 = 0; d0 < 4; ++d0) {
        c0 = __builtin_amdgcn_mfma_f32_32x32x16_bf16(kf[2 * d0], qr[d0], c0, 0, 0, 0);
        c1 = __builtin_amdgcn_mfma_f32_32x32x16_bf16(kf[2 * d0 + 1], qr[d0], c1, 0, 0, 0);
    }
    __builtin_amdgcn_sched_barrier(0);
    s16x4 vl[8], vh[8];
#pragma unroll
    for (int i = 0; i < 8; ++i) { vl[i] = vtr(Vcur + (i >> 2) * 4096 + (i & 3) * 1024); vh[i] = vtr(Vcur + (i >> 2) * 4096 + (i & 3) * 1024 + 512); }
    __builtin_amdgcn_sched_barrier(0);
    p0 = p0 - mhat; p1 = p1 - mhat;
#pragma unroll
    for (int r = 0; r < 16; ++r) { p0[r] = ex2(p0[r]); p1[r] = ex2(p1[r]); }
    const f32x16 t = p0 + p1;
    const f32x8 t8 = t.lo + t.hi; const f32x4 t4 = t8.lo + t8.hi; const f32x2 t2 = t4.lo + t4.hi;
    l += t2.x + t2.y;
    const bf16x8 pa0 = PACK8(p0, 0), pa1 = PACK8(p0, 8), pa2 = PACK8(p1, 0), pa3 = PACK8(p1, 8);
#define VFK(k) (bf16x8){vl[k][0], vl[k][1], vl[k][2], vl[k][3], vh[k][0], vh[k][1], vh[k][2], vh[k][3]}
    o[0] = __builtin_amdgcn_mfma_f32_32x32x16_bf16(pa0, VFK(0), o[0], 0, 0, 0);
    o[1] = __builtin_amdgcn_mfma_f32_32x32x16_bf16(pa0, VFK(4), o[1], 0, 0, 0);
    o[0] = __builtin_amdgcn_mfma_f32_32x32x16_bf16(pa1, VFK(1), o[0], 0, 0, 0);
    o[1] = __builtin_amdgcn_mfma_f32_32x32x16_bf16(pa1, VFK(5), o[1], 0, 0, 0);
    o[0] = __builtin_amdgcn_mfma_f32_32x32x16_bf16(pa2, VFK(2), o[0], 0, 0, 0);
    o[1] = __builtin_amdgcn_mfma_f32_32x32x16_bf16(pa2, VFK(6), o[1], 0, 0, 0);
    o[0] = __builtin_amdgcn_mfma_f32_32x32x16_bf16(pa3, VFK(3), o[0], 0, 0, 0);
    o[1] = __builtin_amdgcn_mfma_f32_32x32x16_bf16(pa3, VFK(7), o[1], 0, 0, 0);
#undef VFK
    n0 = c0; n1 = c1;
}
template <int THR>
__device__ __forceinline__ void softmax_pv(f32x16& p0, f32x16& p1, float& mhat, float& l, f32x16* o, int vb, LAS float* wsf, int r32, int hi) {
    float a = max3f(p0[0], p0[1], p1[0]), b = max3f(p0[2], p0[3], p1[1]); a = max3f(a, p1[2], p1[3]);
#pragma unroll
    for (int r = 4; r < 16; r += 4) { a = max3f(a, p0[r], p0[r + 1]); b = max3f(b, p0[r + 2], p0[r + 3]); a = max3f(a, p1[r], p1[r + 1]); b = max3f(b, p1[r + 2], p1[r + 3]); }
    float rm = fmaxf(a, b); rm = fmaxf(rm, __shfl_xor(rm, 32));
    if (__any(rm > mhat + (float)THR)) {
        const float mnew = fmaxf(mhat, rm), f = ex2(mhat - mnew);
        l *= f; mhat = mnew; scale_rows(o, f, wsf, r32, hi);
    }
    p0 = p0 - mhat; p1 = p1 - mhat;
#pragma unroll
    for (int r = 0; r < 16; ++r) { p0[r] = ex2(p0[r]); p1[r] = ex2(p1[r]); }
    const f32x16 t = p0 + p1;
    const f32x8 t8 = t.lo + t.hi; const f32x4 t4 = t8.lo + t8.hi; const f32x2 t2 = t4.lo + t4.hi;
    l += t2.x + t2.y;
    pv(o, vb, PACK8(p0, 0), PACK8(p0, 8), PACK8(p1, 0), PACK8(p1, 8));
}
__device__ __forceinline__ void store_o(const f32x16* o, float rinv, LAS float* wsf, LAS bf16_t* stg, bf16_t* Og, int pitch, int r32, int hi, int lane) {
    if (hi == 0) wsf[32 + r32] = rinv;
    LGKM_WAIT0();
#pragma unroll
    for (int r = 0; r < 16; ++r) { const int orow = crow(r, hi); const float rl = wsf[32 + orow];
#pragma unroll
        for (int d0 = 0; d0 < 2; ++d0) stg[orow * 64 + d0 * 32 + r32] = (bf16_t)f2bf(o[d0][r] * rl); }
    LGKM_WAIT0();
#pragma unroll
    for (int i = 0; i < 4; ++i) { const int row = i * 8 + (lane >> 3), ch = lane & 7; const u32x4 v = *(const LAS u32x4*)(stg + row * 64 + ch * 8); *(u32x4*)(Og + (size_t)row * pitch + ch * 8) = v; }
    LGKM_WAIT0();
}
__device__ __forceinline__ float log_sigmoid(float x) { return fminf(x, 0.f) - log1pf(__expf(-fabsf(x))); }

constexpr int MX_RING = 0, MX_F = 98304, MX_WSF = 114688, MX_WTOT = 116736, MX_STG_SWA = 65536, MX_STG_FOX = 40960;

struct MixCtx {
    const bf16_t* Z; const float* G; bf16_t* Y;
    const float* sinks; const float* fox_fb; const float* ml_ib; const float* ml_fb; const float* ml_norm;
    unsigned char* ws; const unsigned char* KT; const unsigned char* VT;
};

__device__ __forceinline__ void swa_item(const MixCtx& C, int item, LAS unsigned char* lds) {
    int tid_ = threadIdx.x; asm volatile("" : "+v"(tid_));
    const int tid = tid_, lane = tid & 63, w = __builtin_amdgcn_readfirstlane(tid >> 6), r32 = lane & 31, hi = lane >> 5;
    const int jp = item & 31, kvh = (item >> 5) & 1, b = item >> 6;
    const size_t rowbase = (size_t)b * 4096;
    const int cbase = jp >= 1 ? 2 * jp - 2 : 0, ntl = 2 * jp + 2 - cbase;
    const bf16_t* Kb = C.Z + rowbase * ZP + 512 + 64 * kvh; const bf16_t* Vb = C.Z + rowbase * ZP + 640 + 64 * kvh;
    for (int j = 0; j < ntl; ++j) { dma_k(lds + MX_RING + j * 16384, Kb + (size_t)(cbase + j) * 64 * ZP, ZP, w, lane); dma_v(lds + MX_RING + j * 16384 + 8192, Vb + (size_t)(cbase + j) * 64 * ZP, ZP, w, lane); }
    const int hq = 4 * kvh + (w >> 1);
    bf16x8 qra[4], qrb[4];
    { const bf16_t* Qa = C.Z + (rowbase + 128 * jp + 32 * (w & 1) + r32) * ZP + 64 * hq;
#pragma unroll
      for (int d0 = 0; d0 < 4; ++d0) { qra[d0] = *(const bf16x8*)(Qa + 16 * d0 + 8 * hi); qrb[d0] = *(const bf16x8*)(Qa + (size_t)64 * ZP + 16 * d0 + 8 * hi); } }
    LAS float* wsf = (LAS float*)(lds + MX_WSF) + w * 64; LAS bf16_t* stg = (LAS bf16_t*)(lds + MX_STG_SWA + w * 4096);
    const float sink = C.sinks[hq] * LOG2E;
    VM_WAIT0(); __syncthreads();
    const int vlo = vt_lane_off(lane);
#pragma unroll
    for (int cc = 0; cc < 2; ++cc) {
        const int c = 2 * jp + cc, c0 = c >= 2 ? c - 2 : 0, nt = c - c0 + 1, s0 = c0 - cbase, qw0 = 64 * c + 32 * (w & 1);
        const bf16x8* qr = cc == 0 ? qra : qrb;
        float mhat = sink, l = hi == 0 ? 1.f : 0.f; f32x16 o[2]; o[0] = f32x16{}; o[1] = f32x16{};
        f32x16 p0, p1; qkt(p0, p1, lds + MX_RING + s0 * 16384, qr, r32, hi);
        for (int j = 0; j < nt; ++j) {
            f32x16 n0 = p0, n1 = p1;
            if (j + 1 < nt) qkt(n0, n1, lds + MX_RING + (s0 + j + 1) * 16384, qr, r32, hi);
            softmax_pv<8>(p0, p1, mhat, l, o, (int)(uintptr_t)(lds + MX_RING + (s0 + j) * 16384 + 8192) + vlo, wsf, r32, hi);
            p0 = n0; p1 = n1;
        }
        l += __shfl_xor(l, 32);
        store_o(o, 1.0f / l, wsf, stg, C.Y + (rowbase + qw0) * 1024 + 64 * hq, 1024, r32, hi, lane);
    }
    __syncthreads();
}

__device__ __forceinline__ void fx0_item(const MixCtx& C, float* NF, unsigned* cntF, int bh, LAS unsigned char* lds) {
    int tid_ = threadIdx.x; asm volatile("" : "+v"(tid_));
    const int tid = tid_, lane = tid & 63, w = __builtin_amdgcn_readfirstlane(tid >> 6);
    const int b = bh >> 2, h = bh & 3; const size_t rowbase = (size_t)b * 4096;
    LAS float* wtot = (LAS float*)(lds + MX_WTOT);
    const float fb = C.fox_fb[h]; const int t0 = tid * 8; float v[8]; float run = 0.f;
#pragma unroll
    for (int i = 0; i < 8; ++i) { run += log_sigmoid(C.G[(rowbase + t0 + i) * 16 + h] + fb) * LOG2E; v[i] = run; }
    float inc = run;
#pragma unroll
    for (int o_ = 1; o_ < 64; o_ <<= 1) { const float y = __shfl_up(inc, o_); if (lane >= o_) inc += y; }
    if (lane == 63) wtot[w] = inc;
    __syncthreads();
    float off = inc - run;
    for (int j = 0; j < w; ++j) off += wtot[j];
    *(f32x4*)(NF + bh * 4096 + t0) = (f32x4){-(v[0] + off), -(v[1] + off), -(v[2] + off), -(v[3] + off)};
    *(f32x4*)(NF + bh * 4096 + t0 + 4) = (f32x4){-(v[4] + off), -(v[5] + off), -(v[6] + off), -(v[7] + off)};
    asm volatile("s_waitcnt vmcnt(0)" ::: "memory"); __syncthreads();
    if (tid == 0) { __builtin_amdgcn_fence(__ATOMIC_RELEASE, "agent"); asm volatile("s_waitcnt vmcnt(0)" ::: "memory"); __hip_atomic_fetch_add(cntF + bh, 1u, __ATOMIC_RELAXED, __HIP_MEMORY_SCOPE_AGENT); }
    __syncthreads();
}
__device__ __forceinline__ void fox_block(const MixCtx& C, const float* NF, unsigned* cntF, int bh, int qb, LAS unsigned char* lds, bool first) {
    int tid_ = threadIdx.x; asm volatile("" : "+v"(tid_));
    const int tid = tid_, lane = tid & 63, w = __builtin_amdgcn_readfirstlane(tid >> 6), r32 = lane & 31, hi = lane >> 5;
    const int b = bh >> 2, h = bh & 3; const size_t rowbase = (size_t)b * 4096; const int q0 = qb * 128, nkeys = q0 + 128, nst = qb + 1;
    const unsigned char* Kt = C.KT + (size_t)bh * 64 * 8192; const unsigned char* Vt = C.VT + (size_t)bh * 64 * 8192;
#define FOX_STAGE(st_) do { LAS unsigned char* sb_ = lds + MX_RING + ((st_) % 3) * 32768; \
        dma_lin(sb_, Kt + (size_t)(2 * (st_)) * 8192, w, lane); dma_lin(sb_ + 8192, Kt + (size_t)(2 * (st_) + 1) * 8192, w, lane); \
        dma_lin(sb_ + 16384, Vt + (size_t)(2 * (st_)) * 8192, w, lane); dma_lin(sb_ + 24576, Vt + (size_t)(2 * (st_) + 1) * 8192, w, lane); } while (0)
    FOX_STAGE(0); if (nst > 1) FOX_STAGE(1);
    LAS float* F2 = (LAS float*)(lds + MX_F);
    LAS float* wsf = (LAS float*)(lds + MX_WSF) + w * 64; LAS bf16_t* stg = (LAS bf16_t*)(lds + MX_STG_FOX + w * 4096);
    const int g = w >> 2, qw0 = q0 + 32 * (w & 3);
    const bf16_t* Qb = C.Z + (rowbase + qw0 + r32) * ZP + 768 + 64 * h;
    bf16x8 qr[4];
#pragma unroll
    for (int d0 = 0; d0 < 4; ++d0) qr[d0] = *(const bf16x8*)(Qb + 16 * d0 + 8 * hi);
    if (first) {
        if (tid == 0) { while (__hip_atomic_load(cntF + bh, __ATOMIC_RELAXED, __HIP_MEMORY_SCOPE_AGENT) < 1u) __builtin_amdgcn_s_sleep(2); }
        __syncthreads();
    }
    {
        const int t0 = tid * 8;
        if (first && t0 < nkeys) { const unsigned long long* np = (const unsigned long long*)(NF + bh * 4096 + t0); unsigned long long q[4];
#pragma unroll
            for (int i = 0; i < 4; ++i) q[i] = __hip_atomic_load(np + i, __ATOMIC_RELAXED, __HIP_MEMORY_SCOPE_AGENT);
#pragma unroll
            for (int i = 0; i < 4; ++i) *(LAS unsigned long long*)(F2 + t0 + 2 * i) = q[i]; }
    }
    float mhat = -1e30f, l = 0.f; f32x16 o[2]; o[0] = f32x16{}; o[1] = f32x16{};
    VM_WAIT0(); __syncthreads();
    const int vlo = vt_lane_off(lane), qpos = qw0 + r32;
#define FOX_SCORE(st_, P0, P1) do { const int kb_ = 64 * (2 * (st_) + g); const LAS unsigned char* sk_ = lds + MX_RING + ((st_) % 3) * 32768 + g * 8192; f32x16 c0_, c1_; \
        _Pragma("unroll") for (int rr = 0; rr < 4; ++rr) { const f32x4 f0 = *(const LAS f32x4*)(F2 + kb_ + 8 * rr + 4 * hi), f1 = *(const LAS f32x4*)(F2 + kb_ + 32 + 8 * rr + 4 * hi); \
            _Pragma("unroll") for (int e = 0; e < 4; ++e) { c0_[4 * rr + e] = f0[e]; c1_[4 * rr + e] = f1[e]; } } \
        qkt(P0, P1, sk_, qr, r32, hi, c0_, c1_); } while (0)
    f32x16 p0, p1, n0, n1; FOX_SCORE(0, p0, p1);
#define FOX_STEP(PA0, PA1, PB0, PB1, st_) do { if ((st_) + 2 < nst) FOX_STAGE((st_) + 2); \
        attn_step<24, true>(PA0, PA1, PB0, PB1, lds + MX_RING + (((st_) + 1) % 3) * 32768 + g * 8192, F2 + 64 * (2 * ((st_) + 1) + g) + 4 * hi, \
                           lds + MX_RING + ((st_) % 3) * 32768 + 16384 + g * 8192 + vlo, qr, mhat, l, o, wsf, r32, hi); \
        VM_WAIT0(); __syncthreads(); } while (0)
#define FOX_LAST(PA0, PA1) do { const int st = nst - 1, kbase = 64 * (2 * st + g); \
        if (kbase <= qw0 + 31) { \
            if (kbase + 63 > qw0) { _Pragma("unroll") for (int r = 0; r < 16; ++r) { const int kv = kbase + crow(r, hi); if (kv > qpos) PA0[r] = -INFINITY; if (kv + 32 > qpos) PA1[r] = -INFINITY; } } \
            softmax_pv<24>(PA0, PA1, mhat, l, o, (int)(uintptr_t)(lds + MX_RING + (st % 3) * 32768 + 16384 + g * 8192) + vlo, wsf, r32, hi); } } while (0)
    int st2 = 0;
    for (; st2 + 2 < nst; st2 += 2) { FOX_STEP(p0, p1, n0, n1, st2); FOX_STEP(n0, n1, p0, p1, st2 + 1); }
    if (st2 + 1 < nst) { FOX_STEP(p0, p1, n0, n1, st2); FOX_LAST(n0, n1); } else { FOX_LAST(p0, p1); }
#undef FOX_STEP
#undef FOX_LAST
    __syncthreads();
#undef FOX_SCORE
#undef FOX_STAGE
    l += __shfl_xor(l, 32);
    LAS float* mo = (LAS float*)(lds + MX_RING); LAS float* ml = (LAS float*)(lds + MX_RING + 32768);
    const int wq = w & 3;
    if (g == 1) {
#pragma unroll
        for (int d0 = 0; d0 < 2; ++d0)
#pragma unroll
            for (int r = 0; r < 16; ++r) mo[((wq * 2 + d0) * 16 + r) * 64 + lane] = o[d0][r];
        ml[(wq * 2 + 0) * 64 + lane] = mhat; ml[(wq * 2 + 1) * 64 + lane] = l;
    }
    __syncthreads();
    if (g == 0) {
        const float m1 = ml[(wq * 2 + 0) * 64 + lane], l1 = ml[(wq * 2 + 1) * 64 + lane];
        const float mn = fmaxf(mhat, m1), f0 = ex2(mhat - mn), f1 = ex2(m1 - mn), lt = l * f0 + l1 * f1;
        if (hi == 0) { wsf[r32] = f0; wsf[32 + r32] = f1; }
        LGKM_WAIT0();
#pragma unroll
        for (int r = 0; r < 16; ++r) { const float a0 = wsf[crow(r, hi)], a1 = wsf[32 + crow(r, hi)];
#pragma unroll
            for (int d0 = 0; d0 < 2; ++d0) o[d0][r] = o[d0][r] * a0 + mo[((wq * 2 + d0) * 16 + r) * 64 + lane] * a1; }
        LGKM_WAIT0();
        store_o(o, 1.0f / lt, wsf, stg, C.Y + (rowbase + qw0) * 1024 + 512 + 64 * h, 1024, r32, hi, lane);
    }
    __syncthreads();
}
__device__ __forceinline__ void fox_item(const MixCtx& C, const float* NF, unsigned* cntF, int bh, int i, LAS unsigned char* lds) {
    fox_block(C, NF, cntF, bh, 31 - i, lds, true);
    fox_block(C, NF, cntF, bh, i, lds, false);
}
constexpr int ML_WSF = 98304, ML_STG = 100352, ML_SM = 133120;
struct MlScratch { float* E; float* B; float* PM; float* CL; float* NL; bf16_t* CP; float* NP; float* GC; float* EM; float* MP; unsigned* cnt1; unsigned* cnt2; };
__device__ __forceinline__ void wait_count(unsigned* p, unsigned want, int tid) {
    if (tid == 0) { while (__hip_atomic_load(p, __ATOMIC_RELAXED, __HIP_MEMORY_SCOPE_AGENT) < want) __builtin_amdgcn_s_sleep(2);
        __builtin_amdgcn_fence(__ATOMIC_ACQUIRE, "agent"); asm volatile("s_waitcnt vmcnt(0)" ::: "memory"); }
    __syncthreads();
}
__device__ __forceinline__ void post_count(unsigned* p, int tid) {
    asm volatile("s_waitcnt vmcnt(0)" ::: "memory"); __syncthreads();
    if (tid == 0) { __builtin_amdgcn_fence(__ATOMIC_RELEASE, "agent"); asm volatile("s_waitcnt vmcnt(0)" ::: "memory");
        __hip_atomic_fetch_add(p, 1u, __ATOMIC_RELAXED, __HIP_MEMORY_SCOPE_AGENT); }
}
#define ML_COMMON \
    int tid_ = threadIdx.x; asm volatile("" : "+v"(tid_)); \
    const int tid = tid_, lane = tid & 63, w = __builtin_amdgcn_readfirstlane(tid >> 6), r32 = lane & 31, hi = lane >> 5; \
    const int b = bh >> 2, h = bh & 3; const size_t rowbase = (size_t)b * 4096; \
    float* E = S.E + bh * 4096; float* B = S.B + bh * 4096; float* PM = S.PM + bh * 4096; \
    float* CL = S.CL + (size_t)bh * 64 * 4096; float* NL = S.NL + bh * 4096; bf16_t* CP = S.CP + (size_t)bh * 64 * 4096; float* NP = S.NP + bh * 4096; \
    float* GC = S.GC + bh * 64; float* EM = S.EM + bh * 64; float* MP = S.MP + bh * 64; \
    (void)r32; (void)hi; (void)E; (void)B; (void)PM; (void)CL; (void)NL; (void)CP; (void)NP; (void)GC; (void)EM; (void)MP; (void)rowbase; (void)h;

__device__ __forceinline__ void ml1_item(const MixCtx& C, const MlScratch& S, int bh, int rd, LAS unsigned char* lds) {
    ML_COMMON
    LAS float* le = (LAS float*)(lds + ML_SM); LAS float* lem = le + 512;
    const bf16_t* Kg = C.Z + rowbase * ZP + 1792 + 64 * h; const bf16_t* Vg = C.Z + rowbase * ZP + 2048 + 64 * h;
    const int srow = 16 * (w & 3) + (lane >> 2), scol = (w >> 2) * 32 + (lane & 3) * 8;
    u32x4 kvr[8];
#pragma unroll
    for (int p = 0; p < 8; ++p) kvr[p] = *(const u32x4*)(Kg + (size_t)((8 * rd + p) * 64 + srow) * ZP + scol);
    {
        const int cc = 8 * rd + w, t = cc * 64 + lane;
        const float* gp = C.G + (rowbase + t) * 16;
        const float ig = gp[4 + h] + C.ml_ib[h];
        float bsum = log_sigmoid(gp[8 + h] + C.ml_fb[h]);
#pragma unroll
        for (int o_ = 1; o_ < 64; o_ <<= 1) { const float y = __shfl_up(bsum, o_); if (lane >= o_) bsum += y; }
        const float e = ig - bsum; float pm = e;
#pragma unroll
        for (int o_ = 1; o_ < 64; o_ <<= 1) { const float y = __shfl_up(pm, o_); if (lane >= o_) pm = fmaxf(pm, y); }
        E[t] = e; B[t] = bsum; PM[t] = pm; le[w * 64 + lane] = e;
        if (lane == 63) { GC[cc] = bsum; EM[cc] = pm; lem[w] = pm; }
    }
    __syncthreads();
    const int vlo = vt_lane_off(lane);
    const bf16x8 ones = (bf16x8){0x3F80, 0x3F80, 0x3F80, 0x3F80, 0x3F80, 0x3F80, 0x3F80, 0x3F80};
#pragma unroll
    for (int p = 0; p < 8; ++p) {
        const int cc = 8 * rd + p; LAS unsigned char* sl = lds + p * 16384;
        const float wa = __expf(le[p * 64 + srow] - lem[p]);
        u32x4 w2;
#pragma unroll
        for (int j = 0; j < 4; ++j) { const float lo = __builtin_bit_cast(float, kvr[p][j] << 16), hh = __builtin_bit_cast(float, kvr[p][j] & 0xffff0000u); w2[j] = cvtpk(lo * wa, hh * wa); }
        *(LAS u32x4*)(sl + w * 1024 + lane * 16) = w2;
        dma_v(sl + 8192, Vg + (size_t)cc * 64 * ZP, ZP, w, lane);
    }
    VM_WAIT0(); __syncthreads();
    {
        const int cc = 8 * rd + w; LAS unsigned char* sl = lds + w * 16384;
        const int ka = (int)(uintptr_t)sl + vlo, va = ka + 8192;
        float* cl = CL + (size_t)cc * 4096;
#pragma unroll
        for (int half = 0; half < 2; ++half) {
            f32x16 a0 = {}, a1 = {}, na = {};
#pragma unroll
            for (int ks = 0; ks < 4; ++ks) {
                const bf16x8 A = vfrag(ka, half, ks), B0 = vfrag(va, 0, ks), B1 = vfrag(va, 1, ks);
                a0 = __builtin_amdgcn_mfma_f32_32x32x16_bf16(A, B0, a0, 0, 0, 0);
                a1 = __builtin_amdgcn_mfma_f32_32x32x16_bf16(A, B1, a1, 0, 0, 0);
                na = __builtin_amdgcn_mfma_f32_32x32x16_bf16(A, ones, na, 0, 0, 0);
            }
#pragma unroll
            for (int r = 0; r < 16; ++r) { const int k = 32 * half + crow(r, hi); cl[k * 64 + r32] = a0[r]; cl[k * 64 + 32 + r32] = a1[r]; }
            if (r32 == 0) {
#pragma unroll
                for (int r = 0; r < 16; ++r) NL[cc * 64 + 32 * half + crow(r, hi)] = na[r];
            }
        }
    }
    post_count(S.cnt1 + bh, tid);
    __syncthreads();
}

__device__ __forceinline__ void ml2_item(const MixCtx& C, const MlScratch& S, int bh, int slice, LAS unsigned char* lds) {
    ML_COMMON
    LAS float* lg = (LAS float*)(lds + ML_SM); LAS float* lem = lg + 64; LAS float* lso = lg + 128; LAS float* lsl = lg + 192;
    wait_count(S.cnt1 + bh, 8u, tid);
    if (tid < 64) { lg[tid] = GC[tid]; lem[tid] = EM[tid]; }
    __syncthreads();
    if (tid == 0) { float mcur = 0.f; for (int c = 0; c < 64; ++c) { const float g = lg[c], em = lem[c], mx = fmaxf(mcur, em); if (slice == 0) MP[c] = mcur; lso[c] = __expf(mcur - mx); lsl[c] = __expf(em - mx); mcur = g + mx; } }
    __syncthreads();
    const int idx = slice * 2048 + tid * 4; const bool don = (slice == 0) && (tid < 64);
    f32x4 Cs = (f32x4){0.f, 0.f, 0.f, 0.f}; float ns = 0.f;
    for (int c0 = 0; c0 < 64; c0 += 16) {
        f32x4 lv[16]; float ln[16];
#pragma unroll
        for (int j = 0; j < 16; ++j) { lv[j] = *(const f32x4*)(CL + (size_t)(c0 + j) * 4096 + idx); ln[j] = don ? NL[(c0 + j) * 64 + tid] : 0.f; }
#pragma unroll
        for (int j = 0; j < 16; ++j) {
            const int c = c0 + j;
            u32x2 pk; pk.x = cvtpk(Cs[0], Cs[1]); pk.y = cvtpk(Cs[2], Cs[3]);
            *(u32x2*)(CP + (size_t)c * 4096 + idx) = pk;
            if (don) NP[c * 64 + tid] = ns;
            const float so = lso[c], sl = lsl[c];
            Cs = Cs * so + lv[j] * sl; ns = so * ns + sl * ln[j];
        }
    }
    post_count(S.cnt2 + bh, tid);
    __syncthreads();
}

__device__ __forceinline__ void ml3_item(const MixCtx& C, const MlScratch& S, int bh, int rd, LAS unsigned char* lds) {
    ML_COMMON
    wait_count(S.cnt2 + bh, 2u, tid);
    const int pair = w >> 1, half = w & 1;
    const bf16_t* Kg = C.Z + rowbase * ZP + 1792 + 64 * h; const bf16_t* Vg = C.Z + rowbase * ZP + 2048 + 64 * h; const bf16_t* Qg = C.Z + rowbase * ZP + 1536 + 64 * h;
    const int vlo = vt_lane_off(lane);
    LAS float* wsf = (LAS float*)(lds + ML_WSF) + w * 64; LAS bf16_t* stg = (LAS bf16_t*)(lds + ML_STG + w * 4096);
#pragma unroll
        for (int p = 0; p < 4; ++p) {
            const int cc = 4 * rd + p; LAS unsigned char* sl = lds + p * 24576;
            dma_k(sl, Kg + (size_t)cc * 64 * ZP, ZP, w, lane); dma_v(sl + 8192, Vg + (size_t)cc * 64 * ZP, ZP, w, lane); dma_v(sl + 16384, CP + (size_t)cc * 4096, 64, w, lane);
        }
        const int cc = 4 * rd + pair, lrow = 32 * half + r32, t = cc * 64 + lrow;
        const bf16_t* qp = Qg + (size_t)t * ZP;
        bf16x8 qr[4], qp2[4];
#pragma unroll
        for (int d0 = 0; d0 < 4; ++d0) qr[d0] = *(const bf16x8*)(qp + 16 * d0 + 8 * hi);
#pragma unroll
        for (int ks = 0; ks < 4; ++ks) { const u32x2 a = *(const u32x2*)(qp + 16 * ks + 4 * hi), b2 = *(const u32x2*)(qp + 16 * ks + 8 + 4 * hi); qp2[ks] = __builtin_bit_cast(bf16x8, ((u32x4){a.x, a.y, b2.x, b2.y})); }
        const float mprev = MP[cc], mm = fmaxf(mprev, PM[t]), winter = __expf(mprev - mm), bl = B[t];
        float nd = 0.f;
#pragma unroll
        for (int d0 = 0; d0 < 4; ++d0) { const float* np = NP + cc * 64 + 16 * d0 + 8 * hi; const f32x4 n0 = *(const f32x4*)np, n1 = *(const f32x4*)(np + 4);
            const u32x4 qq = __builtin_bit_cast(u32x4, qr[d0]);
#pragma unroll
            for (int j = 0; j < 4; ++j) { const float lo = __builtin_bit_cast(float, qq[j] << 16), hh = __builtin_bit_cast(float, qq[j] & 0xffff0000u);
                const float na_ = j < 2 ? n0[2 * j] : n1[2 * j - 4], nb_ = j < 2 ? n0[2 * j + 1] : n1[2 * j - 3]; nd += lo * na_ + hh * nb_; } }
        nd += __shfl_xor(nd, 32);
        VM_WAIT0(); __syncthreads();
        {
            LAS unsigned char* sl = lds + pair * 24576; const int base = (int)(uintptr_t)sl + vlo;
            f32x16 o[2]; o[0] = f32x16{}; o[1] = f32x16{};
            pv(o, base + 16384, qp2[0], qp2[1], qp2[2], qp2[3]);
            scale_rows(o, winter, wsf, r32, hi);
            f32x16 p0, p1; qkt(p0, p1, sl, qr, r32, hi);
            float rs = 0.f;
#pragma unroll
            for (int rr = 0; rr < 4; ++rr) { const f32x4 e0 = *(const f32x4*)(E + cc * 64 + 8 * rr + 4 * hi), e1 = *(const f32x4*)(E + cc * 64 + 32 + 8 * rr + 4 * hi);
#pragma unroll
                for (int e = 0; e < 4; ++e) { const int r = 4 * rr + e, s = 8 * rr + 4 * hi + e;
                    const float w0 = (s <= lrow) ? __expf(e0[e] - mm) : 0.f, w1 = (s + 32 <= lrow) ? __expf(e1[e] - mm) : 0.f;
                    p0[r] *= w0; p1[r] *= w1; rs += p0[r] + p1[r]; } }
            rs += __shfl_xor(rs, 32);
            pv(o, base + 8192, PACK8(p0, 0), PACK8(p0, 8), PACK8(p1, 0), PACK8(p1, 8));
            const float den = winter * nd + rs, dn = fmaxf(fabsf(den), __expf(-(bl + mm)));
            const float rinv = 1.0f / dn;
            if (hi == 0) wsf[32 + r32] = rinv;
            LGKM_WAIT0();
#pragma unroll
            for (int r = 0; r < 16; ++r) { const int orow = crow(r, hi); const float rl = wsf[32 + orow];
#pragma unroll
                for (int d0 = 0; d0 < 2; ++d0) stg[orow * 64 + d0 * 32 + r32] = (bf16_t)f2bf(o[d0][r] * rl); }
            LGKM_WAIT0();
#pragma unroll
            for (int i = 0; i < 4; ++i) {
                const int row = i * 8 + (lane >> 3), ch = lane & 7; const u32x4 v = *(const LAS u32x4*)(stg + row * 64 + ch * 8);
                float x[8]; float ss = 0.f;
#pragma unroll
                for (int j = 0; j < 4; ++j) { x[2 * j] = __builtin_bit_cast(float, v[j] << 16); x[2 * j + 1] = __builtin_bit_cast(float, v[j] & 0xffff0000u); ss += x[2 * j] * x[2 * j] + x[2 * j + 1] * x[2 * j + 1]; }
                ss += __shfl_xor(ss, 1); ss += __shfl_xor(ss, 2); ss += __shfl_xor(ss, 4);
                const float rn = rsqrtf(ss * (1.0f / 64.0f) + EPS);
                const size_t tok = rowbase + cc * 64 + 32 * half + row;
                const u32x4 og = *(const u32x4*)(C.Z + tok * ZP + 2304 + 64 * h + ch * 8);
                const f32x4 g0 = *(const f32x4*)(C.ml_norm + h * 64 + ch * 8), g1 = *(const f32x4*)(C.ml_norm + h * 64 + ch * 8 + 4);
                float y[8];
#pragma unroll
                for (int j = 0; j < 4; ++j) { const float o0 = __builtin_bit_cast(float, og[j] << 16), o1 = __builtin_bit_cast(float, og[j] & 0xffff0000u);
                    const float ga = j < 2 ? g0[2 * j] : g1[2 * j - 4], gb = j < 2 ? g0[2 * j + 1] : g1[2 * j - 3];
                    y[2 * j] = x[2 * j] * rn * ga * o0; y[2 * j + 1] = x[2 * j + 1] * rn * gb * o1; }
                u32x4 pk; pk.x = cvtpk(y[0], y[1]); pk.y = cvtpk(y[2], y[3]); pk.z = cvtpk(y[4], y[5]); pk.w = cvtpk(y[6], y[7]);
                *(u32x4*)(C.Y + tok * 1024 + 768 + 64 * h + ch * 8) = pk;
            }
            LGKM_WAIT0();
        }
        __syncthreads();
}
constexpr int MTOK = 16384, DMODEL = 1024, SEQL = 4096, DFF = 4096, NZT = 2816  , DEPTH = 2;
constexpr size_t MiB = 1u << 20;
constexpr size_t WS_CTL = 0, CTL_BYTES = 32768;
constexpr size_t WS_WIN = 2 * MiB, WIN_L = (size_t)NZT * DMODEL * 2;
constexpr size_t WS_WOUT = 13 * MiB, WOUT_L = (size_t)DMODEL * DMODEL * 2;
constexpr size_t WS_WFF1 = 17 * MiB, WFF_L = (size_t)DFF * DMODEL * 2;
constexpr size_t WS_WFF2 = 33 * MiB;
constexpr size_t WS_SSQ2 = 82 * MiB;
constexpr size_t WS_XG = 50 * MiB;
constexpr size_t WS_H = 84 * MiB;
constexpr size_t WS_Z = 84 * MiB, WS_Y = 164 * MiB;
constexpr size_t WS_KT = 196 * MiB, WS_VT = 204 * MiB;
constexpr size_t WS_SSQ = 212 * MiB, WS_ROPE = 214 * MiB, WS_G = 215 * MiB;
constexpr size_t WS_MLE = 216 * MiB, WS_MLB = WS_MLE + 262144, WS_MLPM = WS_MLB + 262144;
constexpr size_t WS_NL = 217 * MiB, WS_NP = WS_NL + 262144, WS_GC = WS_NP + 262144, WS_EM = WS_GC + 4096, WS_MP = WS_EM + 4096;
constexpr size_t WS_CL = 218 * MiB, WS_CP = 234 * MiB, WS_NFX = 242 * MiB, WS_END = 243 * MiB;
constexpr int LDS_BYTES = 147456;
constexpr int N_FOX = 256, N_SWA = 256, N_ML1 = 128, N_ML2 = 32, N_ML3 = 256, N_ML = N_ML1 + N_ML2 + N_ML3, N_FX0 = 16, N_ITEMS = N_FX0 + N_ML + N_FOX + N_SWA;

struct Params { const float* in[16]; float* out; unsigned char* ws; int ph_lo, ph_hi; };

__device__ __forceinline__ int win_src(int n) {
    const int pn = n >> 8, P = n & 255, L = 64 * ((P >> 5) & 3) + 32 * (P >> 7) + (P & 31), z = 256 * pn + L;
    if (z < 1536) return z;
    if (z < 2304) return z + 4;
    if (z < 2560) return z + 12;
    const int i = z - 2560;
    if (i < 4) return 1536 + i;
    if (i < 8) return 2308 + (i - 4);
    if (i < 12) return 2312 + (i - 8);
    return -1;
}
template <bool WIN>
__device__ __forceinline__ void tr_item(const float* W, const float* kgain, int K, int Nsrc, bf16_t* WT, int nblk, int item, LAS float* scr, int lane) {
    const int kb = item / nblk, nb = item % nblk, k0 = 64 * kb, n0 = 32 * nb;
    if (WIN && n0 >= 2560) {
        const int n = n0 + (lane & 31); const int src = win_src(n);
#pragma unroll 8
        for (int i = 0; i < 32; ++i) { const int kk = 2 * i + (lane >> 5); scr[kk * 33 + (lane & 31)] = src >= 0 ? W[(size_t)(k0 + kk) * Nsrc + src] * (kgain ? kgain[k0 + kk] : 1.f) : 0.f; }
    } else {
        const int n4 = (lane & 7) * 4; const int src = WIN ? win_src(n0 + n4) : n0 + n4;
        f32x4 v[8];
#pragma unroll
        for (int i = 0; i < 8; ++i) v[i] = *(const f32x4*)(W + (size_t)(k0 + 8 * i + (lane >> 3)) * Nsrc + src);
#pragma unroll
        for (int i = 0; i < 8; ++i) { const int kk = 8 * i + (lane >> 3); const float g = kgain ? kgain[k0 + kk] : 1.f; LAS float* d = scr + kk * 33 + n4;
            d[0] = v[i][0] * g; d[1] = v[i][1] * g; d[2] = v[i][2] * g; d[3] = v[i][3] * g; }
    }
    LGKM_WAIT0(); asm volatile("" ::: "memory");
    const int c = lane & 7;
#pragma unroll
    for (int j = 0; j < 4; ++j) { const int nn = (lane >> 3) + 8 * j; const LAS float* s = scr + (8 * c) * 33 + nn;
        u32x4 o; o.x = cvtpk(s[0 * 33], s[1 * 33]); o.y = cvtpk(s[2 * 33], s[3 * 33]); o.z = cvtpk(s[4 * 33], s[5 * 33]); o.w = cvtpk(s[6 * 33], s[7 * 33]);
        *(u32x4*)(WT + (size_t)(n0 + nn) * K + k0 + 8 * c) = o; }
    LGKM_WAIT0(); asm volatile("" ::: "memory");
}

#define RLX_AGENT __ATOMIC_RELAXED, __HIP_MEMORY_SCOPE_AGENT
#define XB_TMO      128
#define XB_XCNT(j)  (256  + 64 * (j))
#define XB_XSUB(j)  (1280 + 64 * (j))
#define XB_XGEN(j)  (2304 + 64 * (j))
#define XB_TOP      3328
#define XB_TOPGEN   3392
#define XCD_BAR_WORDS 3456
#define XB_SPIN_CAP (1u << 18)

__device__ __forceinline__ unsigned xb_ld(unsigned* p)              { return __hip_atomic_load(p, __ATOMIC_RELAXED, __HIP_MEMORY_SCOPE_AGENT); }
__device__ __forceinline__ unsigned xb_add(unsigned* p, unsigned v) { return __hip_atomic_fetch_add(p, v, __ATOMIC_RELAXED, __HIP_MEMORY_SCOPE_AGENT); }
__device__ __forceinline__ unsigned xb_xcc_id() { return (unsigned)__builtin_amdgcn_s_getreg((3 << 11) | 20) & 0xFu; }
#define XB_SPIN(cond, bar) do { unsigned _sp = 0; while (cond) { __builtin_amdgcn_s_sleep(1); \
    if ((++_sp & 255u) == 0u) { if (xb_ld(&(bar)[XB_TMO])) break; if (_sp > XB_SPIN_CAP) { atomicAdd(&(bar)[XB_TMO], 1u); break; } } } } while (0)

struct XcdBarrier {
    unsigned* bar; unsigned x;
    volatile LAS unsigned* st;
};

__device__ __forceinline__ XcdBarrier xcd_barrier_post(unsigned* bar, volatile LAS unsigned* st) {
    XcdBarrier b; b.bar = bar; b.x = xb_xcc_id(); b.st = st;
    if (threadIdx.x == 0) (void)xb_add(&bar[XB_XCNT(b.x)], 1u);
    return b;
}
__device__ __forceinline__ void xcd_barrier_complete(unsigned* bar, unsigned x, unsigned& nloc, unsigned& nx) {
    const unsigned G = gridDim.x * gridDim.y * gridDim.z;
    unsigned sum, cnt, mine, sp = 0u;
    for (;;) {
        sum = 0u; cnt = 0u; mine = 0u;
#pragma unroll
        for (unsigned j = 0; j < 16; ++j) { const unsigned c = xb_ld(&bar[XB_XCNT(j)]); sum += c; cnt += (c > 0u) ? 1u : 0u; mine = (j == x) ? c : mine; }
        if (sum == G) break;
        __builtin_amdgcn_s_sleep(1);
        if ((++sp & 255u) == 0u) { if (xb_ld(&bar[XB_TMO])) break; if (sp > XB_SPIN_CAP) { atomicAdd(&bar[XB_TMO], 1u); break; } }
    }
    nloc = mine > 0u ? mine : 1u; nx = cnt > 0u ? cnt : 1u;
}

__device__ __forceinline__ void xcd_barrier(const XcdBarrier& b) {
    asm volatile("s_waitcnt vmcnt(0)" ::: "memory");
    __syncthreads();
    if (threadIdx.x == 0) {
        unsigned* bar = b.bar;
        __builtin_amdgcn_s_waitcnt(0);
        unsigned nloc = b.st[0], nx = b.st[1];
        if (nloc == 0u) { xcd_barrier_complete(bar, b.x, nloc, nx); b.st[0] = nloc; b.st[1] = nx; }
        const unsigned old = xb_add(&bar[XB_XSUB(b.x)], 1u);
        const unsigned gen = old / nloc;
        if (old + 1u == (gen + 1u) * nloc) {
            __builtin_amdgcn_fence(__ATOMIC_RELEASE, "agent");
            asm volatile("s_waitcnt vmcnt(0)" ::: "memory");
            const unsigned og = xb_add(&bar[XB_TOP], 1u);
            const unsigned tg = og / nx;
            if (og + 1u == (tg + 1u) * nx) xb_add(&bar[XB_TOPGEN], 1u);
            else XB_SPIN(xb_ld(&bar[XB_TOPGEN]) == tg, bar);
            __builtin_amdgcn_fence(__ATOMIC_ACQUIRE, "agent");
            xb_add(&bar[XB_XGEN(b.x)], 1u);
            asm volatile("s_waitcnt vmcnt(0)" ::: "memory");
        } else {
            XB_SPIN(xb_ld(&bar[XB_XGEN(b.x)]) == gen, bar);
            __builtin_amdgcn_fence(__ATOMIC_ACQUIRE, "agent");
            asm volatile("s_waitcnt vmcnt(0)" ::: "memory");
        }
    }
    __syncthreads();
}

__global__ void __launch_bounds__(512, 2) fwd_megakernel(Params p) {
    extern __shared__ __attribute__((aligned(16))) unsigned char lds_raw[];
    LAS unsigned char* lds = (LAS unsigned char*)lds_raw;
    cg::grid_group grid = cg::this_grid();
    const int tid = threadIdx.x, lane = tid & 63, wave = __builtin_amdgcn_readfirstlane(tid >> 6);
    const int G = gridDim.x, bx = blockIdx.x;
    unsigned char* ws = p.ws;
    const float* x_in = p.in[0];
    bf16_t* XG = (bf16_t*)(ws + WS_XG); bf16_t* Zb = (bf16_t*)(ws + WS_Z); bf16_t* Yb = (bf16_t*)(ws + WS_Y); bf16_t* Hb = (bf16_t*)(ws + WS_H);
    float* SSQ = (float*)(ws + WS_SSQ); float* SSQ2 = (float*)(ws + WS_SSQ2); float* ROPEC = (float*)(ws + WS_ROPE); float* ROPES = ROPEC + SEQL * 32; float* Gt = (float*)(ws + WS_G);
    unsigned* ctl = (unsigned*)(ws + WS_CTL);
    const int lo = p.ph_lo, hi_ph = p.ph_hi;
    volatile LAS unsigned* bst = (volatile LAS unsigned*)(lds + 143360 + 16);
    if (tid < 2) bst[tid] = 0u;
    __syncthreads();
    XcdBarrier bar = xcd_barrier_post(ctl + 1024, bst);
    if (lo < 0) grid.sync();
#define IN_PH(k) (lo <= (k) && (k) < hi_ph)
#define SEAM(k) do { if (IN_PH(k) && IN_PH((k) + 1)) xcd_barrier(bar); } while (0)

    if (IN_PH(0)) {
        LAS float* scr = (LAS float*)(lds + wave * 16384);
        const int gw = bx * 8 + wave, NGW = G * 8;
        constexpr int I_IN = (DMODEL / 64) * (NZT / 32), I_OUT = (DMODEL / 64) * (DMODEL / 32), I_F1 = (DMODEL / 64) * (DFF / 32), I_F2 = (DFF / 64) * (DMODEL / 32);
        constexpr int I_LAYER = I_IN + I_OUT + I_F1 + I_F2;
        for (int it = gw; it < DEPTH * I_LAYER; it += NGW) {
            const int l = it / I_LAYER; int r = it % I_LAYER;
            if (r < I_IN) { tr_item<true>(p.in[2] + (size_t)l * DMODEL * 2572, p.in[1] + l * DMODEL, DMODEL, 2572, (bf16_t*)(ws + WS_WIN + l * WIN_L), NZT / 32, r, scr, lane); continue; } r -= I_IN;
            if (r < I_OUT) { tr_item<false>(p.in[12] + (size_t)l * DMODEL * DMODEL, nullptr, DMODEL, DMODEL, (bf16_t*)(ws + WS_WOUT + l * WOUT_L), DMODEL / 32, r, scr, lane); continue; } r -= I_OUT;
            if (r < I_F1) { tr_item<false>(p.in[14] + (size_t)l * DMODEL * DFF, p.in[13] + l * DMODEL, DMODEL, DFF, (bf16_t*)(ws + WS_WFF1 + l * WFF_L), DFF / 32, r, scr, lane); continue; } r -= I_F1;
            tr_item<false>(p.in[15] + (size_t)l * DFF * DMODEL, nullptr, DFF, DMODEL, (bf16_t*)(ws + WS_WFF2 + l * WFF_L), DMODEL / 32, r, scr, lane);
        }
        for (int i = bx * 512 + tid; i < SEQL * 32; i += G * 512) {
            const int pos = i >> 5, j = i & 31;
            double inv = 1.0; for (int q = 0; q < j; ++q) inv *= 0.7498942093324558;
            const float ang = (float)pos * (float)inv;
            double rev = (double)ang * 0.15915494309189535; rev -= __builtin_rint(rev);
            ROPEC[i] = __builtin_amdgcn_cosf((float)rev); ROPES[i] = __builtin_amdgcn_sinf((float)rev);
        }
        for (int m = gw; m < MTOK; m += 2 * NGW) {
            const int m2 = m + NGW;
            const bool has2 = m2 < MTOK;
            const f32x4* xr = (const f32x4*)(x_in + (size_t)m * DMODEL) + lane;
            const f32x4* xr2 = (const f32x4*)(x_in + (size_t)(has2 ? m2 : m) * DMODEL) + lane;
            f32x4 va[4], vb[4];
#pragma unroll
            for (int j = 0; j < 4; ++j) { va[j] = xr[64 * j]; vb[j] = xr2[64 * j]; }
#pragma unroll
            for (int rr = 0; rr < 2; ++rr) {
                if (rr == 1 && !has2) break;
                const int mm = rr == 0 ? m : m2;
                unsigned long long* o8 = (unsigned long long*)(XG + (size_t)mm * DMODEL) + lane;
#pragma unroll
                for (int j = 0; j < 4; ++j) {
                    const f32x4 v = rr == 0 ? va[j] : vb[j];
                    float s = (v[0] * v[0] + v[1] * v[1]) + (v[2] * v[2] + v[3] * v[3]);
                    s += __shfl_xor(s, 1); s += __shfl_xor(s, 2); s += __shfl_xor(s, 4);
                    if ((lane & 7) == 0) SSQ[(size_t)mm * 32 + 8 * j + (lane >> 3)] = s;
                    o8[64 * j] = (unsigned long long)cvtpk(v[0], v[1]) | ((unsigned long long)cvtpk(v[2], v[3]) << 32);
                }
            }
        }
    }
    SEAM(0);

    for (int l = 0; l < DEPTH; ++l) {
        const int pb = 1 + 5 * l;
        if (IN_PH(pb)) {
            pg8::Gemm g{XG, (const bf16_t*)(ws + WS_WIN + l * WIN_L), MTOK, NZT, DMODEL}; pg8::StaticOrder S; S.init(MTOK, NZT, G, bx);
            pg8::EpiIn E{Zb, Gt, SSQ, ROPEC, ROPES, p.in[3] + l * 64, p.in[4] + l * 64, p.in[6] + l * 64, p.in[7] + l * 64, ws + WS_KT, ws + WS_VT};
            pg8::gemm_phase<pg8::EpiIn, pg8::StaticOrder, true, true>(lds, g, S, E);
        }
        SEAM(pb);
        if (IN_PH(pb + 1)) {
            MixCtx C{Zb, Gt, Yb, p.in[5] + l * 8, p.in[8] + l * 4, p.in[9] + l * 4, p.in[10] + l * 4, p.in[11] + l * 256, ws, ws + WS_KT, ws + WS_VT};
            MlScratch MS{(float*)(ws + WS_MLE), (float*)(ws + WS_MLB), (float*)(ws + WS_MLPM), (float*)(ws + WS_CL), (float*)(ws + WS_NL), (bf16_t*)(ws + WS_CP), (float*)(ws + WS_NP), (float*)(ws + WS_GC), (float*)(ws + WS_EM), (float*)(ws + WS_MP), ctl + 128 + 32 * l, ctl + 192 + 32 * l};
            LAS int* itm = (LAS int*)(lds + 143360);
            float* NF = (float*)(ws + WS_NFX); unsigned* cntF = ctl + 512 + 32 * l; unsigned* qctr = ctl + 64 * l;
            for (;;) {
                __syncthreads();
                if (tid == 0) *itm = (int)atomicAdd(qctr, 1u);
                __syncthreads();
                const int it = *itm;
                if (it >= N_ITEMS) break;
                constexpr int Q_ML1 = N_FX0, Q_ML2 = Q_ML1 + N_ML1, Q_FOXA = Q_ML2 + N_ML2, N_FOXA = 256, Q_ML3 = Q_FOXA + N_FOXA, Q_FOXB = Q_ML3 + N_ML3, Q_SWA = Q_FOXB + (N_FOX - N_FOXA);
                static_assert(Q_SWA + N_SWA == N_ITEMS, "queue map");
                if (it < Q_ML1) fx0_item(C, NF, cntF, it, lds);
                else if (it < Q_ML2) { const int k = it - Q_ML1; ml1_item(C, MS, k >> 3, k & 7, lds); }
                else if (it < Q_FOXA) { const int k = it - Q_ML2; ml2_item(C, MS, k >> 1, k & 1, lds); }
                else if (it < Q_ML3) {
                    if (tid == 0) { const unsigned x = xb_xcc_id() & 7u; int sel = 0;
                        for (unsigned t = 0; t < 8u; ++t) { const unsigned q = (x + t) & 7u; const unsigned j = atomicAdd(ctl + 640 + 16 * l + q, 1u); if (j < 32u) { sel = (int)(q * 32u + j); break; } }
                        itm[1] = sel; }
                    __syncthreads();
                    const int k = itm[1];
                    fox_item(C, NF, cntF, k >> 4, k & 15, lds); }
                else if (it < Q_FOXB) { const int k = it - Q_ML3; ml3_item(C, MS, k >> 4, k & 15, lds); }
                else if (it < Q_SWA) { const int k = it - Q_FOXB + N_FOXA; fox_item(C, NF, cntF, k & 15, k >> 4, lds); }
                else swa_item(C, it - Q_SWA, lds);
            }
        }
        SEAM(pb + 1);
        if (IN_PH(pb + 2)) {
            pg8::Gemm g{Yb, (const bf16_t*)(ws + WS_WOUT + l * WOUT_L), MTOK, DMODEL, DMODEL}; pg8::StaticOrder S; S.init(MTOK, DMODEL, G, bx);
            pg8::EpiRes E{XG, SSQ2, nullptr, nullptr};
            pg8::gemm_phase<pg8::EpiRes, pg8::StaticOrder, true, true>(lds, g, S, E);
        }
        SEAM(pb + 2);
        if (IN_PH(pb + 3)) {
            pg8::Gemm g{XG, (const bf16_t*)(ws + WS_WFF1 + l * WFF_L), MTOK, DFF, DMODEL}; pg8::StaticOrder S; S.init(MTOK, DFF, G, bx);
            pg8::EpiFF1 E{Hb};
            pg8::gemm_phase<pg8::EpiFF1, pg8::StaticOrder, true, true>(lds, g, S, E);
        }
        SEAM(pb + 3);
        if (IN_PH(pb + 4)) {
            pg8::Gemm g{Hb, (const bf16_t*)(ws + WS_WFF2 + l * WFF_L), MTOK, DMODEL, DFF}; pg8::StaticOrder S; S.init(MTOK, DMODEL, G, bx);
            pg8::EpiRes E{XG, SSQ, l + 1 == DEPTH ? p.out : nullptr, SSQ2};
            pg8::gemm_phase<pg8::EpiRes, pg8::StaticOrder, true, true>(lds, g, S, E);
        }
        SEAM(pb + 4);
    }
#undef IN_PH
#undef SEAM
}

constexpr int N_PHASES = 1 + 5 * DEPTH;
#ifndef MK_MULTI
#define MK_MULTI 0
#endif
extern "C" void kernel_launch(void* const* d_in, const int* in_sizes, int n_in, void* d_out, int out_size, void* d_ws, size_t ws_size, hipStream_t stream) {
    static int grid = 0;
    if (grid == 0) {
        if (n_in != 16 || out_size != MTOK * DMODEL || ws_size < WS_END) { fprintf(stderr, "kernel_launch: unexpected shapes (n_in %d out %d ws %zu)\n", n_in, out_size, ws_size); grid = -1; return; }
        int dev = 0, cus = 0, per_cu = 0;
        hipGetDevice(&dev); hipDeviceGetAttribute(&cus, hipDeviceAttributeMultiprocessorCount, dev);
        if (hipFuncSetAttribute((const void*)fwd_megakernel, hipFuncAttributeMaxDynamicSharedMemorySize, LDS_BYTES) != hipSuccess) { fprintf(stderr, "kernel_launch: hipFuncSetAttribute failed\n"); grid = -1; return; }
        if (hipOccupancyMaxActiveBlocksPerMultiprocessor(&per_cu, (const void*)fwd_megakernel, 512, LDS_BYTES) != hipSuccess || per_cu < 1) { fprintf(stderr, "kernel_launch: occupancy query says %d\n", per_cu); per_cu = 1; }
        (void)hipGetLastError();
        grid = cus;
        if (grid != 256) fprintf(stderr, "kernel_launch: %d CUs (expected 256)\n", grid);
    }
    if (grid < 0) return;
    hipMemsetAsync((char*)d_ws + WS_CTL, 0, CTL_BYTES, stream);
    Params a{};
    for (int i = 0; i < 16; ++i) a.in[i] = (const float*)d_in[i];
    a.out = (float*)d_out; a.ws = (unsigned char*)d_ws;
#if MK_MULTI
    for (int ph = 0; ph < N_PHASES; ++ph) { a.ph_lo = ph; a.ph_hi = ph + 1; hipLaunchKernelGGL(fwd_megakernel, dim3(grid), dim3(512), LDS_BYTES, stream, a); }
#else
    a.ph_lo = 0; a.ph_hi = N_PHASES;
    void* args[] = {&a};
    hipError_t e = hipLaunchCooperativeKernel((const void*)fwd_megakernel, dim3(grid), dim3(512), args, LDS_BYTES, stream);
    if (e != hipSuccess) fprintf(stderr, "cooperative launch failed: %s (grid %d)\n", hipGetErrorString(e), grid);
#endif
}
```

```cpp
#include <hip/hip_runtime.h>
#include <hip/hip_cooperative_groups.h>
#include <cstdio>
#include <cstdint>
#include <cmath>
namespace cg = cooperative_groups;
namespace pg8 {
#define PG8_LAS __attribute__((address_space(3)))
typedef unsigned short bf16_t;
typedef short bf16x8 __attribute__((ext_vector_type(8)));
typedef float f32x4 __attribute__((ext_vector_type(4)));
typedef unsigned u32x4 __attribute__((ext_vector_type(4)));
constexpr int BM = 256, BK = 64, HALF = 128, HTB = HALF * BK * 2  , STAGE_BYTES = 8 * HTB, NXCD = 8, WGM = 8;

__host__ __device__ __forceinline__ int lds_byte(int r, int c) { const int st = (r >> 4) * 2 + (c >> 5), rr = r & 15, cc = c & 31, ob = rr * 64 + cc * 2; return st * 1024 + (ob ^ (((ob >> 9) & 1) << 5)); }
__host__ __device__ __forceinline__ void stage_rc(int b, int& R, int& C) { const int st = b / 1024, sb = b % 1024, swz = sb ^ (((sb >> 9) & 1) << 5); R = (st >> 1) * 16 + swz / 64; C = (st & 1) * 32 + (swz % 64) / 2; }
__host__ __device__ __forceinline__ int perm32(int rho) { const int n = rho >> 4, i = rho & 15; return 8 * (i >> 2) + 4 * n + (i & 3); }

struct Unit { int pm, pn; };
struct Gemm { const bf16_t* A; const bf16_t* Bt; int M, N, K; };

struct StaticOrder {
    int nM, nN, nwg, G, c;
    __host__ __device__ void init(int M, int N, int G_, int c_) { nM = M / BM; nN = N / BM; nwg = nM * nN; G = G_; c = c_; }
    __host__ __device__ bool next(int i, Unit& u) const {
        const long L = (long)i * G + c; if (L >= nwg) return false;
        int wgid = (int)L; { const int q = nwg / NXCD, r = nwg % NXCD, xcd = wgid % NXCD, off = wgid / NXCD; wgid = (xcd < r ? xcd * (q + 1) : r * (q + 1) + (xcd - r) * q) + off; }
        const int nig = WGM * nN, gid = wgid / nig, fm = gid * WGM, gsz = (nM - fm) < WGM ? (nM - fm) : WGM;
        u.pm = fm + ((wgid % nig) % gsz); u.pn = (wgid % nig) / gsz; return true;
    }
    __device__ __forceinline__ void a_ready(const Unit&) const {}
    __device__ __forceinline__ void done(const Unit&) const {}
};

__device__ __forceinline__ unsigned cvt_pk_bf16(float lo, float hi) { unsigned r; asm volatile("v_cvt_pk_bf16_f32 %0, %1, %2" : "=v"(r) : "v"(lo), "v"(hi)); return r; }
constexpr float EPS = 1e-6f;
constexpr float LOG2E = 1.4426950408889634f;
constexpr float C2 = 0.125f * LOG2E;
constexpr int ZP = 2560;

__device__ __forceinline__ float row_rstd(const float* ssq, int row, int fq) {
    const float* sp = ssq + (size_t)row * 32 + fq * 8;
    const f32x4 s0 = *(const f32x4*)sp, s1 = *(const f32x4*)(sp + 4);
    float t = ((s0[0] + s0[1]) + (s0[2] + s0[3])) + ((s1[0] + s1[1]) + (s1[2] + s1[3]));
    t += __shfl_xor(t, 16); t += __shfl_xor(t, 32);
    return rsqrtf(t * (1.0f / 1024.0f) + EPS);
}

struct EpiIn {
    static constexpr bool PERM = true, AFTER_DRAIN = false;
    bf16_t* Z; float* G; const float* ssq; const float* ropec; const float* ropes; const float* gqa; const float* gka; const float* gqb; const float* gkb;
    unsigned char* KT; unsigned char* VT;
    __device__ __forceinline__ void operator()(const f32x4 (&acc)[2][2][4][2], const Unit& u, int wr, int wc, int fr, int fq) const {
        const int pn = u.pn;
        int type = 0; const float* gsel = gqa; bool rp = false; float sc = 1.f;
        if (pn < 2) { type = 1; gsel = gqa; rp = true; sc = C2; }
        else if (pn == 2) { if (wc < 2) { type = 1; gsel = gka; rp = true; } }
        else if (pn == 3) { type = 1; gsel = gqb; sc = C2; }
        else if (pn == 4) { type = 1; gsel = gkb; }
        else if (pn == 7) { sc = 0.125f; }
        else if (pn == 9) { type = 2; }
        else if (pn == 10) { type = 3; }
        if (type == 3 && wc != 0) return;
        const int dcol = 8 * fq;
        unsigned char* tp = nullptr;
        if (pn == 4 || pn == 5) { const size_t tb0 = (size_t)((((u.pm * BM) >> 12) * 4 + wc) * 64 + (((u.pm * BM) & 4095) >> 6) + wr) * 8192;
            tp = pn == 4 ? KT + tb0 + fq * 1024 + fr * 16 : VT + tb0 + (fr * 4 + fq) * 16; }
        float gn[2][8];
#pragma unroll
        for (int bj = 0; bj < 2; ++bj)
#pragma unroll
            for (int i = 0; i < 8; ++i) gn[bj][i] = (type == 1) ? gsel[32 * bj + dcol + i] : 1.f;
#pragma unroll
        for (int ai = 0; ai < 2; ++ai)
#pragma unroll
            for (int m = 0; m < 4; ++m) {
                const int row = u.pm * BM + ai * HALF + wr * 64 + m * 16 + fr;
                const float rstd = ssq[row];
                float v[2][8];
#pragma unroll
                for (int bj = 0; bj < 2; ++bj)
#pragma unroll
                    for (int n = 0; n < 2; ++n)
#pragma unroll
                        for (int e = 0; e < 4; ++e) v[bj][4 * n + e] = acc[ai][bj][m][n][e] * rstd;
                if (type == 1) {
                    float ss = 0.f;
#pragma unroll
                    for (int bj = 0; bj < 2; ++bj)
#pragma unroll
                        for (int i = 0; i < 8; ++i) ss += v[bj][i] * v[bj][i];
                    ss += __shfl_xor(ss, 16); ss += __shfl_xor(ss, 32);
                    const float hr = rsqrtf(ss * (1.0f / 64.0f) + EPS);
#pragma unroll
                    for (int bj = 0; bj < 2; ++bj)
#pragma unroll
                        for (int i = 0; i < 8; ++i) v[bj][i] *= hr * gn[bj][i];
                    if (rp) {
                        const int pos = row & 4095;
                        const f32x4 c0 = *(const f32x4*)(ropec + pos * 32 + dcol), c1 = *(const f32x4*)(ropec + pos * 32 + dcol + 4);
                        const f32x4 s0 = *(const f32x4*)(ropes + pos * 32 + dcol), s1 = *(const f32x4*)(ropes + pos * 32 + dcol + 4);
#pragma unroll
                        for (int i = 0; i < 8; ++i) {
                            const float c = i < 4 ? c0[i & 3] : c1[i & 3], s = i < 4 ? s0[i & 3] : s1[i & 3];
                            const float x1 = v[0][i], x2 = v[1][i];
                            v[0][i] = x1 * c - x2 * s; v[1][i] = x2 * c + x1 * s;
                        }
                    }
#pragma unroll
                    for (int bj = 0; bj < 2; ++bj)
#pragma unroll
                        for (int i = 0; i < 8; ++i) v[bj][i] *= sc;
                } else if (type == 2) {
#pragma unroll
                    for (int bj = 0; bj < 2; ++bj)
#pragma unroll
                        for (int i = 0; i < 8; ++i) v[bj][i] = 1.0f / (1.0f + __expf(-v[bj][i]));
                } else if (type == 0) {
#pragma unroll
                    for (int bj = 0; bj < 2; ++bj)
#pragma unroll
                        for (int i = 0; i < 8; ++i) v[bj][i] *= sc;
                }
                if (type == 3) {
                    float* gp = G + (size_t)row * 16;
                    if (fq == 0) { *(f32x4*)gp = (f32x4){v[0][0], v[0][1], v[0][2], v[0][3]}; *(f32x4*)(gp + 4) = (f32x4){v[0][4], v[0][5], v[0][6], v[0][7]}; }
                    else if (fq == 1) { *(f32x4*)(gp + 8) = (f32x4){v[0][0], v[0][1], v[0][2], v[0][3]}; }
                } else {
#pragma unroll
                    for (int bj = 0; bj < 2; ++bj) {
                        u32x4 w; w.x = cvt_pk_bf16(v[bj][0], v[bj][1]); w.y = cvt_pk_bf16(v[bj][2], v[bj][3]); w.z = cvt_pk_bf16(v[bj][4], v[bj][5]); w.w = cvt_pk_bf16(v[bj][6], v[bj][7]);
                        if (pn == 4) *(u32x4*)(tp + ai * 16384 + bj * 4096 + m * 256) = w;
                        else if (pn == 5) *(u32x4*)(tp + ai * 16384 + bj * 4096 + m * 1024) = w;
                        else
                        *(u32x4*)(Z + (size_t)row * ZP + 256 * pn + 64 * wc + 32 * bj + dcol) = w;
                    }
                }
                if (m & 1) asm volatile("" ::: "memory");
            }
    }
};

struct EpiRes {
    static constexpr bool PERM = true, AFTER_DRAIN = false;
    bf16_t* XB; float* ssq; float* out; const float* rsq;
    __device__ __forceinline__ void operator()(const f32x4 (&acc)[2][2][4][2], const Unit& u, int wr, int wc, int fr, int fq) const {
        float r2[8];
#pragma unroll
        for (int j = 0; j < 8; ++j) r2[j] = 1.f;
        if (rsq) {
#pragma unroll
            for (int j = 0; j < 8; ++j) { const float r = row_rstd(rsq, u.pm * BM + (j >> 2) * HALF + wr * 64 + (j & 3) * 16 + fr, fq); r2[j] = r * r; }
        }
#pragma unroll
        for (int bj = 0; bj < 2; ++bj) {
            const int col0 = u.pn * BM + bj * HALF + wc * 32 + 8 * fq;
#pragma unroll
            for (int ai = 0; ai < 2; ++ai)
#pragma unroll
                for (int m = 0; m < 4; ++m) {
                    const int row = u.pm * BM + ai * HALF + wr * 64 + m * 16 + fr;
                    const size_t off = (size_t)row * 1024 + col0;
                    const u32x4 bw = *(const u32x4*)(XB + off);
                    f32x4 x0 = acc[ai][bj][m][0] * r2[ai * 4 + m], x1 = acc[ai][bj][m][1] * r2[ai * 4 + m];
                    x0[0] += __builtin_bit_cast(float, bw.x << 16); x0[1] += __builtin_bit_cast(float, bw.x & 0xffff0000u);
                    x0[2] += __builtin_bit_cast(float, bw.y << 16); x0[3] += __builtin_bit_cast(float, bw.y & 0xffff0000u);
                    x1[0] += __builtin_bit_cast(float, bw.z << 16); x1[1] += __builtin_bit_cast(float, bw.z & 0xffff0000u);
                    x1[2] += __builtin_bit_cast(float, bw.w << 16); x1[3] += __builtin_bit_cast(float, bw.w & 0xffff0000u);
                    if (out) { *(f32x4*)(out + off) = x0; *(f32x4*)(out + off + 4) = x1; }
                    else {
                        float ss = ((x0[0] * x0[0] + x0[1] * x0[1]) + (x0[2] * x0[2] + x0[3] * x0[3])) + ((x1[0] * x1[0] + x1[1] * x1[1]) + (x1[2] * x1[2] + x1[3] * x1[3]));
                        ss += __shfl_xor(ss, 16); ss += __shfl_xor(ss, 32);
                        if (fq == 0) ssq[(size_t)row * 32 + u.pn * 8 + bj * 4 + wc] = ss;
                        u32x4 w; w.x = cvt_pk_bf16(x0[0], x0[1]); w.y = cvt_pk_bf16(x0[2], x0[3]); w.z = cvt_pk_bf16(x1[0], x1[1]); w.w = cvt_pk_bf16(x1[2], x1[3]);
                        *(u32x4*)(XB + off) = w;
                    }
                }
        }
    }
};

struct EpiFF1 {
    static constexpr bool PERM = true, AFTER_DRAIN = false;
    bf16_t* H;
    __device__ __forceinline__ void operator()(const f32x4 (&acc)[2][2][4][2], const Unit& u, int wr, int wc, int fr, int fq) const {
#pragma unroll
        for (int ai = 0; ai < 2; ++ai)
#pragma unroll
            for (int m = 0; m < 4; ++m) {
                const int row = u.pm * BM + ai * HALF + wr * 64 + m * 16 + fr;
#pragma unroll
                for (int bj = 0; bj < 2; ++bj) {
                    const int col0 = u.pn * BM + bj * HALF + wc * 32 + 8 * fq;
                    f32x4 a = acc[ai][bj][m][0], b = acc[ai][bj][m][1];
#pragma unroll
                    for (int e = 0; e < 4; ++e) { a[e] = fmaxf(a[e], 0.f); a[e] *= a[e]; b[e] = fmaxf(b[e], 0.f); b[e] *= b[e]; }
                    u32x4 w; w.x = cvt_pk_bf16(a[0], a[1]); w.y = cvt_pk_bf16(a[2], a[3]); w.z = cvt_pk_bf16(b[0], b[1]); w.w = cvt_pk_bf16(b[2], b[3]);
                    *(u32x4*)(H + (size_t)row * 4096 + col0) = w;
                }
            }
    }
};

template <class Epi, class Sched, bool ALIGN_EPI = false, bool SP2 = false>
__device__ __forceinline__ void gemm_phase(PG8_LAS unsigned char* lds, const Gemm g, const Sched& S, const Epi& E) {
    int tid_ = threadIdx.x; asm volatile("" : "+v"(tid_));
    const int tid = tid_, wid = __builtin_amdgcn_readfirstlane(tid >> 6), lane = tid & 63, wr = wid >> 2, wc = wid & 3, fr = lane & 15, fq = lane >> 4;
    const int K = g.K, nt = K / BK;
    unsigned voffA[2], voffB[2];
#pragma unroll
    for (int i = 0; i < 2; ++i) { int R, C; stage_rc(tid * 16 + i * 8192, R, C); const int Rb = Epi::PERM ? ((R & ~31) + perm32(R & 31)) : R;
        voffA[i] = (unsigned)(R * K + C) * 2u; voffB[i] = (unsigned)(Rb * K + C) * 2u; }
    const size_t kstep = (size_t)(BK * 2);
    const size_t hstep = (size_t)HALF * K * 2;
    const size_t tstep = 2 * hstep;
    const unsigned ldsw = (unsigned)wid * 1024u;
    const int aoff = lds_byte(wr * 64 + fr, fq * 8), boff = lds_byte(wc * 32 + fr, fq * 8);
#define PG8_SA(b, h) (((b) * 2 + (h)) * HTB)
#define PG8_SB(b, h) ((4 + (b) * 2 + (h)) * HTB)
#define PG8_STAGE(bufoff, gbase, voff) do { _Pragma("unroll") for (int _i = 0; _i < 2; ++_i) \
        __builtin_amdgcn_global_load_lds((const unsigned*)((const char*)(gbase) + (voff)[_i]), (PG8_LAS unsigned*)(lds + (bufoff) + ldsw + _i * 8192), 16, 0, 0); } while (0)
#define PG8_LDA(dst, b, h) do { _Pragma("unroll") for (int m = 0; m < 4; ++m) _Pragma("unroll") for (int k = 0; k < 2; ++k) dst[m][k] = *(const PG8_LAS bf16x8*)(lds + PG8_SA(b, h) + aoff + m * 2048 + k * 1024); } while (0)
#define PG8_LDB(dst, b, h) do { _Pragma("unroll") for (int n = 0; n < 2; ++n) _Pragma("unroll") for (int k = 0; k < 2; ++k) dst[n][k] = *(const PG8_LAS bf16x8*)(lds + PG8_SB(b, h) + boff + n * 2048 + k * 1024); } while (0)
#define PG8_MMA(ai, bj, At, Bt) do { __builtin_amdgcn_s_setprio(1); _Pragma("unroll") for (int m = 0; m < 4; ++m) _Pragma("unroll") for (int n = 0; n < 2; ++n) _Pragma("unroll") for (int k = 0; k < 2; ++k) \
        acc[ai][bj][m][n] = __builtin_amdgcn_mfma_f32_16x16x32_bf16(Bt[n][k], At[m][k], acc[ai][bj][m][n], 0, 0, 0); __builtin_amdgcn_s_setprio(0); } while (0)
#define PG8_WAIT_V(n) asm volatile("s_waitcnt vmcnt(" #n ")" ::: "memory")
#define PG8_WAIT_L(n) asm volatile("s_waitcnt lgkmcnt(" #n ")" ::: "memory")
#define PG8_BAR __builtin_amdgcn_s_barrier()
#define PG8_SCHED __builtin_amdgcn_sched_barrier(0)
    Unit cur, nxt; int ui = 0;
    if (!S.next(0, cur)) return;
    f32x4 acc[2][2][4][2];
#pragma unroll
    for (int a = 0; a < 2; ++a)
#pragma unroll
        for (int b = 0; b < 2; ++b)
#pragma unroll
            for (int m = 0; m < 4; ++m)
#pragma unroll
                for (int n = 0; n < 2; ++n) acc[a][b][m][n] = (f32x4){0.f, 0.f, 0.f, 0.f};
    bf16x8 At[4][2], B0[2][2], B1[2][2];
    const char* cA = (const char*)g.A + (size_t)cur.pm * tstep; const char* cB = (const char*)g.Bt + (size_t)cur.pn * tstep;
    S.a_ready(cur);
    if constexpr (SP2) {
        PG8_STAGE(PG8_SB(0, 0), cB, voffB); PG8_STAGE(PG8_SB(0, 1), cB + hstep, voffB); PG8_STAGE(PG8_SA(0, 0), cA, voffA); PG8_STAGE(PG8_SA(0, 1), cA + hstep, voffA);
        if (wr == 1) PG8_BAR;
        PG8_WAIT_V(2); PG8_BAR;
        PG8_STAGE(PG8_SB(1, 0), cB + kstep, voffB); PG8_STAGE(PG8_SA(1, 0), cA + kstep, voffA); PG8_STAGE(PG8_SB(1, 1), cB + hstep + kstep, voffB);
        PG8_WAIT_V(6); PG8_BAR;
    } else {
        PG8_STAGE(PG8_SB(0, 0), cB, voffB); PG8_STAGE(PG8_SA(0, 0), cA, voffA); PG8_STAGE(PG8_SB(0, 1), cB + hstep, voffB); PG8_STAGE(PG8_SA(0, 1), cA + hstep, voffA);
        if (wr == 1) PG8_BAR;
        PG8_WAIT_V(4); PG8_BAR;
        PG8_STAGE(PG8_SB(1, 0), cB + kstep, voffB); PG8_STAGE(PG8_SA(1, 0), cA + kstep, voffA); PG8_STAGE(PG8_SB(1, 1), cB + hstep + kstep, voffB);
        PG8_WAIT_V(6); PG8_BAR;
    }
    for (;;) {
        const bool has_next = S.next(ui + 1, nxt);
        const char* nA = has_next ? (const char*)g.A + (size_t)nxt.pm * tstep : cA; const char* nB = has_next ? (const char*)g.Bt + (size_t)nxt.pn * tstep : cB;
        for (int t = 0; t < nt; t += 2) {
            const bool last = (t == nt - 2);
            const char* a1 = cA + (size_t)(t + 1) * kstep;
            const char* a2 = last ? nA : cA + (size_t)(t + 2) * kstep; const char* b2 = last ? nB : cB + (size_t)(t + 2) * kstep;
            const char* a3 = a2 + kstep; const char* b3 = b2 + kstep;
            if (last && has_next) S.a_ready(nxt);
            if constexpr (SP2) {
            PG8_LDB(B0, 0, 0); PG8_LDB(B1, 0, 1); PG8_SCHED; PG8_LDA(At, 0, 0); PG8_STAGE(PG8_SA(1, 1), a1 + hstep, voffA);
            PG8_WAIT_V(8); PG8_WAIT_L(0); PG8_BAR; PG8_MMA(0, 0, At, B0); PG8_MMA(0, 1, At, B1); PG8_BAR; PG8_SCHED;
            PG8_LDA(At, 0, 1); PG8_STAGE(PG8_SB(0, 0), b2, voffB); PG8_STAGE(PG8_SB(0, 1), b2 + hstep, voffB); PG8_STAGE(PG8_SA(0, 0), a2, voffA);
            PG8_WAIT_V(8); PG8_WAIT_L(0); PG8_BAR; PG8_MMA(1, 0, At, B0); PG8_MMA(1, 1, At, B1); PG8_BAR; PG8_SCHED;
            PG8_LDB(B0, 1, 0); PG8_LDB(B1, 1, 1); PG8_SCHED; PG8_LDA(At, 1, 0); PG8_STAGE(PG8_SA(0, 1), a2 + hstep, voffA);
            PG8_WAIT_V(8); PG8_WAIT_L(0); PG8_BAR; PG8_MMA(0, 0, At, B0); PG8_MMA(0, 1, At, B1); PG8_BAR; PG8_SCHED;
            PG8_LDA(At, 1, 1); PG8_STAGE(PG8_SB(1, 0), b3, voffB); PG8_STAGE(PG8_SB(1, 1), b3 + hstep, voffB); PG8_STAGE(PG8_SA(1, 0), a3, voffA);
            PG8_WAIT_V(8); PG8_WAIT_L(0); PG8_BAR; PG8_MMA(1, 0, At, B0); PG8_MMA(1, 1, At, B1); PG8_BAR; PG8_SCHED;
            } else {
            PG8_LDB(B0, 0, 0); PG8_SCHED; PG8_LDA(At, 0, 0); PG8_STAGE(PG8_SA(1, 1), a1 + hstep, voffA);
            PG8_WAIT_L(8); PG8_BAR; PG8_WAIT_L(0); PG8_MMA(0, 0, At, B0); PG8_BAR; PG8_SCHED;
            PG8_LDB(B1, 0, 1); PG8_STAGE(PG8_SB(0, 0), b2, voffB);
            PG8_BAR; PG8_WAIT_L(0); PG8_MMA(0, 1, At, B1); PG8_BAR;
            PG8_LDA(At, 0, 1); PG8_STAGE(PG8_SA(0, 0), a2, voffA);
            PG8_BAR; PG8_WAIT_L(0); PG8_MMA(1, 0, At, B0); PG8_BAR; PG8_SCHED;
            PG8_STAGE(PG8_SB(0, 1), b2 + hstep, voffB);
            PG8_WAIT_V(6); PG8_BAR; PG8_MMA(1, 1, At, B1); PG8_BAR;
            PG8_LDB(B0, 1, 0); PG8_SCHED; PG8_LDA(At, 1, 0); PG8_STAGE(PG8_SA(0, 1), a2 + hstep, voffA);
            PG8_WAIT_L(8); PG8_BAR; PG8_WAIT_L(0); PG8_MMA(0, 0, At, B0); PG8_BAR; PG8_SCHED;
            PG8_LDB(B1, 1, 1); PG8_STAGE(PG8_SB(1, 0), b3, voffB);
            PG8_BAR; PG8_WAIT_L(0); PG8_MMA(0, 1, At, B1); PG8_BAR;
            PG8_LDA(At, 1, 1); PG8_STAGE(PG8_SA(1, 0), a3, voffA);
            PG8_BAR; PG8_WAIT_L(0); PG8_MMA(1, 0, At, B0); PG8_BAR; PG8_SCHED;
            PG8_STAGE(PG8_SB(1, 1), b3 + hstep, voffB);
            PG8_WAIT_V(6); PG8_BAR; PG8_MMA(1, 1, At, B1); PG8_BAR;
            }
        }
        if constexpr (ALIGN_EPI) { if (wr == 0) PG8_BAR; }
        if constexpr (!Epi::AFTER_DRAIN) { E(acc, cur, wr, wc, fr, fq); S.done(cur); }
        if (!has_next) break;
#pragma unroll
        for (int a = 0; a < 2; ++a)
#pragma unroll
            for (int b = 0; b < 2; ++b)
#pragma unroll
                for (int m = 0; m < 4; ++m)
#pragma unroll
                    for (int n = 0; n < 2; ++n) acc[a][b][m][n] = (f32x4){0.f, 0.f, 0.f, 0.f};
        cur = nxt; cA = nA; cB = nB; ++ui;
        if constexpr (ALIGN_EPI) { if (wr == 1) PG8_BAR; }
    }
    PG8_WAIT_V(0);
    if constexpr (!ALIGN_EPI) { if (wr == 0) PG8_BAR; }
    PG8_BAR;
    if constexpr (Epi::AFTER_DRAIN) { E.fused(acc, cur, wr, wc, fr, fq, lds, wid, lane); S.done(cur); }
#undef PG8_SA
#undef PG8_SB
#undef PG8_STAGE
#undef PG8_LDA
#undef PG8_LDB
#undef PG8_MMA
#undef PG8_WAIT_V
#undef PG8_WAIT_L
#undef PG8_BAR
#undef PG8_SCHED
}
}
#define LAS __attribute__((address_space(3)))
typedef unsigned short bf16_t;
typedef short bf16x8 __attribute__((ext_vector_type(8)));
typedef short s16x4 __attribute__((ext_vector_type(4)));
typedef float f32x4 __attribute__((ext_vector_type(4)));
typedef float f32x16 __attribute__((ext_vector_type(16)));
typedef unsigned u32x4 __attribute__((ext_vector_type(4)));
typedef unsigned u32x2 __attribute__((ext_vector_type(2)));
using pg8::ZP; using pg8::LOG2E; using pg8::EPS;
__device__ __forceinline__ int crow(int r, int hi) { return (r & 3) + 8 * (r >> 2) + 4 * hi; }
__device__ __forceinline__ unsigned cvtpk(float lo, float hi) { unsigned r; asm volatile("v_cvt_pk_bf16_f32 %0, %1, %2" : "=v"(r) : "v"(lo), "v"(hi)); return r; }
__device__ __forceinline__ unsigned f2bf(float f) { unsigned u = __builtin_bit_cast(unsigned, f); return (u + 0x7fffu + ((u >> 16) & 1u)) >> 16; }
__device__ __forceinline__ float bf2f(unsigned short h) { return __builtin_bit_cast(float, (unsigned)h << 16); }
__device__ __forceinline__ float ex2(float x) { return __builtin_amdgcn_exp2f(x); }
#define VM_WAIT0() asm volatile("s_waitcnt vmcnt(0)" ::: "memory")
#define LGKM_WAIT0() asm volatile("s_waitcnt lgkmcnt(0)" ::: "memory")

__device__ __forceinline__ void dma_k(LAS unsigned char* slot, const bf16_t* src, int pitch, int w, int lane) {
    const bf16_t* s = src + (size_t)lane * pitch + w * 8;
    __builtin_amdgcn_global_load_lds((const unsigned*)s, (LAS unsigned*)(slot + w * 1024), 16, 0, 0);
}
__device__ __forceinline__ void dma_v(LAS unsigned char* slot, const bf16_t* src, int pitch, int w, int lane) {
    const bf16_t* s = src + (size_t)(16 * (w & 3) + (lane >> 2)) * pitch + (w >> 2) * 32 + (lane & 3) * 8;
    __builtin_amdgcn_global_load_lds((const unsigned*)s, (LAS unsigned*)(slot + w * 1024), 16, 0, 0);
}
__device__ __forceinline__ void dma_lin(LAS unsigned char* slot, const unsigned char* src, int w, int lane) {
    __builtin_amdgcn_global_load_lds((const unsigned*)(src + w * 1024 + lane * 16), (LAS unsigned*)(slot + w * 1024), 16, 0, 0);
}
__device__ __forceinline__ void qkt(f32x16& p0, f32x16& p1, const LAS unsigned char* Kslot, const bf16x8* qr, int r32, int hi, f32x16 z0 = f32x16{}, f32x16 z1 = f32x16{}) {
    const LAS unsigned char* kb = Kslot + hi * 1024 + r32 * 16;
#pragma unroll
    for (int d0 = 0; d0 < 4; ++d0) {
        const bf16x8 b0 = *(const LAS bf16x8*)(kb + d0 * 2048);
        const bf16x8 b1 = *(const LAS bf16x8*)(kb + d0 * 2048 + 512);
        z0 = __builtin_amdgcn_mfma_f32_32x32x16_bf16(b0, qr[d0], z0, 0, 0, 0);
        z1 = __builtin_amdgcn_mfma_f32_32x32x16_bf16(b1, qr[d0], z1, 0, 0, 0);
    }
    p0 = z0; p1 = z1;
}
__device__ __forceinline__ int vt_lane_off(int lane) { const int hi = lane >> 5; return ((lane >> 4) & 1) * 32 + (lane & 3) * 8 + (4 * hi + ((lane & 15) >> 2)) * 64; }
__device__ __forceinline__ bf16x8 vfrag(int vb, int d0, int ks) {
    s16x4 lo, hh;
    asm volatile("ds_read_b64_tr_b16 %0, %1" : "=v"(lo) : "v"(vb + d0 * 4096 + ks * 1024) : "memory");
    asm volatile("ds_read_b64_tr_b16 %0, %1" : "=v"(hh) : "v"(vb + d0 * 4096 + ks * 1024 + 512) : "memory");
    asm volatile("s_waitcnt lgkmcnt(0)" : "+v"(lo), "+v"(hh) :: "memory");
    return (bf16x8){lo[0], lo[1], lo[2], lo[3], hh[0], hh[1], hh[2], hh[3]};
}
__device__ __forceinline__ void pv(f32x16* o, int vb, bf16x8 pa0, bf16x8 pa1, bf16x8 pa2, bf16x8 pa3) {
    s16x4 lo[8], hh[8];
#pragma unroll
    for (int i = 0; i < 8; ++i) {
        asm volatile("ds_read_b64_tr_b16 %0, %1 offset:%c2" : "=&v"(lo[i]) : "v"(vb), "i"((i >> 2) * 4096 + (i & 3) * 1024) : "memory");
        asm volatile("ds_read_b64_tr_b16 %0, %1 offset:%c2" : "=&v"(hh[i]) : "v"(vb), "i"((i >> 2) * 4096 + (i & 3) * 1024 + 512) : "memory");
    }
    asm volatile("s_waitcnt lgkmcnt(0)" : "+v"(lo[0]), "+v"(lo[1]), "+v"(lo[2]), "+v"(lo[3]), "+v"(lo[4]), "+v"(lo[5]), "+v"(lo[6]), "+v"(lo[7]),
                 "+v"(hh[0]), "+v"(hh[1]), "+v"(hh[2]), "+v"(hh[3]), "+v"(hh[4]), "+v"(hh[5]), "+v"(hh[6]), "+v"(hh[7]) :: "memory");
#define PVK(k) (bf16x8){lo[k][0], lo[k][1], lo[k][2], lo[k][3], hh[k][0], hh[k][1], hh[k][2], hh[k][3]}
    o[0] = __builtin_amdgcn_mfma_f32_32x32x16_bf16(pa0, PVK(0), o[0], 0, 0, 0);
    o[1] = __builtin_amdgcn_mfma_f32_32x32x16_bf16(pa0, PVK(4), o[1], 0, 0, 0);
    o[0] = __builtin_amdgcn_mfma_f32_32x32x16_bf16(pa1, PVK(1), o[0], 0, 0, 0);
    o[1] = __builtin_amdgcn_mfma_f32_32x32x16_bf16(pa1, PVK(5), o[1], 0, 0, 0);
    o[0] = __builtin_amdgcn_mfma_f32_32x32x16_bf16(pa2, PVK(2), o[0], 0, 0, 0);
    o[1] = __builtin_amdgcn_mfma_f32_32x32x16_bf16(pa2, PVK(6), o[1], 0, 0, 0);
    o[0] = __builtin_amdgcn_mfma_f32_32x32x16_bf16(pa3, PVK(3), o[0], 0, 0, 0);
    o[1] = __builtin_amdgcn_mfma_f32_32x32x16_bf16(pa3, PVK(7), o[1], 0, 0, 0);
#undef PVK
}
#define PACK8(P, B) __builtin_bit_cast(bf16x8, ((u32x4){cvtpk(P[B], P[B + 1]), cvtpk(P[B + 2], P[B + 3]), cvtpk(P[B + 4], P[B + 5]), cvtpk(P[B + 6], P[B + 7])}))
__device__ __forceinline__ void scale_rows(f32x16* o, float f, LAS float* wsf, int r32, int hi) {
    if (hi == 0) wsf[r32] = f;
    LGKM_WAIT0();
#pragma unroll
    for (int r = 0; r < 16; ++r) { const float fr = wsf[crow(r, hi)]; o[0][r] *= fr; o[1][r] *= fr; }
    LGKM_WAIT0();
}
__device__ __forceinline__ float max3f(float x, float y, float z) { return __builtin_fmaxf(__builtin_fmaxf(x, y), z); }
typedef float f32x8 __attribute__((ext_vector_type(8)));
typedef float f32x2 __attribute__((ext_vector_type(2)));
typedef short v4i16_t __attribute__((ext_vector_type(4)));
__device__ __forceinline__ s16x4 vtr(const LAS unsigned char* p) { return __builtin_bit_cast(s16x4, __builtin_amdgcn_ds_read_tr16_b64_v4i16((LAS v4i16_t*)p)); }
__device__ __forceinline__ float rowmax32(const f32x16& p0, const f32x16& p1) {
    float a = max3f(p0[0], p0[1], p1[0]), b = max3f(p0[2], p0[3], p1[1]); a = max3f(a, p1[2], p1[3]);
#pragma unroll
    for (int r = 4; r < 16; r += 4) { a = max3f(a, p0[r], p0[r + 1]); b = max3f(b, p0[r + 2], p0[r + 3]); a = max3f(a, p1[r], p1[r + 1]); b = max3f(b, p1[r + 2], p1[r + 3]); }
    const float m = fmaxf(a, b);
    auto rr = __builtin_amdgcn_permlane32_swap(__builtin_bit_cast(unsigned, m), __builtin_bit_cast(unsigned, m), false, false);
    return fmaxf(__builtin_bit_cast(float, (unsigned)rr[0]), __builtin_bit_cast(float, (unsigned)rr[1]));
}
template <int THR, bool HASF>
__device__ __forceinline__ void attn_step(f32x16& p0, f32x16& p1, f32x16& n0, f32x16& n1, const LAS unsigned char* Knext, const LAS float* Fnext, const LAS unsigned char* Vcur,
                                          const bf16x8* qr, float& mhat, float& l, f32x16* o, LAS float* wsf, int r32, int hi) {
    f32x16 c0 = f32x16{}, c1 = f32x16{};
    if (HASF) {
#pragma unroll
        for (int rr = 0; rr < 4; ++rr) { const f32x4 f0 = *(const LAS f32x4*)(Fnext + 8 * rr), f1 = *(const LAS f32x4*)(Fnext + 32 + 8 * rr);
#pragma unroll
            for (int e = 0; e < 4; ++e) { c0[4 * rr + e] = f0[e]; c1[4 * rr + e] = f1[e]; } }
    }
    bf16x8 kf[8];
    { const LAS unsigned char* kb = Knext + hi * 1024 + r32 * 16;
#pragma unroll
      for (int d0 = 0; d0 < 4; ++d0) { kf[2 * d0] = *(const LAS bf16x8*)(kb + d0 * 2048); kf[2 * d0 + 1] = *(const LAS bf16x8*)(kb + d0 * 2048 + 512); } }
    __builtin_amdgcn_sched_barrier(0);
    const float rm = rowmax32(p0, p1);
    if (__any(rm > mhat + (float)THR)) {
        const float mnew = fmaxf(mhat, rm), f = ex2(mhat - mnew);
        l *= f; mhat = mnew; scale_rows(o, f, wsf, r32, hi);
    }
#pragma unroll
    for (int d0 = 0; d0 < 4; ++d0) {
        c0 = __builtin_amdgcn_mfma_f32_32x32x16_bf16(kf[2 * d0], qr[d0], c0, 0, 0, 0);
        c1 = __builtin_amdgcn_mfma_f32_32x32x16_bf16(kf[2 * d0 + 1], qr[d0], c1, 0, 0, 0);
    }
    __builtin_amdgcn_sched_barrier(0);
    s16x4 vl[8], vh[8];
#pragma unroll
    for (int i = 0; i < 8; ++i) { vl[i] = vtr(Vcur + (i >> 2) * 4096 + (i & 3) * 1024); vh[i] = vtr(Vcur + (i >> 2) * 4096 + (i & 3) * 1024 + 512); }
    __builtin_amdgcn_sched_barrier(0);
    p0 = p0 - mhat; p1 = p1 - mhat;
#pragma unroll
    for (int r = 0; r < 16; ++r) { p0[r] = ex2(p0[r]); p1[r] = ex2(p1[r]); }
    const f32x16 t = p0 + p1;
    const f32x8 t8 = t.lo + t.hi; const f32x4 t4 = t8.lo + t8.hi; const f32x2 t2 = t4.lo + t4.hi;
    l += t2.x + t2.y;
    const bf16x8 pa0 = PACK8(p0, 0), pa1 = PACK8(p0, 8), pa2 = PACK8(p1, 0), pa3 = PACK8(p1, 8);
#define VFK(k) (bf16x8){vl[k][0], vl[k][1], vl[k][2], vl[k][3], vh[k][0], vh[k][1], vh[k][2], vh[k][3]}
    o[0] = __builtin_amdgcn_mfma_f32_32x32x16_bf16(pa0, VFK(0), o[0], 0, 0, 0);
    o[1] = __builtin_amdgcn_mfma_f32_32x32x16_bf16(pa0, VFK(4), o[1], 0, 0, 0);
    o[0] = __builtin_amdgcn_mfma_f32_32x32x16_bf16(pa1, VFK(1), o[0], 0, 0, 0);
    o[1] = __builtin_amdgcn_mfma_f32_32x32x16_bf16(pa1, VFK(5), o[1], 0, 0, 0);
    o[0] = __builtin_amdgcn_mfma_f32_32x32x16_bf16(pa2, VFK(2), o[0], 0, 0, 0);
    o[1] = __builtin_amdgcn_mfma_f32_32x32x16_bf16(pa2, VFK(6), o[1], 0, 0, 0);
    o[0] = __builtin_amdgcn_mfma_f32_32x32x16_bf16(pa3, VFK(3), o[0], 0, 0, 0);
    o[1] = __builtin_amdgcn_mfma_f32_32x32x16_bf16(pa3, VFK(7), o[1], 0, 0, 0);
#undef VFK
    n0 = c0; n1 = c1;
}
template <int THR>
__device__ __forceinline__ void softmax_pv(f32x16& p0, f32x16& p1, float& mhat, float& l, f32x16* o, int vb, LAS float* wsf, int r32, int hi) {
    float a = max3f(p0[0], p0[1], p1[0]), b = max3f(p0[2], p0[3], p1[1]); a = max3f(a, p1[2], p1[3]);
#pragma unroll
    for (int r = 4; r < 16; r += 4) { a = max3f(a, p0[r], p0[r + 1]); b = max3f(b, p0[r + 2], p0[r + 3]); a = max3f(a, p1[r], p1[r + 1]); b = max3f(b, p1[r + 2], p1[r + 3]); }
    float rm = fmaxf(a, b); rm = fmaxf(rm, __shfl_xor(rm, 32));
    if (__any(rm > mhat + (float)THR)) {
        const float mnew = fmaxf(mhat, rm), f = ex2(mhat - mnew);
        l *= f; mhat = mnew; scale_rows(o, f, wsf, r32, hi);
    }
    p0 = p0 - mhat; p1 = p1 - mhat;
#pragma unroll
    for (int r = 0; r < 16; ++r) { p0[r] = ex2(p0[r]); p1[r] = ex2(p1[r]); }
    const f32x16 t = p0 + p1;
    const f32x8 t8 = t.lo + t.hi; const f32x4 t4 = t8.lo + t8.hi; const f32x2 t2 = t4.lo + t4.hi;
    l += t2.x + t2.y;
    pv(o, vb, PACK8(p0, 0), PACK8(p0, 8), PACK8(p1, 0), PACK8(p1, 8));
}
__device__ __forceinline__ void store_o(const f32x16* o, float rinv, LAS float* wsf, LAS bf16_t* stg, bf16_t* Og, int pitch, int r32, int hi, int lane) {
    if (hi == 0) wsf[32 + r32] = rinv;
    LGKM_WAIT0();
#pragma unroll
    for (int r = 0; r < 16; ++r) { const int orow = crow(r, hi); const float rl = wsf[32 + orow];
#pragma unroll
        for (int d0 = 0; d0 < 2; ++d0) stg[orow * 64 + d0 * 32 + r32] = (bf16_t)f2bf(o[d0][r] * rl); }
    LGKM_WAIT0();
#pragma unroll
    for (int i = 0; i < 4; ++i) { const int row = i * 8 + (lane >> 3), ch = lane & 7; const u32x4 v = *(const LAS u32x4*)(stg + row * 64 + ch * 8); *(u32x4*)(Og + (size_t)row * pitch + ch * 8) = v; }
    LGKM_WAIT0();
}
__device__ __forceinline__ float log_sigmoid(float x) { return fminf(x, 0.f) - log1pf(__expf(-fabsf(x))); }

constexpr int MX_RING = 0, MX_F = 98304, MX_WSF = 114688, MX_WTOT = 116736, MX_STG_SWA = 65536, MX_STG_FOX = 40960;

struct MixCtx {
    const bf16_t* Z; const float* G; bf16_t* Y;
    const float* sinks; const float* fox_fb; const float* ml_ib; const float* ml_fb; const float* ml_norm;
    unsigned char* ws; const unsigned char* KT; const unsigned char* VT;
};

__device__ __forceinline__ void swa_item(const MixCtx& C, int item, LAS unsigned char* lds) {
    int tid_ = threadIdx.x; asm volatile("" : "+v"(tid_));
    const int tid = tid_, lane = tid & 63, w = __builtin_amdgcn_readfirstlane(tid >> 6), r32 = lane & 31, hi = lane >> 5;
    const int jp = item & 31, kvh = (item >> 5) & 1, b = item >> 6;
    const size_t rowbase = (size_t)b * 4096;
    const int cbase = jp >= 1 ? 2 * jp - 2 : 0, ntl = 2 * jp + 2 - cbase;
    const bf16_t* Kb = C.Z + rowbase * ZP + 512 + 64 * kvh; const bf16_t* Vb = C.Z + rowbase * ZP + 640 + 64 * kvh;
    for (int j = 0; j < ntl; ++j) { dma_k(lds + MX_RING + j * 16384, Kb + (size_t)(cbase + j) * 64 * ZP, ZP, w, lane); dma_v(lds + MX_RING + j * 16384 + 8192, Vb + (size_t)(cbase + j) * 64 * ZP, ZP, w, lane); }
    const int hq = 4 * kvh + (w >> 1);
    bf16x8 qra[4], qrb[4];
    { const bf16_t* Qa = C.Z + (rowbase + 128 * jp + 32 * (w & 1) + r32) * ZP + 64 * hq;
#pragma unroll
      for (int d0 = 0; d0 < 4; ++d0) { qra[d0] = *(const bf16x8*)(Qa + 16 * d0 + 8 * hi); qrb[d0] = *(const bf16x8*)(Qa + (size_t)64 * ZP + 16 * d0 + 8 * hi); } }
    LAS float* wsf = (LAS float*)(lds + MX_WSF) + w * 64; LAS bf16_t* stg = (LAS bf16_t*)(lds + MX_STG_SWA + w * 4096);
    const float sink = C.sinks[hq] * LOG2E;
    VM_WAIT0(); __syncthreads();
    const int vlo = vt_lane_off(lane);
#pragma unroll
    for (int cc = 0; cc < 2; ++cc) {
        const int c = 2 * jp + cc, c0 = c >= 2 ? c - 2 : 0, nt = c - c0 + 1, s0 = c0 - cbase, qw0 = 64 * c + 32 * (w & 1);
        const bf16x8* qr = cc == 0 ? qra : qrb;
        float mhat = sink, l = hi == 0 ? 1.f : 0.f; f32x16 o[2]; o[0] = f32x16{}; o[1] = f32x16{};
        f32x16 p0, p1; qkt(p0, p1, lds + MX_RING + s0 * 16384, qr, r32, hi);
        for (int j = 0; j < nt; ++j) {
            f32x16 n0 = p0, n1 = p1;
            if (j + 1 < nt) qkt(n0, n1, lds + MX_RING + (s0 + j + 1) * 16384, qr, r32, hi);
            softmax_pv<8>(p0, p1, mhat, l, o, (int)(uintptr_t)(lds + MX_RING + (s0 + j) * 16384 + 8192) + vlo, wsf, r32, hi);
            p0 = n0; p1 = n1;
        }
        l += __shfl_xor(l, 32);
        store_o(o, 1.0f / l, wsf, stg, C.Y + (rowbase + qw0) * 1024 + 64 * hq, 1024, r32, hi, lane);
    }
    __syncthreads();
}

__device__ __forceinline__ void fx0_item(const MixCtx& C, float* NF, unsigned* cntF, int bh, LAS unsigned char* lds) {
    int tid_ = threadIdx.x; asm volatile("" : "+v"(tid_));
    const int tid = tid_, lane = tid & 63, w = __builtin_amdgcn_readfirstlane(tid >> 6);
    const int b = bh >> 2, h = bh & 3; const size_t rowbase = (size_t)b * 4096;
    LAS float* wtot = (LAS float*)(lds + MX_WTOT);
    const float fb = C.fox_fb[h]; const int t0 = tid * 8; float v[8]; float run = 0.f;
#pragma unroll
    for (int i = 0; i < 8; ++i) { run += log_sigmoid(C.G[(rowbase + t0 + i) * 16 + h] + fb) * LOG2E; v[i] = run; }
    float inc = run;
#pragma unroll
    for (int o_ = 1; o_ < 64; o_ <<= 1) { const float y = __shfl_up(inc, o_); if (lane >= o_) inc += y; }
    if (lane == 63) wtot[w] = inc;
    __syncthreads();
    float off = inc - run;
    for (int j = 0; j < w; ++j) off += wtot[j];
    *(f32x4*)(NF + bh * 4096 + t0) = (f32x4){-(v[0] + off), -(v[1] + off), -(v[2] + off), -(v[3] + off)};
    *(f32x4*)(NF + bh * 4096 + t0 + 4) = (f32x4){-(v[4] + off), -(v[5] + off), -(v[6] + off), -(v[7] + off)};
    asm volatile("s_waitcnt vmcnt(0)" ::: "memory"); __syncthreads();
    if (tid == 0) { __builtin_amdgcn_fence(__ATOMIC_RELEASE, "agent"); asm volatile("s_waitcnt vmcnt(0)" ::: "memory"); __hip_atomic_fetch_add(cntF + bh, 1u, __ATOMIC_RELAXED, __HIP_MEMORY_SCOPE_AGENT); }
    __syncthreads();
}
__device__ __forceinline__ void fox_block(const MixCtx& C, const float* NF, unsigned* cntF, int bh, int qb, LAS unsigned char* lds, bool first) {
    int tid_ = threadIdx.x; asm volatile("" : "+v"(tid_));
    const int tid = tid_, lane = tid & 63, w = __builtin_amdgcn_readfirstlane(tid >> 6), r32 = lane & 31, hi = lane >> 5;
    const int b = bh >> 2, h = bh & 3; const size_t rowbase = (size_t)b * 4096; const int q0 = qb * 128, nkeys = q0 + 128, nst = qb + 1;
    const unsigned char* Kt = C.KT + (size_t)bh * 64 * 8192; const unsigned char* Vt = C.VT + (size_t)bh * 64 * 8192;
#define FOX_STAGE(st_) do { LAS unsigned char* sb_ = lds + MX_RING + ((st_) % 3) * 32768; \
        dma_lin(sb_, Kt + (size_t)(2 * (st_)) * 8192, w, lane); dma_lin(sb_ + 8192, Kt + (size_t)(2 * (st_) + 1) * 8192, w, lane); \
        dma_lin(sb_ + 16384, Vt + (size_t)(2 * (st_)) * 8192, w, lane); dma_lin(sb_ + 24576, Vt + (size_t)(2 * (st_) + 1) * 8192, w, lane); } while (0)
    FOX_STAGE(0); if (nst > 1) FOX_STAGE(1);
    LAS float* F2 = (LAS float*)(lds + MX_F);
    LAS float* wsf = (LAS float*)(lds + MX_WSF) + w * 64; LAS bf16_t* stg = (LAS bf16_t*)(lds + MX_STG_FOX + w * 4096);
    const int g = w >> 2, qw0 = q0 + 32 * (w & 3);
    const bf16_t* Qb = C.Z + (rowbase + qw0 + r32) * ZP + 768 + 64 * h;
    bf16x8 qr[4];
#pragma unroll
    for (int d0 = 0; d0 < 4; ++d0) qr[d0] = *(const bf16x8*)(Qb + 16 * d0 + 8 * hi);
    if (first) {
        if (tid == 0) { while (__hip_atomic_load(cntF + bh, __ATOMIC_RELAXED, __HIP_MEMORY_SCOPE_AGENT) < 1u) __builtin_amdgcn_s_sleep(2); }
        __syncthreads();
    }
    {
        const int t0 = tid * 8;
        if (first && t0 < nkeys) { const unsigned long long* np = (const unsigned long long*)(NF + bh * 4096 + t0); unsigned long long q[4];
#pragma unroll
            for (int i = 0; i < 4; ++i) q[i] = __hip_atomic_load(np + i, __ATOMIC_RELAXED, __HIP_MEMORY_SCOPE_AGENT);
#pragma unroll
            for (int i = 0; i < 4; ++i) *(LAS unsigned long long*)(F2 + t0 + 2 * i) = q[i]; }
    }
    float mhat = -1e30f, l = 0.f; f32x16 o[2]; o[0] = f32x16{}; o[1] = f32x16{};
    VM_WAIT0(); __syncthreads();
    const int vlo = vt_lane_off(lane), qpos = qw0 + r32;
#define FOX_SCORE(st_, P0, P1) do { const int kb_ = 64 * (2 * (st_) + g); const LAS unsigned char* sk_ = lds + MX_RING + ((st_) % 3) * 32768 + g * 8192; f32x16 c0_, c1_; \
        _Pragma("unroll") for (int rr = 0; rr < 4; ++rr) { const f32x4 f0 = *(const LAS f32x4*)(F2 + kb_ + 8 * rr + 4 * hi), f1 = *(const LAS f32x4*)(F2 + kb_ + 32 + 8 * rr + 4 * hi); \
            _Pragma("unroll") for (int e = 0; e < 4; ++e) { c0_[4 * rr + e] = f0[e]; c1_[4 * rr + e] = f1[e]; } } \
        qkt(P0, P1, sk_, qr, r32, hi, c0_, c1_); } while (0)
    f32x16 p0, p1, n0, n1; FOX_SCORE(0, p0, p1);
#define FOX_STEP(PA0, PA1, PB0, PB1, st_) do { if ((st_) + 2 < nst) FOX_STAGE((st_) + 2); \
        attn_step<24, true>(PA0, PA1, PB0, PB1, lds + MX_RING + (((st_) + 1) % 3) * 32768 + g * 8192, F2 + 64 * (2 * ((st_) + 1) + g) + 4 * hi, \
                           lds + MX_RING + ((st_) % 3) * 32768 + 16384 + g * 8192 + vlo, qr, mhat, l, o, wsf, r32, hi); \
        VM_WAIT0(); __syncthreads(); } while (0)
#define FOX_LAST(PA0, PA1) do { const int st = nst - 1, kbase = 64 * (2 * st + g); \
        if (kbase <= qw0 + 31) { \
            if (kbase + 63 > qw0) { _Pragma("unroll") for (int r = 0; r < 16; ++r) { const int kv = kbase + crow(r, hi); if (kv > qpos) PA0[r] = -INFINITY; if (kv + 32 > qpos) PA1[r] = -INFINITY; } } \
            softmax_pv<24>(PA0, PA1, mhat, l, o, (int)(uintptr_t)(lds + MX_RING + (st % 3) * 32768 + 16384 + g * 8192) + vlo, wsf, r32, hi); } } while (0)
    int st2 = 0;
    for (; st2 + 2 < nst; st2 += 2) { FOX_STEP(p0, p1, n0, n1, st2); FOX_STEP(n0, n1, p0, p1, st2 + 1); }
    if (st2 + 1 < nst) { FOX_STEP(p0, p1, n0, n1, st2); FOX_LAST(n0, n1); } else { FOX_LAST(p0, p1); }
#undef FOX_STEP
#undef FOX_LAST
    __syncthreads();
#undef FOX_SCORE
#undef FOX_STAGE
    l += __shfl_xor(l, 32);
    LAS float* mo = (LAS float*)(lds + MX_RING); LAS float* ml = (LAS float*)(lds + MX_RING + 32768);
    const int wq = w & 3;
    if (g == 1) {
#pragma unroll
        for (int d0 = 0; d0 < 2; ++d0)
#pragma unroll
            for (int r = 0; r < 16; ++r) mo[((wq * 2 + d0) * 16 + r) * 64 + lane] = o[d0][r];
        ml[(wq * 2 + 0) * 64 + lane] = mhat; ml[(wq * 2 + 1) * 64 + lane] = l;
    }
    __syncthreads();
    if (g == 0) {
        const float m1 = ml[(wq * 2 + 0) * 64 + lane], l1 = ml[(wq * 2 + 1) * 64 + lane];
        const float mn = fmaxf(mhat, m1), f0 = ex2(mhat - mn), f1 = ex2(m1 - mn), lt = l * f0 + l1 * f1;
        if (hi == 0) { wsf[r32] = f0; wsf[32 + r32] = f1; }
        LGKM_WAIT0();
#pragma unroll
        for (int r = 0; r < 16; ++r) { const float a0 = wsf[crow(r, hi)], a1 = wsf[32 + crow(r, hi)];
#pragma unroll
            for (int d0 = 0; d0 < 2; ++d0) o[d0][r] = o[d0][r] * a0 + mo[((wq * 2 + d0) * 16 + r) * 64 + lane] * a1; }
        LGKM_WAIT0();
        store_o(o, 1.0f / lt, wsf, stg, C.Y + (rowbase + qw0) * 1024 + 512 + 64 * h, 1024, r32, hi, lane);
    }
    __syncthreads();
}
__device__ __forceinline__ void fox_item(const MixCtx& C, const float* NF, unsigned* cntF, int bh, int i, LAS unsigned char* lds) {
    fox_block(C, NF, cntF, bh, 31 - i, lds, true);
    fox_block(C, NF, cntF, bh, i, lds, false);
}
constexpr int ML_WSF = 98304, ML_STG = 100352, ML_SM = 133120;
struct MlScratch { float* E; float* B; float* PM; float* CL; float* NL; bf16_t* CP; float* NP; float* GC; float* EM; float* MP; unsigned* cnt1; unsigned* cnt2; };
__device__ __forceinline__ void wait_count(unsigned* p, unsigned want, int tid) {
    if (tid == 0) { while (__hip_atomic_load(p, __ATOMIC_RELAXED, __HIP_MEMORY_SCOPE_AGENT) < want) __builtin_amdgcn_s_sleep(2);
        __builtin_amdgcn_fence(__ATOMIC_ACQUIRE, "agent"); asm volatile("s_waitcnt vmcnt(0)" ::: "memory"); }
    __syncthreads();
}
__device__ __forceinline__ void post_count(unsigned* p, int tid) {
    asm volatile("s_waitcnt vmcnt(0)" ::: "memory"); __syncthreads();
    if (tid == 0) { __builtin_amdgcn_fence(__ATOMIC_RELEASE, "agent"); asm volatile("s_waitcnt vmcnt(0)" ::: "memory");
        __hip_atomic_fetch_add(p, 1u, __ATOMIC_RELAXED, __HIP_MEMORY_SCOPE_AGENT); }
}
#define ML_COMMON \
    int tid_ = threadIdx.x; asm volatile("" : "+v"(tid_)); \
    const int tid = tid_, lane = tid & 63, w = __builtin_amdgcn_readfirstlane(tid >> 6), r32 = lane & 31, hi = lane >> 5; \
    const int b = bh >> 2, h = bh & 3; const size_t rowbase = (size_t)b * 4096; \
    float* E = S.E + bh * 4096; float* B = S.B + bh * 4096; float* PM = S.PM + bh * 4096; \
    float* CL = S.CL + (size_t)bh * 64 * 4096; float* NL = S.NL + bh * 4096; bf16_t* CP = S.CP + (size_t)bh * 64 * 4096; float* NP = S.NP + bh * 4096; \
    float* GC = S.GC + bh * 64; float* EM = S.EM + bh * 64; float* MP = S.MP + bh * 64; \
    (void)r32; (void)hi; (void)E; (void)B; (void)PM; (void)CL; (void)NL; (void)CP; (void)NP; (void)GC; (void)EM; (void)MP; (void)rowbase; (void)h;

__device__ __forceinline__ void ml1_item(const MixCtx& C, const MlScratch& S, int bh, int rd, LAS unsigned char* lds) {
    ML_COMMON
    LAS float* le = (LAS float*)(lds + ML_SM); LAS float* lem = le + 512;
    const bf16_t* Kg = C.Z + rowbase * ZP + 1792 + 64 * h; const bf16_t* Vg = C.Z + rowbase * ZP + 2048 + 64 * h;
    const int srow = 16 * (w & 3) + (lane >> 2), scol = (w >> 2) * 32 + (lane & 3) * 8;
    u32x4 kvr[8];
#pragma unroll
    for (int p = 0; p < 8; ++p) kvr[p] = *(const u32x4*)(Kg + (size_t)((8 * rd + p) * 64 + srow) * ZP + scol);
    {
        const int cc = 8 * rd + w, t = cc * 64 + lane;
        const float* gp = C.G + (rowbase + t) * 16;
        const float ig = gp[4 + h] + C.ml_ib[h];
        float bsum = log_sigmoid(gp[8 + h] + C.ml_fb[h]);
#pragma unroll
        for (int o_ = 1; o_ < 64; o_ <<= 1) { const float y = __shfl_up(bsum, o_); if (lane >= o_) bsum += y; }
        const float e = ig - bsum; float pm = e;
#pragma unroll
        for (int o_ = 1; o_ < 64; o_ <<= 1) { const float y = __shfl_up(pm, o_); if (lane >= o_) pm = fmaxf(pm, y); }
        E[t] = e; B[t] = bsum; PM[t] = pm; le[w * 64 + lane] = e;
        if (lane == 63) { GC[cc] = bsum; EM[cc] = pm; lem[w] = pm; }
    }
    __syncthreads();
    const int vlo = vt_lane_off(lane);
    const bf16x8 ones = (bf16x8){0x3F80, 0x3F80, 0x3F80, 0x3F80, 0x3F80, 0x3F80, 0x3F80, 0x3F80};
#pragma unroll
    for (int p = 0; p < 8; ++p) {
        const int cc = 8 * rd + p; LAS unsigned char* sl = lds + p * 16384;
        const float wa = __expf(le[p * 64 + srow] - lem[p]);
        u32x4 w2;
#pragma unroll
        for (int j = 0; j < 4; ++j) { const float lo = __builtin_bit_cast(float, kvr[p][j] << 16), hh = __builtin_bit_cast(float, kvr[p][j] & 0xffff0000u); w2[j] = cvtpk(lo * wa, hh * wa); }
        *(LAS u32x4*)(sl + w * 1024 + lane * 16) = w2;
        dma_v(sl + 8192, Vg + (size_t)cc * 64 * ZP, ZP, w, lane);
    }
    VM_WAIT0(); __syncthreads();
    {
        const int cc = 8 * rd + w; LAS unsigned char* sl = lds + w * 16384;
        const int ka = (int)(uintptr_t)sl + vlo, va = ka + 8192;
        float* cl = CL + (size_t)cc * 4096;
#pragma unroll
        for (int half = 0; half < 2; ++half) {
            f32x16 a0 = {}, a1 = {}, na = {};
#pragma unroll
            for (int ks = 0; ks < 4; ++ks) {
                const bf16x8 A = vfrag(ka, half, ks), B0 = vfrag(va, 0, ks), B1 = vfrag(va, 1, ks);
                a0 = __builtin_amdgcn_mfma_f32_32x32x16_bf16(A, B0, a0, 0, 0, 0);
                a1 = __builtin_amdgcn_mfma_f32_32x32x16_bf16(A, B1, a1, 0, 0, 0);
                na = __builtin_amdgcn_mfma_f32_32x32x16_bf16(A, ones, na, 0, 0, 0);
            }
#pragma unroll
            for (int r = 0; r < 16; ++r) { const int k = 32 * half + crow(r, hi); cl[k * 64 + r32] = a0[r]; cl[k * 64 + 32 + r32] = a1[r]; }
            if (r32 == 0) {
#pragma unroll
                for (int r = 0; r < 16; ++r) NL[cc * 64 + 32 * half + crow(r, hi)] = na[r];
            }
        }
    }
    post_count(S.cnt1 + bh, tid);
    __syncthreads();
}

__device__ __forceinline__ void ml2_item(const MixCtx& C, const MlScratch& S, int bh, int slice, LAS unsigned char* lds) {
    ML_COMMON
    LAS float* lg = (LAS float*)(lds + ML_SM); LAS float* lem = lg + 64; LAS float* lso = lg + 128; LAS float* lsl = lg + 192;
    wait_count(S.cnt1 + bh, 8u, tid);
    if (tid < 64) { lg[tid] = GC[tid]; lem[tid] = EM[tid]; }
    __syncthreads();
    if (tid == 0) { float mcur = 0.f; for (int c = 0; c < 64; ++c) { const float g = lg[c], em = lem[c], mx = fmaxf(mcur, em); if (slice == 0) MP[c] = mcur; lso[c] = __expf(mcur - mx); lsl[c] = __expf(em - mx); mcur = g + mx; } }
    __syncthreads();
    const int idx = slice * 2048 + tid * 4; const bool don = (slice == 0) && (tid < 64);
    f32x4 Cs = (f32x4){0.f, 0.f, 0.f, 0.f}; float ns = 0.f;
    for (int c0 = 0; c0 < 64; c0 += 16) {
        f32x4 lv[16]; float ln[16];
#pragma unroll
        for (int j = 0; j < 16; ++j) { lv[j] = *(const f32x4*)(CL + (size_t)(c0 + j) * 4096 + idx); ln[j] = don ? NL[(c0 + j) * 64 + tid] : 0.f; }
#pragma unroll
        for (int j = 0; j < 16; ++j) {
            const int c = c0 + j;
            u32x2 pk; pk.x = cvtpk(Cs[0], Cs[1]); pk.y = cvtpk(Cs[2], Cs[3]);
            *(u32x2*)(CP + (size_t)c * 4096 + idx) = pk;
            if (don) NP[c * 64 + tid] = ns;
            const float so = lso[c], sl = lsl[c];
            Cs = Cs * so + lv[j] * sl; ns = so * ns + sl * ln[j];
        }
    }
    post_count(S.cnt2 + bh, tid);
    __syncthreads();
}

__device__ __forceinline__ void ml3_item(const MixCtx& C, const MlScratch& S, int bh, int rd, LAS unsigned char* lds) {
    ML_COMMON
    wait_count(S.cnt2 + bh, 2u, tid);
    const int pair = w >> 1, half = w & 1;
    const bf16_t* Kg = C.Z + rowbase * ZP + 1792 + 64 * h; const bf16_t* Vg = C.Z + rowbase * ZP + 2048 + 64 * h; const bf16_t* Qg = C.Z + rowbase * ZP + 1536 + 64 * h;
    const int vlo = vt_lane_off(lane);
    LAS float* wsf = (LAS float*)(lds + ML_WSF) + w * 64; LAS bf16_t* stg = (LAS bf16_t*)(lds + ML_STG + w * 4096);
#pragma unroll
        for (int p = 0; p < 4; ++p) {
            const int cc = 4 * rd + p; LAS unsigned char* sl = lds + p * 24576;
            dma_k(sl, Kg + (size_t)cc * 64 * ZP, ZP, w, lane); dma_v(sl + 8192, Vg + (size_t)cc * 64 * ZP, ZP, w, lane); dma_v(sl + 16384, CP + (size_t)cc * 4096, 64, w, lane);
        }
        const int cc = 4 * rd + pair, lrow = 32 * half + r32, t = cc * 64 + lrow;
        const bf16_t* qp = Qg + (size_t)t * ZP;
        bf16x8 qr[4], qp2[4];
#pragma unroll
        for (int d0 = 0; d0 < 4; ++d0) qr[d0] = *(const bf16x8*)(qp + 16 * d0 + 8 * hi);
#pragma unroll
        for (int ks = 0; ks < 4; ++ks) { const u32x2 a = *(const u32x2*)(qp + 16 * ks + 4 * hi), b2 = *(const u32x2*)(qp + 16 * ks + 8 + 4 * hi); qp2[ks] = __builtin_bit_cast(bf16x8, ((u32x4){a.x, a.y, b2.x, b2.y})); }
        const float mprev = MP[cc], mm = fmaxf(mprev, PM[t]), winter = __expf(mprev - mm), bl = B[t];
        float nd = 0.f;
#pragma unroll
        for (int d0 = 0; d0 < 4; ++d0) { const float* np = NP + cc * 64 + 16 * d0 + 8 * hi; const f32x4 n0 = *(const f32x4*)np, n1 = *(const f32x4*)(np + 4);
            const u32x4 qq = __builtin_bit_cast(u32x4, qr[d0]);
#pragma unroll
            for (int j = 0; j < 4; ++j) { const float lo = __builtin_bit_cast(float, qq[j] << 16), hh = __builtin_bit_cast(float, qq[j] & 0xffff0000u);
                const float na_ = j < 2 ? n0[2 * j] : n1[2 * j - 4], nb_ = j < 2 ? n0[2 * j + 1] : n1[2 * j - 3]; nd += lo * na_ + hh * nb_; } }
        nd += __shfl_xor(nd, 32);
        VM_WAIT0(); __syncthreads();
        {
            LAS unsigned char* sl = lds + pair * 24576; const int base = (int)(uintptr_t)sl + vlo;
            f32x16 o[2]; o[0] = f32x16{}; o[1] = f32x16{};
            pv(o, base + 16384, qp2[0], qp2[1], qp2[2], qp2[3]);
            scale_rows(o, winter, wsf, r32, hi);
            f32x16 p0, p1; qkt(p0, p1, sl, qr, r32, hi);
            float rs = 0.f;
#pragma unroll
            for (int rr = 0; rr < 4; ++rr) { const f32x4 e0 = *(const f32x4*)(E + cc * 64 + 8 * rr + 4 * hi), e1 = *(const f32x4*)(E + cc * 64 + 32 + 8 * rr + 4 * hi);
#pragma unroll
                for (int e = 0; e < 4; ++e) { const int r = 4 * rr + e, s = 8 * rr + 4 * hi + e;
                    const float w0 = (s <= lrow) ? __expf(e0[e] - mm) : 0.f, w1 = (s + 32 <= lrow) ? __expf(e1[e] - mm) : 0.f;
                    p0[r] *= w0; p1[r] *= w1; rs += p0[r] + p1[r]; } }
            rs += __shfl_xor(rs, 32);
            pv(o, base + 8192, PACK8(p0, 0), PACK8(p0, 8), PACK8(p1, 0), PACK8(p1, 8));
            const float den = winter * nd + rs, dn = fmaxf(fabsf(den), __expf(-(bl + mm)));
            const float rinv = 1.0f / dn;
            if (hi == 0) wsf[32 + r32] = rinv;
            LGKM_WAIT0();
#pragma unroll
            for (int r = 0; r < 16; ++r) { const int orow = crow(r, hi); const float rl = wsf[32 + orow];
#pragma unroll
                for (int d0 = 0; d0 < 2; ++d0) stg[orow * 64 + d0 * 32 + r32] = (bf16_t)f2bf(o[d0][r] * rl); }
            LGKM_WAIT0();
#pragma unroll
            for (int i = 0; i < 4; ++i) {
                const int row = i * 8 + (lane >> 3), ch = lane & 7; const u32x4 v = *(const LAS u32x4*)(stg + row * 64 + ch * 8);
                float x[8]; float ss = 0.f;
#pragma unroll
                for (int j = 0; j < 4; ++j) { x[2 * j] = __builtin_bit_cast(float, v[j] << 16); x[2 * j + 1] = __builtin_bit_cast(float, v[j] & 0xffff0000u); ss += x[2 * j] * x[2 * j] + x[2 * j + 1] * x[2 * j + 1]; }
                ss += __shfl_xor(ss, 1); ss += __shfl_xor(ss, 2); ss += __shfl_xor(ss, 4);
                const float rn = rsqrtf(ss * (1.0f / 64.0f) + EPS);
                const size_t tok = rowbase + cc * 64 + 32 * half + row;
                const u32x4 og = *(const u32x4*)(C.Z + tok * ZP + 2304 + 64 * h + ch * 8);
                const f32x4 g0 = *(const f32x4*)(C.ml_norm + h * 64 + ch * 8), g1 = *(const f32x4*)(C.ml_norm + h * 64 + ch * 8 + 4);
                float y[8];
#pragma unroll
                for (int j = 0; j < 4; ++j) { const float o0 = __builtin_bit_cast(float, og[j] << 16), o1 = __builtin_bit_cast(float, og[j] & 0xffff0000u);
                    const float ga = j < 2 ? g0[2 * j] : g1[2 * j - 4], gb = j < 2 ? g0[2 * j + 1] : g1[2 * j - 3];
                    y[2 * j] = x[2 * j] * rn * ga * o0; y[2 * j + 1] = x[2 * j + 1] * rn * gb * o1; }
                u32x4 pk; pk.x = cvtpk(y[0], y[1]); pk.y = cvtpk(y[2], y[3]); pk.z = cvtpk(y[4], y[5]); pk.w = cvtpk(y[6], y[7]);
                *(u32x4*)(C.Y + tok * 1024 + 768 + 64 * h + ch * 8) = pk;
            }
            LGKM_WAIT0();
        }
        __syncthreads();
}
constexpr int MTOK = 16384, DMODEL = 1024, SEQL = 4096, DFF = 4096, NZT = 2816  , DEPTH = 2;
constexpr size_t MiB = 1u << 20;
constexpr size_t WS_CTL = 0, CTL_BYTES = 32768;
constexpr size_t WS_WIN = 2 * MiB, WIN_L = (size_t)NZT * DMODEL * 2;
constexpr size_t WS_WOUT = 13 * MiB, WOUT_L = (size_t)DMODEL * DMODEL * 2;
constexpr size_t WS_WFF1 = 17 * MiB, WFF_L = (size_t)DFF * DMODEL * 2;
constexpr size_t WS_WFF2 = 33 * MiB;
constexpr size_t WS_SSQ2 = 82 * MiB;
constexpr size_t WS_XG = 50 * MiB;
constexpr size_t WS_H = 84 * MiB;
constexpr size_t WS_Z = 84 * MiB, WS_Y = 164 * MiB;
constexpr size_t WS_KT = 196 * MiB, WS_VT = 204 * MiB;
constexpr size_t WS_SSQ = 212 * MiB, WS_ROPE = 214 * MiB, WS_G = 215 * MiB;
constexpr size_t WS_MLE = 216 * MiB, WS_MLB = WS_MLE + 262144, WS_MLPM = WS_MLB + 262144;
constexpr size_t WS_NL = 217 * MiB, WS_NP = WS_NL + 262144, WS_GC = WS_NP + 262144, WS_EM = WS_GC + 4096, WS_MP = WS_EM + 4096;
constexpr size_t WS_CL = 218 * MiB, WS_CP = 234 * MiB, WS_NFX = 242 * MiB, WS_RS = WS_NFX + 524288  , WS_END = 243 * MiB;
constexpr int LDS_BYTES = 147456;
constexpr int N_FOX = 256, N_SWA = 256, N_ML1 = 128, N_ML2 = 32, N_ML3 = 256, N_ML = N_ML1 + N_ML2 + N_ML3, N_FX0 = 16, N_ITEMS = N_FX0 + N_ML + N_FOX + N_SWA;

struct Params { const float* in[16]; float* out; unsigned char* ws; int ph_lo, ph_hi; };

__device__ __forceinline__ int win_src(int n) {
    const int pn = n >> 8, P = n & 255, L = 64 * ((P >> 5) & 3) + 32 * (P >> 7) + (P & 31), z = 256 * pn + L;
    if (z < 1536) return z;
    if (z < 2304) return z + 4;
    if (z < 2560) return z + 12;
    const int i = z - 2560;
    if (i < 4) return 1536 + i;
    if (i < 8) return 2308 + (i - 4);
    if (i < 12) return 2312 + (i - 8);
    return -1;
}
template <bool WIN>
__device__ __forceinline__ void tr_item(const float* W, const float* kgain, int K, int Nsrc, bf16_t* WT, int nblk, int item, LAS float* scr, int lane) {
    const int kb = item / nblk, nb = item % nblk, k0 = 64 * kb, n0 = 32 * nb;
    if (WIN && n0 >= 2560) {
        const int n = n0 + (lane & 31); const int src = win_src(n);
#pragma unroll 8
        for (int i = 0; i < 32; ++i) { const int kk = 2 * i + (lane >> 5); scr[kk * 33 + (lane & 31)] = src >= 0 ? W[(size_t)(k0 + kk) * Nsrc + src] * (kgain ? kgain[k0 + kk] : 1.f) : 0.f; }
    } else {
        const int n4 = (lane & 7) * 4; const int src = WIN ? win_src(n0 + n4) : n0 + n4;
        f32x4 v[8];
#pragma unroll
        for (int i = 0; i < 8; ++i) v[i] = *(const f32x4*)(W + (size_t)(k0 + 8 * i + (lane >> 3)) * Nsrc + src);
#pragma unroll
        for (int i = 0; i < 8; ++i) { const int kk = 8 * i + (lane >> 3); const float g = kgain ? kgain[k0 + kk] : 1.f; LAS float* d = scr + kk * 33 + n4;
            d[0] = v[i][0] * g; d[1] = v[i][1] * g; d[2] = v[i][2] * g; d[3] = v[i][3] * g; }
    }
    LGKM_WAIT0(); asm volatile("" ::: "memory");
    const int c = lane & 7;
#pragma unroll
    for (int j = 0; j < 4; ++j) { const int nn = (lane >> 3) + 8 * j; const LAS float* s = scr + (8 * c) * 33 + nn;
        u32x4 o; o.x = cvtpk(s[0 * 33], s[1 * 33]); o.y = cvtpk(s[2 * 33], s[3 * 33]); o.z = cvtpk(s[4 * 33], s[5 * 33]); o.w = cvtpk(s[6 * 33], s[7 * 33]);
        *(u32x4*)(WT + (size_t)(n0 + nn) * K + k0 + 8 * c) = o; }
    LGKM_WAIT0(); asm volatile("" ::: "memory");
}

#define RLX_AGENT __ATOMIC_RELAXED, __HIP_MEMORY_SCOPE_AGENT
#define XB_TMO      128
#define XB_XCNT(j)  (256  + 64 * (j))
#define XB_XSUB(j)  (1280 + 64 * (j))
#define XB_XGEN(j)  (2304 + 64 * (j))
#define XB_TOP      3328
#define XB_TOPGEN   3392
#define XCD_BAR_WORDS 3456
#define XB_SPIN_CAP (1u << 18)

__device__ __forceinline__ unsigned xb_ld(unsigned* p)              { return __hip_atomic_load(p, __ATOMIC_RELAXED, __HIP_MEMORY_SCOPE_AGENT); }
__device__ __forceinline__ unsigned xb_add(unsigned* p, unsigned v) { return __hip_atomic_fetch_add(p, v, __ATOMIC_RELAXED, __HIP_MEMORY_SCOPE_AGENT); }
__device__ __forceinline__ unsigned xb_xcc_id() { return (unsigned)__builtin_amdgcn_s_getreg((3 << 11) | 20) & 0xFu; }
#define XB_SPIN(cond, bar) do { unsigned _sp = 0; while (cond) { __builtin_amdgcn_s_sleep(1); \
    if ((++_sp & 255u) == 0u) { if (xb_ld(&(bar)[XB_TMO])) break; if (_sp > XB_SPIN_CAP) { atomicAdd(&(bar)[XB_TMO], 1u); break; } } } } while (0)

struct XcdBarrier {
    unsigned* bar; unsigned x;
    volatile LAS unsigned* st;
};

__device__ __forceinline__ XcdBarrier xcd_barrier_post(unsigned* bar, volatile LAS unsigned* st) {
    XcdBarrier b; b.bar = bar; b.x = xb_xcc_id(); b.st = st;
    if (threadIdx.x == 0) (void)xb_add(&bar[XB_XCNT(b.x)], 1u);
    return b;
}
__device__ __forceinline__ void xcd_barrier_complete(unsigned* bar, unsigned x, unsigned& nloc, unsigned& nx) {
    const unsigned G = gridDim.x * gridDim.y * gridDim.z;
    unsigned sum, cnt, mine, sp = 0u;
    for (;;) {
        sum = 0u; cnt = 0u; mine = 0u;
#pragma unroll
        for (unsigned j = 0; j < 16; ++j) { const unsigned c = xb_ld(&bar[XB_XCNT(j)]); sum += c; cnt += (c > 0u) ? 1u : 0u; mine = (j == x) ? c : mine; }
        if (sum == G) break;
        __builtin_amdgcn_s_sleep(1);
        if ((++sp & 255u) == 0u) { if (xb_ld(&bar[XB_TMO])) break; if (sp > XB_SPIN_CAP) { atomicAdd(&bar[XB_TMO], 1u); break; } }
    }
    nloc = mine > 0u ? mine : 1u; nx = cnt > 0u ? cnt : 1u;
}

__device__ __forceinline__ void xcd_barrier(const XcdBarrier& b) {
    asm volatile("s_waitcnt vmcnt(0)" ::: "memory");
    __syncthreads();
    if (threadIdx.x == 0) {
        unsigned* bar = b.bar;
        __builtin_amdgcn_s_waitcnt(0);
        unsigned nloc = b.st[0], nx = b.st[1];
        if (nloc == 0u) { xcd_barrier_complete(bar, b.x, nloc, nx); b.st[0] = nloc; b.st[1] = nx; }
        const unsigned old = xb_add(&bar[XB_XSUB(b.x)], 1u);
        const unsigned gen = old / nloc;
        if (old + 1u == (gen + 1u) * nloc) {
            __builtin_amdgcn_fence(__ATOMIC_RELEASE, "agent");
            asm volatile("s_waitcnt vmcnt(0)" ::: "memory");
            const unsigned og = xb_add(&bar[XB_TOP], 1u);
            const unsigned tg = og / nx;
            if (og + 1u == (tg + 1u) * nx) xb_add(&bar[XB_TOPGEN], 1u);
            else XB_SPIN(xb_ld(&bar[XB_TOPGEN]) == tg, bar);
            __builtin_amdgcn_fence(__ATOMIC_ACQUIRE, "agent");
            xb_add(&bar[XB_XGEN(b.x)], 1u);
            asm volatile("s_waitcnt vmcnt(0)" ::: "memory");
        } else {
            XB_SPIN(xb_ld(&bar[XB_XGEN(b.x)]) == gen, bar);
            __builtin_amdgcn_fence(__ATOMIC_ACQUIRE, "agent");
            asm volatile("s_waitcnt vmcnt(0)" ::: "memory");
        }
    }
    __syncthreads();
}

__global__ void __launch_bounds__(512, 2) fwd_megakernel(Params p) {
    extern __shared__ __attribute__((aligned(16))) unsigned char lds_raw[];
    LAS unsigned char* lds = (LAS unsigned char*)lds_raw;
    cg::grid_group grid = cg::this_grid();
    const int tid = threadIdx.x, lane = tid & 63, wave = __builtin_amdgcn_readfirstlane(tid >> 6);
    const int G = gridDim.x, bx = blockIdx.x;
    unsigned char* ws = p.ws;
    const float* x_in = p.in[0];
    bf16_t* XG = (bf16_t*)(ws + WS_XG); bf16_t* Zb = (bf16_t*)(ws + WS_Z); bf16_t* Yb = (bf16_t*)(ws + WS_Y); bf16_t* Hb = (bf16_t*)(ws + WS_H);
    float* SSQ = (float*)(ws + WS_SSQ); float* SSQ2 = (float*)(ws + WS_SSQ2); float* ROPEC = (float*)(ws + WS_ROPE); float* ROPES = ROPEC + SEQL * 32; float* Gt = (float*)(ws + WS_G);
    unsigned* ctl = (unsigned*)(ws + WS_CTL);
    const int lo = p.ph_lo, hi_ph = p.ph_hi;
    volatile LAS unsigned* bst = (volatile LAS unsigned*)(lds + 143360 + 16);
    if (tid < 2) bst[tid] = 0u;
    __syncthreads();
    XcdBarrier bar = xcd_barrier_post(ctl + 1024, bst);
    if (lo < 0) grid.sync();
#define IN_PH(k) (lo <= (k) && (k) < hi_ph)
#define SEAM(k) do { if (IN_PH(k) && IN_PH((k) + 1)) xcd_barrier(bar); } while (0)

    if (IN_PH(0)) {
        LAS float* scr = (LAS float*)(lds + wave * 16384);
        const int gw = bx * 8 + wave, NGW = G * 8;
        constexpr int I_IN = (DMODEL / 64) * (NZT / 32), I_OUT = (DMODEL / 64) * (DMODEL / 32), I_F1 = (DMODEL / 64) * (DFF / 32), I_F2 = (DFF / 64) * (DMODEL / 32);
        constexpr int I_LAYER = I_IN + I_OUT + I_F1 + I_F2;
        for (int it = gw; it < DEPTH * I_LAYER; it += NGW) {
            const int l = it / I_LAYER; int r = it % I_LAYER;
            if (r < I_IN) { tr_item<true>(p.in[2] + (size_t)l * DMODEL * 2572, p.in[1] + l * DMODEL, DMODEL, 2572, (bf16_t*)(ws + WS_WIN + l * WIN_L), NZT / 32, r, scr, lane); continue; } r -= I_IN;
            if (r < I_OUT) { tr_item<false>(p.in[12] + (size_t)l * DMODEL * DMODEL, nullptr, DMODEL, DMODEL, (bf16_t*)(ws + WS_WOUT + l * WOUT_L), DMODEL / 32, r, scr, lane); continue; } r -= I_OUT;
            if (r < I_F1) { tr_item<false>(p.in[14] + (size_t)l * DMODEL * DFF, p.in[13] + l * DMODEL, DMODEL, DFF, (bf16_t*)(ws + WS_WFF1 + l * WFF_L), DFF / 32, r, scr, lane); continue; } r -= I_F1;
            tr_item<false>(p.in[15] + (size_t)l * DFF * DMODEL, nullptr, DFF, DMODEL, (bf16_t*)(ws + WS_WFF2 + l * WFF_L), DMODEL / 32, r, scr, lane);
        }
        for (int i = bx * 512 + tid; i < SEQL * 32; i += G * 512) {
            const int pos = i >> 5, j = i & 31;
            double inv = 1.0; for (int q = 0; q < j; ++q) inv *= 0.7498942093324558;
            const float ang = (float)pos * (float)inv;
            double rev = (double)ang * 0.15915494309189535; rev -= __builtin_rint(rev);
            ROPEC[i] = __builtin_amdgcn_cosf((float)rev); ROPES[i] = __builtin_amdgcn_sinf((float)rev);
        }
        for (int m = gw; m < MTOK; m += 2 * NGW) {
            const int m2 = m + NGW;
            const bool has2 = m2 < MTOK;
            const f32x4* xr = (const f32x4*)(x_in + (size_t)m * DMODEL) + lane;
            const f32x4* xr2 = (const f32x4*)(x_in + (size_t)(has2 ? m2 : m) * DMODEL) + lane;
            f32x4 va[4], vb[4];
#pragma unroll
            for (int j = 0; j < 4; ++j) { va[j] = xr[64 * j]; vb[j] = xr2[64 * j]; }
#pragma unroll
            for (int rr = 0; rr < 2; ++rr) {
                if (rr == 1 && !has2) break;
                const int mm = rr == 0 ? m : m2;
                unsigned long long* o8 = (unsigned long long*)(XG + (size_t)mm * DMODEL) + lane;
#pragma unroll
                for (int j = 0; j < 4; ++j) {
                    const f32x4 v = rr == 0 ? va[j] : vb[j];
                    float s = (v[0] * v[0] + v[1] * v[1]) + (v[2] * v[2] + v[3] * v[3]);
                    s += __shfl_xor(s, 1); s += __shfl_xor(s, 2); s += __shfl_xor(s, 4);
                    if ((lane & 7) == 0) SSQ[(size_t)mm * 32 + 8 * j + (lane >> 3)] = s;
                    o8[64 * j] = (unsigned long long)cvtpk(v[0], v[1]) | ((unsigned long long)cvtpk(v[2], v[3]) << 32);
                }
            }
        }
    }
    SEAM(0);

    for (int l = 0; l < DEPTH; ++l) {
        const int pb = 1 + 5 * l;
        if (IN_PH(pb)) {
            pg8::Gemm g{XG, (const bf16_t*)(ws + WS_WIN + l * WIN_L), MTOK, NZT, DMODEL}; pg8::StaticOrder S; S.init(MTOK, NZT, G, bx);
            float* RS = (float*)(ws + WS_RS);
            { int t3_ = threadIdx.x; asm volatile("" : "+v"(t3_)); pg8::Unit ux; int lastpm = -1;
              for (int i = 0; S.next(i, ux); ++i) { if (ux.pm == lastpm) continue; lastpm = ux.pm;
                  if (t3_ < 256) { const f32x4* sp = (const f32x4*)(SSQ + (size_t)(ux.pm * 256 + t3_) * 32); f32x4 a = sp[0];
#pragma unroll
                      for (int j = 1; j < 8; ++j) a = a + sp[j];
                      RS[ux.pm * 256 + t3_] = rsqrtf(((a[0] + a[1]) + (a[2] + a[3])) * (1.0f / 1024.0f) + pg8::EPS); } }
              asm volatile("s_waitcnt vmcnt(0)" ::: "memory"); }
            __syncthreads();
            pg8::EpiIn E{Zb, Gt, RS, ROPEC, ROPES, p.in[3] + l * 64, p.in[4] + l * 64, p.in[6] + l * 64, p.in[7] + l * 64, ws + WS_KT, ws + WS_VT};
            pg8::gemm_phase<pg8::EpiIn, pg8::StaticOrder, true, true>(lds, g, S, E);
        }
        SEAM(pb);
        if (IN_PH(pb + 1)) {
            MixCtx C{Zb, Gt, Yb, p.in[5] + l * 8, p.in[8] + l * 4, p.in[9] + l * 4, p.in[10] + l * 4, p.in[11] + l * 256, ws, ws + WS_KT, ws + WS_VT};
            MlScratch MS{(float*)(ws + WS_MLE), (float*)(ws + WS_MLB), (float*)(ws + WS_MLPM), (float*)(ws + WS_CL), (float*)(ws + WS_NL), (bf16_t*)(ws + WS_CP), (float*)(ws + WS_NP), (float*)(ws + WS_GC), (float*)(ws + WS_EM), (float*)(ws + WS_MP), ctl + 128 + 32 * l, ctl + 192 + 32 * l};
            LAS int* itm = (LAS int*)(lds + 143360);
            float* NF = (float*)(ws + WS_NFX); unsigned* cntF = ctl + 512 + 32 * l; unsigned* qctr = ctl + 64 * l;
            for (;;) {
                __syncthreads();
                if (tid == 0) *itm = (int)atomicAdd(qctr, 1u);
                __syncthreads();
                const int it = *itm;
                if (it >= N_ITEMS) break;
                constexpr int Q_ML1 = N_FX0, Q_ML2 = Q_ML1 + N_ML1, Q_FOXA = Q_ML2 + N_ML2, N_FOXA = 256, Q_ML3 = Q_FOXA + N_FOXA, Q_FOXB = Q_ML3 + N_ML3, Q_SWA = Q_FOXB + (N_FOX - N_FOXA);
                static_assert(Q_SWA + N_SWA == N_ITEMS, "queue map");
                if (it < Q_ML1) fx0_item(C, NF, cntF, it, lds);
                else if (it < Q_ML2) { const int k = it - Q_ML1; ml1_item(C, MS, k >> 3, k & 7, lds); }
                else if (it < Q_FOXA) { const int k = it - Q_ML2; ml2_item(C, MS, k >> 1, k & 1, lds); }
                else if (it < Q_ML3) {
                    if (tid == 0) { const unsigned x = xb_xcc_id() & 7u; int sel = 0;
                        for (unsigned t = 0; t < 8u; ++t) { const unsigned q = (x + t) & 7u; const unsigned j = atomicAdd(ctl + 640 + 16 * l + q, 1u); if (j < 32u) { sel = (int)(q * 32u + j); break; } }
                        itm[1] = sel; }
                    __syncthreads();
                    const int k = itm[1];
                    fox_item(C, NF, cntF, k >> 4, k & 15, lds); }
                else if (it < Q_FOXB) { const int k = it - Q_ML3; ml3_item(C, MS, k >> 4, k & 15, lds); }
                else if (it < Q_SWA) { const int k = it - Q_FOXB + N_FOXA; fox_item(C, NF, cntF, k & 15, k >> 4, lds); }
                else swa_item(C, it - Q_SWA, lds);
            }
        }
        SEAM(pb + 1);
        if (IN_PH(pb + 2)) {
            pg8::Gemm g{Yb, (const bf16_t*)(ws + WS_WOUT + l * WOUT_L), MTOK, DMODEL, DMODEL}; pg8::StaticOrder S; S.init(MTOK, DMODEL, G, bx);
            pg8::EpiRes E{XG, SSQ2, nullptr, nullptr};
            pg8::gemm_phase<pg8::EpiRes, pg8::StaticOrder, true, true>(lds, g, S, E);
        }
        SEAM(pb + 2);
        if (IN_PH(pb + 3)) {
            pg8::Gemm g{XG, (const bf16_t*)(ws + WS_WFF1 + l * WFF_L), MTOK, DFF, DMODEL}; pg8::StaticOrder S; S.init(MTOK, DFF, G, bx);
            pg8::EpiFF1 E{Hb};
            pg8::gemm_phase<pg8::EpiFF1, pg8::StaticOrder, true, true>(lds, g, S, E);
        }
        SEAM(pb + 3);
        if (IN_PH(pb + 4)) {
            pg8::Gemm g{Hb, (const bf16_t*)(ws + WS_WFF2 + l * WFF_L), MTOK, DMODEL, DFF}; pg8::StaticOrder S; S.init(MTOK, DMODEL, G, bx);
            pg8::EpiRes E{XG, SSQ, l + 1 == DEPTH ? p.out : nullptr, SSQ2};
            pg8::gemm_phase<pg8::EpiRes, pg8::StaticOrder, true, true>(lds, g, S, E);
        }
        SEAM(pb + 4);
    }
#undef IN_PH
#undef SEAM
}

constexpr int N_PHASES = 1 + 5 * DEPTH;
#ifndef MK_MULTI
#define MK_MULTI 0
#endif
extern "C" void kernel_launch(void* const* d_in, const int* in_sizes, int n_in, void* d_out, int out_size, void* d_ws, size_t ws_size, hipStream_t stream) {
    static int grid = 0;
    if (grid == 0) {
        if (n_in != 16 || out_size != MTOK * DMODEL || ws_size < WS_END) { fprintf(stderr, "kernel_launch: unexpected shapes (n_in %d out %d ws %zu)\n", n_in, out_size, ws_size); grid = -1; return; }
        int dev = 0, cus = 0, per_cu = 0;
        hipGetDevice(&dev); hipDeviceGetAttribute(&cus, hipDeviceAttributeMultiprocessorCount, dev);
        if (hipFuncSetAttribute((const void*)fwd_megakernel, hipFuncAttributeMaxDynamicSharedMemorySize, LDS_BYTES) != hipSuccess) { fprintf(stderr, "kernel_launch: hipFuncSetAttribute failed\n"); grid = -1; return; }
        if (hipOccupancyMaxActiveBlocksPerMultiprocessor(&per_cu, (const void*)fwd_megakernel, 512, LDS_BYTES) != hipSuccess || per_cu < 1) { fprintf(stderr, "kernel_launch: occupancy query says %d\n", per_cu); per_cu = 1; }
        (void)hipGetLastError();
        grid = cus;
        if (grid != 256) fprintf(stderr, "kernel_launch: %d CUs (expected 256)\n", grid);
    }
    if (grid < 0) return;
    hipMemsetAsync((char*)d_ws + WS_CTL, 0, CTL_BYTES, stream);
    Params a{};
    for (int i = 0; i < 16; ++i) a.in[i] = (const float*)d_in[i];
    a.out = (float*)d_out; a.ws = (unsigned char*)d_ws;
#if MK_MULTI
    for (int ph = 0; ph < N_PHASES; ++ph) { a.ph_lo = ph; a.ph_hi = ph + 1; hipLaunchKernelGGL(fwd_megakernel, dim3(grid), dim3(512), LDS_BYTES, stream, a); }
#else
    a.ph_lo = 0; a.ph_hi = N_PHASES;
    void* args[] = {&a};
    hipError_t e = hipLaunchCooperativeKernel((const void*)fwd_megakernel, dim3(grid), dim3(512), args, LDS_BYTES, stream);
    if (e != hipSuccess) fprintf(stderr, "cooperative launch failed: %s (grid %d)\n", hipGetErrorString(e), grid);
#endif
}
```

```cpp
#include <hip/hip_runtime.h>
#include <hip/hip_cooperative_groups.h>
#include <cstdio>
#include <cstdint>
#include <cmath>
namespace cg = cooperative_groups;
namespace pg8 {
#define PG8_LAS __attribute__((address_space(3)))
typedef unsigned short bf16_t;
typedef short bf16x8 __attribute__((ext_vector_type(8)));
typedef float f32x4 __attribute__((ext_vector_type(4)));
typedef unsigned u32x4 __attribute__((ext_vector_type(4)));
constexpr int BM = 256, BK = 64, HALF = 128, HTB = HALF * BK * 2  , STAGE_BYTES = 8 * HTB, NXCD = 8, WGM = 4;

__host__ __device__ __forceinline__ int lds_byte(int r, int c) { const int st = (r >> 4) * 2 + (c >> 5), rr = r & 15, cc = c & 31, ob = rr * 64 + cc * 2; return st * 1024 + (ob ^ (((ob >> 9) & 1) << 5)); }
__host__ __device__ __forceinline__ void stage_rc(int b, int& R, int& C) { const int st = b / 1024, sb = b % 1024, swz = sb ^ (((sb >> 9) & 1) << 5); R = (st >> 1) * 16 + swz / 64; C = (st & 1) * 32 + (swz % 64) / 2; }
__host__ __device__ __forceinline__ int perm32(int rho) { const int n = rho >> 4, i = rho & 15; return 8 * (i >> 2) + 4 * n + (i & 3); }

struct Unit { int pm, pn; };
struct Gemm { const bf16_t* A; const bf16_t* Bt; int M, N, K; };

struct StaticOrder {
    int nM, nN, nwg, G, c;
    __host__ __device__ void init(int M, int N, int G_, int c_) { nM = M / BM; nN = N / BM; nwg = nM * nN; G = G_; c = c_; }
    __host__ __device__ bool next(int i, Unit& u) const {
        const long L = (long)i * G + c; if (L >= nwg) return false;
        int wgid = (int)L; { const int q = nwg / NXCD, r = nwg % NXCD, xcd = wgid % NXCD, off = wgid / NXCD; wgid = (xcd < r ? xcd * (q + 1) : r * (q + 1) + (xcd - r) * q) + off; }
        const int nig = WGM * nN, gid = wgid / nig, fm = gid * WGM, gsz = (nM - fm) < WGM ? (nM - fm) : WGM;
        u.pm = fm + ((wgid % nig) % gsz); u.pn = (wgid % nig) / gsz; return true;
    }
    __device__ __forceinline__ void a_ready(const Unit&) const {}
    __device__ __forceinline__ void done(const Unit&) const {}
};

__device__ __forceinline__ unsigned cvt_pk_bf16(float lo, float hi) { unsigned r; asm volatile("v_cvt_pk_bf16_f32 %0, %1, %2" : "=v"(r) : "v"(lo), "v"(hi)); return r; }
constexpr float EPS = 1e-6f;
constexpr float LOG2E = 1.4426950408889634f;
constexpr float C2 = 0.125f * LOG2E;
constexpr int ZP = 2560;

__device__ __forceinline__ float row_rstd(const float* ssq, int row, int fq) {
    const float* sp = ssq + (size_t)row * 32 + fq * 8;
    const f32x4 s0 = *(const f32x4*)sp, s1 = *(const f32x4*)(sp + 4);
    float t = ((s0[0] + s0[1]) + (s0[2] + s0[3])) + ((s1[0] + s1[1]) + (s1[2] + s1[3]));
    t += __shfl_xor(t, 16); t += __shfl_xor(t, 32);
    return rsqrtf(t * (1.0f / 1024.0f) + EPS);
}

struct EpiIn {
    static constexpr bool PERM = true, AFTER_DRAIN = false;
    bf16_t* Z; float* G; const float* ssq; const float* ropec; const float* ropes; const float* gqa; const float* gka; const float* gqb; const float* gkb;
    unsigned char* KT; unsigned char* VT;
    __device__ __forceinline__ void operator()(const f32x4 (&acc)[2][2][4][2], const Unit& u, int wr, int wc, int fr, int fq) const {
        const int pn = u.pn;
        int type = 0; const float* gsel = gqa; bool rp = false; float sc = 1.f;
        if (pn < 2) { type = 1; gsel = gqa; rp = true; sc = C2; }
        else if (pn == 2) { if (wc < 2) { type = 1; gsel = gka; rp = true; } }
        else if (pn == 3) { type = 1; gsel = gqb; sc = C2; }
        else if (pn == 4) { type = 1; gsel = gkb; }
        else if (pn == 7) { sc = 0.125f; }
        else if (pn == 9) { type = 2; }
        else if (pn == 10) { type = 3; }
        if (type == 3 && wc != 0) return;
        const int dcol = 8 * fq;
        unsigned char* tp = nullptr;
        if (pn == 4 || pn == 5) { const size_t tb0 = (size_t)((((u.pm * BM) >> 12) * 4 + wc) * 64 + (((u.pm * BM) & 4095) >> 6) + wr) * 8192;
            tp = pn == 4 ? KT + tb0 + fq * 1024 + fr * 16 : VT + tb0 + (fr * 4 + fq) * 16; }
        float gn[2][8];
#pragma unroll
        for (int bj = 0; bj < 2; ++bj)
#pragma unroll
            for (int i = 0; i < 8; ++i) gn[bj][i] = (type == 1) ? gsel[32 * bj + dcol + i] : 1.f;
#pragma unroll
        for (int ai = 0; ai < 2; ++ai)
#pragma unroll
            for (int m = 0; m < 4; ++m) {
                const int row = u.pm * BM + ai * HALF + wr * 64 + m * 16 + fr;
                const float rstd = ssq[row];
                float v[2][8];
#pragma unroll
                for (int bj = 0; bj < 2; ++bj)
#pragma unroll
                    for (int n = 0; n < 2; ++n)
#pragma unroll
                        for (int e = 0; e < 4; ++e) v[bj][4 * n + e] = acc[ai][bj][m][n][e] * rstd;
                if (type == 1) {
                    float ss = 0.f;
#pragma unroll
                    for (int bj = 0; bj < 2; ++bj)
#pragma unroll
                        for (int i = 0; i < 8; ++i) ss += v[bj][i] * v[bj][i];
                    ss += __shfl_xor(ss, 16); ss += __shfl_xor(ss, 32);
                    const float hr = rsqrtf(ss * (1.0f / 64.0f) + EPS);
#pragma unroll
                    for (int bj = 0; bj < 2; ++bj)
#pragma unroll
                        for (int i = 0; i < 8; ++i) v[bj][i] *= hr * gn[bj][i];
                    if (rp) {
                        const int pos = row & 4095;
                        const f32x4 c0 = *(const f32x4*)(ropec + pos * 32 + dcol), c1 = *(const f32x4*)(ropec + pos * 32 + dcol + 4);
                        const f32x4 s0 = *(const f32x4*)(ropes + pos * 32 + dcol), s1 = *(const f32x4*)(ropes + pos * 32 + dcol + 4);
#pragma unroll
                        for (int i = 0; i < 8; ++i) {
                            const float c = i < 4 ? c0[i & 3] : c1[i & 3], s = i < 4 ? s0[i & 3] : s1[i & 3];
                            const float x1 = v[0][i], x2 = v[1][i];
                            v[0][i] = x1 * c - x2 * s; v[1][i] = x2 * c + x1 * s;
                        }
                    }
#pragma unroll
                    for (int bj = 0; bj < 2; ++bj)
#pragma unroll
                        for (int i = 0; i < 8; ++i) v[bj][i] *= sc;
                } else if (type == 2) {
#pragma unroll
                    for (int bj = 0; bj < 2; ++bj)
#pragma unroll
                        for (int i = 0; i < 8; ++i) v[bj][i] = 1.0f / (1.0f + __expf(-v[bj][i]));
                } else if (type == 0) {
#pragma unroll
                    for (int bj = 0; bj < 2; ++bj)
#pragma unroll
                        for (int i = 0; i < 8; ++i) v[bj][i] *= sc;
                }
                if (type == 3) {
                    float* gp = G + (size_t)row * 16;
                    if (fq == 0) { *(f32x4*)gp = (f32x4){v[0][0], v[0][1], v[0][2], v[0][3]}; *(f32x4*)(gp + 4) = (f32x4){v[0][4], v[0][5], v[0][6], v[0][7]}; }
                    else if (fq == 1) { *(f32x4*)(gp + 8) = (f32x4){v[0][0], v[0][1], v[0][2], v[0][3]}; }
                } else {
#pragma unroll
                    for (int bj = 0; bj < 2; ++bj) {
                        u32x4 w; w.x = cvt_pk_bf16(v[bj][0], v[bj][1]); w.y = cvt_pk_bf16(v[bj][2], v[bj][3]); w.z = cvt_pk_bf16(v[bj][4], v[bj][5]); w.w = cvt_pk_bf16(v[bj][6], v[bj][7]);
                        if (pn == 4) *(u32x4*)(tp + ai * 16384 + bj * 4096 + m * 256) = w;
                        else if (pn == 5) *(u32x4*)(tp + ai * 16384 + bj * 4096 + m * 1024) = w;
                        else
                        *(u32x4*)(Z + (size_t)row * ZP + 256 * pn + 64 * wc + 32 * bj + dcol) = w;
                    }
                }
                if (m & 1) asm volatile("" ::: "memory");
            }
    }
};

struct EpiRes {
    static constexpr bool PERM = true, AFTER_DRAIN = false;
    bf16_t* XB; float* ssq; float* out; const float* rsq;
    __device__ __forceinline__ void operator()(const f32x4 (&acc)[2][2][4][2], const Unit& u, int wr, int wc, int fr, int fq) const {
        float r2[8];
#pragma unroll
        for (int j = 0; j < 8; ++j) r2[j] = 1.f;
        if (rsq) {
#pragma unroll
            for (int j = 0; j < 8; ++j) { const float r = row_rstd(rsq, u.pm * BM + (j >> 2) * HALF + wr * 64 + (j & 3) * 16 + fr, fq); r2[j] = r * r; }
        }
#pragma unroll
        for (int bj = 0; bj < 2; ++bj) {
            const int col0 = u.pn * BM + bj * HALF + wc * 32 + 8 * fq;
#pragma unroll
            for (int ai = 0; ai < 2; ++ai)
#pragma unroll
                for (int m = 0; m < 4; ++m) {
                    const int row = u.pm * BM + ai * HALF + wr * 64 + m * 16 + fr;
                    const size_t off = (size_t)row * 1024 + col0;
                    const u32x4 bw = *(const u32x4*)(XB + off);
                    f32x4 x0 = acc[ai][bj][m][0] * r2[ai * 4 + m], x1 = acc[ai][bj][m][1] * r2[ai * 4 + m];
                    x0[0] += __builtin_bit_cast(float, bw.x << 16); x0[1] += __builtin_bit_cast(float, bw.x & 0xffff0000u);
                    x0[2] += __builtin_bit_cast(float, bw.y << 16); x0[3] += __builtin_bit_cast(float, bw.y & 0xffff0000u);
                    x1[0] += __builtin_bit_cast(float, bw.z << 16); x1[1] += __builtin_bit_cast(float, bw.z & 0xffff0000u);
                    x1[2] += __builtin_bit_cast(float, bw.w << 16); x1[3] += __builtin_bit_cast(float, bw.w & 0xffff0000u);
                    if (out) { *(f32x4*)(out + off) = x0; *(f32x4*)(out + off + 4) = x1; }
                    else {
                        float ss = ((x0[0] * x0[0] + x0[1] * x0[1]) + (x0[2] * x0[2] + x0[3] * x0[3])) + ((x1[0] * x1[0] + x1[1] * x1[1]) + (x1[2] * x1[2] + x1[3] * x1[3]));
                        ss += __shfl_xor(ss, 16); ss += __shfl_xor(ss, 32);
                        if (fq == 0) ssq[(size_t)row * 32 + u.pn * 8 + bj * 4 + wc] = ss;
                        u32x4 w; w.x = cvt_pk_bf16(x0[0], x0[1]); w.y = cvt_pk_bf16(x0[2], x0[3]); w.z = cvt_pk_bf16(x1[0], x1[1]); w.w = cvt_pk_bf16(x1[2], x1[3]);
                        *(u32x4*)(XB + off) = w;
                    }
                }
        }
    }
};

struct EpiFF1 {
    static constexpr bool PERM = true, AFTER_DRAIN = false;
    bf16_t* H;
    __device__ __forceinline__ void operator()(const f32x4 (&acc)[2][2][4][2], const Unit& u, int wr, int wc, int fr, int fq) const {
#pragma unroll
        for (int ai = 0; ai < 2; ++ai)
#pragma unroll
            for (int m = 0; m < 4; ++m) {
                const int row = u.pm * BM + ai * HALF + wr * 64 + m * 16 + fr;
#pragma unroll
                for (int bj = 0; bj < 2; ++bj) {
                    const int col0 = u.pn * BM + bj * HALF + wc * 32 + 8 * fq;
                    f32x4 a = acc[ai][bj][m][0], b = acc[ai][bj][m][1];
#pragma unroll
                    for (int e = 0; e < 4; ++e) { a[e] = fmaxf(a[e], 0.f); a[e] *= a[e]; b[e] = fmaxf(b[e], 0.f); b[e] *= b[e]; }
                    u32x4 w; w.x = cvt_pk_bf16(a[0], a[1]); w.y = cvt_pk_bf16(a[2], a[3]); w.z = cvt_pk_bf16(b[0], b[1]); w.w = cvt_pk_bf16(b[2], b[3]);
                    *(u32x4*)(H + (size_t)row * 4096 + col0) = w;
                }
            }
    }
};

template <class Epi, class Sched, bool ALIGN_EPI = false, bool SP2 = false>
__device__ __forceinline__ void gemm_phase(PG8_LAS unsigned char* lds, const Gemm g, const Sched& S, const Epi& E) {
    int tid_ = threadIdx.x; asm volatile("" : "+v"(tid_));
    const int tid = tid_, wid = __builtin_amdgcn_readfirstlane(tid >> 6), lane = tid & 63, wr = wid >> 2, wc = wid & 3, fr = lane & 15, fq = lane >> 4;
    const int K = g.K, nt = K / BK;
    unsigned voffA[2], voffB[2];
#pragma unroll
    for (int i = 0; i < 2; ++i) { int R, C; stage_rc(tid * 16 + i * 8192, R, C); const int Rb = Epi::PERM ? ((R & ~31) + perm32(R & 31)) : R;
        voffA[i] = (unsigned)(R * K + C) * 2u; voffB[i] = (unsigned)(Rb * K + C) * 2u; }
    const size_t kstep = (size_t)(BK * 2);
    const size_t hstep = (size_t)HALF * K * 2;
    const size_t tstep = 2 * hstep;
    const unsigned ldsw = (unsigned)wid * 1024u;
    const int aoff = lds_byte(wr * 64 + fr, fq * 8), boff = lds_byte(wc * 32 + fr, fq * 8);
#define PG8_SA(b, h) (((b) * 2 + (h)) * HTB)
#define PG8_SB(b, h) ((4 + (b) * 2 + (h)) * HTB)
#define PG8_STAGE(bufoff, gbase, voff) do { _Pragma("unroll") for (int _i = 0; _i < 2; ++_i) \
        __builtin_amdgcn_global_load_lds((const unsigned*)((const char*)(gbase) + (voff)[_i]), (PG8_LAS unsigned*)(lds + (bufoff) + ldsw + _i * 8192), 16, 0, 0); } while (0)
#define PG8_LDA(dst, b, h) do { _Pragma("unroll") for (int m = 0; m < 4; ++m) _Pragma("unroll") for (int k = 0; k < 2; ++k) dst[m][k] = *(const PG8_LAS bf16x8*)(lds + PG8_SA(b, h) + aoff + m * 2048 + k * 1024); } while (0)
#define PG8_LDB(dst, b, h) do { _Pragma("unroll") for (int n = 0; n < 2; ++n) _Pragma("unroll") for (int k = 0; k < 2; ++k) dst[n][k] = *(const PG8_LAS bf16x8*)(lds + PG8_SB(b, h) + boff + n * 2048 + k * 1024); } while (0)
#define PG8_MMA(ai, bj, At, Bt) do { __builtin_amdgcn_s_setprio(1); _Pragma("unroll") for (int m = 0; m < 4; ++m) _Pragma("unroll") for (int n = 0; n < 2; ++n) _Pragma("unroll") for (int k = 0; k < 2; ++k) \
        acc[ai][bj][m][n] = __builtin_amdgcn_mfma_f32_16x16x32_bf16(Bt[n][k], At[m][k], acc[ai][bj][m][n], 0, 0, 0); __builtin_amdgcn_s_setprio(0); } while (0)
#define PG8_WAIT_V(n) asm volatile("s_waitcnt vmcnt(" #n ")" ::: "memory")
#define PG8_WAIT_L(n) asm volatile("s_waitcnt lgkmcnt(" #n ")" ::: "memory")
#define PG8_BAR __builtin_amdgcn_s_barrier()
#define PG8_SCHED __builtin_amdgcn_sched_barrier(0)
    Unit cur, nxt; int ui = 0;
    if (!S.next(0, cur)) return;
    f32x4 acc[2][2][4][2];
#pragma unroll
    for (int a = 0; a < 2; ++a)
#pragma unroll
        for (int b = 0; b < 2; ++b)
#pragma unroll
            for (int m = 0; m < 4; ++m)
#pragma unroll
                for (int n = 0; n < 2; ++n) acc[a][b][m][n] = (f32x4){0.f, 0.f, 0.f, 0.f};
    bf16x8 At[4][2], B0[2][2], B1[2][2];
    const char* cA = (const char*)g.A + (size_t)cur.pm * tstep; const char* cB = (const char*)g.Bt + (size_t)cur.pn * tstep;
    S.a_ready(cur);
    if constexpr (SP2) {
        PG8_STAGE(PG8_SB(0, 0), cB, voffB); PG8_STAGE(PG8_SB(0, 1), cB + hstep, voffB); PG8_STAGE(PG8_SA(0, 0), cA, voffA); PG8_STAGE(PG8_SA(0, 1), cA + hstep, voffA);
        if (wr == 1) PG8_BAR;
        PG8_WAIT_V(2); PG8_BAR;
        PG8_STAGE(PG8_SB(1, 0), cB + kstep, voffB); PG8_STAGE(PG8_SA(1, 0), cA + kstep, voffA); PG8_STAGE(PG8_SB(1, 1), cB + hstep + kstep, voffB);
        PG8_WAIT_V(6); PG8_BAR;
    } else {
        PG8_STAGE(PG8_SB(0, 0), cB, voffB); PG8_STAGE(PG8_SA(0, 0), cA, voffA); PG8_STAGE(PG8_SB(0, 1), cB + hstep, voffB); PG8_STAGE(PG8_SA(0, 1), cA + hstep, voffA);
        if (wr == 1) PG8_BAR;
        PG8_WAIT_V(4); PG8_BAR;
        PG8_STAGE(PG8_SB(1, 0), cB + kstep, voffB); PG8_STAGE(PG8_SA(1, 0), cA + kstep, voffA); PG8_STAGE(PG8_SB(1, 1), cB + hstep + kstep, voffB);
        PG8_WAIT_V(6); PG8_BAR;
    }
    for (;;) {
        const bool has_next = S.next(ui + 1, nxt);
        const char* nA = has_next ? (const char*)g.A + (size_t)nxt.pm * tstep : cA; const char* nB = has_next ? (const char*)g.Bt + (size_t)nxt.pn * tstep : cB;
        for (int t = 0; t < nt; t += 2) {
            const bool last = (t == nt - 2);
            const char* a1 = cA + (size_t)(t + 1) * kstep;
            const char* a2 = last ? nA : cA + (size_t)(t + 2) * kstep; const char* b2 = last ? nB : cB + (size_t)(t + 2) * kstep;
            const char* a3 = a2 + kstep; const char* b3 = b2 + kstep;
            if (last && has_next) S.a_ready(nxt);
            if constexpr (SP2) {
            PG8_LDB(B0, 0, 0); PG8_LDB(B1, 0, 1); PG8_SCHED; PG8_LDA(At, 0, 0); PG8_STAGE(PG8_SA(1, 1), a1 + hstep, voffA);
            PG8_WAIT_V(8); PG8_WAIT_L(0); PG8_BAR; PG8_MMA(0, 0, At, B0); PG8_MMA(0, 1, At, B1); PG8_BAR; PG8_SCHED;
            PG8_LDA(At, 0, 1); PG8_STAGE(PG8_SB(0, 0), b2, voffB); PG8_STAGE(PG8_SB(0, 1), b2 + hstep, voffB); PG8_STAGE(PG8_SA(0, 0), a2, voffA);
            PG8_WAIT_V(8); PG8_WAIT_L(0); PG8_BAR; PG8_MMA(1, 0, At, B0); PG8_MMA(1, 1, At, B1); PG8_BAR; PG8_SCHED;
            PG8_LDB(B0, 1, 0); PG8_LDB(B1, 1, 1); PG8_SCHED; PG8_LDA(At, 1, 0); PG8_STAGE(PG8_SA(0, 1), a2 + hstep, voffA);
            PG8_WAIT_V(8); PG8_WAIT_L(0); PG8_BAR; PG8_MMA(0, 0, At, B0); PG8_MMA(0, 1, At, B1); PG8_BAR; PG8_SCHED;
            PG8_LDA(At, 1, 1); PG8_STAGE(PG8_SB(1, 0), b3, voffB); PG8_STAGE(PG8_SB(1, 1), b3 + hstep, voffB); PG8_STAGE(PG8_SA(1, 0), a3, voffA);
            PG8_WAIT_V(8); PG8_WAIT_L(0); PG8_BAR; PG8_MMA(1, 0, At, B0); PG8_MMA(1, 1, At, B1); PG8_BAR; PG8_SCHED;
            } else {
            PG8_LDB(B0, 0, 0); PG8_SCHED; PG8_LDA(At, 0, 0); PG8_STAGE(PG8_SA(1, 1), a1 + hstep, voffA);
            PG8_WAIT_L(8); PG8_BAR; PG8_WAIT_L(0); PG8_MMA(0, 0, At, B0); PG8_BAR; PG8_SCHED;
            PG8_LDB(B1, 0, 1); PG8_STAGE(PG8_SB(0, 0), b2, voffB);
            PG8_BAR; PG8_WAIT_L(0); PG8_MMA(0, 1, At, B1); PG8_BAR;
            PG8_LDA(At, 0, 1); PG8_STAGE(PG8_SA(0, 0), a2, voffA);
            PG8_BAR; PG8_WAIT_L(0); PG8_MMA(1, 0, At, B0); PG8_BAR; PG8_SCHED;
            PG8_STAGE(PG8_SB(0, 1), b2 + hstep, voffB);
            PG8_WAIT_V(6); PG8_BAR; PG8_MMA(1, 1, At, B1); PG8_BAR;
            PG8_LDB(B0, 1, 0); PG8_SCHED; PG8_LDA(At, 1, 0); PG8_STAGE(PG8_SA(0, 1), a2 + hstep, voffA);
            PG8_WAIT_L(8); PG8_BAR; PG8_WAIT_L(0); PG8_MMA(0, 0, At, B0); PG8_BAR; PG8_SCHED;
            PG8_LDB(B1, 1, 1); PG8_STAGE(PG8_SB(1, 0), b3, voffB);
            PG8_BAR; PG8_WAIT_L(0); PG8_MMA(0, 1, At, B1); PG8_BAR;
            PG8_LDA(At, 1, 1); PG8_STAGE(PG8_SA(1, 0), a3, voffA);
            PG8_BAR; PG8_WAIT_L(0); PG8_MMA(1, 0, At, B0); PG8_BAR; PG8_SCHED;
            PG8_STAGE(PG8_SB(1, 1), b3 + hstep, voffB);
            PG8_WAIT_V(6); PG8_BAR; PG8_MMA(1, 1, At, B1); PG8_BAR;
            }
        }
        if constexpr (ALIGN_EPI) { if (wr == 0) PG8_BAR; }
        if constexpr (!Epi::AFTER_DRAIN) { E(acc, cur, wr, wc, fr, fq); S.done(cur); }
        if (!has_next) break;
#pragma unroll
        for (int a = 0; a < 2; ++a)
#pragma unroll
            for (int b = 0; b < 2; ++b)
#pragma unroll
                for (int m = 0; m < 4; ++m)
#pragma unroll
                    for (int n = 0; n < 2; ++n) acc[a][b][m][n] = (f32x4){0.f, 0.f, 0.f, 0.f};
        cur = nxt; cA = nA; cB = nB; ++ui;
        if constexpr (ALIGN_EPI) { if (wr == 1) PG8_BAR; }
    }
    PG8_WAIT_V(0);
    if constexpr (!ALIGN_EPI) { if (wr == 0) PG8_BAR; }
    PG8_BAR;
    if constexpr (Epi::AFTER_DRAIN) { E.fused(acc, cur, wr, wc, fr, fq, lds, wid, lane); S.done(cur); }
#undef PG8_SA
#undef PG8_SB
#undef PG8_STAGE
#undef PG8_LDA
#undef PG8_LDB
#undef PG8_MMA
#undef PG8_WAIT_V
#undef PG8_WAIT_L
#undef PG8_BAR
#undef PG8_SCHED
}
}
#define LAS __attribute__((address_space(3)))
typedef unsigned short bf16_t;
typedef short bf16x8 __attribute__((ext_vector_type(8)));
typedef short s16x4 __attribute__((ext_vector_type(4)));
typedef float f32x4 __attribute__((ext_vector_type(4)));
typedef float f32x16 __attribute__((ext_vector_type(16)));
typedef unsigned u32x4 __attribute__((ext_vector_type(4)));
typedef unsigned u32x2 __attribute__((ext_vector_type(2)));
using pg8::ZP; using pg8::LOG2E; using pg8::EPS;
__device__ __forceinline__ int crow(int r, int hi) { return (r & 3) + 8 * (r >> 2) + 4 * hi; }
__device__ __forceinline__ unsigned cvtpk(float lo, float hi) { unsigned r; asm volatile("v_cvt_pk_bf16_f32 %0, %1, %2" : "=v"(r) : "v"(lo), "v"(hi)); return r; }
__device__ __forceinline__ unsigned f2bf(float f) { unsigned u = __builtin_bit_cast(unsigned, f); return (u + 0x7fffu + ((u >> 16) & 1u)) >> 16; }
__device__ __forceinline__ float bf2f(unsigned short h) { return __builtin_bit_cast(float, (unsigned)h << 16); }
__device__ __forceinline__ float ex2(float x) { return __builtin_amdgcn_exp2f(x); }
#define VM_WAIT0() asm volatile("s_waitcnt vmcnt(0)" ::: "memory")
#define LGKM_WAIT0() asm volatile("s_waitcnt lgkmcnt(0)" ::: "memory")

__device__ __forceinline__ void dma_k(LAS unsigned char* slot, const bf16_t* src, int pitch, int w, int lane) {
    const bf16_t* s = src + (size_t)lane * pitch + w * 8;
    __builtin_amdgcn_global_load_lds((const unsigned*)s, (LAS unsigned*)(slot + w * 1024), 16, 0, 0);
}
__device__ __forceinline__ void dma_v(LAS unsigned char* slot, const bf16_t* src, int pitch, int w, int lane) {
    const bf16_t* s = src + (size_t)(16 * (w & 3) + (lane >> 2)) * pitch + (w >> 2) * 32 + (lane & 3) * 8;
    __builtin_amdgcn_global_load_lds((const unsigned*)s, (LAS unsigned*)(slot + w * 1024), 16, 0, 0);
}
__device__ __forceinline__ void dma_lin(LAS unsigned char* slot, const unsigned char* src, int w, int lane) {
    __builtin_amdgcn_global_load_lds((const unsigned*)(src + w * 1024 + lane * 16), (LAS unsigned*)(slot + w * 1024), 16, 0, 0);
}
__device__ __forceinline__ void qkt(f32x16& p0, f32x16& p1, const LAS unsigned char* Kslot, const bf16x8* qr, int r32, int hi, f32x16 z0 = f32x16{}, f32x16 z1 = f32x16{}) {
    const LAS unsigned char* kb = Kslot + hi * 1024 + r32 * 16;
#pragma unroll
    for (int d0 = 0; d0 < 4; ++d0) {
        const bf16x8 b0 = *(const LAS bf16x8*)(kb + d0 * 2048);
        const bf16x8 b1 = *(const LAS bf16x8*)(kb + d0 * 2048 + 512);
        z0 = __builtin_amdgcn_mfma_f32_32x32x16_bf16(b0, qr[d0], z0, 0, 0, 0);
        z1 = __builtin_amdgcn_mfma_f32_32x32x16_bf16(b1, qr[d0], z1, 0, 0, 0);
    }
    p0 = z0; p1 = z1;
}
__device__ __forceinline__ int vt_lane_off(int lane) { const int hi = lane >> 5; return ((lane >> 4) & 1) * 32 + (lane & 3) * 8 + (4 * hi + ((lane & 15) >> 2)) * 64; }
__device__ __forceinline__ bf16x8 vfrag(int vb, int d0, int ks) {
    s16x4 lo, hh;
    asm volatile("ds_read_b64_tr_b16 %0, %1" : "=v"(lo) : "v"(vb + d0 * 4096 + ks * 1024) : "memory");
    asm volatile("ds_read_b64_tr_b16 %0, %1" : "=v"(hh) : "v"(vb + d0 * 4096 + ks * 1024 + 512) : "memory");
    asm volatile("s_waitcnt lgkmcnt(0)" : "+v"(lo), "+v"(hh) :: "memory");
    return (bf16x8){lo[0], lo[1], lo[2], lo[3], hh[0], hh[1], hh[2], hh[3]};
}
__device__ __forceinline__ void pv(f32x16* o, int vb, bf16x8 pa0, bf16x8 pa1, bf16x8 pa2, bf16x8 pa3) {
    s16x4 lo[8], hh[8];
#pragma unroll
    for (int i = 0; i < 8; ++i) {
        asm volatile("ds_read_b64_tr_b16 %0, %1 offset:%c2" : "=&v"(lo[i]) : "v"(vb), "i"((i >> 2) * 4096 + (i & 3) * 1024) : "memory");
        asm volatile("ds_read_b64_tr_b16 %0, %1 offset:%c2" : "=&v"(hh[i]) : "v"(vb), "i"((i >> 2) * 4096 + (i & 3) * 1024 + 512) : "memory");
    }
    asm volatile("s_waitcnt lgkmcnt(0)" : "+v"(lo[0]), "+v"(lo[1]), "+v"(lo[2]), "+v"(lo[3]), "+v"(lo[4]), "+v"(lo[5]), "+v"(lo[6]), "+v"(lo[7]),
                 "+v"(hh[0]), "+v"(hh[1]), "+v"(hh[2]), "+v"(hh[3]), "+v"(hh[4]), "+v"(hh[5]), "+v"(hh[6]), "+v"(hh[7]) :: "memory");
#define PVK(k) (bf16x8){lo[k][0], lo[k][1], lo[k][2], lo[k][3], hh[k][0], hh[k][1], hh[k][2], hh[k][3]}
    o[0] = __builtin_amdgcn_mfma_f32_32x32x16_bf16(pa0, PVK(0), o[0], 0, 0, 0);
    o[1] = __builtin_amdgcn_mfma_f32_32x32x16_bf16(pa0, PVK(4), o[1], 0, 0, 0);
    o[0] = __builtin_amdgcn_mfma_f32_32x32x16_bf16(pa1, PVK(1), o[0], 0, 0, 0);
    o[1] = __builtin_amdgcn_mfma_f32_32x32x16_bf16(pa1, PVK(5), o[1], 0, 0, 0);
    o[0] = __builtin_amdgcn_mfma_f32_32x32x16_bf16(pa2, PVK(2), o[0], 0, 0, 0);
    o[1] = __builtin_amdgcn_mfma_f32_32x32x16_bf16(pa2, PVK(6), o[1], 0, 0, 0);
    o[0] = __builtin_amdgcn_mfma_f32_32x32x16_bf16(pa3, PVK(3), o[0], 0, 0, 0);
    o[1] = __builtin_amdgcn_mfma_f32_32x32x16_bf16(pa3, PVK(7), o[1], 0, 0, 0);
#undef PVK
}
#define PACK8(P, B) __builtin_bit_cast(bf16x8, ((u32x4){cvtpk(P[B], P[B + 1]), cvtpk(P[B + 2], P[B + 3]), cvtpk(P[B + 4], P[B + 5]), cvtpk(P[B + 6], P[B + 7])}))
__device__ __forceinline__ void scale_rows(f32x16* o, float f, LAS float* wsf, int r32, int hi) {
    if (hi == 0) wsf[r32] = f;
    LGKM_WAIT0();
#pragma unroll
    for (int r = 0; r < 16; ++r) { const float fr = wsf[crow(r, hi)]; o[0][r] *= fr; o[1][r] *= fr; }
    LGKM_WAIT0();
}
__device__ __forceinline__ float max3f(float x, float y, float z) { return __builtin_fmaxf(__builtin_fmaxf(x, y), z); }
typedef float f32x8 __attribute__((ext_vector_type(8)));
typedef float f32x2 __attribute__((ext_vector_type(2)));
typedef short v4i16_t __attribute__((ext_vector_type(4)));
__device__ __forceinline__ s16x4 vtr(const LAS unsigned char* p) { return __builtin_bit_cast(s16x4, __builtin_amdgcn_ds_read_tr16_b64_v4i16((LAS v4i16_t*)p)); }
__device__ __forceinline__ float rowmax32(const f32x16& p0, const f32x16& p1) {
    float a = max3f(p0[0], p0[1], p1[0]), b = max3f(p0[2], p0[3], p1[1]); a = max3f(a, p1[2], p1[3]);
#pragma unroll
    for (int r = 4; r < 16; r += 4) { a = max3f(a, p0[r], p0[r + 1]); b = max3f(b, p0[r + 2], p0[r + 3]); a = max3f(a, p1[r], p1[r + 1]); b = max3f(b, p1[r + 2], p1[r + 3]); }
    const float m = fmaxf(a, b);
    auto rr = __builtin_amdgcn_permlane32_swap(__builtin_bit_cast(unsigned, m), __builtin_bit_cast(unsigned, m), false, false);
    return fmaxf(__builtin_bit_cast(float, (unsigned)rr[0]), __builtin_bit_cast(float, (unsigned)rr[1]));
}
template <int THR, bool HASF>
__device__ __forceinline__ void attn_step(f32x16& p0, f32x16& p1, f32x16& n0, f32x16& n1, const LAS unsigned char* Knext, const LAS float* Fnext, const LAS unsigned char* Vcur,
                                          const bf16x8* qr, float& mhat, float& l, f32x16* o, LAS float* wsf, int r32, int hi) {
    f32x16 c0 = f32x16{}, c1 = f32x16{};
    if (HASF) {
#pragma unroll
        for (int rr = 0; rr < 4; ++rr) { const f32x4 f0 = *(const LAS f32x4*)(Fnext + 8 * rr), f1 = *(const LAS f32x4*)(Fnext + 32 + 8 * rr);
#pragma unroll
            for (int e = 0; e < 4; ++e) { c0[4 * rr + e] = f0[e]; c1[4 * rr + e] = f1[e]; } }
    }
    bf16x8 kf[8];
    { const LAS unsigned char* kb = Knext + hi * 1024 + r32 * 16;
#pragma unroll
      for (int d0 = 0; d0 < 4; ++d0) { kf[2 * d0] = *(const LAS bf16x8*)(kb + d0 * 2048); kf[2 * d0 + 1] = *(const LAS bf16x8*)(kb + d0 * 2048 + 512); } }
    __builtin_amdgcn_sched_barrier(0);
    const float rm = rowmax32(p0, p1);
    if (__any(rm > mhat + (float)THR)) {
        const float mnew = fmaxf(mhat, rm), f = ex2(mhat - mnew);
        l *= f; mhat = mnew; scale_rows(o, f, wsf, r32, hi);
    }
#pragma unroll
    for (int d0 = 0; d0 < 4; ++d0) {
        c0 = __builtin_amdgcn_mfma_f32_32x32x16_bf16(kf[2 * d0], qr[d0], c0, 0, 0, 0);
        c1 = __builtin_amdgcn_mfma_f32_32x32x16_bf16(kf[2 * d0 + 1], qr[d0], c1, 0, 0, 0);
    }
    __builtin_amdgcn_sched_barrier(0);
    s16x4 vl[8], vh[8];
#pragma unroll
    for (int i = 0; i < 8; ++i) { vl[i] = vtr(Vcur + (i >> 2) * 4096 + (i & 3) * 1024); vh[i] = vtr(Vcur + (i >> 2) * 4096 + (i & 3) * 1024 + 512); }
    __builtin_amdgcn_sched_barrier(0);
    p0 = p0 - mhat; p1 = p1 - mhat;
#pragma unroll
    for (int r = 0; r < 16; ++r) { p0[r] = ex2(p0[r]); p1[r] = ex2(p1[r]); }
    const f32x16 t = p0 + p1;
    const f32x8 t8 = t.lo + t.hi; const f32x4 t4 = t8.lo + t8.hi; const f32x2 t2 = t4.lo + t4.hi;
    l += t2.x + t2.y;
    const bf16x8 pa0 = PACK8(p0, 0), pa1 = PACK8(p0, 8), pa2 = PACK8(p1, 0), pa3 = PACK8(p1, 8);
#define VFK(k) (bf16x8){vl[k][0], vl[k][1], vl[k][2], vl[k][3], vh[k][0], vh[k][1], vh[k][2], vh[k][3]}
    o[0] = __builtin_amdgcn_mfma_f32_32x32x16_bf16(pa0, VFK(0), o[0], 0, 0, 0);
    o[1] = __builtin_amdgcn_mfma_f32_32x32x16_bf16(pa0, VFK(4), o[1], 0, 0, 0);
    o[0] = __builtin_amdgcn_mfma_f32_32x32x16_bf16(pa1, VFK(1), o[0], 0, 0, 0);
    o[1] = __builtin_amdgcn_mfma_f32_32x32x16_bf16(pa1, VFK(5), o[1], 0, 0, 0);
    o[0] = __builtin_amdgcn_mfma_f32_32x32x16_bf16(pa2, VFK(2), o[0], 0, 0, 0);
    o[1] = __builtin_amdgcn_mfma_f32_32x32x16_bf16(pa2, VFK(6), o[1], 0, 0, 0);
    o[0] = __builtin_amdgcn_mfma_f32_32x32x16_bf16(pa3, VFK(3), o[0], 0, 0, 0);
    o[1] = __builtin_amdgcn_mfma_f32_32x32x16_bf16(pa3, VFK(7), o[1], 0, 0, 0);
#undef VFK
    n0 = c0; n1 = c1;
}
template <int THR>
__device__ __forceinline__ void softmax_pv(f32x16& p0, f32x16& p1, float& mhat, float& l, f32x16* o, int vb, LAS float* wsf, int r32, int hi) {
    float a = max3f(p0[0], p0[1], p1[0]), b = max3f(p0[2], p0[3], p1[1]); a = max3f(a, p1[2], p1[3]);
#pragma unroll
    for (int r = 4; r < 16; r += 4) { a = max3f(a, p0[r], p0[r + 1]); b = max3f(b, p0[r + 2], p0[r + 3]); a = max3f(a, p1[r], p1[r + 1]); b = max3f(b, p1[r + 2], p1[r + 3]); }
    float rm = fmaxf(a, b); rm = fmaxf(rm, __shfl_xor(rm, 32));
    if (__any(rm > mhat + (float)THR)) {
        const float mnew = fmaxf(mhat, rm), f = ex2(mhat - mnew);
        l *= f; mhat = mnew; scale_rows(o, f, wsf, r32, hi);
    }
    p0 = p0 - mhat; p1 = p1 - mhat;
#pragma unroll
    for (int r = 0; r < 16; ++r) { p0[r] = ex2(p0[r]); p1[r] = ex2(p1[r]); }
    const f32x16 t = p0 + p1;
    const f32x8 t8 = t.lo + t.hi; const f32x4 t4 = t8.lo + t8.hi; const f32x2 t2 = t4.lo + t4.hi;
    l += t2.x + t2.y;
    pv(o, vb, PACK8(p0, 0), PACK8(p0, 8), PACK8(p1, 0), PACK8(p1, 8));
}
__device__ __forceinline__ void store_o(const f32x16* o, float rinv, LAS float* wsf, LAS bf16_t* stg, bf16_t* Og, int pitch, int r32, int hi, int lane) {
    if (hi == 0) wsf[32 + r32] = rinv;
    LGKM_WAIT0();
#pragma unroll
    for (int r = 0; r < 16; ++r) { const int orow = crow(r, hi); const float rl = wsf[32 + orow];
#pragma unroll
        for (int d0 = 0; d0 < 2; ++d0) stg[orow * 64 + d0 * 32 + r32] = (bf16_t)f2bf(o[d0][r] * rl); }
    LGKM_WAIT0();
#pragma unroll
    for (int i = 0; i < 4; ++i) { const int row = i * 8 + (lane >> 3), ch = lane & 7; const u32x4 v = *(const LAS u32x4*)(stg + row * 64 + ch * 8); *(u32x4*)(Og + (size_t)row * pitch + ch * 8) = v; }
    LGKM_WAIT0();
}
__device__ __forceinline__ float log_sigmoid(float x) { return fminf(x, 0.f) - log1pf(__expf(-fabsf(x))); }

constexpr int MX_RING = 0, MX_F = 98304, MX_WSF = 114688, MX_WTOT = 116736, MX_STG_SWA = 65536, MX_STG_FOX = 40960;

struct MixCtx {
    const bf16_t* Z; const float* G; bf16_t* Y;
    const float* sinks; const float* fox_fb; const float* ml_ib; const float* ml_fb; const float* ml_norm;
    unsigned char* ws; const unsigned char* KT; const unsigned char* VT;
};

__device__ __forceinline__ void swa_item(const MixCtx& C, int item, LAS unsigned char* lds) {
    int tid_ = threadIdx.x; asm volatile("" : "+v"(tid_));
    const int tid = tid_, lane = tid & 63, w = __builtin_amdgcn_readfirstlane(tid >> 6), r32 = lane & 31, hi = lane >> 5;
    const int jp = item & 31, kvh = (item >> 5) & 1, b = item >> 6;
    const size_t rowbase = (size_t)b * 4096;
    const int cbase = jp >= 1 ? 2 * jp - 2 : 0, ntl = 2 * jp + 2 - cbase;
    const bf16_t* Kb = C.Z + rowbase * ZP + 512 + 64 * kvh; const bf16_t* Vb = C.Z + rowbase * ZP + 640 + 64 * kvh;
    for (int j = 0; j < ntl; ++j) { dma_k(lds + MX_RING + j * 16384, Kb + (size_t)(cbase + j) * 64 * ZP, ZP, w, lane); dma_v(lds + MX_RING + j * 16384 + 8192, Vb + (size_t)(cbase + j) * 64 * ZP, ZP, w, lane); }
    const int hq = 4 * kvh + (w >> 1);
    bf16x8 qra[4], qrb[4];
    { const bf16_t* Qa = C.Z + (rowbase + 128 * jp + 32 * (w & 1) + r32) * ZP + 64 * hq;
#pragma unroll
      for (int d0 = 0; d0 < 4; ++d0) { qra[d0] = *(const bf16x8*)(Qa + 16 * d0 + 8 * hi); qrb[d0] = *(const bf16x8*)(Qa + (size_t)64 * ZP + 16 * d0 + 8 * hi); } }
    LAS float* wsf = (LAS float*)(lds + MX_WSF) + w * 64; LAS bf16_t* stg = (LAS bf16_t*)(lds + MX_STG_SWA + w * 4096);
    const float sink = C.sinks[hq] * LOG2E;
    VM_WAIT0(); __syncthreads();
    const int vlo = vt_lane_off(lane);
#pragma unroll
    for (int cc = 0; cc < 2; ++cc) {
        const int c = 2 * jp + cc, c0 = c >= 2 ? c - 2 : 0, nt = c - c0 + 1, s0 = c0 - cbase, qw0 = 64 * c + 32 * (w & 1);
        const bf16x8* qr = cc == 0 ? qra : qrb;
        float mhat = sink, l = hi == 0 ? 1.f : 0.f; f32x16 o[2]; o[0] = f32x16{}; o[1] = f32x16{};
        f32x16 p0, p1; qkt(p0, p1, lds + MX_RING + s0 * 16384, qr, r32, hi);
        for (int j = 0; j < nt; ++j) {
            f32x16 n0 = p0, n1 = p1;
            if (j + 1 < nt) qkt(n0, n1, lds + MX_RING + (s0 + j + 1) * 16384, qr, r32, hi);
            softmax_pv<8>(p0, p1, mhat, l, o, (int)(uintptr_t)(lds + MX_RING + (s0 + j) * 16384 + 8192) + vlo, wsf, r32, hi);
            p0 = n0; p1 = n1;
        }
        l += __shfl_xor(l, 32);
        store_o(o, 1.0f / l, wsf, stg, C.Y + (rowbase + qw0) * 1024 + 64 * hq, 1024, r32, hi, lane);
    }
    __syncthreads();
}

__device__ __forceinline__ void fx0_item(const MixCtx& C, float* NF, unsigned* cntF, int bh, LAS unsigned char* lds) {
    int tid_ = threadIdx.x; asm volatile("" : "+v"(tid_));
    const int tid = tid_, lane = tid & 63, w = __builtin_amdgcn_readfirstlane(tid >> 6);
    const int b = bh >> 2, h = bh & 3; const size_t rowbase = (size_t)b * 4096;
    LAS float* wtot = (LAS float*)(lds + MX_WTOT);
    const float fb = C.fox_fb[h]; const int t0 = tid * 8; float v[8]; float run = 0.f;
#pragma unroll
    for (int i = 0; i < 8; ++i) { run += log_sigmoid(C.G[(rowbase + t0 + i) * 16 + h] + fb) * LOG2E; v[i] = run; }
    float inc = run;
#pragma unroll
    for (int o_ = 1; o_ < 64; o_ <<= 1) { const float y = __shfl_up(inc, o_); if (lane >= o_) inc += y; }
    if (lane == 63) wtot[w] = inc;
    __syncthreads();
    float off = inc - run;
    for (int j = 0; j < w; ++j) off += wtot[j];
    *(f32x4*)(NF + bh * 4096 + t0) = (f32x4){-(v[0] + off), -(v[1] + off), -(v[2] + off), -(v[3] + off)};
    *(f32x4*)(NF + bh * 4096 + t0 + 4) = (f32x4){-(v[4] + off), -(v[5] + off), -(v[6] + off), -(v[7] + off)};
    asm volatile("s_waitcnt vmcnt(0)" ::: "memory"); __syncthreads();
    if (tid == 0) { __builtin_amdgcn_fence(__ATOMIC_RELEASE, "agent"); asm volatile("s_waitcnt vmcnt(0)" ::: "memory"); __hip_atomic_fetch_add(cntF + bh, 1u, __ATOMIC_RELAXED, __HIP_MEMORY_SCOPE_AGENT); }
    __syncthreads();
}
__device__ __forceinline__ void fox_block(const MixCtx& C, const float* NF, unsigned* cntF, int bh, int qb, LAS unsigned char* lds, bool first) {
    int tid_ = threadIdx.x; asm volatile("" : "+v"(tid_));
    const int tid = tid_, lane = tid & 63, w = __builtin_amdgcn_readfirstlane(tid >> 6), r32 = lane & 31, hi = lane >> 5;
    const int b = bh >> 2, h = bh & 3; const size_t rowbase = (size_t)b * 4096; const int q0 = qb * 128, nkeys = q0 + 128, nst = qb + 1;
    const unsigned char* Kt = C.KT + (size_t)bh * 64 * 8192; const unsigned char* Vt = C.VT + (size_t)bh * 64 * 8192;
#define FOX_STAGE(st_) do { LAS unsigned char* sb_ = lds + MX_RING + ((st_) % 3) * 32768; \
        dma_lin(sb_, Kt + (size_t)(2 * (st_)) * 8192, w, lane); dma_lin(sb_ + 8192, Kt + (size_t)(2 * (st_) + 1) * 8192, w, lane); \
        dma_lin(sb_ + 16384, Vt + (size_t)(2 * (st_)) * 8192, w, lane); dma_lin(sb_ + 24576, Vt + (size_t)(2 * (st_) + 1) * 8192, w, lane); } while (0)
    FOX_STAGE(0); if (nst > 1) FOX_STAGE(1);
    LAS float* F2 = (LAS float*)(lds + MX_F);
    LAS float* wsf = (LAS float*)(lds + MX_WSF) + w * 64; LAS bf16_t* stg = (LAS bf16_t*)(lds + MX_STG_FOX + w * 4096);
    const int g = w >> 2, qw0 = q0 + 32 * (w & 3);
    const bf16_t* Qb = C.Z + (rowbase + qw0 + r32) * ZP + 768 + 64 * h;
    bf16x8 qr[4];
#pragma unroll
    for (int d0 = 0; d0 < 4; ++d0) qr[d0] = *(const bf16x8*)(Qb + 16 * d0 + 8 * hi);
    if (first) {
        if (tid == 0) { while (__hip_atomic_load(cntF + bh, __ATOMIC_RELAXED, __HIP_MEMORY_SCOPE_AGENT) < 1u) __builtin_amdgcn_s_sleep(2); }
        __syncthreads();
    }
    {
        const int t0 = tid * 8;
        if (first && t0 < nkeys) { const unsigned long long* np = (const unsigned long long*)(NF + bh * 4096 + t0); unsigned long long q[4];
#pragma unroll
            for (int i = 0; i < 4; ++i) q[i] = __hip_atomic_load(np + i, __ATOMIC_RELAXED, __HIP_MEMORY_SCOPE_AGENT);
#pragma unroll
            for (int i = 0; i < 4; ++i) *(LAS unsigned long long*)(F2 + t0 + 2 * i) = q[i]; }
    }
    float mhat = -1e30f, l = 0.f; f32x16 o[2]; o[0] = f32x16{}; o[1] = f32x16{};
    VM_WAIT0(); __syncthreads();
    const int vlo = vt_lane_off(lane), qpos = qw0 + r32;
#define FOX_SCORE(st_, P0, P1) do { const int kb_ = 64 * (2 * (st_) + g); const LAS unsigned char* sk_ = lds + MX_RING + ((st_) % 3) * 32768 + g * 8192; f32x16 c0_, c1_; \
        _Pragma("unroll") for (int rr = 0; rr < 4; ++rr) { const f32x4 f0 = *(const LAS f32x4*)(F2 + kb_ + 8 * rr + 4 * hi), f1 = *(const LAS f32x4*)(F2 + kb_ + 32 + 8 * rr + 4 * hi); \
            _Pragma("unroll") for (int e = 0; e < 4; ++e) { c0_[4 * rr + e] = f0[e]; c1_[4 * rr + e] = f1[e]; } } \
        qkt(P0, P1, sk_, qr, r32, hi, c0_, c1_); } while (0)
    f32x16 p0, p1, n0, n1; FOX_SCORE(0, p0, p1);
#define FOX_STEP(PA0, PA1, PB0, PB1, st_) do { if ((st_) + 2 < nst) FOX_STAGE((st_) + 2); \
        attn_step<24, true>(PA0, PA1, PB0, PB1, lds + MX_RING + (((st_) + 1) % 3) * 32768 + g * 8192, F2 + 64 * (2 * ((st_) + 1) + g) + 4 * hi, \
                           lds + MX_RING + ((st_) % 3) * 32768 + 16384 + g * 8192 + vlo, qr, mhat, l, o, wsf, r32, hi); \
        VM_WAIT0(); __syncthreads(); } while (0)
#define FOX_LAST(PA0, PA1) do { const int st = nst - 1, kbase = 64 * (2 * st + g); \
        if (kbase <= qw0 + 31) { \
            if (kbase + 63 > qw0) { _Pragma("unroll") for (int r = 0; r < 16; ++r) { const int kv = kbase + crow(r, hi); if (kv > qpos) PA0[r] = -INFINITY; if (kv + 32 > qpos) PA1[r] = -INFINITY; } } \
            softmax_pv<24>(PA0, PA1, mhat, l, o, (int)(uintptr_t)(lds + MX_RING + (st % 3) * 32768 + 16384 + g * 8192) + vlo, wsf, r32, hi); } } while (0)
    int st2 = 0;
    for (; st2 + 2 < nst; st2 += 2) { FOX_STEP(p0, p1, n0, n1, st2); FOX_STEP(n0, n1, p0, p1, st2 + 1); }
    if (st2 + 1 < nst) { FOX_STEP(p0, p1, n0, n1, st2); FOX_LAST(n0, n1); } else { FOX_LAST(p0, p1); }
#undef FOX_STEP
#undef FOX_LAST
    __syncthreads();
#undef FOX_SCORE
#undef FOX_STAGE
    l += __shfl_xor(l, 32);
    LAS float* mo = (LAS float*)(lds + MX_RING); LAS float* ml = (LAS float*)(lds + MX_RING + 32768);
    const int wq = w & 3;
    if (g == 1) {
#pragma unroll
        for (int d0 = 0; d0 < 2; ++d0)
#pragma unroll
            for (int r = 0; r < 16; ++r) mo[((wq * 2 + d0) * 16 + r) * 64 + lane] = o[d0][r];
        ml[(wq * 2 + 0) * 64 + lane] = mhat; ml[(wq * 2 + 1) * 64 + lane] = l;
    }
    __syncthreads();
    if (g == 0) {
        const float m1 = ml[(wq * 2 + 0) * 64 + lane], l1 = ml[(wq * 2 + 1) * 64 + lane];
        const float mn = fmaxf(mhat, m1), f0 = ex2(mhat - mn), f1 = ex2(m1 - mn), lt = l * f0 + l1 * f1;
        if (hi == 0) { wsf[r32] = f0; wsf[32 + r32] = f1; }
        LGKM_WAIT0();
#pragma unroll
        for (int r = 0; r < 16; ++r) { const float a0 = wsf[crow(r, hi)], a1 = wsf[32 + crow(r, hi)];
#pragma unroll
            for (int d0 = 0; d0 < 2; ++d0) o[d0][r] = o[d0][r] * a0 + mo[((wq * 2 + d0) * 16 + r) * 64 + lane] * a1; }
        LGKM_WAIT0();
        store_o(o, 1.0f / lt, wsf, stg, C.Y + (rowbase + qw0) * 1024 + 512 + 64 * h, 1024, r32, hi, lane);
    }
    __syncthreads();
}
__device__ __forceinline__ void fox_item(const MixCtx& C, const float* NF, unsigned* cntF, int bh, int i, LAS unsigned char* lds) {
    fox_block(C, NF, cntF, bh, 31 - i, lds, true);
    fox_block(C, NF, cntF, bh, i, lds, false);
}
constexpr int ML_WSF = 98304, ML_STG = 100352, ML_SM = 133120;
struct MlScratch { float* E; float* B; float* PM; float* CL; float* NL; bf16_t* CP; float* NP; float* GC; float* EM; float* MP; unsigned* cnt1; unsigned* cnt2; };
__device__ __forceinline__ void wait_count(unsigned* p, unsigned want, int tid) {
    if (tid == 0) { while (__hip_atomic_load(p, __ATOMIC_RELAXED, __HIP_MEMORY_SCOPE_AGENT) < want) __builtin_amdgcn_s_sleep(2);
        __builtin_amdgcn_fence(__ATOMIC_ACQUIRE, "agent"); asm volatile("s_waitcnt vmcnt(0)" ::: "memory"); }
    __syncthreads();
}
__device__ __forceinline__ void post_count(unsigned* p, int tid) {
    asm volatile("s_waitcnt vmcnt(0)" ::: "memory"); __syncthreads();
    if (tid == 0) { __builtin_amdgcn_fence(__ATOMIC_RELEASE, "agent"); asm volatile("s_waitcnt vmcnt(0)" ::: "memory");
        __hip_atomic_fetch_add(p, 1u, __ATOMIC_RELAXED, __HIP_MEMORY_SCOPE_AGENT); }
}
#define ML_COMMON \
    int tid_ = threadIdx.x; asm volatile("" : "+v"(tid_)); \
    const int tid = tid_, lane = tid & 63, w = __builtin_amdgcn_readfirstlane(tid >> 6), r32 = lane & 31, hi = lane >> 5; \
    const int b = bh >> 2, h = bh & 3; const size_t rowbase = (size_t)b * 4096; \
    float* E = S.E + bh * 4096; float* B = S.B + bh * 4096; float* PM = S.PM + bh * 4096; \
    float* CL = S.CL + (size_t)bh * 64 * 4096; float* NL = S.NL + bh * 4096; bf16_t* CP = S.CP + (size_t)bh * 64 * 4096; float* NP = S.NP + bh * 4096; \
    float* GC = S.GC + bh * 64; float* EM = S.EM + bh * 64; float* MP = S.MP + bh * 64; \
    (void)r32; (void)hi; (void)E; (void)B; (void)PM; (void)CL; (void)NL; (void)CP; (void)NP; (void)GC; (void)EM; (void)MP; (void)rowbase; (void)h;

__device__ __forceinline__ void ml1_item(const MixCtx& C, const MlScratch& S, int bh, int rd, LAS unsigned char* lds) {
    ML_COMMON
    LAS float* le = (LAS float*)(lds + ML_SM); LAS float* lem = le + 512;
    const bf16_t* Kg = C.Z + rowbase * ZP + 1792 + 64 * h; const bf16_t* Vg = C.Z + rowbase * ZP + 2048 + 64 * h;
    const int srow = 16 * (w & 3) + (lane >> 2), scol = (w >> 2) * 32 + (lane & 3) * 8;
    u32x4 kvr[8];
#pragma unroll
    for (int p = 0; p < 8; ++p) kvr[p] = *(const u32x4*)(Kg + (size_t)((8 * rd + p) * 64 + srow) * ZP + scol);
    {
        const int cc = 8 * rd + w, t = cc * 64 + lane;
        const float* gp = C.G + (rowbase + t) * 16;
        const float ig = gp[4 + h] + C.ml_ib[h];
        float bsum = log_sigmoid(gp[8 + h] + C.ml_fb[h]);
#pragma unroll
        for (int o_ = 1; o_ < 64; o_ <<= 1) { const float y = __shfl_up(bsum, o_); if (lane >= o_) bsum += y; }
        const float e = ig - bsum; float pm = e;
#pragma unroll
        for (int o_ = 1; o_ < 64; o_ <<= 1) { const float y = __shfl_up(pm, o_); if (lane >= o_) pm = fmaxf(pm, y); }
        E[t] = e; B[t] = bsum; PM[t] = pm; le[w * 64 + lane] = e;
        if (lane == 63) { GC[cc] = bsum; EM[cc] = pm; lem[w] = pm; }
    }
    __syncthreads();
    const int vlo = vt_lane_off(lane);
    const bf16x8 ones = (bf16x8){0x3F80, 0x3F80, 0x3F80, 0x3F80, 0x3F80, 0x3F80, 0x3F80, 0x3F80};
#pragma unroll
    for (int p = 0; p < 8; ++p) {
        const int cc = 8 * rd + p; LAS unsigned char* sl = lds + p * 16384;
        const float wa = __expf(le[p * 64 + srow] - lem[p]);
        u32x4 w2;
#pragma unroll
        for (int j = 0; j < 4; ++j) { const float lo = __builtin_bit_cast(float, kvr[p][j] << 16), hh = __builtin_bit_cast(float, kvr[p][j] & 0xffff0000u); w2[j] = cvtpk(lo * wa, hh * wa); }
        *(LAS u32x4*)(sl + w * 1024 + lane * 16) = w2;
        dma_v(sl + 8192, Vg + (size_t)cc * 64 * ZP, ZP, w, lane);
    }
    VM_WAIT0(); __syncthreads();
    {
        const int cc = 8 * rd + w; LAS unsigned char* sl = lds + w * 16384;
        const int ka = (int)(uintptr_t)sl + vlo, va = ka + 8192;
        float* cl = CL + (size_t)cc * 4096;
#pragma unroll
        for (int half = 0; half < 2; ++half) {
            f32x16 a0 = {}, a1 = {}, na = {};
#pragma unroll
            for (int ks = 0; ks < 4; ++ks) {
                const bf16x8 A = vfrag(ka, half, ks), B0 = vfrag(va, 0, ks), B1 = vfrag(va, 1, ks);
                a0 = __builtin_amdgcn_mfma_f32_32x32x16_bf16(A, B0, a0, 0, 0, 0);
                a1 = __builtin_amdgcn_mfma_f32_32x32x16_bf16(A, B1, a1, 0, 0, 0);
                na = __builtin_amdgcn_mfma_f32_32x32x16_bf16(A, ones, na, 0, 0, 0);
            }
#pragma unroll
            for (int r = 0; r < 16; ++r) { const int k = 32 * half + crow(r, hi); cl[k * 64 + r32] = a0[r]; cl[k * 64 + 32 + r32] = a1[r]; }
            if (r32 == 0) {
#pragma unroll
                for (int r = 0; r < 16; ++r) NL[cc * 64 + 32 * half + crow(r, hi)] = na[r];
            }
        }
    }
    post_count(S.cnt1 + bh, tid);
    __syncthreads();
}

__device__ __forceinline__ void ml2_item(const MixCtx& C, const MlScratch& S, int bh, int slice, LAS unsigned char* lds) {
    ML_COMMON
    LAS float* lg = (LAS float*)(lds + ML_SM); LAS float* lem = lg + 64; LAS float* lso = lg + 128; LAS float* lsl = lg + 192;
    wait_count(S.cnt1 + bh, 8u, tid);
    if (tid < 64) { lg[tid] = GC[tid]; lem[tid] = EM[tid]; }
    __syncthreads();
    if (tid == 0) { float mcur = 0.f; for (int c = 0; c < 64; ++c) { const float g = lg[c], em = lem[c], mx = fmaxf(mcur, em); if (slice == 0) MP[c] = mcur; lso[c] = __expf(mcur - mx); lsl[c] = __expf(em - mx); mcur = g + mx; } }
    __syncthreads();
    const int idx = slice * 2048 + tid * 4; const bool don = (slice == 0) && (tid < 64);
    f32x4 Cs = (f32x4){0.f, 0.f, 0.f, 0.f}; float ns = 0.f;
    for (int c0 = 0; c0 < 64; c0 += 16) {
        f32x4 lv[16]; float ln[16];
#pragma unroll
        for (int j = 0; j < 16; ++j) { lv[j] = *(const f32x4*)(CL + (size_t)(c0 + j) * 4096 + idx); ln[j] = don ? NL[(c0 + j) * 64 + tid] : 0.f; }
#pragma unroll
        for (int j = 0; j < 16; ++j) {
            const int c = c0 + j;
            u32x2 pk; pk.x = cvtpk(Cs[0], Cs[1]); pk.y = cvtpk(Cs[2], Cs[3]);
            *(u32x2*)(CP + (size_t)c * 4096 + idx) = pk;
            if (don) NP[c * 64 + tid] = ns;
            const float so = lso[c], sl = lsl[c];
            Cs = Cs * so + lv[j] * sl; ns = so * ns + sl * ln[j];
        }
    }
    post_count(S.cnt2 + bh, tid);
    __syncthreads();
}

__device__ __forceinline__ void ml3_item(const MixCtx& C, const MlScratch& S, int bh, int rd, LAS unsigned char* lds) {
    ML_COMMON
    wait_count(S.cnt2 + bh, 2u, tid);
    const int pair = w >> 1, half = w & 1;
    const bf16_t* Kg = C.Z + rowbase * ZP + 1792 + 64 * h; const bf16_t* Vg = C.Z + rowbase * ZP + 2048 + 64 * h; const bf16_t* Qg = C.Z + rowbase * ZP + 1536 + 64 * h;
    const int vlo = vt_lane_off(lane);
    LAS float* wsf = (LAS float*)(lds + ML_WSF) + w * 64; LAS bf16_t* stg = (LAS bf16_t*)(lds + ML_STG + w * 4096);
#pragma unroll
        for (int p = 0; p < 4; ++p) {
            const int cc = 4 * rd + p; LAS unsigned char* sl = lds + p * 24576;
            dma_k(sl, Kg + (size_t)cc * 64 * ZP, ZP, w, lane); dma_v(sl + 8192, Vg + (size_t)cc * 64 * ZP, ZP, w, lane); dma_v(sl + 16384, CP + (size_t)cc * 4096, 64, w, lane);
        }
        const int cc = 4 * rd + pair, lrow = 32 * half + r32, t = cc * 64 + lrow;
        const bf16_t* qp = Qg + (size_t)t * ZP;
        bf16x8 qr[4], qp2[4];
#pragma unroll
        for (int d0 = 0; d0 < 4; ++d0) qr[d0] = *(const bf16x8*)(qp + 16 * d0 + 8 * hi);
#pragma unroll
        for (int ks = 0; ks < 4; ++ks) { const u32x2 a = *(const u32x2*)(qp + 16 * ks + 4 * hi), b2 = *(const u32x2*)(qp + 16 * ks + 8 + 4 * hi); qp2[ks] = __builtin_bit_cast(bf16x8, ((u32x4){a.x, a.y, b2.x, b2.y})); }
        const float mprev = MP[cc], mm = fmaxf(mprev, PM[t]), winter = __expf(mprev - mm), bl = B[t];
        float nd = 0.f;
#pragma unroll
        for (int d0 = 0; d0 < 4; ++d0) { const float* np = NP + cc * 64 + 16 * d0 + 8 * hi; const f32x4 n0 = *(const f32x4*)np, n1 = *(const f32x4*)(np + 4);
            const u32x4 qq = __builtin_bit_cast(u32x4, qr[d0]);
#pragma unroll
            for (int j = 0; j < 4; ++j) { const float lo = __builtin_bit_cast(float, qq[j] << 16), hh = __builtin_bit_cast(float, qq[j] & 0xffff0000u);
                const float na_ = j < 2 ? n0[2 * j] : n1[2 * j - 4], nb_ = j < 2 ? n0[2 * j + 1] : n1[2 * j - 3]; nd += lo * na_ + hh * nb_; } }
        nd += __shfl_xor(nd, 32);
        VM_WAIT0(); __syncthreads();
        {
            LAS unsigned char* sl = lds + pair * 24576; const int base = (int)(uintptr_t)sl + vlo;
            f32x16 o[2]; o[0] = f32x16{}; o[1] = f32x16{};
            pv(o, base + 16384, qp2[0], qp2[1], qp2[2], qp2[3]);
            scale_rows(o, winter, wsf, r32, hi);
            f32x16 p0, p1; qkt(p0, p1, sl, qr, r32, hi);
            float rs = 0.f;
#pragma unroll
            for (int rr = 0; rr < 4; ++rr) { const f32x4 e0 = *(const f32x4*)(E + cc * 64 + 8 * rr + 4 * hi), e1 = *(const f32x4*)(E + cc * 64 + 32 + 8 * rr + 4 * hi);
#pragma unroll
                for (int e = 0; e < 4; ++e) { const int r = 4 * rr + e, s = 8 * rr + 4 * hi + e;
                    const float w0 = (s <= lrow) ? __expf(e0[e] - mm) : 0.f, w1 = (s + 32 <= lrow) ? __expf(e1[e] - mm) : 0.f;
                    p0[r] *= w0; p1[r] *= w1; rs += p0[r] + p1[r]; } }
            rs += __shfl_xor(rs, 32);
            pv(o, base + 8192, PACK8(p0, 0), PACK8(p0, 8), PACK8(p1, 0), PACK8(p1, 8));
            const float den = winter * nd + rs, dn = fmaxf(fabsf(den), __expf(-(bl + mm)));
            const float rinv = 1.0f / dn;
            if (hi == 0) wsf[32 + r32] = rinv;
            LGKM_WAIT0();
#pragma unroll
            for (int r = 0; r < 16; ++r) { const int orow = crow(r, hi); const float rl = wsf[32 + orow];
#pragma unroll
                for (int d0 = 0; d0 < 2; ++d0) stg[orow * 64 + d0 * 32 + r32] = (bf16_t)f2bf(o[d0][r] * rl); }
            LGKM_WAIT0();
#pragma unroll
            for (int i = 0; i < 4; ++i) {
                const int row = i * 8 + (lane >> 3), ch = lane & 7; const u32x4 v = *(const LAS u32x4*)(stg + row * 64 + ch * 8);
                float x[8]; float ss = 0.f;
#pragma unroll
                for (int j = 0; j < 4; ++j) { x[2 * j] = __builtin_bit_cast(float, v[j] << 16); x[2 * j + 1] = __builtin_bit_cast(float, v[j] & 0xffff0000u); ss += x[2 * j] * x[2 * j] + x[2 * j + 1] * x[2 * j + 1]; }
                ss += __shfl_xor(ss, 1); ss += __shfl_xor(ss, 2); ss += __shfl_xor(ss, 4);
                const float rn = rsqrtf(ss * (1.0f / 64.0f) + EPS);
                const size_t tok = rowbase + cc * 64 + 32 * half + row;
                const u32x4 og = *(const u32x4*)(C.Z + tok * ZP + 2304 + 64 * h + ch * 8);
                const f32x4 g0 = *(const f32x4*)(C.ml_norm + h * 64 + ch * 8), g1 = *(const f32x4*)(C.ml_norm + h * 64 + ch * 8 + 4);
                float y[8];
#pragma unroll
                for (int j = 0; j < 4; ++j) { const float o0 = __builtin_bit_cast(float, og[j] << 16), o1 = __builtin_bit_cast(float, og[j] & 0xffff0000u);
                    const float ga = j < 2 ? g0[2 * j] : g1[2 * j - 4], gb = j < 2 ? g0[2 * j + 1] : g1[2 * j - 3];
                    y[2 * j] = x[2 * j] * rn * ga * o0; y[2 * j + 1] = x[2 * j + 1] * rn * gb * o1; }
                u32x4 pk; pk.x = cvtpk(y[0], y[1]); pk.y = cvtpk(y[2], y[3]); pk.z = cvtpk(y[4], y[5]); pk.w = cvtpk(y[6], y[7]);
                *(u32x4*)(C.Y + tok * 1024 + 768 + 64 * h + ch * 8) = pk;
            }
            LGKM_WAIT0();
        }
        __syncthreads();
}
constexpr int MTOK = 16384, DMODEL = 1024, SEQL = 4096, DFF = 4096, NZT = 2816  , DEPTH = 2;
constexpr size_t MiB = 1u << 20;
constexpr size_t WS_CTL = 0, CTL_BYTES = 32768;
constexpr size_t WS_WIN = 2 * MiB, WIN_L = (size_t)NZT * DMODEL * 2;
constexpr size_t WS_WOUT = 13 * MiB, WOUT_L = (size_t)DMODEL * DMODEL * 2;
constexpr size_t WS_WFF1 = 17 * MiB, WFF_L = (size_t)DFF * DMODEL * 2;
constexpr size_t WS_WFF2 = 33 * MiB;
constexpr size_t WS_SSQ2 = 82 * MiB;
constexpr size_t WS_XG = 50 * MiB;
constexpr size_t WS_H = 84 * MiB;
constexpr size_t WS_Z = 84 * MiB, WS_Y = 164 * MiB;
constexpr size_t WS_KT = 196 * MiB, WS_VT = 204 * MiB;
constexpr size_t WS_SSQ = 212 * MiB, WS_ROPE = 214 * MiB, WS_G = 215 * MiB;
constexpr size_t WS_MLE = 216 * MiB, WS_MLB = WS_MLE + 262144, WS_MLPM = WS_MLB + 262144;
constexpr size_t WS_NL = 217 * MiB, WS_NP = WS_NL + 262144, WS_GC = WS_NP + 262144, WS_EM = WS_GC + 4096, WS_MP = WS_EM + 4096;
constexpr size_t WS_CL = 218 * MiB, WS_CP = 234 * MiB, WS_NFX = 242 * MiB, WS_RS = WS_NFX + 524288  , WS_END = 243 * MiB;
constexpr int LDS_BYTES = 147456;
constexpr int N_FOX = 256, N_SWA = 256, N_ML1 = 128, N_ML2 = 32, N_ML3 = 256, N_ML = N_ML1 + N_ML2 + N_ML3, N_FX0 = 16, N_ITEMS = N_FX0 + N_ML + N_FOX + N_SWA;

struct Params { const float* in[16]; float* out; unsigned char* ws; int ph_lo, ph_hi; };

__device__ __forceinline__ int win_src(int n) {
    const int pn = n >> 8, P = n & 255, L = 64 * ((P >> 5) & 3) + 32 * (P >> 7) + (P & 31), z = 256 * pn + L;
    if (z < 1536) return z;
    if (z < 2304) return z + 4;
    if (z < 2560) return z + 12;
    const int i = z - 2560;
    if (i < 4) return 1536 + i;
    if (i < 8) return 2308 + (i - 4);
    if (i < 12) return 2312 + (i - 8);
    return -1;
}
template <bool WIN>
__device__ __forceinline__ void tr_item(const float* W, const float* kgain, int K, int Nsrc, bf16_t* WT, int nblk, int item, LAS float* scr, int lane) {
    const int kb = item / nblk, nb = item % nblk, k0 = 64 * kb, n0 = 32 * nb;
    if (WIN && n0 >= 2560) {
        const int n = n0 + (lane & 31); const int src = win_src(n);
#pragma unroll 8
        for (int i = 0; i < 32; ++i) { const int kk = 2 * i + (lane >> 5); scr[kk * 33 + (lane & 31)] = src >= 0 ? W[(size_t)(k0 + kk) * Nsrc + src] * (kgain ? kgain[k0 + kk] : 1.f) : 0.f; }
    } else {
        const int n4 = (lane & 7) * 4; const int src = WIN ? win_src(n0 + n4) : n0 + n4;
        f32x4 v[8];
#pragma unroll
        for (int i = 0; i < 8; ++i) v[i] = *(const f32x4*)(W + (size_t)(k0 + 8 * i + (lane >> 3)) * Nsrc + src);
#pragma unroll
        for (int i = 0; i < 8; ++i) { const int kk = 8 * i + (lane >> 3); const float g = kgain ? kgain[k0 + kk] : 1.f; LAS float* d = scr + kk * 33 + n4;
            d[0] = v[i][0] * g; d[1] = v[i][1] * g; d[2] = v[i][2] * g; d[3] = v[i][3] * g; }
    }
    LGKM_WAIT0(); asm volatile("" ::: "memory");
    const int c = lane & 7;
#pragma unroll
    for (int j = 0; j < 4; ++j) { const int nn = (lane >> 3) + 8 * j; const LAS float* s = scr + (8 * c) * 33 + nn;
        u32x4 o; o.x = cvtpk(s[0 * 33], s[1 * 33]); o.y = cvtpk(s[2 * 33], s[3 * 33]); o.z = cvtpk(s[4 * 33], s[5 * 33]); o.w = cvtpk(s[6 * 33], s[7 * 33]);
        *(u32x4*)(WT + (size_t)(n0 + nn) * K + k0 + 8 * c) = o; }
    LGKM_WAIT0(); asm volatile("" ::: "memory");
}

#define RLX_AGENT __ATOMIC_RELAXED, __HIP_MEMORY_SCOPE_AGENT
#define XB_TMO      128
#define XB_XCNT(j)  (256  + 64 * (j))
#define XB_XSUB(j)  (1280 + 64 * (j))
#define XB_XGEN(j)  (2304 + 64 * (j))
#define XB_TOP      3328
#define XB_TOPGEN   3392
#define XCD_BAR_WORDS 3456
#define XB_SPIN_CAP (1u << 18)

__device__ __forceinline__ unsigned xb_ld(unsigned* p)              { return __hip_atomic_load(p, __ATOMIC_RELAXED, __HIP_MEMORY_SCOPE_AGENT); }
__device__ __forceinline__ unsigned xb_add(unsigned* p, unsigned v) { return __hip_atomic_fetch_add(p, v, __ATOMIC_RELAXED, __HIP_MEMORY_SCOPE_AGENT); }
__device__ __forceinline__ unsigned xb_xcc_id() { return (unsigned)__builtin_amdgcn_s_getreg((3 << 11) | 20) & 0xFu; }
#define XB_SPIN(cond, bar) do { unsigned _sp = 0; while (cond) { __builtin_amdgcn_s_sleep(1); \
    if ((++_sp & 255u) == 0u) { if (xb_ld(&(bar)[XB_TMO])) break; if (_sp > XB_SPIN_CAP) { atomicAdd(&(bar)[XB_TMO], 1u); break; } } } } while (0)

struct XcdBarrier {
    unsigned* bar; unsigned x;
    volatile LAS unsigned* st;
};

__device__ __forceinline__ XcdBarrier xcd_barrier_post(unsigned* bar, volatile LAS unsigned* st) {
    XcdBarrier b; b.bar = bar; b.x = xb_xcc_id(); b.st = st;
    if (threadIdx.x == 0) (void)xb_add(&bar[XB_XCNT(b.x)], 1u);
    return b;
}
__device__ __forceinline__ void xcd_barrier_complete(unsigned* bar, unsigned x, unsigned& nloc, unsigned& nx) {
    const unsigned G = gridDim.x * gridDim.y * gridDim.z;
    unsigned sum, cnt, mine, sp = 0u;
    for (;;) {
        sum = 0u; cnt = 0u; mine = 0u;
#pragma unroll
        for (unsigned j = 0; j < 16; ++j) { const unsigned c = xb_ld(&bar[XB_XCNT(j)]); sum += c; cnt += (c > 0u) ? 1u : 0u; mine = (j == x) ? c : mine; }
        if (sum == G) break;
        __builtin_amdgcn_s_sleep(1);
        if ((++sp & 255u) == 0u) { if (xb_ld(&bar[XB_TMO])) break; if (sp > XB_SPIN_CAP) { atomicAdd(&bar[XB_TMO], 1u); break; } }
    }
    nloc = mine > 0u ? mine : 1u; nx = cnt > 0u ? cnt : 1u;
}

__device__ __forceinline__ void xcd_barrier(const XcdBarrier& b) {
    asm volatile("s_waitcnt vmcnt(0)" ::: "memory");
    __syncthreads();
    if (threadIdx.x == 0) {
        unsigned* bar = b.bar;
        __builtin_amdgcn_s_waitcnt(0);
        unsigned nloc = b.st[0], nx = b.st[1];
        if (nloc == 0u) { xcd_barrier_complete(bar, b.x, nloc, nx); b.st[0] = nloc; b.st[1] = nx; }
        const unsigned old = xb_add(&bar[XB_XSUB(b.x)], 1u);
        const unsigned gen = old / nloc;
        if (old + 1u == (gen + 1u) * nloc) {
            __builtin_amdgcn_fence(__ATOMIC_RELEASE, "agent");
            asm volatile("s_waitcnt vmcnt(0)" ::: "memory");
            const unsigned og = xb_add(&bar[XB_TOP], 1u);
            const unsigned tg = og / nx;
            if (og + 1u == (tg + 1u) * nx) xb_add(&bar[XB_TOPGEN], 1u);
            else XB_SPIN(xb_ld(&bar[XB_TOPGEN]) == tg, bar);
            __builtin_amdgcn_fence(__ATOMIC_ACQUIRE, "agent");
            xb_add(&bar[XB_XGEN(b.x)], 1u);
            asm volatile("s_waitcnt vmcnt(0)" ::: "memory");
        } else {
            XB_SPIN(xb_ld(&bar[XB_XGEN(b.x)]) == gen, bar);
            __builtin_amdgcn_fence(__ATOMIC_ACQUIRE, "agent");
            asm volatile("s_waitcnt vmcnt(0)" ::: "memory");
        }
    }
    __syncthreads();
}

__global__ void __launch_bounds__(512, 2) fwd_megakernel(Params p) {
    extern __shared__ __attribute__((aligned(16))) unsigned char lds_raw[];
    LAS unsigned char* lds = (LAS unsigned char*)lds_raw;
    cg::grid_group grid = cg::this_grid();
    const int tid = threadIdx.x, lane = tid & 63, wave = __builtin_amdgcn_readfirstlane(tid >> 6);
    const int G = gridDim.x, bx = blockIdx.x;
    unsigned char* ws = p.ws;
    const float* x_in = p.in[0];
    bf16_t* XG = (bf16_t*)(ws + WS_XG); bf16_t* Zb = (bf16_t*)(ws + WS_Z); bf16_t* Yb = (bf16_t*)(ws + WS_Y); bf16_t* Hb = (bf16_t*)(ws + WS_H);
    float* SSQ = (float*)(ws + WS_SSQ); float* SSQ2 = (float*)(ws + WS_SSQ2); float* ROPEC = (float*)(ws + WS_ROPE); float* ROPES = ROPEC + SEQL * 32; float* Gt = (float*)(ws + WS_G);
    unsigned* ctl = (unsigned*)(ws + WS_CTL);
    const int lo = p.ph_lo, hi_ph = p.ph_hi;
    volatile LAS unsigned* bst = (volatile LAS unsigned*)(lds + 143360 + 16);
    if (tid < 2) bst[tid] = 0u;
    __syncthreads();
    XcdBarrier bar = xcd_barrier_post(ctl + 1024, bst);
    if (lo < 0) grid.sync();
#define IN_PH(k) (lo <= (k) && (k) < hi_ph)
#define SEAM(k) do { if (IN_PH(k) && IN_PH((k) + 1)) xcd_barrier(bar); } while (0)

    if (IN_PH(0)) {
        LAS float* scr = (LAS float*)(lds + wave * 16384);
        const int gw = bx * 8 + wave, NGW = G * 8;
        constexpr int I_IN = (DMODEL / 64) * (NZT / 32), I_OUT = (DMODEL / 64) * (DMODEL / 32), I_F1 = (DMODEL / 64) * (DFF / 32), I_F2 = (DFF / 64) * (DMODEL / 32);
        constexpr int I_LAYER = I_IN + I_OUT + I_F1 + I_F2;
        for (int it = gw; it < DEPTH * I_LAYER; it += NGW) {
            const int l = it / I_LAYER; int r = it % I_LAYER;
            if (r < I_IN) { tr_item<true>(p.in[2] + (size_t)l * DMODEL * 2572, p.in[1] + l * DMODEL, DMODEL, 2572, (bf16_t*)(ws + WS_WIN + l * WIN_L), NZT / 32, r, scr, lane); continue; } r -= I_IN;
            if (r < I_OUT) { tr_item<false>(p.in[12] + (size_t)l * DMODEL * DMODEL, nullptr, DMODEL, DMODEL, (bf16_t*)(ws + WS_WOUT + l * WOUT_L), DMODEL / 32, r, scr, lane); continue; } r -= I_OUT;
            if (r < I_F1) { tr_item<false>(p.in[14] + (size_t)l * DMODEL * DFF, p.in[13] + l * DMODEL, DMODEL, DFF, (bf16_t*)(ws + WS_WFF1 + l * WFF_L), DFF / 32, r, scr, lane); continue; } r -= I_F1;
            tr_item<false>(p.in[15] + (size_t)l * DFF * DMODEL, nullptr, DFF, DMODEL, (bf16_t*)(ws + WS_WFF2 + l * WFF_L), DMODEL / 32, r, scr, lane);
        }
        for (int i = bx * 512 + tid; i < SEQL * 32; i += G * 512) {
            const int pos = i >> 5, j = i & 31;
            double inv = 1.0; for (int q = 0; q < j; ++q) inv *= 0.7498942093324558;
            const float ang = (float)pos * (float)inv;
            double rev = (double)ang * 0.15915494309189535; rev -= __builtin_rint(rev);
            ROPEC[i] = __builtin_amdgcn_cosf((float)rev); ROPES[i] = __builtin_amdgcn_sinf((float)rev);
        }
        for (int m = gw; m < MTOK; m += 2 * NGW) {
            const int m2 = m + NGW;
            const bool has2 = m2 < MTOK;
            const f32x4* xr = (const f32x4*)(x_in + (size_t)m * DMODEL) + lane;
            const f32x4* xr2 = (const f32x4*)(x_in + (size_t)(has2 ? m2 : m) * DMODEL) + lane;
            f32x4 va[4], vb[4];
#pragma unroll
            for (int j = 0; j < 4; ++j) { va[j] = xr[64 * j]; vb[j] = xr2[64 * j]; }
#pragma unroll
            for (int rr = 0; rr < 2; ++rr) {
                if (rr == 1 && !has2) break;
                const int mm = rr == 0 ? m : m2;
                unsigned long long* o8 = (unsigned long long*)(XG + (size_t)mm * DMODEL) + lane;
#pragma unroll
                for (int j = 0; j < 4; ++j) {
                    const f32x4 v = rr == 0 ? va[j] : vb[j];
                    float s = (v[0] * v[0] + v[1] * v[1]) + (v[2] * v[2] + v[3] * v[3]);
                    s += __shfl_xor(s, 1); s += __shfl_xor(s, 2); s += __shfl_xor(s, 4);
                    if ((lane & 7) == 0) SSQ[(size_t)mm * 32 + 8 * j + (lane >> 3)] = s;
                    o8[64 * j] = (unsigned long long)cvtpk(v[0], v[1]) | ((unsigned long long)cvtpk(v[2], v[3]) << 32);
                }
            }
        }
    }
    SEAM(0);

    for (int l = 0; l < DEPTH; ++l) {
        const int pb = 1 + 5 * l;
        if (IN_PH(pb)) {
            pg8::Gemm g{XG, (const bf16_t*)(ws + WS_WIN + l * WIN_L), MTOK, NZT, DMODEL}; pg8::StaticOrder S; S.init(MTOK, NZT, G, bx);
            float* RS = (float*)(ws + WS_RS);
            { int t3_ = threadIdx.x; asm volatile("" : "+v"(t3_)); pg8::Unit ux; int lastpm = -1;
              for (int i = 0; S.next(i, ux); ++i) { if (ux.pm == lastpm) continue; lastpm = ux.pm;
                  if (t3_ < 256) { const f32x4* sp = (const f32x4*)(SSQ + (size_t)(ux.pm * 256 + t3_) * 32); f32x4 a = sp[0];
#pragma unroll
                      for (int j = 1; j < 8; ++j) a = a + sp[j];
                      RS[ux.pm * 256 + t3_] = rsqrtf(((a[0] + a[1]) + (a[2] + a[3])) * (1.0f / 1024.0f) + pg8::EPS); } }
              asm volatile("s_waitcnt vmcnt(0)" ::: "memory"); }
            __syncthreads();
            pg8::EpiIn E{Zb, Gt, RS, ROPEC, ROPES, p.in[3] + l * 64, p.in[4] + l * 64, p.in[6] + l * 64, p.in[7] + l * 64, ws + WS_KT, ws + WS_VT};
            pg8::gemm_phase<pg8::EpiIn, pg8::StaticOrder, true, true>(lds, g, S, E);
        }
        SEAM(pb);
        if (IN_PH(pb + 1)) {
            MixCtx C{Zb, Gt, Yb, p.in[5] + l * 8, p.in[8] + l * 4, p.in[9] + l * 4, p.in[10] + l * 4, p.in[11] + l * 256, ws, ws + WS_KT, ws + WS_VT};
            MlScratch MS{(float*)(ws + WS_MLE), (float*)(ws + WS_MLB), (float*)(ws + WS_MLPM), (float*)(ws + WS_CL), (float*)(ws + WS_NL), (bf16_t*)(ws + WS_CP), (float*)(ws + WS_NP), (float*)(ws + WS_GC), (float*)(ws + WS_EM), (float*)(ws + WS_MP), ctl + 128 + 32 * l, ctl + 192 + 32 * l};
            LAS int* itm = (LAS int*)(lds + 143360);
            float* NF = (float*)(ws + WS_NFX); unsigned* cntF = ctl + 512 + 32 * l; unsigned* qctr = ctl + 64 * l;
            for (;;) {
                __syncthreads();
                if (tid == 0) *itm = (int)atomicAdd(qctr, 1u);
                __syncthreads();
                const int it = *itm;
                if (it >= N_ITEMS) break;
                constexpr int Q_ML1 = N_FX0, Q_ML2 = Q_ML1 + N_ML1, Q_FOXA = Q_ML2 + N_ML2, N_FOXA = 256, Q_ML3 = Q_FOXA + N_FOXA, Q_FOXB = Q_ML3 + N_ML3, Q_SWA = Q_FOXB + (N_FOX - N_FOXA);
                static_assert(Q_SWA + N_SWA == N_ITEMS, "queue map");
                if (it < Q_ML1) fx0_item(C, NF, cntF, it, lds);
                else if (it < Q_ML2) { const int k = it - Q_ML1; ml1_item(C, MS, k >> 3, k & 7, lds); }
                else if (it < Q_FOXA) { const int k = it - Q_ML2; ml2_item(C, MS, k >> 1, k & 1, lds); }
                else if (it < Q_ML3) {
                    if (tid == 0) { const unsigned x = xb_xcc_id() & 7u; int sel = 0;
                        for (unsigned t = 0; t < 8u; ++t) { const unsigned q = (x + t) & 7u; const unsigned j = atomicAdd(ctl + 640 + 16 * l + q, 1u); if (j < 32u) { sel = (int)(q * 32u + j); break; } }
                        itm[1] = sel; }
                    __syncthreads();
                    const int k = itm[1];
                    fox_item(C, NF, cntF, k >> 4, k & 15, lds); }
                else if (it < Q_FOXB) { const int k = it - Q_ML3; ml3_item(C, MS, k >> 4, k & 15, lds); }
                else if (it < Q_SWA) { const int k = it - Q_FOXB + N_FOXA; fox_item(C, NF, cntF, k & 15, k >> 4, lds); }
                else swa_item(C, it - Q_SWA, lds);
            }
        }
        SEAM(pb + 1);
        if (IN_PH(pb + 2)) {
            pg8::Gemm g{Yb, (const bf16_t*)(ws + WS_WOUT + l * WOUT_L), MTOK, DMODEL, DMODEL}; pg8::StaticOrder S; S.init(MTOK, DMODEL, G, bx);
            pg8::EpiRes E{XG, SSQ2, nullptr, nullptr};
            pg8::gemm_phase<pg8::EpiRes, pg8::StaticOrder, true, true>(lds, g, S, E);
        }
        SEAM(pb + 2);
        if (IN_PH(pb + 3)) {
            pg8::Gemm g{XG, (const bf16_t*)(ws + WS_WFF1 + l * WFF_L), MTOK, DFF, DMODEL}; pg8::StaticOrder S; S.init(MTOK, DFF, G, bx);
            pg8::EpiFF1 E{Hb};
            pg8::gemm_phase<pg8::EpiFF1, pg8::StaticOrder, true, true>(lds, g, S, E);
        }
        SEAM(pb + 3);
        if (IN_PH(pb + 4)) {
            pg8::Gemm g{Hb, (const bf16_t*)(ws + WS_WFF2 + l * WFF_L), MTOK, DMODEL, DFF}; pg8::StaticOrder S; S.init(MTOK, DMODEL, G, bx);
            pg8::EpiRes E{XG, SSQ, l + 1 == DEPTH ? p.out : nullptr, SSQ2};
            pg8::gemm_phase<pg8::EpiRes, pg8::StaticOrder, true, true>(lds, g, S, E);
        }
        SEAM(pb + 4);
    }
#undef IN_PH
#undef SEAM
}

constexpr int N_PHASES = 1 + 5 * DEPTH;
#ifndef MK_MULTI
#define MK_MULTI 0
#endif
extern "C" void kernel_launch(void* const* d_in, const int* in_sizes, int n_in, void* d_out, int out_size, void* d_ws, size_t ws_size, hipStream_t stream) {
    static int grid = 0;
    if (grid == 0) {
        if (n_in != 16 || out_size != MTOK * DMODEL || ws_size < WS_END) { fprintf(stderr, "kernel_launch: unexpected shapes (n_in %d out %d ws %zu)\n", n_in, out_size, ws_size); grid = -1; return; }
        int dev = 0, cus = 0, per_cu = 0;
        hipGetDevice(&dev); hipDeviceGetAttribute(&cus, hipDeviceAttributeMultiprocessorCount, dev);
        if (hipFuncSetAttribute((const void*)fwd_megakernel, hipFuncAttributeMaxDynamicSharedMemorySize, LDS_BYTES) != hipSuccess) { fprintf(stderr, "kernel_launch: hipFuncSetAttribute failed\n"); grid = -1; return; }
        if (hipOccupancyMaxActiveBlocksPerMultiprocessor(&per_cu, (const void*)fwd_megakernel, 512, LDS_BYTES) != hipSuccess || per_cu < 1) { fprintf(stderr, "kernel_launch: occupancy query says %d\n", per_cu); per_cu = 1; }
        (void)hipGetLastError();
        grid = cus;
        if (grid != 256) fprintf(stderr, "kernel_launch: %d CUs (expected 256)\n", grid);
    }
    if (grid < 0) return;
    hipMemsetAsync((char*)d_ws + WS_CTL, 0, CTL_BYTES, stream);
    Params a{};
    for (int i = 0; i < 16; ++i) a.in[i] = (const float*)d_in[i];
    a.out = (float*)d_out; a.ws = (unsigned char*)d_ws;
#if MK_MULTI
    for (int ph = 0; ph < N_PHASES; ++ph) { a.ph_lo = ph; a.ph_hi = ph + 1; hipLaunchKernelGGL(fwd_megakernel, dim3(grid), dim3(512), LDS_BYTES, stream, a); }
#else
    a.ph_lo = 0; a.ph_hi = N_PHASES;
    void* args[] = {&a};
    hipError_t e = hipLaunchCooperativeKernel((const void*)fwd_megakernel, dim3(grid), dim3(512), args, LDS_BYTES, stream);
    if (e != hipSuccess) fprintf(stderr, "cooperative launch failed: %s (grid %d)\n", hipGetErrorString(e), grid);
#endif
}
```

```cpp
#include <hip/hip_runtime.h>
#include <hip/hip_cooperative_groups.h>
#include <cstdio>
#include <cstdint>
#include <cmath>
namespace cg = cooperative_groups;
namespace pg8 {
#define PG8_LAS __attribute__((address_space(3)))
typedef unsigned short bf16_t;
typedef short bf16x8 __attribute__((ext_vector_type(8)));
typedef float f32x4 __attribute__((ext_vector_type(4)));
typedef unsigned u32x4 __attribute__((ext_vector_type(4)));
constexpr int BM = 256, BK = 64, HALF = 128, HTB = HALF * BK * 2  , STAGE_BYTES = 8 * HTB, NXCD = 8;

__host__ __device__ __forceinline__ int lds_byte(int r, int c) { const int st = (r >> 4) * 2 + (c >> 5), rr = r & 15, cc = c & 31, ob = rr * 64 + cc * 2; return st * 1024 + (ob ^ (((ob >> 9) & 1) << 5)); }
__host__ __device__ __forceinline__ void stage_rc(int b, int& R, int& C) { const int st = b / 1024, sb = b % 1024, swz = sb ^ (((sb >> 9) & 1) << 5); R = (st >> 1) * 16 + swz / 64; C = (st & 1) * 32 + (swz % 64) / 2; }
__host__ __device__ __forceinline__ int perm32(int rho) { const int n = rho >> 4, i = rho & 15; return 8 * (i >> 2) + 4 * n + (i & 3); }

struct Unit { int pm, pn; };
struct Gemm { const bf16_t* A; const bf16_t* Bt; int M, N, K; };

struct StaticOrder {
    int nM, nN, nwg, G, c, WGM;
    __host__ __device__ void init(int M, int N, int G_, int c_, int wgm_ = 4) { nM = M / BM; nN = N / BM; nwg = nM * nN; G = G_; c = c_; WGM = wgm_; }
    __host__ __device__ bool next(int i, Unit& u) const {
        const long L = (long)i * G + c; if (L >= nwg) return false;
        int wgid = (int)L; { const int q = nwg / NXCD, r = nwg % NXCD, xcd = wgid % NXCD, off = wgid / NXCD; wgid = (xcd < r ? xcd * (q + 1) : r * (q + 1) + (xcd - r) * q) + off; }
        const int nig = WGM * nN, gid = wgid / nig, fm = gid * WGM, gsz = (nM - fm) < WGM ? (nM - fm) : WGM;
        u.pm = fm + ((wgid % nig) % gsz); u.pn = (wgid % nig) / gsz; return true;
    }
    __device__ __forceinline__ void a_ready(const Unit&) const {}
    __device__ __forceinline__ void done(const Unit&) const {}
};

__device__ __forceinline__ unsigned cvt_pk_bf16(float lo, float hi) { unsigned r; asm volatile("v_cvt_pk_bf16_f32 %0, %1, %2" : "=v"(r) : "v"(lo), "v"(hi)); return r; }
constexpr float EPS = 1e-6f;
constexpr float LOG2E = 1.4426950408889634f;
constexpr float C2 = 0.125f * LOG2E;
constexpr int ZP = 2560;

__device__ __forceinline__ float row_rstd(const float* ssq, int row, int fq) {
    const float* sp = ssq + (size_t)row * 32 + fq * 8;
    const f32x4 s0 = *(const f32x4*)sp, s1 = *(const f32x4*)(sp + 4);
    float t = ((s0[0] + s0[1]) + (s0[2] + s0[3])) + ((s1[0] + s1[1]) + (s1[2] + s1[3]));
    t += __shfl_xor(t, 16); t += __shfl_xor(t, 32);
    return rsqrtf(t * (1.0f / 1024.0f) + EPS);
}

struct EpiIn {
    static constexpr bool PERM = true, AFTER_DRAIN = false;
    bf16_t* Z; float* G; const float* ssq; const float* ropec; const float* ropes; const float* gqa; const float* gka; const float* gqb; const float* gkb;
    unsigned char* KT; unsigned char* VT;
    __device__ __forceinline__ void operator()(const f32x4 (&acc)[2][2][4][2], const Unit& u, int wr, int wc, int fr, int fq) const {
        const int pn = u.pn;
        int type = 0; const float* gsel = gqa; bool rp = false; float sc = 1.f;
        if (pn < 2) { type = 1; gsel = gqa; rp = true; sc = C2; }
        else if (pn == 2) { if (wc < 2) { type = 1; gsel = gka; rp = true; } }
        else if (pn == 3) { type = 1; gsel = gqb; sc = C2; }
        else if (pn == 4) { type = 1; gsel = gkb; }
        else if (pn == 7) { sc = 0.125f; }
        else if (pn == 9) { type = 2; }
        else if (pn == 10) { type = 3; }
        if (type == 3 && wc != 0) return;
        const int dcol = 8 * fq;
        unsigned char* tp = nullptr;
        if (pn == 4 || pn == 5) { const size_t tb0 = (size_t)((((u.pm * BM) >> 12) * 4 + wc) * 64 + (((u.pm * BM) & 4095) >> 6) + wr) * 8192;
            tp = pn == 4 ? KT + tb0 + fq * 1024 + fr * 16 : VT + tb0 + (fr * 4 + fq) * 16; }
        float gn[2][8];
#pragma unroll
        for (int bj = 0; bj < 2; ++bj)
#pragma unroll
            for (int i = 0; i < 8; ++i) gn[bj][i] = (type == 1) ? gsel[32 * bj + dcol + i] : 1.f;
#pragma unroll
        for (int ai = 0; ai < 2; ++ai)
#pragma unroll
            for (int m = 0; m < 4; ++m) {
                const int row = u.pm * BM + ai * HALF + wr * 64 + m * 16 + fr;
                const float rstd = ssq[row];
                float v[2][8];
#pragma unroll
                for (int bj = 0; bj < 2; ++bj)
#pragma unroll
                    for (int n = 0; n < 2; ++n)
#pragma unroll
                        for (int e = 0; e < 4; ++e) v[bj][4 * n + e] = acc[ai][bj][m][n][e] * rstd;
                if (type == 1) {
                    float ss = 0.f;
#pragma unroll
                    for (int bj = 0; bj < 2; ++bj)
#pragma unroll
                        for (int i = 0; i < 8; ++i) ss += v[bj][i] * v[bj][i];
                    ss += __shfl_xor(ss, 16); ss += __shfl_xor(ss, 32);
                    const float hr = rsqrtf(ss * (1.0f / 64.0f) + EPS);
#pragma unroll
                    for (int bj = 0; bj < 2; ++bj)
#pragma unroll
                        for (int i = 0; i < 8; ++i) v[bj][i] *= hr * gn[bj][i];
                    if (rp) {
                        const int pos = row & 4095;
                        const f32x4 c0 = *(const f32x4*)(ropec + pos * 32 + dcol), c1 = *(const f32x4*)(ropec + pos * 32 + dcol + 4);
                        const f32x4 s0 = *(const f32x4*)(ropes + pos * 32 + dcol), s1 = *(const f32x4*)(ropes + pos * 32 + dcol + 4);
#pragma unroll
                        for (int i = 0; i < 8; ++i) {
                            const float c = i < 4 ? c0[i & 3] : c1[i & 3], s = i < 4 ? s0[i & 3] : s1[i & 3];
                            const float x1 = v[0][i], x2 = v[1][i];
                            v[0][i] = x1 * c - x2 * s; v[1][i] = x2 * c + x1 * s;
                        }
                    }
#pragma unroll
                    for (int bj = 0; bj < 2; ++bj)
#pragma unroll
                        for (int i = 0; i < 8; ++i) v[bj][i] *= sc;
                } else if (type == 2) {
#pragma unroll
                    for (int bj = 0; bj < 2; ++bj)
#pragma unroll
                        for (int i = 0; i < 8; ++i) v[bj][i] = 1.0f / (1.0f + __expf(-v[bj][i]));
                } else if (type == 0) {
#pragma unroll
                    for (int bj = 0; bj < 2; ++bj)
#pragma unroll
                        for (int i = 0; i < 8; ++i) v[bj][i] *= sc;
                }
                if (type == 3) {
                    float* gp = G + (size_t)row * 16;
                    if (fq == 0) { *(f32x4*)gp = (f32x4){v[0][0], v[0][1], v[0][2], v[0][3]}; *(f32x4*)(gp + 4) = (f32x4){v[0][4], v[0][5], v[0][6], v[0][7]}; }
                    else if (fq == 1) { *(f32x4*)(gp + 8) = (f32x4){v[0][0], v[0][1], v[0][2], v[0][3]}; }
                } else {
#pragma unroll
                    for (int bj = 0; bj < 2; ++bj) {
                        u32x4 w; w.x = cvt_pk_bf16(v[bj][0], v[bj][1]); w.y = cvt_pk_bf16(v[bj][2], v[bj][3]); w.z = cvt_pk_bf16(v[bj][4], v[bj][5]); w.w = cvt_pk_bf16(v[bj][6], v[bj][7]);
                        if (pn == 4) *(u32x4*)(tp + ai * 16384 + bj * 4096 + m * 256) = w;
                        else if (pn == 5) *(u32x4*)(tp + ai * 16384 + bj * 4096 + m * 1024) = w;
                        else
                        *(u32x4*)(Z + (size_t)row * ZP + 256 * pn + 64 * wc + 32 * bj + dcol) = w;
                    }
                }
                if (m & 1) asm volatile("" ::: "memory");
            }
    }
};

struct EpiRes {
    static constexpr bool PERM = true, AFTER_DRAIN = false;
    bf16_t* XB; float* ssq; float* out; const float* rsq;
    __device__ __forceinline__ void operator()(const f32x4 (&acc)[2][2][4][2], const Unit& u, int wr, int wc, int fr, int fq) const {
        float r2[8];
#pragma unroll
        for (int j = 0; j < 8; ++j) r2[j] = 1.f;
        if (rsq) {
#pragma unroll
            for (int j = 0; j < 8; ++j) { const float r = row_rstd(rsq, u.pm * BM + (j >> 2) * HALF + wr * 64 + (j & 3) * 16 + fr, fq); r2[j] = r * r; }
        }
#pragma unroll
        for (int bj = 0; bj < 2; ++bj) {
            const int col0 = u.pn * BM + bj * HALF + wc * 32 + 8 * fq;
#pragma unroll
            for (int ai = 0; ai < 2; ++ai)
#pragma unroll
                for (int m = 0; m < 4; ++m) {
                    const int row = u.pm * BM + ai * HALF + wr * 64 + m * 16 + fr;
                    const size_t off = (size_t)row * 1024 + col0;
                    const u32x4 bw = *(const u32x4*)(XB + off);
                    f32x4 x0 = acc[ai][bj][m][0] * r2[ai * 4 + m], x1 = acc[ai][bj][m][1] * r2[ai * 4 + m];
                    x0[0] += __builtin_bit_cast(float, bw.x << 16); x0[1] += __builtin_bit_cast(float, bw.x & 0xffff0000u);
                    x0[2] += __builtin_bit_cast(float, bw.y << 16); x0[3] += __builtin_bit_cast(float, bw.y & 0xffff0000u);
                    x1[0] += __builtin_bit_cast(float, bw.z << 16); x1[1] += __builtin_bit_cast(float, bw.z & 0xffff0000u);
                    x1[2] += __builtin_bit_cast(float, bw.w << 16); x1[3] += __builtin_bit_cast(float, bw.w & 0xffff0000u);
                    if (out) { *(f32x4*)(out + off) = x0; *(f32x4*)(out + off + 4) = x1; }
                    else {
                        float ss = ((x0[0] * x0[0] + x0[1] * x0[1]) + (x0[2] * x0[2] + x0[3] * x0[3])) + ((x1[0] * x1[0] + x1[1] * x1[1]) + (x1[2] * x1[2] + x1[3] * x1[3]));
                        ss += __shfl_xor(ss, 16); ss += __shfl_xor(ss, 32);
                        if (fq == 0) ssq[(size_t)row * 32 + u.pn * 8 + bj * 4 + wc] = ss;
                        u32x4 w; w.x = cvt_pk_bf16(x0[0], x0[1]); w.y = cvt_pk_bf16(x0[2], x0[3]); w.z = cvt_pk_bf16(x1[0], x1[1]); w.w = cvt_pk_bf16(x1[2], x1[3]);
                        *(u32x4*)(XB + off) = w;
                    }
                }
        }
    }
};

struct EpiFF1 {
    static constexpr bool PERM = true, AFTER_DRAIN = false;
    bf16_t* H;
    __device__ __forceinline__ void operator()(const f32x4 (&acc)[2][2][4][2], const Unit& u, int wr, int wc, int fr, int fq) const {
#pragma unroll
        for (int ai = 0; ai < 2; ++ai)
#pragma unroll
            for (int m = 0; m < 4; ++m) {
                const int row = u.pm * BM + ai * HALF + wr * 64 + m * 16 + fr;
#pragma unroll
                for (int bj = 0; bj < 2; ++bj) {
                    const int col0 = u.pn * BM + bj * HALF + wc * 32 + 8 * fq;
                    f32x4 a = acc[ai][bj][m][0], b = acc[ai][bj][m][1];
#pragma unroll
                    for (int e = 0; e < 4; ++e) { a[e] = fmaxf(a[e], 0.f); a[e] *= a[e]; b[e] = fmaxf(b[e], 0.f); b[e] *= b[e]; }
                    u32x4 w; w.x = cvt_pk_bf16(a[0], a[1]); w.y = cvt_pk_bf16(a[2], a[3]); w.z = cvt_pk_bf16(b[0], b[1]); w.w = cvt_pk_bf16(b[2], b[3]);
                    *(u32x4*)(H + (size_t)row * 4096 + col0) = w;
                }
            }
    }
};

template <class Epi, class Sched, bool ALIGN_EPI = false, bool SP2 = false>
__device__ __forceinline__ void gemm_phase(PG8_LAS unsigned char* lds, const Gemm g, const Sched& S, const Epi& E) {
    int tid_ = threadIdx.x; asm volatile("" : "+v"(tid_));
    const int tid = tid_, wid = __builtin_amdgcn_readfirstlane(tid >> 6), lane = tid & 63, wr = wid >> 2, wc = wid & 3, fr = lane & 15, fq = lane >> 4;
    const int K = g.K, nt = K / BK;
    unsigned voffA[2], voffB[2];
#pragma unroll
    for (int i = 0; i < 2; ++i) { int R, C; stage_rc(tid * 16 + i * 8192, R, C); const int Rb = Epi::PERM ? ((R & ~31) + perm32(R & 31)) : R;
        voffA[i] = (unsigned)(R * K + C) * 2u; voffB[i] = (unsigned)(Rb * K + C) * 2u; }
    const size_t kstep = (size_t)(BK * 2);
    const size_t hstep = (size_t)HALF * K * 2;
    const size_t tstep = 2 * hstep;
    const unsigned ldsw = (unsigned)wid * 1024u;
    const int aoff = lds_byte(wr * 64 + fr, fq * 8), boff = lds_byte(wc * 32 + fr, fq * 8);
#define PG8_SA(b, h) (((b) * 2 + (h)) * HTB)
#define PG8_SB(b, h) ((4 + (b) * 2 + (h)) * HTB)
#define PG8_STAGE(bufoff, gbase, voff) do { _Pragma("unroll") for (int _i = 0; _i < 2; ++_i) \
        __builtin_amdgcn_global_load_lds((const unsigned*)((const char*)(gbase) + (voff)[_i]), (PG8_LAS unsigned*)(lds + (bufoff) + ldsw + _i * 8192), 16, 0, 0); } while (0)
#define PG8_LDA(dst, b, h) do { _Pragma("unroll") for (int m = 0; m < 4; ++m) _Pragma("unroll") for (int k = 0; k < 2; ++k) dst[m][k] = *(const PG8_LAS bf16x8*)(lds + PG8_SA(b, h) + aoff + m * 2048 + k * 1024); } while (0)
#define PG8_LDB(dst, b, h) do { _Pragma("unroll") for (int n = 0; n < 2; ++n) _Pragma("unroll") for (int k = 0; k < 2; ++k) dst[n][k] = *(const PG8_LAS bf16x8*)(lds + PG8_SB(b, h) + boff + n * 2048 + k * 1024); } while (0)
#define PG8_MMA(ai, bj, At, Bt) do { __builtin_amdgcn_s_setprio(1); _Pragma("unroll") for (int m = 0; m < 4; ++m) _Pragma("unroll") for (int n = 0; n < 2; ++n) _Pragma("unroll") for (int k = 0; k < 2; ++k) \
        acc[ai][bj][m][n] = __builtin_amdgcn_mfma_f32_16x16x32_bf16(Bt[n][k], At[m][k], acc[ai][bj][m][n], 0, 0, 0); __builtin_amdgcn_s_setprio(0); } while (0)
#define PG8_WAIT_V(n) asm volatile("s_waitcnt vmcnt(" #n ")" ::: "memory")
#define PG8_WAIT_L(n) asm volatile("s_waitcnt lgkmcnt(" #n ")" ::: "memory")
#define PG8_BAR __builtin_amdgcn_s_barrier()
#define PG8_SCHED __builtin_amdgcn_sched_barrier(0)
    Unit cur, nxt; int ui = 0;
    if (!S.next(0, cur)) return;
    f32x4 acc[2][2][4][2];
#pragma unroll
    for (int a = 0; a < 2; ++a)
#pragma unroll
        for (int b = 0; b < 2; ++b)
#pragma unroll
            for (int m = 0; m < 4; ++m)
#pragma unroll
                for (int n = 0; n < 2; ++n) acc[a][b][m][n] = (f32x4){0.f, 0.f, 0.f, 0.f};
    bf16x8 At[4][2], B0[2][2], B1[2][2];
    const char* cA = (const char*)g.A + (size_t)cur.pm * tstep; const char* cB = (const char*)g.Bt + (size_t)cur.pn * tstep;
    S.a_ready(cur);
    if constexpr (SP2) {
        PG8_STAGE(PG8_SB(0, 0), cB, voffB); PG8_STAGE(PG8_SB(0, 1), cB + hstep, voffB); PG8_STAGE(PG8_SA(0, 0), cA, voffA); PG8_STAGE(PG8_SA(0, 1), cA + hstep, voffA);
        if (wr == 1) PG8_BAR;
        PG8_WAIT_V(2); PG8_BAR;
        PG8_STAGE(PG8_SB(1, 0), cB + kstep, voffB); PG8_STAGE(PG8_SA(1, 0), cA + kstep, voffA); PG8_STAGE(PG8_SB(1, 1), cB + hstep + kstep, voffB);
        PG8_WAIT_V(6); PG8_BAR;
    } else {
        PG8_STAGE(PG8_SB(0, 0), cB, voffB); PG8_STAGE(PG8_SA(0, 0), cA, voffA); PG8_STAGE(PG8_SB(0, 1), cB + hstep, voffB); PG8_STAGE(PG8_SA(0, 1), cA + hstep, voffA);
        if (wr == 1) PG8_BAR;
        PG8_WAIT_V(4); PG8_BAR;
        PG8_STAGE(PG8_SB(1, 0), cB + kstep, voffB); PG8_STAGE(PG8_SA(1, 0), cA + kstep, voffA); PG8_STAGE(PG8_SB(1, 1), cB + hstep + kstep, voffB);
        PG8_WAIT_V(6); PG8_BAR;
    }
    for (;;) {
        const bool has_next = S.next(ui + 1, nxt);
        const char* nA = has_next ? (const char*)g.A + (size_t)nxt.pm * tstep : cA; const char* nB = has_next ? (const char*)g.Bt + (size_t)nxt.pn * tstep : cB;
        for (int t = 0; t < nt; t += 2) {
            const bool last = (t == nt - 2);
            const char* a1 = cA + (size_t)(t + 1) * kstep;
            const char* a2 = last ? nA : cA + (size_t)(t + 2) * kstep; const char* b2 = last ? nB : cB + (size_t)(t + 2) * kstep;
            const char* a3 = a2 + kstep; const char* b3 = b2 + kstep;
            if (last && has_next) S.a_ready(nxt);
            if constexpr (SP2) {
            PG8_LDB(B0, 0, 0); PG8_LDB(B1, 0, 1); PG8_SCHED; PG8_LDA(At, 0, 0); PG8_STAGE(PG8_SA(1, 1), a1 + hstep, voffA);
            PG8_WAIT_V(8); PG8_WAIT_L(0); PG8_BAR; PG8_MMA(0, 0, At, B0); PG8_MMA(0, 1, At, B1); PG8_BAR; PG8_SCHED;
            PG8_LDA(At, 0, 1); PG8_STAGE(PG8_SB(0, 0), b2, voffB); PG8_STAGE(PG8_SB(0, 1), b2 + hstep, voffB); PG8_STAGE(PG8_SA(0, 0), a2, voffA);
            PG8_WAIT_V(8); PG8_WAIT_L(0); PG8_BAR; PG8_MMA(1, 0, At, B0); PG8_MMA(1, 1, At, B1); PG8_BAR; PG8_SCHED;
            PG8_LDB(B0, 1, 0); PG8_LDB(B1, 1, 1); PG8_SCHED; PG8_LDA(At, 1, 0); PG8_STAGE(PG8_SA(0, 1), a2 + hstep, voffA);
            PG8_WAIT_V(8); PG8_WAIT_L(0); PG8_BAR; PG8_MMA(0, 0, At, B0); PG8_MMA(0, 1, At, B1); PG8_BAR; PG8_SCHED;
            PG8_LDA(At, 1, 1); PG8_STAGE(PG8_SB(1, 0), b3, voffB); PG8_STAGE(PG8_SB(1, 1), b3 + hstep, voffB); PG8_STAGE(PG8_SA(1, 0), a3, voffA);
            PG8_WAIT_V(8); PG8_WAIT_L(0); PG8_BAR; PG8_MMA(1, 0, At, B0); PG8_MMA(1, 1, At, B1); PG8_BAR; PG8_SCHED;
            } else {
            PG8_LDB(B0, 0, 0); PG8_SCHED; PG8_LDA(At, 0, 0); PG8_STAGE(PG8_SA(1, 1), a1 + hstep, voffA);
            PG8_WAIT_L(8); PG8_BAR; PG8_WAIT_L(0); PG8_MMA(0, 0, At, B0); PG8_BAR; PG8_SCHED;
            PG8_LDB(B1, 0, 1); PG8_STAGE(PG8_SB(0, 0), b2, voffB);
            PG8_BAR; PG8_WAIT_L(0); PG8_MMA(0, 1, At, B1); PG8_BAR;
            PG8_LDA(At, 0, 1); PG8_STAGE(PG8_SA(0, 0), a2, voffA);
            PG8_BAR; PG8_WAIT_L(0); PG8_MMA(1, 0, At, B0); PG8_BAR; PG8_SCHED;
            PG8_STAGE(PG8_SB(0, 1), b2 + hstep, voffB);
            PG8_WAIT_V(6); PG8_BAR; PG8_MMA(1, 1, At, B1); PG8_BAR;
            PG8_LDB(B0, 1, 0); PG8_SCHED; PG8_LDA(At, 1, 0); PG8_STAGE(PG8_SA(0, 1), a2 + hstep, voffA);
            PG8_WAIT_L(8); PG8_BAR; PG8_WAIT_L(0); PG8_MMA(0, 0, At, B0); PG8_BAR; PG8_SCHED;
            PG8_LDB(B1, 1, 1); PG8_STAGE(PG8_SB(1, 0), b3, voffB);
            PG8_BAR; PG8_WAIT_L(0); PG8_MMA(0, 1, At, B1); PG8_BAR;
            PG8_LDA(At, 1, 1); PG8_STAGE(PG8_SA(1, 0), a3, voffA);
            PG8_BAR; PG8_WAIT_L(0); PG8_MMA(1, 0, At, B0); PG8_BAR; PG8_SCHED;
            PG8_STAGE(PG8_SB(1, 1), b3 + hstep, voffB);
            PG8_WAIT_V(6); PG8_BAR; PG8_MMA(1, 1, At, B1); PG8_BAR;
            }
        }
        if constexpr (ALIGN_EPI) { if (wr == 0) PG8_BAR; }
        if constexpr (!Epi::AFTER_DRAIN) { E(acc, cur, wr, wc, fr, fq); S.done(cur); }
        if (!has_next) break;
#pragma unroll
        for (int a = 0; a < 2; ++a)
#pragma unroll
            for (int b = 0; b < 2; ++b)
#pragma unroll
                for (int m = 0; m < 4; ++m)
#pragma unroll
                    for (int n = 0; n < 2; ++n) acc[a][b][m][n] = (f32x4){0.f, 0.f, 0.f, 0.f};
        cur = nxt; cA = nA; cB = nB; ++ui;
        if constexpr (ALIGN_EPI) { if (wr == 1) PG8_BAR; }
    }
    PG8_WAIT_V(0);
    if constexpr (!ALIGN_EPI) { if (wr == 0) PG8_BAR; }
    PG8_BAR;
    if constexpr (Epi::AFTER_DRAIN) { E.fused(acc, cur, wr, wc, fr, fq, lds, wid, lane); S.done(cur); }
#undef PG8_SA
#undef PG8_SB
#undef PG8_STAGE
#undef PG8_LDA
#undef PG8_LDB
#undef PG8_MMA
#undef PG8_WAIT_V
#undef PG8_WAIT_L
#undef PG8_BAR
#undef PG8_SCHED
}
}
#define LAS __attribute__((address_space(3)))
typedef unsigned short bf16_t;
typedef short bf16x8 __attribute__((ext_vector_type(8)));
typedef short s16x4 __attribute__((ext_vector_type(4)));
typedef float f32x4 __attribute__((ext_vector_type(4)));
typedef float f32x16 __attribute__((ext_vector_type(16)));
typedef unsigned u32x4 __attribute__((ext_vector_type(4)));
typedef unsigned u32x2 __attribute__((ext_vector_type(2)));
using pg8::ZP; using pg8::LOG2E; using pg8::EPS;
__device__ __forceinline__ int crow(int r, int hi) { return (r & 3) + 8 * (r >> 2) + 4 * hi; }
__device__ __forceinline__ unsigned cvtpk(float lo, float hi) { unsigned r; asm volatile("v_cvt_pk_bf16_f32 %0, %1, %2" : "=v"(r) : "v"(lo), "v"(hi)); return r; }
__device__ __forceinline__ unsigned f2bf(float f) { unsigned u = __builtin_bit_cast(unsigned, f); return (u + 0x7fffu + ((u >> 16) & 1u)) >> 16; }
__device__ __forceinline__ float bf2f(unsigned short h) { return __builtin_bit_cast(float, (unsigned)h << 16); }
__device__ __forceinline__ float ex2(float x) { return __builtin_amdgcn_exp2f(x); }
#define VM_WAIT0() asm volatile("s_waitcnt vmcnt(0)" ::: "memory")
#define LGKM_WAIT0() asm volatile("s_waitcnt lgkmcnt(0)" ::: "memory")

__device__ __forceinline__ void dma_k(LAS unsigned char* slot, const bf16_t* src, int pitch, int w, int lane) {
    const bf16_t* s = src + (size_t)lane * pitch + w * 8;
    __builtin_amdgcn_global_load_lds((const unsigned*)s, (LAS unsigned*)(slot + w * 1024), 16, 0, 0);
}
__device__ __forceinline__ void dma_v(LAS unsigned char* slot, const bf16_t* src, int pitch, int w, int lane) {
    const bf16_t* s = src + (size_t)(16 * (w & 3) + (lane >> 2)) * pitch + (w >> 2) * 32 + (lane & 3) * 8;
    __builtin_amdgcn_global_load_lds((const unsigned*)s, (LAS unsigned*)(slot + w * 1024), 16, 0, 0);
}
__device__ __forceinline__ void dma_lin(LAS unsigned char* slot, const unsigned char* src, int w, int lane) {
    __builtin_amdgcn_global_load_lds((const unsigned*)(src + w * 1024 + lane * 16), (LAS unsigned*)(slot + w * 1024), 16, 0, 0);
}
__device__ __forceinline__ void qkt(f32x16& p0, f32x16& p1, const LAS unsigned char* Kslot, const bf16x8* qr, int r32, int hi, f32x16 z0 = f32x16{}, f32x16 z1 = f32x16{}) {
    const LAS unsigned char* kb = Kslot + hi * 1024 + r32 * 16;
#pragma unroll
    for (int d0 = 0; d0 < 4; ++d0) {
        const bf16x8 b0 = *(const LAS bf16x8*)(kb + d0 * 2048);
        const bf16x8 b1 = *(const LAS bf16x8*)(kb + d0 * 2048 + 512);
        z0 = __builtin_amdgcn_mfma_f32_32x32x16_bf16(b0, qr[d0], z0, 0, 0, 0);
        z1 = __builtin_amdgcn_mfma_f32_32x32x16_bf16(b1, qr[d0], z1, 0, 0, 0);
    }
    p0 = z0; p1 = z1;
}
__device__ __forceinline__ int vt_lane_off(int lane) { const int hi = lane >> 5; return ((lane >> 4) & 1) * 32 + (lane & 3) * 8 + (4 * hi + ((lane & 15) >> 2)) * 64; }
__device__ __forceinline__ bf16x8 vfrag(int vb, int d0, int ks) {
    s16x4 lo, hh;
    asm volatile("ds_read_b64_tr_b16 %0, %1" : "=v"(lo) : "v"(vb + d0 * 4096 + ks * 1024) : "memory");
    asm volatile("ds_read_b64_tr_b16 %0, %1" : "=v"(hh) : "v"(vb + d0 * 4096 + ks * 1024 + 512) : "memory");
    asm volatile("s_waitcnt lgkmcnt(0)" : "+v"(lo), "+v"(hh) :: "memory");
    return (bf16x8){lo[0], lo[1], lo[2], lo[3], hh[0], hh[1], hh[2], hh[3]};
}
__device__ __forceinline__ void pv(f32x16* o, int vb, bf16x8 pa0, bf16x8 pa1, bf16x8 pa2, bf16x8 pa3) {
    s16x4 lo[8], hh[8];
#pragma unroll
    for (int i = 0; i < 8; ++i) {
        asm volatile("ds_read_b64_tr_b16 %0, %1 offset:%c2" : "=&v"(lo[i]) : "v"(vb), "i"((i >> 2) * 4096 + (i & 3) * 1024) : "memory");
        asm volatile("ds_read_b64_tr_b16 %0, %1 offset:%c2" : "=&v"(hh[i]) : "v"(vb), "i"((i >> 2) * 4096 + (i & 3) * 1024 + 512) : "memory");
    }
    asm volatile("s_waitcnt lgkmcnt(0)" : "+v"(lo[0]), "+v"(lo[1]), "+v"(lo[2]), "+v"(lo[3]), "+v"(lo[4]), "+v"(lo[5]), "+v"(lo[6]), "+v"(lo[7]),
                 "+v"(hh[0]), "+v"(hh[1]), "+v"(hh[2]), "+v"(hh[3]), "+v"(hh[4]), "+v"(hh[5]), "+v"(hh[6]), "+v"(hh[7]) :: "memory");
#define PVK(k) (bf16x8){lo[k][0], lo[k][1], lo[k][2], lo[k][3], hh[k][0], hh[k][1], hh[k][2], hh[k][3]}
    o[0] = __builtin_amdgcn_mfma_f32_32x32x16_bf16(pa0, PVK(0), o[0], 0, 0, 0);
    o[1] = __builtin_amdgcn_mfma_f32_32x32x16_bf16(pa0, PVK(4), o[1], 0, 0, 0);
    o[0] = __builtin_amdgcn_mfma_f32_32x32x16_bf16(pa1, PVK(1), o[0], 0, 0, 0);
    o[1] = __builtin_amdgcn_mfma_f32_32x32x16_bf16(pa1, PVK(5), o[1], 0, 0, 0);
    o[0] = __builtin_amdgcn_mfma_f32_32x32x16_bf16(pa2, PVK(2), o[0], 0, 0, 0);
    o[1] = __builtin_amdgcn_mfma_f32_32x32x16_bf16(pa2, PVK(6), o[1], 0, 0, 0);
    o[0] = __builtin_amdgcn_mfma_f32_32x32x16_bf16(pa3, PVK(3), o[0], 0, 0, 0);
    o[1] = __builtin_amdgcn_mfma_f32_32x32x16_bf16(pa3, PVK(7), o[1], 0, 0, 0);
#undef PVK
}
#define PACK8(P, B) __builtin_bit_cast(bf16x8, ((u32x4){cvtpk(P[B], P[B + 1]), cvtpk(P[B + 2], P[B + 3]), cvtpk(P[B + 4], P[B + 5]), cvtpk(P[B + 6], P[B + 7])}))
__device__ __forceinline__ void scale_rows(f32x16* o, float f, LAS float* wsf, int r32, int hi) {
    if (hi == 0) wsf[r32] = f;
    LGKM_WAIT0();
#pragma unroll
    for (int r = 0; r < 16; ++r) { const float fr = wsf[crow(r, hi)]; o[0][r] *= fr; o[1][r] *= fr; }
    LGKM_WAIT0();
}
__device__ __forceinline__ float max3f(float x, float y, float z) { return __builtin_fmaxf(__builtin_fmaxf(x, y), z); }
typedef float f32x8 __attribute__((ext_vector_type(8)));
typedef float f32x2 __attribute__((ext_vector_type(2)));
typedef short v4i16_t __attribute__((ext_vector_type(4)));
__device__ __forceinline__ s16x4 vtr(const LAS unsigned char* p) { return __builtin_bit_cast(s16x4, __builtin_amdgcn_ds_read_tr16_b64_v4i16((LAS v4i16_t*)p)); }
__device__ __forceinline__ float rowmax32(const f32x16& p0, const f32x16& p1) {
    float a = max3f(p0[0], p0[1], p1[0]), b = max3f(p0[2], p0[3], p1[1]); a = max3f(a, p1[2], p1[3]);
#pragma unroll
    for (int r = 4; r < 16; r += 4) { a = max3f(a, p0[r], p0[r + 1]); b = max3f(b, p0[r + 2], p0[r + 3]); a = max3f(a, p1[r], p1[r + 1]); b = max3f(b, p1[r + 2], p1[r + 3]); }
    const float m = fmaxf(a, b);
    auto rr = __builtin_amdgcn_permlane32_swap(__builtin_bit_cast(unsigned, m), __builtin_bit_cast(unsigned, m), false, false);
    return fmaxf(__builtin_bit_cast(float, (unsigned)rr[0]), __builtin_bit_cast(float, (unsigned)rr[1]));
}
template <int THR, bool HASF>
__device__ __forceinline__ void attn_step(f32x16& p0, f32x16& p1, f32x16& n0, f32x16& n1, const LAS unsigned char* Knext, const LAS float* Fnext, const LAS unsigned char* Vcur,
                                          const bf16x8* qr, float& mhat, float& l, f32x16* o, LAS float* wsf, int r32, int hi) {
    f32x16 c0 = f32x16{}, c1 = f32x16{};
    if (HASF) {
#pragma unroll
        for (int rr = 0; rr < 4; ++rr) { const f32x4 f0 = *(const LAS f32x4*)(Fnext + 8 * rr), f1 = *(const LAS f32x4*)(Fnext + 32 + 8 * rr);
#pragma unroll
            for (int e = 0; e < 4; ++e) { c0[4 * rr + e] = f0[e]; c1[4 * rr + e] = f1[e]; } }
    }
    bf16x8 kf[8];
    { const LAS unsigned char* kb = Knext + hi * 1024 + r32 * 16;
#pragma unroll
      for (int d0 = 0; d0 < 4; ++d0) { kf[2 * d0] = *(const LAS bf16x8*)(kb + d0 * 2048); kf[2 * d0 + 1] = *(const LAS bf16x8*)(kb + d0 * 2048 + 512); } }
    __builtin_amdgcn_sched_barrier(0);
    const float rm = rowmax32(p0, p1);
    if (__any(rm > mhat + (float)THR)) {
        const float mnew = fmaxf(mhat, rm), f = ex2(mhat - mnew);
        l *= f; mhat = mnew; scale_rows(o, f, wsf, r32, hi);
    }
#pragma unroll
    for (int d0 = 0; d0 < 4; ++d0) {
        c0 = __builtin_amdgcn_mfma_f32_32x32x16_bf16(kf[2 * d0], qr[d0], c0, 0, 0, 0);
        c1 = __builtin_amdgcn_mfma_f32_32x32x16_bf16(kf[2 * d0 + 1], qr[d0], c1, 0, 0, 0);
    }
    __builtin_amdgcn_sched_barrier(0);
    s16x4 vl[8], vh[8];
#pragma unroll
    for (int i = 0; i < 8; ++i) { vl[i] = vtr(Vcur + (i >> 2) * 4096 + (i & 3) * 1024); vh[i] = vtr(Vcur + (i >> 2) * 4096 + (i & 3) * 1024 + 512); }
    __builtin_amdgcn_sched_barrier(0);
    p0 = p0 - mhat; p1 = p1 - mhat;
#pragma unroll
    for (int r = 0; r < 16; ++r) { p0[r] = ex2(p0[r]); p1[r] = ex2(p1[r]); }
    const f32x16 t = p0 + p1;
    const f32x8 t8 = t.lo + t.hi; const f32x4 t4 = t8.lo + t8.hi; const f32x2 t2 = t4.lo + t4.hi;
    l += t2.x + t2.y;
    const bf16x8 pa0 = PACK8(p0, 0), pa1 = PACK8(p0, 8), pa2 = PACK8(p1, 0), pa3 = PACK8(p1, 8);
#define VFK(k) (bf16x8){vl[k][0], vl[k][1], vl[k][2], vl[k][3], vh[k][0], vh[k][1], vh[k][2], vh[k][3]}
    o[0] = __builtin_amdgcn_mfma_f32_32x32x16_bf16(pa0, VFK(0), o[0], 0, 0, 0);
    o[1] = __builtin_amdgcn_mfma_f32_32x32x16_bf16(pa0, VFK(4), o[1], 0, 0, 0);
    o[0] = __builtin_amdgcn_mfma_f32_32x32x16_bf16(pa1, VFK(1), o[0], 0, 0, 0);
    o[1] = __builtin_amdgcn_mfma_f32_32x32x16_bf16(pa1, VFK(5), o[1], 0, 0, 0);
    o[0] = __builtin_amdgcn_mfma_f32_32x32x16_bf16(pa2, VFK(2), o[0], 0, 0, 0);
    o[1] = __builtin_amdgcn_mfma_f32_32x32x16_bf16(pa2, VFK(6), o[1], 0, 0, 0);
    o[0] = __builtin_amdgcn_mfma_f32_32x32x16_bf16(pa3, VFK(3), o[0], 0, 0, 0);
    o[1] = __builtin_amdgcn_mfma_f32_32x32x16_bf16(pa3, VFK(7), o[1], 0, 0, 0);
#undef VFK
    n0 = c0; n1 = c1;
}
template <int THR>
__device__ __forceinline__ void softmax_pv(f32x16& p0, f32x16& p1, float& mhat, float& l, f32x16* o, int vb, LAS float* wsf, int r32, int hi) {
    float a = max3f(p0[0], p0[1], p1[0]), b = max3f(p0[2], p0[3], p1[1]); a = max3f(a, p1[2], p1[3]);
#pragma unroll
    for (int r = 4; r < 16; r += 4) { a = max3f(a, p0[r], p0[r + 1]); b = max3f(b, p0[r + 2], p0[r + 3]); a = max3f(a, p1[r], p1[r + 1]); b = max3f(b, p1[r + 2], p1[r + 3]); }
    float rm = fmaxf(a, b); rm = fmaxf(rm, __shfl_xor(rm, 32));
    if (__any(rm > mhat + (float)THR)) {
        const float mnew = fmaxf(mhat, rm), f = ex2(mhat - mnew);
        l *= f; mhat = mnew; scale_rows(o, f, wsf, r32, hi);
    }
    p0 = p0 - mhat; p1 = p1 - mhat;
#pragma unroll
    for (int r = 0; r < 16; ++r) { p0[r] = ex2(p0[r]); p1[r] = ex2(p1[r]); }
    const f32x16 t = p0 + p1;
    const f32x8 t8 = t.lo + t.hi; const f32x4 t4 = t8.lo + t8.hi; const f32x2 t2 = t4.lo + t4.hi;
    l += t2.x + t2.y;
    pv(o, vb, PACK8(p0, 0), PACK8(p0, 8), PACK8(p1, 0), PACK8(p1, 8));
}
__device__ __forceinline__ void store_o(const f32x16* o, float rinv, LAS float* wsf, LAS bf16_t* stg, bf16_t* Og, int pitch, int r32, int hi, int lane) {
    if (hi == 0) wsf[32 + r32] = rinv;
    LGKM_WAIT0();
#pragma unroll
    for (int r = 0; r < 16; ++r) { const int orow = crow(r, hi); const float rl = wsf[32 + orow];
#pragma unroll
        for (int d0 = 0; d0 < 2; ++d0) stg[orow * 64 + d0 * 32 + r32] = (bf16_t)f2bf(o[d0][r] * rl); }
    LGKM_WAIT0();
#pragma unroll
    for (int i = 0; i < 4; ++i) { const int row = i * 8 + (lane >> 3), ch = lane & 7; const u32x4 v = *(const LAS u32x4*)(stg + row * 64 + ch * 8); *(u32x4*)(Og + (size_t)row * pitch + ch * 8) = v; }
    LGKM_WAIT0();
}
__device__ __forceinline__ float log_sigmoid(float x) { return fminf(x, 0.f) - log1pf(__expf(-fabsf(x))); }

constexpr int MX_RING = 0, MX_F = 98304, MX_WSF = 114688, MX_WTOT = 116736, MX_STG_SWA = 65536, MX_STG_FOX = 40960;

struct MixCtx {
    const bf16_t* Z; const float* G; bf16_t* Y;
    const float* sinks; const float* fox_fb; const float* ml_ib; const float* ml_fb; const float* ml_norm;
    unsigned char* ws; const unsigned char* KT; const unsigned char* VT;
};

__device__ __forceinline__ void swa_item(const MixCtx& C, int item, LAS unsigned char* lds) {
    int tid_ = threadIdx.x; asm volatile("" : "+v"(tid_));
    const int tid = tid_, lane = tid & 63, w = __builtin_amdgcn_readfirstlane(tid >> 6), r32 = lane & 31, hi = lane >> 5;
    const int jp = item & 31, kvh = (item >> 5) & 1, b = item >> 6;
    const size_t rowbase = (size_t)b * 4096;
    const int cbase = jp >= 1 ? 2 * jp - 2 : 0, ntl = 2 * jp + 2 - cbase;
    const bf16_t* Kb = C.Z + rowbase * ZP + 512 + 64 * kvh; const bf16_t* Vb = C.Z + rowbase * ZP + 640 + 64 * kvh;
    for (int j = 0; j < ntl; ++j) { dma_k(lds + MX_RING + j * 16384, Kb + (size_t)(cbase + j) * 64 * ZP, ZP, w, lane); dma_v(lds + MX_RING + j * 16384 + 8192, Vb + (size_t)(cbase + j) * 64 * ZP, ZP, w, lane); }
    const int hq = 4 * kvh + (w >> 1);
    bf16x8 qra[4], qrb[4];
    { const bf16_t* Qa = C.Z + (rowbase + 128 * jp + 32 * (w & 1) + r32) * ZP + 64 * hq;
#pragma unroll
      for (int d0 = 0; d0 < 4; ++d0) { qra[d0] = *(const bf16x8*)(Qa + 16 * d0 + 8 * hi); qrb[d0] = *(const bf16x8*)(Qa + (size_t)64 * ZP + 16 * d0 + 8 * hi); } }
    LAS float* wsf = (LAS float*)(lds + MX_WSF) + w * 64; LAS bf16_t* stg = (LAS bf16_t*)(lds + MX_STG_SWA + w * 4096);
    const float sink = C.sinks[hq] * LOG2E;
    VM_WAIT0(); __syncthreads();
    const int vlo = vt_lane_off(lane);
#pragma unroll
    for (int cc = 0; cc < 2; ++cc) {
        const int c = 2 * jp + cc, c0 = c >= 2 ? c - 2 : 0, nt = c - c0 + 1, s0 = c0 - cbase, qw0 = 64 * c + 32 * (w & 1);
        const bf16x8* qr = cc == 0 ? qra : qrb;
        float mhat = sink, l = hi == 0 ? 1.f : 0.f; f32x16 o[2]; o[0] = f32x16{}; o[1] = f32x16{};
        f32x16 p0, p1; qkt(p0, p1, lds + MX_RING + s0 * 16384, qr, r32, hi);
        for (int j = 0; j < nt; ++j) {
            f32x16 n0 = p0, n1 = p1;
            if (j + 1 < nt) qkt(n0, n1, lds + MX_RING + (s0 + j + 1) * 16384, qr, r32, hi);
            softmax_pv<8>(p0, p1, mhat, l, o, (int)(uintptr_t)(lds + MX_RING + (s0 + j) * 16384 + 8192) + vlo, wsf, r32, hi);
            p0 = n0; p1 = n1;
        }
        l += __shfl_xor(l, 32);
        store_o(o, 1.0f / l, wsf, stg, C.Y + (rowbase + qw0) * 1024 + 64 * hq, 1024, r32, hi, lane);
    }
    __syncthreads();
}

__device__ __forceinline__ void fx0_item(const MixCtx& C, float* NF, unsigned* cntF, int bh, LAS unsigned char* lds) {
    int tid_ = threadIdx.x; asm volatile("" : "+v"(tid_));
    const int tid = tid_, lane = tid & 63, w = __builtin_amdgcn_readfirstlane(tid >> 6);
    const int b = bh >> 2, h = bh & 3; const size_t rowbase = (size_t)b * 4096;
    LAS float* wtot = (LAS float*)(lds + MX_WTOT);
    const float fb = C.fox_fb[h]; const int t0 = tid * 8; float v[8]; float run = 0.f;
#pragma unroll
    for (int i = 0; i < 8; ++i) { run += log_sigmoid(C.G[(rowbase + t0 + i) * 16 + h] + fb) * LOG2E; v[i] = run; }
    float inc = run;
#pragma unroll
    for (int o_ = 1; o_ < 64; o_ <<= 1) { const float y = __shfl_up(inc, o_); if (lane >= o_) inc += y; }
    if (lane == 63) wtot[w] = inc;
    __syncthreads();
    float off = inc - run;
    for (int j = 0; j < w; ++j) off += wtot[j];
    *(f32x4*)(NF + bh * 4096 + t0) = (f32x4){-(v[0] + off), -(v[1] + off), -(v[2] + off), -(v[3] + off)};
    *(f32x4*)(NF + bh * 4096 + t0 + 4) = (f32x4){-(v[4] + off), -(v[5] + off), -(v[6] + off), -(v[7] + off)};
    asm volatile("s_waitcnt vmcnt(0)" ::: "memory"); __syncthreads();
    if (tid == 0) { __builtin_amdgcn_fence(__ATOMIC_RELEASE, "agent"); asm volatile("s_waitcnt vmcnt(0)" ::: "memory"); __hip_atomic_fetch_add(cntF + bh, 1u, __ATOMIC_RELAXED, __HIP_MEMORY_SCOPE_AGENT); }
    __syncthreads();
}
__device__ __forceinline__ void fox_block(const MixCtx& C, const float* NF, unsigned* cntF, int bh, int qb, LAS unsigned char* lds, bool first) {
    int tid_ = threadIdx.x; asm volatile("" : "+v"(tid_));
    const int tid = tid_, lane = tid & 63, w = __builtin_amdgcn_readfirstlane(tid >> 6), r32 = lane & 31, hi = lane >> 5;
    const int b = bh >> 2, h = bh & 3; const size_t rowbase = (size_t)b * 4096; const int q0 = qb * 128, nkeys = q0 + 128, nst = qb + 1;
    const unsigned char* Kt = C.KT + (size_t)bh * 64 * 8192; const unsigned char* Vt = C.VT + (size_t)bh * 64 * 8192;
#define FOX_STAGE(st_) do { LAS unsigned char* sb_ = lds + MX_RING + ((st_) % 3) * 32768; \
        dma_lin(sb_, Kt + (size_t)(2 * (st_)) * 8192, w, lane); dma_lin(sb_ + 8192, Kt + (size_t)(2 * (st_) + 1) * 8192, w, lane); \
        dma_lin(sb_ + 16384, Vt + (size_t)(2 * (st_)) * 8192, w, lane); dma_lin(sb_ + 24576, Vt + (size_t)(2 * (st_) + 1) * 8192, w, lane); } while (0)
    FOX_STAGE(0); if (nst > 1) FOX_STAGE(1);
    LAS float* F2 = (LAS float*)(lds + MX_F);
    LAS float* wsf = (LAS float*)(lds + MX_WSF) + w * 64; LAS bf16_t* stg = (LAS bf16_t*)(lds + MX_STG_FOX + w * 4096);
    const int g = w >> 2, qw0 = q0 + 32 * (w & 3);
    const bf16_t* Qb = C.Z + (rowbase + qw0 + r32) * ZP + 768 + 64 * h;
    bf16x8 qr[4];
#pragma unroll
    for (int d0 = 0; d0 < 4; ++d0) qr[d0] = *(const bf16x8*)(Qb + 16 * d0 + 8 * hi);
    if (first) {
        if (tid == 0) { while (__hip_atomic_load(cntF + bh, __ATOMIC_RELAXED, __HIP_MEMORY_SCOPE_AGENT) < 1u) __builtin_amdgcn_s_sleep(2); }
        __syncthreads();
    }
    {
        const int t0 = tid * 8;
        if (first && t0 < nkeys) { const unsigned long long* np = (const unsigned long long*)(NF + bh * 4096 + t0); unsigned long long q[4];
#pragma unroll
            for (int i = 0; i < 4; ++i) q[i] = __hip_atomic_load(np + i, __ATOMIC_RELAXED, __HIP_MEMORY_SCOPE_AGENT);
#pragma unroll
            for (int i = 0; i < 4; ++i) *(LAS unsigned long long*)(F2 + t0 + 2 * i) = q[i]; }
    }
    float mhat = -1e30f, l = 0.f; f32x16 o[2]; o[0] = f32x16{}; o[1] = f32x16{};
    VM_WAIT0(); __syncthreads();
    const int vlo = vt_lane_off(lane), qpos = qw0 + r32;
#define FOX_SCORE(st_, P0, P1) do { const int kb_ = 64 * (2 * (st_) + g); const LAS unsigned char* sk_ = lds + MX_RING + ((st_) % 3) * 32768 + g * 8192; f32x16 c0_, c1_; \
        _Pragma("unroll") for (int rr = 0; rr < 4; ++rr) { const f32x4 f0 = *(const LAS f32x4*)(F2 + kb_ + 8 * rr + 4 * hi), f1 = *(const LAS f32x4*)(F2 + kb_ + 32 + 8 * rr + 4 * hi); \
            _Pragma("unroll") for (int e = 0; e < 4; ++e) { c0_[4 * rr + e] = f0[e]; c1_[4 * rr + e] = f1[e]; } } \
        qkt(P0, P1, sk_, qr, r32, hi, c0_, c1_); } while (0)
    f32x16 p0, p1, n0, n1; FOX_SCORE(0, p0, p1);
#define FOX_STEP(PA0, PA1, PB0, PB1, st_) do { if ((st_) + 2 < nst) FOX_STAGE((st_) + 2); \
        attn_step<24, true>(PA0, PA1, PB0, PB1, lds + MX_RING + (((st_) + 1) % 3) * 32768 + g * 8192, F2 + 64 * (2 * ((st_) + 1) + g) + 4 * hi, \
                           lds + MX_RING + ((st_) % 3) * 32768 + 16384 + g * 8192 + vlo, qr, mhat, l, o, wsf, r32, hi); \
        VM_WAIT0(); __syncthreads(); } while (0)
#define FOX_LAST(PA0, PA1) do { const int st = nst - 1, kbase = 64 * (2 * st + g); \
        if (kbase <= qw0 + 31) { \
            if (kbase + 63 > qw0) { _Pragma("unroll") for (int r = 0; r < 16; ++r) { const int kv = kbase + crow(r, hi); if (kv > qpos) PA0[r] = -INFINITY; if (kv + 32 > qpos) PA1[r] = -INFINITY; } } \
            softmax_pv<24>(PA0, PA1, mhat, l, o, (int)(uintptr_t)(lds + MX_RING + (st % 3) * 32768 + 16384 + g * 8192) + vlo, wsf, r32, hi); } } while (0)
    int st2 = 0;
    for (; st2 + 2 < nst; st2 += 2) { FOX_STEP(p0, p1, n0, n1, st2); FOX_STEP(n0, n1, p0, p1, st2 + 1); }
    if (st2 + 1 < nst) { FOX_STEP(p0, p1, n0, n1, st2); FOX_LAST(n0, n1); } else { FOX_LAST(p0, p1); }
#undef FOX_STEP
#undef FOX_LAST
    __syncthreads();
#undef FOX_SCORE
#undef FOX_STAGE
    l += __shfl_xor(l, 32);
    LAS float* mo = (LAS float*)(lds + MX_RING); LAS float* ml = (LAS float*)(lds + MX_RING + 32768);
    const int wq = w & 3;
    if (g == 1) {
#pragma unroll
        for (int d0 = 0; d0 < 2; ++d0)
#pragma unroll
            for (int r = 0; r < 16; ++r) mo[((wq * 2 + d0) * 16 + r) * 64 + lane] = o[d0][r];
        ml[(wq * 2 + 0) * 64 + lane] = mhat; ml[(wq * 2 + 1) * 64 + lane] = l;
    }
    __syncthreads();
    if (g == 0) {
        const float m1 = ml[(wq * 2 + 0) * 64 + lane], l1 = ml[(wq * 2 + 1) * 64 + lane];
        const float mn = fmaxf(mhat, m1), f0 = ex2(mhat - mn), f1 = ex2(m1 - mn), lt = l * f0 + l1 * f1;
        if (hi == 0) { wsf[r32] = f0; wsf[32 + r32] = f1; }
        LGKM_WAIT0();
#pragma unroll
        for (int r = 0; r < 16; ++r) { const float a0 = wsf[crow(r, hi)], a1 = wsf[32 + crow(r, hi)];
#pragma unroll
            for (int d0 = 0; d0 < 2; ++d0) o[d0][r] = o[d0][r] * a0 + mo[((wq * 2 + d0) * 16 + r) * 64 + lane] * a1; }
        LGKM_WAIT0();
        store_o(o, 1.0f / lt, wsf, stg, C.Y + (rowbase + qw0) * 1024 + 512 + 64 * h, 1024, r32, hi, lane);
    }
    __syncthreads();
}
__device__ __forceinline__ void fox_item(const MixCtx& C, const float* NF, unsigned* cntF, int bh, int i, LAS unsigned char* lds) {
    fox_block(C, NF, cntF, bh, 31 - i, lds, true);
    fox_block(C, NF, cntF, bh, i, lds, false);
}
constexpr int ML_WSF = 98304, ML_STG = 100352, ML_SM = 133120;
struct MlScratch { float* E; float* B; float* PM; float* CL; float* NL; bf16_t* CP; float* NP; float* GC; float* EM; float* MP; unsigned* cnt1; unsigned* cnt2; };
__device__ __forceinline__ void wait_count(unsigned* p, unsigned want, int tid) {
    if (tid == 0) { while (__hip_atomic_load(p, __ATOMIC_RELAXED, __HIP_MEMORY_SCOPE_AGENT) < want) __builtin_amdgcn_s_sleep(2);
        __builtin_amdgcn_fence(__ATOMIC_ACQUIRE, "agent"); asm volatile("s_waitcnt vmcnt(0)" ::: "memory"); }
    __syncthreads();
}
__device__ __forceinline__ void post_count(unsigned* p, int tid) {
    asm volatile("s_waitcnt vmcnt(0)" ::: "memory"); __syncthreads();
    if (tid == 0) { __builtin_amdgcn_fence(__ATOMIC_RELEASE, "agent"); asm volatile("s_waitcnt vmcnt(0)" ::: "memory");
        __hip_atomic_fetch_add(p, 1u, __ATOMIC_RELAXED, __HIP_MEMORY_SCOPE_AGENT); }
}
#define ML_COMMON \
    int tid_ = threadIdx.x; asm volatile("" : "+v"(tid_)); \
    const int tid = tid_, lane = tid & 63, w = __builtin_amdgcn_readfirstlane(tid >> 6), r32 = lane & 31, hi = lane >> 5; \
    const int b = bh >> 2, h = bh & 3; const size_t rowbase = (size_t)b * 4096; \
    float* E = S.E + bh * 4096; float* B = S.B + bh * 4096; float* PM = S.PM + bh * 4096; \
    float* CL = S.CL + (size_t)bh * 64 * 4096; float* NL = S.NL + bh * 4096; bf16_t* CP = S.CP + (size_t)bh * 64 * 4096; float* NP = S.NP + bh * 4096; \
    float* GC = S.GC + bh * 64; float* EM = S.EM + bh * 64; float* MP = S.MP + bh * 64; \
    (void)r32; (void)hi; (void)E; (void)B; (void)PM; (void)CL; (void)NL; (void)CP; (void)NP; (void)GC; (void)EM; (void)MP; (void)rowbase; (void)h;

__device__ __forceinline__ void ml1_item(const MixCtx& C, const MlScratch& S, int bh, int rd, LAS unsigned char* lds) {
    ML_COMMON
    LAS float* le = (LAS float*)(lds + ML_SM); LAS float* lem = le + 512;
    const bf16_t* Kg = C.Z + rowbase * ZP + 1792 + 64 * h; const bf16_t* Vg = C.Z + rowbase * ZP + 2048 + 64 * h;
    const int srow = 16 * (w & 3) + (lane >> 2), scol = (w >> 2) * 32 + (lane & 3) * 8;
    u32x4 kvr[8];
#pragma unroll
    for (int p = 0; p < 8; ++p) kvr[p] = *(const u32x4*)(Kg + (size_t)((8 * rd + p) * 64 + srow) * ZP + scol);
    {
        const int cc = 8 * rd + w, t = cc * 64 + lane;
        const float* gp = C.G + (rowbase + t) * 16;
        const float ig = gp[4 + h] + C.ml_ib[h];
        float bsum = log_sigmoid(gp[8 + h] + C.ml_fb[h]);
#pragma unroll
        for (int o_ = 1; o_ < 64; o_ <<= 1) { const float y = __shfl_up(bsum, o_); if (lane >= o_) bsum += y; }
        const float e = ig - bsum; float pm = e;
#pragma unroll
        for (int o_ = 1; o_ < 64; o_ <<= 1) { const float y = __shfl_up(pm, o_); if (lane >= o_) pm = fmaxf(pm, y); }
        E[t] = e; B[t] = bsum; PM[t] = pm; le[w * 64 + lane] = e;
        if (lane == 63) { GC[cc] = bsum; EM[cc] = pm; lem[w] = pm; }
    }
    __syncthreads();
    const int vlo = vt_lane_off(lane);
    const bf16x8 ones = (bf16x8){0x3F80, 0x3F80, 0x3F80, 0x3F80, 0x3F80, 0x3F80, 0x3F80, 0x3F80};
#pragma unroll
    for (int p = 0; p < 8; ++p) {
        const int cc = 8 * rd + p; LAS unsigned char* sl = lds + p * 16384;
        const float wa = __expf(le[p * 64 + srow] - lem[p]);
        u32x4 w2;
#pragma unroll
        for (int j = 0; j < 4; ++j) { const float lo = __builtin_bit_cast(float, kvr[p][j] << 16), hh = __builtin_bit_cast(float, kvr[p][j] & 0xffff0000u); w2[j] = cvtpk(lo * wa, hh * wa); }
        *(LAS u32x4*)(sl + w * 1024 + lane * 16) = w2;
        dma_v(sl + 8192, Vg + (size_t)cc * 64 * ZP, ZP, w, lane);
    }
    VM_WAIT0(); __syncthreads();
    {
        const int cc = 8 * rd + w; LAS unsigned char* sl = lds + w * 16384;
        const int ka = (int)(uintptr_t)sl + vlo, va = ka + 8192;
        float* cl = CL + (size_t)cc * 4096;
#pragma unroll
        for (int half = 0; half < 2; ++half) {
            f32x16 a0 = {}, a1 = {}, na = {};
#pragma unroll
            for (int ks = 0; ks < 4; ++ks) {
                const bf16x8 A = vfrag(ka, half, ks), B0 = vfrag(va, 0, ks), B1 = vfrag(va, 1, ks);
                a0 = __builtin_amdgcn_mfma_f32_32x32x16_bf16(A, B0, a0, 0, 0, 0);
                a1 = __builtin_amdgcn_mfma_f32_32x32x16_bf16(A, B1, a1, 0, 0, 0);
                na = __builtin_amdgcn_mfma_f32_32x32x16_bf16(A, ones, na, 0, 0, 0);
            }
#pragma unroll
            for (int r = 0; r < 16; ++r) { const int k = 32 * half + crow(r, hi); cl[k * 64 + r32] = a0[r]; cl[k * 64 + 32 + r32] = a1[r]; }
            if (r32 == 0) {
#pragma unroll
                for (int r = 0; r < 16; ++r) NL[cc * 64 + 32 * half + crow(r, hi)] = na[r];
            }
        }
    }
    post_count(S.cnt1 + bh, tid);
    __syncthreads();
}

__device__ __forceinline__ void ml2_item(const MixCtx& C, const MlScratch& S, int bh, int slice, LAS unsigned char* lds) {
    ML_COMMON
    LAS float* lg = (LAS float*)(lds + ML_SM); LAS float* lem = lg + 64; LAS float* lso = lg + 128; LAS float* lsl = lg + 192;
    wait_count(S.cnt1 + bh, 8u, tid);
    if (tid < 64) { lg[tid] = GC[tid]; lem[tid] = EM[tid]; }
    __syncthreads();
    if (tid == 0) { float mcur = 0.f; for (int c = 0; c < 64; ++c) { const float g = lg[c], em = lem[c], mx = fmaxf(mcur, em); if (slice == 0) MP[c] = mcur; lso[c] = __expf(mcur - mx); lsl[c] = __expf(em - mx); mcur = g + mx; } }
    __syncthreads();
    const int idx = slice * 2048 + tid * 4; const bool don = (slice == 0) && (tid < 64);
    f32x4 Cs = (f32x4){0.f, 0.f, 0.f, 0.f}; float ns = 0.f;
    for (int c0 = 0; c0 < 64; c0 += 16) {
        f32x4 lv[16]; float ln[16];
#pragma unroll
        for (int j = 0; j < 16; ++j) { lv[j] = *(const f32x4*)(CL + (size_t)(c0 + j) * 4096 + idx); ln[j] = don ? NL[(c0 + j) * 64 + tid] : 0.f; }
#pragma unroll
        for (int j = 0; j < 16; ++j) {
            const int c = c0 + j;
            u32x2 pk; pk.x = cvtpk(Cs[0], Cs[1]); pk.y = cvtpk(Cs[2], Cs[3]);
            *(u32x2*)(CP + (size_t)c * 4096 + idx) = pk;
            if (don) NP[c * 64 + tid] = ns;
            const float so = lso[c], sl = lsl[c];
            Cs = Cs * so + lv[j] * sl; ns = so * ns + sl * ln[j];
        }
    }
    post_count(S.cnt2 + bh, tid);
    __syncthreads();
}

__device__ __forceinline__ void ml3_item(const MixCtx& C, const MlScratch& S, int bh, int rd, LAS unsigned char* lds) {
    ML_COMMON
    wait_count(S.cnt2 + bh, 2u, tid);
    const int pair = w >> 1, half = w & 1;
    const bf16_t* Kg = C.Z + rowbase * ZP + 1792 + 64 * h; const bf16_t* Vg = C.Z + rowbase * ZP + 2048 + 64 * h; const bf16_t* Qg = C.Z + rowbase * ZP + 1536 + 64 * h;
    const int vlo = vt_lane_off(lane);
    LAS float* wsf = (LAS float*)(lds + ML_WSF) + w * 64; LAS bf16_t* stg = (LAS bf16_t*)(lds + ML_STG + w * 4096);
#pragma unroll
        for (int p = 0; p < 4; ++p) {
            const int cc = 4 * rd + p; LAS unsigned char* sl = lds + p * 24576;
            dma_k(sl, Kg + (size_t)cc * 64 * ZP, ZP, w, lane); dma_v(sl + 8192, Vg + (size_t)cc * 64 * ZP, ZP, w, lane); dma_v(sl + 16384, CP + (size_t)cc * 4096, 64, w, lane);
        }
        const int cc = 4 * rd + pair, lrow = 32 * half + r32, t = cc * 64 + lrow;
        const bf16_t* qp = Qg + (size_t)t * ZP;
        bf16x8 qr[4], qp2[4];
#pragma unroll
        for (int d0 = 0; d0 < 4; ++d0) qr[d0] = *(const bf16x8*)(qp + 16 * d0 + 8 * hi);
#pragma unroll
        for (int ks = 0; ks < 4; ++ks) { const u32x2 a = *(const u32x2*)(qp + 16 * ks + 4 * hi), b2 = *(const u32x2*)(qp + 16 * ks + 8 + 4 * hi); qp2[ks] = __builtin_bit_cast(bf16x8, ((u32x4){a.x, a.y, b2.x, b2.y})); }
        const float mprev = MP[cc], mm = fmaxf(mprev, PM[t]), winter = __expf(mprev - mm), bl = B[t];
        float nd = 0.f;
#pragma unroll
        for (int d0 = 0; d0 < 4; ++d0) { const float* np = NP + cc * 64 + 16 * d0 + 8 * hi; const f32x4 n0 = *(const f32x4*)np, n1 = *(const f32x4*)(np + 4);
            const u32x4 qq = __builtin_bit_cast(u32x4, qr[d0]);
#pragma unroll
            for (int j = 0; j < 4; ++j) { const float lo = __builtin_bit_cast(float, qq[j] << 16), hh = __builtin_bit_cast(float, qq[j] & 0xffff0000u);
                const float na_ = j < 2 ? n0[2 * j] : n1[2 * j - 4], nb_ = j < 2 ? n0[2 * j + 1] : n1[2 * j - 3]; nd += lo * na_ + hh * nb_; } }
        nd += __shfl_xor(nd, 32);
        VM_WAIT0(); __syncthreads();
        {
            LAS unsigned char* sl = lds + pair * 24576; const int base = (int)(uintptr_t)sl + vlo;
            f32x16 o[2]; o[0] = f32x16{}; o[1] = f32x16{};
            pv(o, base + 16384, qp2[0], qp2[1], qp2[2], qp2[3]);
            scale_rows(o, winter, wsf, r32, hi);
            f32x16 p0, p1; qkt(p0, p1, sl, qr, r32, hi);
            float rs = 0.f;
#pragma unroll
            for (int rr = 0; rr < 4; ++rr) { const f32x4 e0 = *(const f32x4*)(E + cc * 64 + 8 * rr + 4 * hi), e1 = *(const f32x4*)(E + cc * 64 + 32 + 8 * rr + 4 * hi);
#pragma unroll
                for (int e = 0; e < 4; ++e) { const int r = 4 * rr + e, s = 8 * rr + 4 * hi + e;
                    const float w0 = (s <= lrow) ? __expf(e0[e] - mm) : 0.f, w1 = (s + 32 <= lrow) ? __expf(e1[e] - mm) : 0.f;
                    p0[r] *= w0; p1[r] *= w1; rs += p0[r] + p1[r]; } }
            rs += __shfl_xor(rs, 32);
            pv(o, base + 8192, PACK8(p0, 0), PACK8(p0, 8), PACK8(p1, 0), PACK8(p1, 8));
            const float den = winter * nd + rs, dn = fmaxf(fabsf(den), __expf(-(bl + mm)));
            const float rinv = 1.0f / dn;
            if (hi == 0) wsf[32 + r32] = rinv;
            LGKM_WAIT0();
#pragma unroll
            for (int r = 0; r < 16; ++r) { const int orow = crow(r, hi); const float rl = wsf[32 + orow];
#pragma unroll
                for (int d0 = 0; d0 < 2; ++d0) stg[orow * 64 + d0 * 32 + r32] = (bf16_t)f2bf(o[d0][r] * rl); }
            LGKM_WAIT0();
#pragma unroll
            for (int i = 0; i < 4; ++i) {
                const int row = i * 8 + (lane >> 3), ch = lane & 7; const u32x4 v = *(const LAS u32x4*)(stg + row * 64 + ch * 8);
                float x[8]; float ss = 0.f;
#pragma unroll
                for (int j = 0; j < 4; ++j) { x[2 * j] = __builtin_bit_cast(float, v[j] << 16); x[2 * j + 1] = __builtin_bit_cast(float, v[j] & 0xffff0000u); ss += x[2 * j] * x[2 * j] + x[2 * j + 1] * x[2 * j + 1]; }
                ss += __shfl_xor(ss, 1); ss += __shfl_xor(ss, 2); ss += __shfl_xor(ss, 4);
                const float rn = rsqrtf(ss * (1.0f / 64.0f) + EPS);
                const size_t tok = rowbase + cc * 64 + 32 * half + row;
                const u32x4 og = *(const u32x4*)(C.Z + tok * ZP + 2304 + 64 * h + ch * 8);
                const f32x4 g0 = *(const f32x4*)(C.ml_norm + h * 64 + ch * 8), g1 = *(const f32x4*)(C.ml_norm + h * 64 + ch * 8 + 4);
                float y[8];
#pragma unroll
                for (int j = 0; j < 4; ++j) { const float o0 = __builtin_bit_cast(float, og[j] << 16), o1 = __builtin_bit_cast(float, og[j] & 0xffff0000u);
                    const float ga = j < 2 ? g0[2 * j] : g1[2 * j - 4], gb = j < 2 ? g0[2 * j + 1] : g1[2 * j - 3];
                    y[2 * j] = x[2 * j] * rn * ga * o0; y[2 * j + 1] = x[2 * j + 1] * rn * gb * o1; }
                u32x4 pk; pk.x = cvtpk(y[0], y[1]); pk.y = cvtpk(y[2], y[3]); pk.z = cvtpk(y[4], y[5]); pk.w = cvtpk(y[6], y[7]);
                *(u32x4*)(C.Y + tok * 1024 + 768 + 64 * h + ch * 8) = pk;
            }
            LGKM_WAIT0();
        }
        __syncthreads();
}
constexpr int MTOK = 16384, DMODEL = 1024, SEQL = 4096, DFF = 4096, NZT = 2816  , DEPTH = 2;
constexpr size_t MiB = 1u << 20;
constexpr size_t WS_CTL = 0, CTL_BYTES = 32768;
constexpr size_t WS_WIN = 2 * MiB, WIN_L = (size_t)NZT * DMODEL * 2;
constexpr size_t WS_WOUT = 13 * MiB, WOUT_L = (size_t)DMODEL * DMODEL * 2;
constexpr size_t WS_WFF1 = 17 * MiB, WFF_L = (size_t)DFF * DMODEL * 2;
constexpr size_t WS_WFF2 = 33 * MiB;
constexpr size_t WS_SSQ2 = 82 * MiB;
constexpr size_t WS_XG = 50 * MiB;
constexpr size_t WS_H = 84 * MiB;
constexpr size_t WS_Z = 84 * MiB, WS_Y = 164 * MiB;
constexpr size_t WS_KT = 196 * MiB, WS_VT = 204 * MiB;
constexpr size_t WS_SSQ = 212 * MiB, WS_ROPE = 214 * MiB, WS_G = 215 * MiB;
constexpr size_t WS_MLE = 216 * MiB, WS_MLB = WS_MLE + 262144, WS_MLPM = WS_MLB + 262144;
constexpr size_t WS_NL = 217 * MiB, WS_NP = WS_NL + 262144, WS_GC = WS_NP + 262144, WS_EM = WS_GC + 4096, WS_MP = WS_EM + 4096;
constexpr size_t WS_CL = 218 * MiB, WS_CP = 234 * MiB, WS_NFX = 242 * MiB, WS_RS = WS_NFX + 524288  , WS_END = 243 * MiB;
constexpr int LDS_BYTES = 147456;
constexpr int WGM_P1 = 2, WGM_P3 = 4, WGM_P4 = 4, WGM_P5 = 4;
constexpr int N_FOX = 256, N_SWA = 256, N_ML1 = 128, N_ML2 = 32, N_ML3 = 256, N_ML = N_ML1 + N_ML2 + N_ML3, N_FX0 = 16, N_ITEMS = N_FX0 + N_ML + N_FOX + N_SWA;

struct Params { const float* in[16]; float* out; unsigned char* ws; int ph_lo, ph_hi; };

__device__ __forceinline__ int win_src(int n) {
    const int pn = n >> 8, P = n & 255, L = 64 * ((P >> 5) & 3) + 32 * (P >> 7) + (P & 31), z = 256 * pn + L;
    if (z < 1536) return z;
    if (z < 2304) return z + 4;
    if (z < 2560) return z + 12;
    const int i = z - 2560;
    if (i < 4) return 1536 + i;
    if (i < 8) return 2308 + (i - 4);
    if (i < 12) return 2312 + (i - 8);
    return -1;
}
template <bool WIN>
__device__ __forceinline__ void tr_item(const float* W, const float* kgain, int K, int Nsrc, bf16_t* WT, int nblk, int item, LAS float* scr, int lane) {
    const int kb = item / nblk, nb = item % nblk, k0 = 64 * kb, n0 = 32 * nb;
    if (WIN && n0 >= 2560) {
        const int n = n0 + (lane & 31); const int src = win_src(n);
#pragma unroll 8
        for (int i = 0; i < 32; ++i) { const int kk = 2 * i + (lane >> 5); scr[kk * 33 + (lane & 31)] = src >= 0 ? W[(size_t)(k0 + kk) * Nsrc + src] * (kgain ? kgain[k0 + kk] : 1.f) : 0.f; }
    } else {
        const int n4 = (lane & 7) * 4; const int src = WIN ? win_src(n0 + n4) : n0 + n4;
        f32x4 v[8];
#pragma unroll
        for (int i = 0; i < 8; ++i) v[i] = *(const f32x4*)(W + (size_t)(k0 + 8 * i + (lane >> 3)) * Nsrc + src);
#pragma unroll
        for (int i = 0; i < 8; ++i) { const int kk = 8 * i + (lane >> 3); const float g = kgain ? kgain[k0 + kk] : 1.f; LAS float* d = scr + kk * 33 + n4;
            d[0] = v[i][0] * g; d[1] = v[i][1] * g; d[2] = v[i][2] * g; d[3] = v[i][3] * g; }
    }
    LGKM_WAIT0(); asm volatile("" ::: "memory");
    const int c = lane & 7;
#pragma unroll
    for (int j = 0; j < 4; ++j) { const int nn = (lane >> 3) + 8 * j; const LAS float* s = scr + (8 * c) * 33 + nn;
        u32x4 o; o.x = cvtpk(s[0 * 33], s[1 * 33]); o.y = cvtpk(s[2 * 33], s[3 * 33]); o.z = cvtpk(s[4 * 33], s[5 * 33]); o.w = cvtpk(s[6 * 33], s[7 * 33]);
        *(u32x4*)(WT + (size_t)(n0 + nn) * K + k0 + 8 * c) = o; }
    LGKM_WAIT0(); asm volatile("" ::: "memory");
}

#define RLX_AGENT __ATOMIC_RELAXED, __HIP_MEMORY_SCOPE_AGENT
#define XB_TMO      128
#define XB_XCNT(j)  (256  + 64 * (j))
#define XB_XSUB(j)  (1280 + 64 * (j))
#define XB_XGEN(j)  (2304 + 64 * (j))
#define XB_TOP      3328
#define XB_TOPGEN   3392
#define XCD_BAR_WORDS 3456
#define XB_SPIN_CAP (1u << 18)

__device__ __forceinline__ unsigned xb_ld(unsigned* p)              { return __hip_atomic_load(p, __ATOMIC_RELAXED, __HIP_MEMORY_SCOPE_AGENT); }
__device__ __forceinline__ unsigned xb_add(unsigned* p, unsigned v) { return __hip_atomic_fetch_add(p, v, __ATOMIC_RELAXED, __HIP_MEMORY_SCOPE_AGENT); }
__device__ __forceinline__ unsigned xb_xcc_id() { return (unsigned)__builtin_amdgcn_s_getreg((3 << 11) | 20) & 0xFu; }
#define XB_SPIN(cond, bar) do { unsigned _sp = 0; while (cond) { __builtin_amdgcn_s_sleep(1); \
    if ((++_sp & 255u) == 0u) { if (xb_ld(&(bar)[XB_TMO])) break; if (_sp > XB_SPIN_CAP) { atomicAdd(&(bar)[XB_TMO], 1u); break; } } } } while (0)

struct XcdBarrier {
    unsigned* bar; unsigned x;
    volatile LAS unsigned* st;
};

__device__ __forceinline__ XcdBarrier xcd_barrier_post(unsigned* bar, volatile LAS unsigned* st) {
    XcdBarrier b; b.bar = bar; b.x = xb_xcc_id(); b.st = st;
    if (threadIdx.x == 0) (void)xb_add(&bar[XB_XCNT(b.x)], 1u);
    return b;
}
__device__ __forceinline__ void xcd_barrier_complete(unsigned* bar, unsigned x, unsigned& nloc, unsigned& nx) {
    const unsigned G = gridDim.x * gridDim.y * gridDim.z;
    unsigned sum, cnt, mine, sp = 0u;
    for (;;) {
        sum = 0u; cnt = 0u; mine = 0u;
#pragma unroll
        for (unsigned j = 0; j < 16; ++j) { const unsigned c = xb_ld(&bar[XB_XCNT(j)]); sum += c; cnt += (c > 0u) ? 1u : 0u; mine = (j == x) ? c : mine; }
        if (sum == G) break;
        __builtin_amdgcn_s_sleep(1);
        if ((++sp & 255u) == 0u) { if (xb_ld(&bar[XB_TMO])) break; if (sp > XB_SPIN_CAP) { atomicAdd(&bar[XB_TMO], 1u); break; } }
    }
    nloc = mine > 0u ? mine : 1u; nx = cnt > 0u ? cnt : 1u;
}

__device__ __forceinline__ void xcd_barrier(const XcdBarrier& b) {
    asm volatile("s_waitcnt vmcnt(0)" ::: "memory");
    __syncthreads();
    if (threadIdx.x == 0) {
        unsigned* bar = b.bar;
        __builtin_amdgcn_s_waitcnt(0);
        unsigned nloc = b.st[0], nx = b.st[1];
        if (nloc == 0u) { xcd_barrier_complete(bar, b.x, nloc, nx); b.st[0] = nloc; b.st[1] = nx; }
        const unsigned old = xb_add(&bar[XB_XSUB(b.x)], 1u);
        const unsigned gen = old / nloc;
        if (old + 1u == (gen + 1u) * nloc) {
            __builtin_amdgcn_fence(__ATOMIC_RELEASE, "agent");
            asm volatile("s_waitcnt vmcnt(0)" ::: "memory");
            const unsigned og = xb_add(&bar[XB_TOP], 1u);
            const unsigned tg = og / nx;
            if (og + 1u == (tg + 1u) * nx) xb_add(&bar[XB_TOPGEN], 1u);
            else XB_SPIN(xb_ld(&bar[XB_TOPGEN]) == tg, bar);
            __builtin_amdgcn_fence(__ATOMIC_ACQUIRE, "agent");
            xb_add(&bar[XB_XGEN(b.x)], 1u);
            asm volatile("s_waitcnt vmcnt(0)" ::: "memory");
        } else {
            XB_SPIN(xb_ld(&bar[XB_XGEN(b.x)]) == gen, bar);
            __builtin_amdgcn_fence(__ATOMIC_ACQUIRE, "agent");
            asm volatile("s_waitcnt vmcnt(0)" ::: "memory");
        }
    }
    __syncthreads();
}

__global__ void __launch_bounds__(512, 2) fwd_megakernel(Params p) {
    extern __shared__ __attribute__((aligned(16))) unsigned char lds_raw[];
    LAS unsigned char* lds = (LAS unsigned char*)lds_raw;
    cg::grid_group grid = cg::this_grid();
    const int tid = threadIdx.x, lane = tid & 63, wave = __builtin_amdgcn_readfirstlane(tid >> 6);
    const int G = gridDim.x, bx = blockIdx.x;
    unsigned char* ws = p.ws;
    const float* x_in = p.in[0];
    bf16_t* XG = (bf16_t*)(ws + WS_XG); bf16_t* Zb = (bf16_t*)(ws + WS_Z); bf16_t* Yb = (bf16_t*)(ws + WS_Y); bf16_t* Hb = (bf16_t*)(ws + WS_H);
    float* SSQ = (float*)(ws + WS_SSQ); float* SSQ2 = (float*)(ws + WS_SSQ2); float* ROPEC = (float*)(ws + WS_ROPE); float* ROPES = ROPEC + SEQL * 32; float* Gt = (float*)(ws + WS_G);
    unsigned* ctl = (unsigned*)(ws + WS_CTL);
    const int lo = p.ph_lo, hi_ph = p.ph_hi;
    volatile LAS unsigned* bst = (volatile LAS unsigned*)(lds + 143360 + 16);
    if (tid < 2) bst[tid] = 0u;
    __syncthreads();
    XcdBarrier bar = xcd_barrier_post(ctl + 1024, bst);
    if (lo < 0) grid.sync();
#define IN_PH(k) (lo <= (k) && (k) < hi_ph)
#define SEAM(k) do { if (IN_PH(k) && IN_PH((k) + 1)) xcd_barrier(bar); } while (0)

    if (IN_PH(0)) {
        LAS float* scr = (LAS float*)(lds + wave * 16384);
        const int gw = bx * 8 + wave, NGW = G * 8;
        constexpr int I_IN = (DMODEL / 64) * (NZT / 32), I_OUT = (DMODEL / 64) * (DMODEL / 32), I_F1 = (DMODEL / 64) * (DFF / 32), I_F2 = (DFF / 64) * (DMODEL / 32);
        constexpr int I_LAYER = I_IN + I_OUT + I_F1 + I_F2;
        for (int it = gw; it < DEPTH * I_LAYER; it += NGW) {
            const int l = it / I_LAYER; int r = it % I_LAYER;
            if (r < I_IN) { tr_item<true>(p.in[2] + (size_t)l * DMODEL * 2572, p.in[1] + l * DMODEL, DMODEL, 2572, (bf16_t*)(ws + WS_WIN + l * WIN_L), NZT / 32, r, scr, lane); continue; } r -= I_IN;
            if (r < I_OUT) { tr_item<false>(p.in[12] + (size_t)l * DMODEL * DMODEL, nullptr, DMODEL, DMODEL, (bf16_t*)(ws + WS_WOUT + l * WOUT_L), DMODEL / 32, r, scr, lane); continue; } r -= I_OUT;
            if (r < I_F1) { tr_item<false>(p.in[14] + (size_t)l * DMODEL * DFF, p.in[13] + l * DMODEL, DMODEL, DFF, (bf16_t*)(ws + WS_WFF1 + l * WFF_L), DFF / 32, r, scr, lane); continue; } r -= I_F1;
            tr_item<false>(p.in[15] + (size_t)l * DFF * DMODEL, nullptr, DFF, DMODEL, (bf16_t*)(ws + WS_WFF2 + l * WFF_L), DMODEL / 32, r, scr, lane);
        }
        for (int i = bx * 512 + tid; i < SEQL * 32; i += G * 512) {
            const int pos = i >> 5, j = i & 31;
            double inv = 1.0; for (int q = 0; q < j; ++q) inv *= 0.7498942093324558;
            const float ang = (float)pos * (float)inv;
            double rev = (double)ang * 0.15915494309189535; rev -= __builtin_rint(rev);
            ROPEC[i] = __builtin_amdgcn_cosf((float)rev); ROPES[i] = __builtin_amdgcn_sinf((float)rev);
        }
        for (int m = gw; m < MTOK; m += 2 * NGW) {
            const int m2 = m + NGW;
            const bool has2 = m2 < MTOK;
            const f32x4* xr = (const f32x4*)(x_in + (size_t)m * DMODEL) + lane;
            const f32x4* xr2 = (const f32x4*)(x_in + (size_t)(has2 ? m2 : m) * DMODEL) + lane;
            f32x4 va[4], vb[4];
#pragma unroll
            for (int j = 0; j < 4; ++j) { va[j] = xr[64 * j]; vb[j] = xr2[64 * j]; }
#pragma unroll
            for (int rr = 0; rr < 2; ++rr) {
                if (rr == 1 && !has2) break;
                const int mm = rr == 0 ? m : m2;
                unsigned long long* o8 = (unsigned long long*)(XG + (size_t)mm * DMODEL) + lane;
#pragma unroll
                for (int j = 0; j < 4; ++j) {
                    const f32x4 v = rr == 0 ? va[j] : vb[j];
                    float s = (v[0] * v[0] + v[1] * v[1]) + (v[2] * v[2] + v[3] * v[3]);
                    s += __shfl_xor(s, 1); s += __shfl_xor(s, 2); s += __shfl_xor(s, 4);
                    if ((lane & 7) == 0) SSQ[(size_t)mm * 32 + 8 * j + (lane >> 3)] = s;
                    o8[64 * j] = (unsigned long long)cvtpk(v[0], v[1]) | ((unsigned long long)cvtpk(v[2], v[3]) << 32);
                }
            }
        }
    }
    SEAM(0);

    for (int l = 0; l < DEPTH; ++l) {
        const int pb = 1 + 5 * l;
        if (IN_PH(pb)) {
            pg8::Gemm g{XG, (const bf16_t*)(ws + WS_WIN + l * WIN_L), MTOK, NZT, DMODEL}; pg8::StaticOrder S; S.init(MTOK, NZT, G, bx, WGM_P1);
            float* RS = (float*)(ws + WS_RS);
            { int t3_ = threadIdx.x; asm volatile("" : "+v"(t3_)); pg8::Unit ux; int lastpm = -1;
              for (int i = 0; S.next(i, ux); ++i) { if (ux.pm == lastpm) continue; lastpm = ux.pm;
                  if (t3_ < 256) { const f32x4* sp = (const f32x4*)(SSQ + (size_t)(ux.pm * 256 + t3_) * 32); f32x4 a = sp[0];
#pragma unroll
                      for (int j = 1; j < 8; ++j) a = a + sp[j];
                      RS[ux.pm * 256 + t3_] = rsqrtf(((a[0] + a[1]) + (a[2] + a[3])) * (1.0f / 1024.0f) + pg8::EPS); } }
              asm volatile("s_waitcnt vmcnt(0)" ::: "memory"); }
            __syncthreads();
            pg8::EpiIn E{Zb, Gt, RS, ROPEC, ROPES, p.in[3] + l * 64, p.in[4] + l * 64, p.in[6] + l * 64, p.in[7] + l * 64, ws + WS_KT, ws + WS_VT};
            pg8::gemm_phase<pg8::EpiIn, pg8::StaticOrder, true, true>(lds, g, S, E);
        }
        SEAM(pb);
        if (IN_PH(pb + 1)) {
            MixCtx C{Zb, Gt, Yb, p.in[5] + l * 8, p.in[8] + l * 4, p.in[9] + l * 4, p.in[10] + l * 4, p.in[11] + l * 256, ws, ws + WS_KT, ws + WS_VT};
            MlScratch MS{(float*)(ws + WS_MLE), (float*)(ws + WS_MLB), (float*)(ws + WS_MLPM), (float*)(ws + WS_CL), (float*)(ws + WS_NL), (bf16_t*)(ws + WS_CP), (float*)(ws + WS_NP), (float*)(ws + WS_GC), (float*)(ws + WS_EM), (float*)(ws + WS_MP), ctl + 128 + 32 * l, ctl + 192 + 32 * l};
            LAS int* itm = (LAS int*)(lds + 143360);
            float* NF = (float*)(ws + WS_NFX); unsigned* cntF = ctl + 512 + 32 * l; unsigned* qctr = ctl + 64 * l;
            for (;;) {
                __syncthreads();
                if (tid == 0) *itm = (int)atomicAdd(qctr, 1u);
                __syncthreads();
                const int it = *itm;
                if (it >= N_ITEMS) break;
                constexpr int Q_ML1 = N_FX0, Q_ML2 = Q_ML1 + N_ML1, Q_FOXA = Q_ML2 + N_ML2, N_FOXA = 256, Q_ML3 = Q_FOXA + N_FOXA, Q_FOXB = Q_ML3 + N_ML3, Q_SWA = Q_FOXB + (N_FOX - N_FOXA);
                static_assert(Q_SWA + N_SWA == N_ITEMS, "queue map");
                if (it < Q_ML1) fx0_item(C, NF, cntF, it, lds);
                else if (it < Q_ML2) { const int k = it - Q_ML1; ml1_item(C, MS, k >> 3, k & 7, lds); }
                else if (it < Q_FOXA) { const int k = it - Q_ML2; ml2_item(C, MS, k >> 1, k & 1, lds); }
                else if (it < Q_ML3) {
                    if (tid == 0) { const unsigned x = xb_xcc_id() & 7u; int sel = 0;
                        for (unsigned t = 0; t < 8u; ++t) { const unsigned q = (x + t) & 7u; const unsigned j = atomicAdd(ctl + 640 + 16 * l + q, 1u); if (j < 32u) { sel = (int)(q * 32u + j); break; } }
                        itm[1] = sel; }
                    __syncthreads();
                    const int k = itm[1];
                    fox_item(C, NF, cntF, k >> 4, k & 15, lds); }
                else if (it < Q_FOXB) { const int k = it - Q_ML3; ml3_item(C, MS, k >> 4, k & 15, lds); }
                else if (it < Q_SWA) { const int k = it - Q_FOXB + N_FOXA; fox_item(C, NF, cntF, k & 15, k >> 4, lds); }
                else swa_item(C, it - Q_SWA, lds);
            }
        }
        SEAM(pb + 1);
        if (IN_PH(pb + 2)) {
            pg8::Gemm g{Yb, (const bf16_t*)(ws + WS_WOUT + l * WOUT_L), MTOK, DMODEL, DMODEL}; pg8::StaticOrder S; S.init(MTOK, DMODEL, G, bx, WGM_P3);
            pg8::EpiRes E{XG, SSQ2, nullptr, nullptr};
            pg8::gemm_phase<pg8::EpiRes, pg8::StaticOrder, true, true>(lds, g, S, E);
        }
        SEAM(pb + 2);
        if (IN_PH(pb + 3)) {
            pg8::Gemm g{XG, (const bf16_t*)(ws + WS_WFF1 + l * WFF_L), MTOK, DFF, DMODEL}; pg8::StaticOrder S; S.init(MTOK, DFF, G, bx, WGM_P4);
            pg8::EpiFF1 E{Hb};
            pg8::gemm_phase<pg8::EpiFF1, pg8::StaticOrder, true, true>(lds, g, S, E);
        }
        SEAM(pb + 3);
        if (IN_PH(pb + 4)) {
            pg8::Gemm g{Hb, (const bf16_t*)(ws + WS_WFF2 + l * WFF_L), MTOK, DMODEL, DFF}; pg8::StaticOrder S; S.init(MTOK, DMODEL, G, bx, WGM_P5);
            pg8::EpiRes E{XG, SSQ, l + 1 == DEPTH ? p.out : nullptr, SSQ2};
            pg8::gemm_phase<pg8::EpiRes, pg8::StaticOrder, true, true>(lds, g, S, E);
        }
        SEAM(pb + 4);
    }
#undef IN_PH
#undef SEAM
}

constexpr int N_PHASES = 1 + 5 * DEPTH;
#ifndef MK_MULTI
#define MK_MULTI 0
#endif
extern "C" void kernel_launch(void* const* d_in, const int* in_sizes, int n_in, void* d_out, int out_size, void* d_ws, size_t ws_size, hipStream_t stream) {
    static int grid = 0;
    if (grid == 0) {
        if (n_in != 16 || out_size != MTOK * DMODEL || ws_size < WS_END) { fprintf(stderr, "kernel_launch: unexpected shapes (n_in %d out %d ws %zu)\n", n_in, out_size, ws_size); grid = -1; return; }
        int dev = 0, cus = 0, per_cu = 0;
        hipGetDevice(&dev); hipDeviceGetAttribute(&cus, hipDeviceAttributeMultiprocessorCount, dev);
        if (hipFuncSetAttribute((const void*)fwd_megakernel, hipFuncAttributeMaxDynamicSharedMemorySize, LDS_BYTES) != hipSuccess) { fprintf(stderr, "kernel_launch: hipFuncSetAttribute failed\n"); grid = -1; return; }
        if (hipOccupancyMaxActiveBlocksPerMultiprocessor(&per_cu, (const void*)fwd_megakernel, 512, LDS_BYTES) != hipSuccess || per_cu < 1) { fprintf(stderr, "kernel_launch: occupancy query says %d\n", per_cu); per_cu = 1; }
        (void)hipGetLastError();
        grid = cus;
        if (grid != 256) fprintf(stderr, "kernel_launch: %d CUs (expected 256)\n", grid);
    }
    if (grid < 0) return;
    hipMemsetAsync((char*)d_ws + WS_CTL, 0, CTL_BYTES, stream);
    Params a{};
    for (int i = 0; i < 16; ++i) a.in[i] = (const float*)d_in[i];
    a.out = (float*)d_out; a.ws = (unsigned char*)d_ws;
#if MK_MULTI
    for (int ph = 0; ph < N_PHASES; ++ph) { a.ph_lo = ph; a.ph_hi = ph + 1; hipLaunchKernelGGL(fwd_megakernel, dim3(grid), dim3(512), LDS_BYTES, stream, a); }
#else
    a.ph_lo = 0; a.ph_hi = N_PHASES;
    void* args[] = {&a};
    hipError_t e = hipLaunchCooperativeKernel((const void*)fwd_megakernel, dim3(grid), dim3(512), args, LDS_BYTES, stream);
    if (e != hipSuccess) fprintf(stderr, "cooperative launch failed: %s (grid %d)\n", hipGetErrorString(e), grid);
#endif
}
```

```cpp
#include <hip/hip_runtime.h>
#include <hip/hip_cooperative_groups.h>
#include <cstdio>
#include <cstdint>
#include <cmath>
namespace cg = cooperative_groups;
namespace pg8 {
#define PG8_LAS __attribute__((address_space(3)))
typedef unsigned short bf16_t;
typedef short bf16x8 __attribute__((ext_vector_type(8)));
typedef float f32x4 __attribute__((ext_vector_type(4)));
typedef unsigned u32x4 __attribute__((ext_vector_type(4)));
constexpr int BM = 256, BK = 64, HALF = 128, HTB = HALF * BK * 2  , STAGE_BYTES = 8 * HTB, NXCD = 8;

__host__ __device__ __forceinline__ int lds_byte(int r, int c) { const int st = (r >> 4) * 2 + (c >> 5), rr = r & 15, cc = c & 31, ob = rr * 64 + cc * 2; return st * 1024 + (ob ^ (((ob >> 9) & 1) << 5)); }
__host__ __device__ __forceinline__ void stage_rc(int b, int& R, int& C) { const int st = b / 1024, sb = b % 1024, swz = sb ^ (((sb >> 9) & 1) << 5); R = (st >> 1) * 16 + swz / 64; C = (st & 1) * 32 + (swz % 64) / 2; }
__host__ __device__ __forceinline__ int perm32(int rho) { const int n = rho >> 4, i = rho & 15; return 8 * (i >> 2) + 4 * n + (i & 3); }

struct Unit { int pm, pn; };
struct Gemm { const bf16_t* A; const bf16_t* Bt; int M, N, K; };

struct StaticOrder {
    int nM, nN, nwg, G, c, WGM;
    __host__ __device__ void init(int M, int N, int G_, int c_, int wgm_ = 4) { nM = M / BM; nN = N / BM; nwg = nM * nN; G = G_; c = c_; WGM = wgm_; }
    __host__ __device__ bool next(int i, Unit& u) const {
        const long L = (long)i * G + c; if (L >= nwg) return false;
        int wgid = (int)L; { const int q = nwg / NXCD, r = nwg % NXCD, xcd = wgid % NXCD, off = wgid / NXCD; wgid = (xcd < r ? xcd * (q + 1) : r * (q + 1) + (xcd - r) * q) + off; }
        const int nig = WGM * nN, gid = wgid / nig, fm = gid * WGM, gsz = (nM - fm) < WGM ? (nM - fm) : WGM;
        u.pm = fm + ((wgid % nig) % gsz); u.pn = (wgid % nig) / gsz; return true;
    }
    __device__ __forceinline__ void a_ready(const Unit&) const {}
    __device__ __forceinline__ void done(const Unit&) const {}
};

__device__ __forceinline__ unsigned cvt_pk_bf16(float lo, float hi) { unsigned r; asm volatile("v_cvt_pk_bf16_f32 %0, %1, %2" : "=v"(r) : "v"(lo), "v"(hi)); return r; }
constexpr float EPS = 1e-6f;
constexpr float LOG2E = 1.4426950408889634f;
constexpr float C2 = 0.125f * LOG2E;
constexpr int ZP = 2560;

__device__ __forceinline__ float row_rstd(const float* ssq, int row, int fq) {
    const float* sp = ssq + (size_t)row * 32 + fq * 8;
    const f32x4 s0 = *(const f32x4*)sp, s1 = *(const f32x4*)(sp + 4);
    float t = ((s0[0] + s0[1]) + (s0[2] + s0[3])) + ((s1[0] + s1[1]) + (s1[2] + s1[3]));
    t += __shfl_xor(t, 16); t += __shfl_xor(t, 32);
    return rsqrtf(t * (1.0f / 1024.0f) + EPS);
}

struct EpiIn {
    static constexpr bool PERM = true, AFTER_DRAIN = false;
    bf16_t* Z; float* G; const float* ssq; const float* ropec; const float* ropes; const float* gqa; const float* gka; const float* gqb; const float* gkb;
    unsigned char* KT; unsigned char* VT;
    __device__ __forceinline__ void operator()(const f32x4 (&acc)[2][2][4][2], const Unit& u, int wr, int wc, int fr, int fq) const {
        const int pn = u.pn;
        int type = 0; const float* gsel = gqa; bool rp = false; float sc = 1.f;
        if (pn < 2) { type = 1; gsel = gqa; rp = true; sc = C2; }
        else if (pn == 2) { if (wc < 2) { type = 1; gsel = gka; rp = true; } }
        else if (pn == 3) { type = 1; gsel = gqb; sc = C2; }
        else if (pn == 4) { type = 1; gsel = gkb; }
        else if (pn == 7) { sc = 0.125f; }
        else if (pn == 9) { type = 2; }
        else if (pn == 10) { type = 3; }
        if (type == 3 && wc != 0) return;
        const int dcol = 8 * fq;
        unsigned char* tp = nullptr;
        if (pn == 4 || pn == 5) { const size_t tb0 = (size_t)((((u.pm * BM) >> 12) * 4 + wc) * 64 + (((u.pm * BM) & 4095) >> 6) + wr) * 8192;
            tp = pn == 4 ? KT + tb0 + fq * 1024 + fr * 16 : VT + tb0 + (fr * 4 + fq) * 16; }
        float gn[2][8];
#pragma unroll
        for (int bj = 0; bj < 2; ++bj)
#pragma unroll
            for (int i = 0; i < 8; ++i) gn[bj][i] = (type == 1) ? gsel[32 * bj + dcol + i] : 1.f;
#pragma unroll
        for (int ai = 0; ai < 2; ++ai)
#pragma unroll
            for (int m = 0; m < 4; ++m) {
                const int row = u.pm * BM + ai * HALF + wr * 64 + m * 16 + fr;
                const float rstd = ssq[row];
                float v[2][8];
#pragma unroll
                for (int bj = 0; bj < 2; ++bj)
#pragma unroll
                    for (int n = 0; n < 2; ++n)
#pragma unroll
                        for (int e = 0; e < 4; ++e) v[bj][4 * n + e] = acc[ai][bj][m][n][e] * rstd;
                if (type == 1) {
                    float ss = 0.f;
#pragma unroll
                    for (int bj = 0; bj < 2; ++bj)
#pragma unroll
                        for (int i = 0; i < 8; ++i) ss += v[bj][i] * v[bj][i];
                    ss += __shfl_xor(ss, 16); ss += __shfl_xor(ss, 32);
                    const float hr = rsqrtf(ss * (1.0f / 64.0f) + EPS);
#pragma unroll
                    for (int bj = 0; bj < 2; ++bj)
#pragma unroll
                        for (int i = 0; i < 8; ++i) v[bj][i] *= hr * gn[bj][i];
                    if (rp) {
                        const int pos = row & 4095;
                        const f32x4 c0 = *(const f32x4*)(ropec + pos * 32 + dcol), c1 = *(const f32x4*)(ropec + pos * 32 + dcol + 4);
                        const f32x4 s0 = *(const f32x4*)(ropes + pos * 32 + dcol), s1 = *(const f32x4*)(ropes + pos * 32 + dcol + 4);
#pragma unroll
                        for (int i = 0; i < 8; ++i) {
                            const float c = i < 4 ? c0[i & 3] : c1[i & 3], s = i < 4 ? s0[i & 3] : s1[i & 3];
                            const float x1 = v[0][i], x2 = v[1][i];
                            v[0][i] = x1 * c - x2 * s; v[1][i] = x2 * c + x1 * s;
                        }
                    }
#pragma unroll
                    for (int bj = 0; bj < 2; ++bj)
#pragma unroll
                        for (int i = 0; i < 8; ++i) v[bj][i] *= sc;
                } else if (type == 2) {
#pragma unroll
                    for (int bj = 0; bj < 2; ++bj)
#pragma unroll
                        for (int i = 0; i < 8; ++i) v[bj][i] = 1.0f / (1.0f + __expf(-v[bj][i]));
                } else if (type == 0) {
#pragma unroll
                    for (int bj = 0; bj < 2; ++bj)
#pragma unroll
                        for (int i = 0; i < 8; ++i) v[bj][i] *= sc;
                }
                if (type == 3) {
                    float* gp = G + row;
                    if (fq == 0) {
#pragma unroll
                        for (int i = 0; i < 8; ++i) gp[(size_t)i * 16384] = v[0][i]; }
                    else if (fq == 1) {
#pragma unroll
                        for (int i = 0; i < 4; ++i) gp[(size_t)(8 + i) * 16384] = v[0][i]; }
                } else {
#pragma unroll
                    for (int bj = 0; bj < 2; ++bj) {
                        u32x4 w; w.x = cvt_pk_bf16(v[bj][0], v[bj][1]); w.y = cvt_pk_bf16(v[bj][2], v[bj][3]); w.z = cvt_pk_bf16(v[bj][4], v[bj][5]); w.w = cvt_pk_bf16(v[bj][6], v[bj][7]);
                        if (pn == 4) *(u32x4*)(tp + ai * 16384 + bj * 4096 + m * 256) = w;
                        else if (pn == 5) *(u32x4*)(tp + ai * 16384 + bj * 4096 + m * 1024) = w;
                        else
                        *(u32x4*)(Z + (size_t)row * ZP + 256 * pn + 64 * wc + 32 * bj + dcol) = w;
                    }
                }
                if (m & 1) asm volatile("" ::: "memory");
            }
    }
};

struct EpiRes {
    static constexpr bool PERM = true, AFTER_DRAIN = false;
    bf16_t* XB; float* ssq; float* out; const float* rsq;
    __device__ __forceinline__ void operator()(const f32x4 (&acc)[2][2][4][2], const Unit& u, int wr, int wc, int fr, int fq) const {
        float r2[8];
#pragma unroll
        for (int j = 0; j < 8; ++j) r2[j] = 1.f;
        if (rsq) {
#pragma unroll
            for (int j = 0; j < 8; ++j) { const float r = row_rstd(rsq, u.pm * BM + (j >> 2) * HALF + wr * 64 + (j & 3) * 16 + fr, fq); r2[j] = r * r; }
        }
#pragma unroll
        for (int bj = 0; bj < 2; ++bj) {
            const int col0 = u.pn * BM + bj * HALF + wc * 32 + 8 * fq;
#pragma unroll
            for (int ai = 0; ai < 2; ++ai)
#pragma unroll
                for (int m = 0; m < 4; ++m) {
                    const int row = u.pm * BM + ai * HALF + wr * 64 + m * 16 + fr;
                    const size_t off = (size_t)row * 1024 + col0;
                    const u32x4 bw = *(const u32x4*)(XB + off);
                    f32x4 x0 = acc[ai][bj][m][0] * r2[ai * 4 + m], x1 = acc[ai][bj][m][1] * r2[ai * 4 + m];
                    x0[0] += __builtin_bit_cast(float, bw.x << 16); x0[1] += __builtin_bit_cast(float, bw.x & 0xffff0000u);
                    x0[2] += __builtin_bit_cast(float, bw.y << 16); x0[3] += __builtin_bit_cast(float, bw.y & 0xffff0000u);
                    x1[0] += __builtin_bit_cast(float, bw.z << 16); x1[1] += __builtin_bit_cast(float, bw.z & 0xffff0000u);
                    x1[2] += __builtin_bit_cast(float, bw.w << 16); x1[3] += __builtin_bit_cast(float, bw.w & 0xffff0000u);
                    if (out) { *(f32x4*)(out + off) = x0; *(f32x4*)(out + off + 4) = x1; }
                    else {
                        float ss = ((x0[0] * x0[0] + x0[1] * x0[1]) + (x0[2] * x0[2] + x0[3] * x0[3])) + ((x1[0] * x1[0] + x1[1] * x1[1]) + (x1[2] * x1[2] + x1[3] * x1[3]));
                        ss += __shfl_xor(ss, 16); ss += __shfl_xor(ss, 32);
                        if (fq == 0) ssq[(size_t)row * 32 + u.pn * 8 + bj * 4 + wc] = ss;
                        u32x4 w; w.x = cvt_pk_bf16(x0[0], x0[1]); w.y = cvt_pk_bf16(x0[2], x0[3]); w.z = cvt_pk_bf16(x1[0], x1[1]); w.w = cvt_pk_bf16(x1[2], x1[3]);
                        *(u32x4*)(XB + off) = w;
                    }
                }
        }
    }
};

struct EpiFF1 {
    static constexpr bool PERM = true, AFTER_DRAIN = false;
    bf16_t* H;
    __device__ __forceinline__ void operator()(const f32x4 (&acc)[2][2][4][2], const Unit& u, int wr, int wc, int fr, int fq) const {
#pragma unroll
        for (int ai = 0; ai < 2; ++ai)
#pragma unroll
            for (int m = 0; m < 4; ++m) {
                const int row = u.pm * BM + ai * HALF + wr * 64 + m * 16 + fr;
#pragma unroll
                for (int bj = 0; bj < 2; ++bj) {
                    const int col0 = u.pn * BM + bj * HALF + wc * 32 + 8 * fq;
                    f32x4 a = acc[ai][bj][m][0], b = acc[ai][bj][m][1];
#pragma unroll
                    for (int e = 0; e < 4; ++e) { a[e] = fmaxf(a[e], 0.f); a[e] *= a[e]; b[e] = fmaxf(b[e], 0.f); b[e] *= b[e]; }
                    u32x4 w; w.x = cvt_pk_bf16(a[0], a[1]); w.y = cvt_pk_bf16(a[2], a[3]); w.z = cvt_pk_bf16(b[0], b[1]); w.w = cvt_pk_bf16(b[2], b[3]);
                    *(u32x4*)(H + (size_t)row * 4096 + col0) = w;
                }
            }
    }
};

template <class Epi, class Sched, bool ALIGN_EPI = false, bool SP2 = false>
__device__ __forceinline__ void gemm_phase(PG8_LAS unsigned char* lds, const Gemm g, const Sched& S, const Epi& E) {
    int tid_ = threadIdx.x; asm volatile("" : "+v"(tid_));
    const int tid = tid_, wid = __builtin_amdgcn_readfirstlane(tid >> 6), lane = tid & 63, wr = wid >> 2, wc = wid & 3, fr = lane & 15, fq = lane >> 4;
    const int K = g.K, nt = K / BK;
    unsigned voffA[2], voffB[2];
#pragma unroll
    for (int i = 0; i < 2; ++i) { int R, C; stage_rc(tid * 16 + i * 8192, R, C); const int Rb = Epi::PERM ? ((R & ~31) + perm32(R & 31)) : R;
        voffA[i] = (unsigned)(R * K + C) * 2u; voffB[i] = (unsigned)(Rb * K + C) * 2u; }
    const size_t kstep = (size_t)(BK * 2);
    const size_t hstep = (size_t)HALF * K * 2;
    const size_t tstep = 2 * hstep;
    const unsigned ldsw = (unsigned)wid * 1024u;
    const int aoff = lds_byte(wr * 64 + fr, fq * 8), boff = lds_byte(wc * 32 + fr, fq * 8);
#define PG8_SA(b, h) (((b) * 2 + (h)) * HTB)
#define PG8_SB(b, h) ((4 + (b) * 2 + (h)) * HTB)
#define PG8_STAGE(bufoff, gbase, voff) do { _Pragma("unroll") for (int _i = 0; _i < 2; ++_i) \
        __builtin_amdgcn_global_load_lds((const unsigned*)((const char*)(gbase) + (voff)[_i]), (PG8_LAS unsigned*)(lds + (bufoff) + ldsw + _i * 8192), 16, 0, 0); } while (0)
#define PG8_LDA(dst, b, h) do { _Pragma("unroll") for (int m = 0; m < 4; ++m) _Pragma("unroll") for (int k = 0; k < 2; ++k) dst[m][k] = *(const PG8_LAS bf16x8*)(lds + PG8_SA(b, h) + aoff + m * 2048 + k * 1024); } while (0)
#define PG8_LDB(dst, b, h) do { _Pragma("unroll") for (int n = 0; n < 2; ++n) _Pragma("unroll") for (int k = 0; k < 2; ++k) dst[n][k] = *(const PG8_LAS bf16x8*)(lds + PG8_SB(b, h) + boff + n * 2048 + k * 1024); } while (0)
#define PG8_MMA(ai, bj, At, Bt) do { __builtin_amdgcn_s_setprio(1); _Pragma("unroll") for (int m = 0; m < 4; ++m) _Pragma("unroll") for (int n = 0; n < 2; ++n) _Pragma("unroll") for (int k = 0; k < 2; ++k) \
        acc[ai][bj][m][n] = __builtin_amdgcn_mfma_f32_16x16x32_bf16(Bt[n][k], At[m][k], acc[ai][bj][m][n], 0, 0, 0); __builtin_amdgcn_s_setprio(0); } while (0)
#define PG8_WAIT_V(n) asm volatile("s_waitcnt vmcnt(" #n ")" ::: "memory")
#define PG8_WAIT_L(n) asm volatile("s_waitcnt lgkmcnt(" #n ")" ::: "memory")
#define PG8_BAR __builtin_amdgcn_s_barrier()
#define PG8_SCHED __builtin_amdgcn_sched_barrier(0)
    Unit cur, nxt; int ui = 0;
    if (!S.next(0, cur)) return;
    f32x4 acc[2][2][4][2];
#pragma unroll
    for (int a = 0; a < 2; ++a)
#pragma unroll
        for (int b = 0; b < 2; ++b)
#pragma unroll
            for (int m = 0; m < 4; ++m)
#pragma unroll
                for (int n = 0; n < 2; ++n) acc[a][b][m][n] = (f32x4){0.f, 0.f, 0.f, 0.f};
    bf16x8 At[4][2], B0[2][2], B1[2][2];
    const char* cA = (const char*)g.A + (size_t)cur.pm * tstep; const char* cB = (const char*)g.Bt + (size_t)cur.pn * tstep;
    S.a_ready(cur);
    if constexpr (SP2) {
        PG8_STAGE(PG8_SB(0, 0), cB, voffB); PG8_STAGE(PG8_SB(0, 1), cB + hstep, voffB); PG8_STAGE(PG8_SA(0, 0), cA, voffA); PG8_STAGE(PG8_SA(0, 1), cA + hstep, voffA);
        if (wr == 1) PG8_BAR;
        PG8_WAIT_V(2); PG8_BAR;
        PG8_STAGE(PG8_SB(1, 0), cB + kstep, voffB); PG8_STAGE(PG8_SA(1, 0), cA + kstep, voffA); PG8_STAGE(PG8_SB(1, 1), cB + hstep + kstep, voffB);
        PG8_WAIT_V(6); PG8_BAR;
    } else {
        PG8_STAGE(PG8_SB(0, 0), cB, voffB); PG8_STAGE(PG8_SA(0, 0), cA, voffA); PG8_STAGE(PG8_SB(0, 1), cB + hstep, voffB); PG8_STAGE(PG8_SA(0, 1), cA + hstep, voffA);
        if (wr == 1) PG8_BAR;
        PG8_WAIT_V(4); PG8_BAR;
        PG8_STAGE(PG8_SB(1, 0), cB + kstep, voffB); PG8_STAGE(PG8_SA(1, 0), cA + kstep, voffA); PG8_STAGE(PG8_SB(1, 1), cB + hstep + kstep, voffB);
        PG8_WAIT_V(6); PG8_BAR;
    }
    for (;;) {
        const bool has_next = S.next(ui + 1, nxt);
        const char* nA = has_next ? (const char*)g.A + (size_t)nxt.pm * tstep : cA; const char* nB = has_next ? (const char*)g.Bt + (size_t)nxt.pn * tstep : cB;
        for (int t = 0; t < nt; t += 2) {
            const bool last = (t == nt - 2);
            const char* a1 = cA + (size_t)(t + 1) * kstep;
            const char* a2 = last ? nA : cA + (size_t)(t + 2) * kstep; const char* b2 = last ? nB : cB + (size_t)(t + 2) * kstep;
            const char* a3 = a2 + kstep; const char* b3 = b2 + kstep;
            if (last && has_next) S.a_ready(nxt);
            if constexpr (SP2) {
            PG8_LDB(B0, 0, 0); PG8_LDB(B1, 0, 1); PG8_SCHED; PG8_LDA(At, 0, 0); PG8_STAGE(PG8_SA(1, 1), a1 + hstep, voffA);
            PG8_WAIT_V(8); PG8_WAIT_L(0); PG8_BAR; PG8_MMA(0, 0, At, B0); PG8_MMA(0, 1, At, B1); PG8_BAR; PG8_SCHED;
            PG8_LDA(At, 0, 1); PG8_STAGE(PG8_SB(0, 0), b2, voffB); PG8_STAGE(PG8_SB(0, 1), b2 + hstep, voffB); PG8_STAGE(PG8_SA(0, 0), a2, voffA);
            PG8_WAIT_V(8); PG8_WAIT_L(0); PG8_BAR; PG8_MMA(1, 0, At, B0); PG8_MMA(1, 1, At, B1); PG8_BAR; PG8_SCHED;
            PG8_LDB(B0, 1, 0); PG8_LDB(B1, 1, 1); PG8_SCHED; PG8_LDA(At, 1, 0); PG8_STAGE(PG8_SA(0, 1), a2 + hstep, voffA);
            PG8_WAIT_V(8); PG8_WAIT_L(0); PG8_BAR; PG8_MMA(0, 0, At, B0); PG8_MMA(0, 1, At, B1); PG8_BAR; PG8_SCHED;
            PG8_LDA(At, 1, 1); PG8_STAGE(PG8_SB(1, 0), b3, voffB); PG8_STAGE(PG8_SB(1, 1), b3 + hstep, voffB); PG8_STAGE(PG8_SA(1, 0), a3, voffA);
            PG8_WAIT_V(8); PG8_WAIT_L(0); PG8_BAR; PG8_MMA(1, 0, At, B0); PG8_MMA(1, 1, At, B1); PG8_BAR; PG8_SCHED;
            } else {
            PG8_LDB(B0, 0, 0); PG8_SCHED; PG8_LDA(At, 0, 0); PG8_STAGE(PG8_SA(1, 1), a1 + hstep, voffA);
            PG8_WAIT_L(8); PG8_BAR; PG8_WAIT_L(0); PG8_MMA(0, 0, At, B0); PG8_BAR; PG8_SCHED;
            PG8_LDB(B1, 0, 1); PG8_STAGE(PG8_SB(0, 0), b2, voffB);
            PG8_BAR; PG8_WAIT_L(0); PG8_MMA(0, 1, At, B1); PG8_BAR;
            PG8_LDA(At, 0, 1); PG8_STAGE(PG8_SA(0, 0), a2, voffA);
            PG8_BAR; PG8_WAIT_L(0); PG8_MMA(1, 0, At, B0); PG8_BAR; PG8_SCHED;
            PG8_STAGE(PG8_SB(0, 1), b2 + hstep, voffB);
            PG8_WAIT_V(6); PG8_BAR; PG8_MMA(1, 1, At, B1); PG8_BAR;
            PG8_LDB(B0, 1, 0); PG8_SCHED; PG8_LDA(At, 1, 0); PG8_STAGE(PG8_SA(0, 1), a2 + hstep, voffA);
            PG8_WAIT_L(8); PG8_BAR; PG8_WAIT_L(0); PG8_MMA(0, 0, At, B0); PG8_BAR; PG8_SCHED;
            PG8_LDB(B1, 1, 1); PG8_STAGE(PG8_SB(1, 0), b3, voffB);
            PG8_BAR; PG8_WAIT_L(0); PG8_MMA(0, 1, At, B1); PG8_BAR;
            PG8_LDA(At, 1, 1); PG8_STAGE(PG8_SA(1, 0), a3, voffA);
            PG8_BAR; PG8_WAIT_L(0); PG8_MMA(1, 0, At, B0); PG8_BAR; PG8_SCHED;
            PG8_STAGE(PG8_SB(1, 1), b3 + hstep, voffB);
            PG8_WAIT_V(6); PG8_BAR; PG8_MMA(1, 1, At, B1); PG8_BAR;
            }
        }
        if constexpr (ALIGN_EPI) { if (wr == 0) PG8_BAR; }
        if constexpr (!Epi::AFTER_DRAIN) { E(acc, cur, wr, wc, fr, fq); S.done(cur); }
        if (!has_next) break;
#pragma unroll
        for (int a = 0; a < 2; ++a)
#pragma unroll
            for (int b = 0; b < 2; ++b)
#pragma unroll
                for (int m = 0; m < 4; ++m)
#pragma unroll
                    for (int n = 0; n < 2; ++n) acc[a][b][m][n] = (f32x4){0.f, 0.f, 0.f, 0.f};
        cur = nxt; cA = nA; cB = nB; ++ui;
        if constexpr (ALIGN_EPI) { if (wr == 1) PG8_BAR; }
    }
    PG8_WAIT_V(0);
    if constexpr (!ALIGN_EPI) { if (wr == 0) PG8_BAR; }
    PG8_BAR;
    if constexpr (Epi::AFTER_DRAIN) { E.fused(acc, cur, wr, wc, fr, fq, lds, wid, lane); S.done(cur); }
#undef PG8_SA
#undef PG8_SB
#undef PG8_STAGE
#undef PG8_LDA
#undef PG8_LDB
#undef PG8_MMA
#undef PG8_WAIT_V
#undef PG8_WAIT_L
#undef PG8_BAR
#undef PG8_SCHED
}
}
#define LAS __attribute__((address_space(3)))
typedef unsigned short bf16_t;
typedef short bf16x8 __attribute__((ext_vector_type(8)));
typedef short s16x4 __attribute__((ext_vector_type(4)));
typedef float f32x4 __attribute__((ext_vector_type(4)));
typedef float f32x16 __attribute__((ext_vector_type(16)));
typedef unsigned u32x4 __attribute__((ext_vector_type(4)));
typedef unsigned u32x2 __attribute__((ext_vector_type(2)));
using pg8::ZP; using pg8::LOG2E; using pg8::EPS;
__device__ __forceinline__ int crow(int r, int hi) { return (r & 3) + 8 * (r >> 2) + 4 * hi; }
__device__ __forceinline__ unsigned cvtpk(float lo, float hi) { unsigned r; asm volatile("v_cvt_pk_bf16_f32 %0, %1, %2" : "=v"(r) : "v"(lo), "v"(hi)); return r; }
__device__ __forceinline__ unsigned f2bf(float f) { unsigned u = __builtin_bit_cast(unsigned, f); return (u + 0x7fffu + ((u >> 16) & 1u)) >> 16; }
__device__ __forceinline__ float bf2f(unsigned short h) { return __builtin_bit_cast(float, (unsigned)h << 16); }
__device__ __forceinline__ float ex2(float x) { return __builtin_amdgcn_exp2f(x); }
#define VM_WAIT0() asm volatile("s_waitcnt vmcnt(0)" ::: "memory")
#define LGKM_WAIT0() asm volatile("s_waitcnt lgkmcnt(0)" ::: "memory")

__device__ __forceinline__ void dma_k(LAS unsigned char* slot, const bf16_t* src, int pitch, int w, int lane) {
    const bf16_t* s = src + (size_t)lane * pitch + w * 8;
    __builtin_amdgcn_global_load_lds((const unsigned*)s, (LAS unsigned*)(slot + w * 1024), 16, 0, 0);
}
__device__ __forceinline__ void dma_v(LAS unsigned char* slot, const bf16_t* src, int pitch, int w, int lane) {
    const bf16_t* s = src + (size_t)(16 * (w & 3) + (lane >> 2)) * pitch + (w >> 2) * 32 + (lane & 3) * 8;
    __builtin_amdgcn_global_load_lds((const unsigned*)s, (LAS unsigned*)(slot + w * 1024), 16, 0, 0);
}
__device__ __forceinline__ void dma_lin(LAS unsigned char* slot, const unsigned char* src, int w, int lane) {
    __builtin_amdgcn_global_load_lds((const unsigned*)(src + w * 1024 + lane * 16), (LAS unsigned*)(slot + w * 1024), 16, 0, 0);
}
__device__ __forceinline__ void qkt(f32x16& p0, f32x16& p1, const LAS unsigned char* Kslot, const bf16x8* qr, int r32, int hi, f32x16 z0 = f32x16{}, f32x16 z1 = f32x16{}) {
    const LAS unsigned char* kb = Kslot + hi * 1024 + r32 * 16;
#pragma unroll
    for (int d0 = 0; d0 < 4; ++d0) {
        const bf16x8 b0 = *(const LAS bf16x8*)(kb + d0 * 2048);
        const bf16x8 b1 = *(const LAS bf16x8*)(kb + d0 * 2048 + 512);
        z0 = __builtin_amdgcn_mfma_f32_32x32x16_bf16(b0, qr[d0], z0, 0, 0, 0);
        z1 = __builtin_amdgcn_mfma_f32_32x32x16_bf16(b1, qr[d0], z1, 0, 0, 0);
    }
    p0 = z0; p1 = z1;
}
__device__ __forceinline__ int vt_lane_off(int lane) { const int hi = lane >> 5; return ((lane >> 4) & 1) * 32 + (lane & 3) * 8 + (4 * hi + ((lane & 15) >> 2)) * 64; }
__device__ __forceinline__ bf16x8 vfrag(int vb, int d0, int ks) {
    s16x4 lo, hh;
    asm volatile("ds_read_b64_tr_b16 %0, %1" : "=v"(lo) : "v"(vb + d0 * 4096 + ks * 1024) : "memory");
    asm volatile("ds_read_b64_tr_b16 %0, %1" : "=v"(hh) : "v"(vb + d0 * 4096 + ks * 1024 + 512) : "memory");
    asm volatile("s_waitcnt lgkmcnt(0)" : "+v"(lo), "+v"(hh) :: "memory");
    return (bf16x8){lo[0], lo[1], lo[2], lo[3], hh[0], hh[1], hh[2], hh[3]};
}
__device__ __forceinline__ void pv(f32x16* o, int vb, bf16x8 pa0, bf16x8 pa1, bf16x8 pa2, bf16x8 pa3) {
    s16x4 lo[8], hh[8];
#pragma unroll
    for (int i = 0; i < 8; ++i) {
        asm volatile("ds_read_b64_tr_b16 %0, %1 offset:%c2" : "=&v"(lo[i]) : "v"(vb), "i"((i >> 2) * 4096 + (i & 3) * 1024) : "memory");
        asm volatile("ds_read_b64_tr_b16 %0, %1 offset:%c2" : "=&v"(hh[i]) : "v"(vb), "i"((i >> 2) * 4096 + (i & 3) * 1024 + 512) : "memory");
    }
    asm volatile("s_waitcnt lgkmcnt(0)" : "+v"(lo[0]), "+v"(lo[1]), "+v"(lo[2]), "+v"(lo[3]), "+v"(lo[4]), "+v"(lo[5]), "+v"(lo[6]), "+v"(lo[7]),
                 "+v"(hh[0]), "+v"(hh[1]), "+v"(hh[2]), "+v"(hh[3]), "+v"(hh[4]), "+v"(hh[5]), "+v"(hh[6]), "+v"(hh[7]) :: "memory");
#define PVK(k) (bf16x8){lo[k][0], lo[k][1], lo[k][2], lo[k][3], hh[k][0], hh[k][1], hh[k][2], hh[k][3]}
    o[0] = __builtin_amdgcn_mfma_f32_32x32x16_bf16(pa0, PVK(0), o[0], 0, 0, 0);
    o[1] = __builtin_amdgcn_mfma_f32_32x32x16_bf16(pa0, PVK(4), o[1], 0, 0, 0);
    o[0] = __builtin_amdgcn_mfma_f32_32x32x16_bf16(pa1, PVK(1), o[0], 0, 0, 0);
    o[1] = __builtin_amdgcn_mfma_f32_32x32x16_bf16(pa1, PVK(5), o[1], 0, 0, 0);
    o[0] = __builtin_amdgcn_mfma_f32_32x32x16_bf16(pa2, PVK(2), o[0], 0, 0, 0);
    o[1] = __builtin_amdgcn_mfma_f32_32x32x16_bf16(pa2, PVK(6), o[1], 0, 0, 0);
    o[0] = __builtin_amdgcn_mfma_f32_32x32x16_bf16(pa3, PVK(3), o[0], 0, 0, 0);
    o[1] = __builtin_amdgcn_mfma_f32_32x32x16_bf16(pa3, PVK(7), o[1], 0, 0, 0);
#undef PVK
}
#define PACK8(P, B) __builtin_bit_cast(bf16x8, ((u32x4){cvtpk(P[B], P[B + 1]), cvtpk(P[B + 2], P[B + 3]), cvtpk(P[B + 4], P[B + 5]), cvtpk(P[B + 6], P[B + 7])}))
__device__ __forceinline__ void scale_rows(f32x16* o, float f, LAS float* wsf, int r32, int hi) {
    if (hi == 0) wsf[r32] = f;
    LGKM_WAIT0();
#pragma unroll
    for (int r = 0; r < 16; ++r) { const float fr = wsf[crow(r, hi)]; o[0][r] *= fr; o[1][r] *= fr; }
    LGKM_WAIT0();
}
__device__ __forceinline__ float max3f(float x, float y, float z) { return __builtin_fmaxf(__builtin_fmaxf(x, y), z); }
typedef float f32x8 __attribute__((ext_vector_type(8)));
typedef float f32x2 __attribute__((ext_vector_type(2)));
typedef short v4i16_t __attribute__((ext_vector_type(4)));
__device__ __forceinline__ s16x4 vtr(const LAS unsigned char* p) { return __builtin_bit_cast(s16x4, __builtin_amdgcn_ds_read_tr16_b64_v4i16((LAS v4i16_t*)p)); }
__device__ __forceinline__ float rowmax32(const f32x16& p0, const f32x16& p1) {
    float a = max3f(p0[0], p0[1], p1[0]), b = max3f(p0[2], p0[3], p1[1]); a = max3f(a, p1[2], p1[3]);
#pragma unroll
    for (int r = 4; r < 16; r += 4) { a = max3f(a, p0[r], p0[r + 1]); b = max3f(b, p0[r + 2], p0[r + 3]); a = max3f(a, p1[r], p1[r + 1]); b = max3f(b, p1[r + 2], p1[r + 3]); }
    const float m = fmaxf(a, b);
    auto rr = __builtin_amdgcn_permlane32_swap(__builtin_bit_cast(unsigned, m), __builtin_bit_cast(unsigned, m), false, false);
    return fmaxf(__builtin_bit_cast(float, (unsigned)rr[0]), __builtin_bit_cast(float, (unsigned)rr[1]));
}
template <int THR, bool HASF>
__device__ __forceinline__ void attn_step(f32x16& p0, f32x16& p1, f32x16& n0, f32x16& n1, const LAS unsigned char* Knext, const LAS float* Fnext, const LAS unsigned char* Vcur,
                                          const bf16x8* qr, float& mhat, float& l, f32x16* o, LAS float* wsf, int r32, int hi) {
    f32x16 c0 = f32x16{}, c1 = f32x16{};
    if (HASF) {
#pragma unroll
        for (int rr = 0; rr < 4; ++rr) { const f32x4 f0 = *(const LAS f32x4*)(Fnext + 8 * rr), f1 = *(const LAS f32x4*)(Fnext + 32 + 8 * rr);
#pragma unroll
            for (int e = 0; e < 4; ++e) { c0[4 * rr + e] = f0[e]; c1[4 * rr + e] = f1[e]; } }
    }
    bf16x8 kf[8];
    { const LAS unsigned char* kb = Knext + hi * 1024 + r32 * 16;
#pragma unroll
      for (int d0 = 0; d0 < 4; ++d0) { kf[2 * d0] = *(const LAS bf16x8*)(kb + d0 * 2048); kf[2 * d0 + 1] = *(const LAS bf16x8*)(kb + d0 * 2048 + 512); } }
    __builtin_amdgcn_sched_barrier(0);
    const float rm = rowmax32(p0, p1);
    if (__any(rm > mhat + (float)THR)) {
        const float mnew = fmaxf(mhat, rm), f = ex2(mhat - mnew);
        l *= f; mhat = mnew; scale_rows(o, f, wsf, r32, hi);
    }
#pragma unroll
    for (int d0 = 0; d0 < 4; ++d0) {
        c0 = __builtin_amdgcn_mfma_f32_32x32x16_bf16(kf[2 * d0], qr[d0], c0, 0, 0, 0);
        c1 = __builtin_amdgcn_mfma_f32_32x32x16_bf16(kf[2 * d0 + 1], qr[d0], c1, 0, 0, 0);
    }
    __builtin_amdgcn_sched_barrier(0);
    s16x4 vl[8], vh[8];
#pragma unroll
    for (int i = 0; i < 8; ++i) { vl[i] = vtr(Vcur + (i >> 2) * 4096 + (i & 3) * 1024); vh[i] = vtr(Vcur + (i >> 2) * 4096 + (i & 3) * 1024 + 512); }
    __builtin_amdgcn_sched_barrier(0);
    p0 = p0 - mhat; p1 = p1 - mhat;
#pragma unroll
    for (int r = 0; r < 16; ++r) { p0[r] = ex2(p0[r]); p1[r] = ex2(p1[r]); }
    const f32x16 t = p0 + p1;
    const f32x8 t8 = t.lo + t.hi; const f32x4 t4 = t8.lo + t8.hi; const f32x2 t2 = t4.lo + t4.hi;
    l += t2.x + t2.y;
    const bf16x8 pa0 = PACK8(p0, 0), pa1 = PACK8(p0, 8), pa2 = PACK8(p1, 0), pa3 = PACK8(p1, 8);
#define VFK(k) (bf16x8){vl[k][0], vl[k][1], vl[k][2], vl[k][3], vh[k][0], vh[k][1], vh[k][2], vh[k][3]}
    o[0] = __builtin_amdgcn_mfma_f32_32x32x16_bf16(pa0, VFK(0), o[0], 0, 0, 0);
    o[1] = __builtin_amdgcn_mfma_f32_32x32x16_bf16(pa0, VFK(4), o[1], 0, 0, 0);
    o[0] = __builtin_amdgcn_mfma_f32_32x32x16_bf16(pa1, VFK(1), o[0], 0, 0, 0);
    o[1] = __builtin_amdgcn_mfma_f32_32x32x16_bf16(pa1, VFK(5), o[1], 0, 0, 0);
    o[0] = __builtin_amdgcn_mfma_f32_32x32x16_bf16(pa2, VFK(2), o[0], 0, 0, 0);
    o[1] = __builtin_amdgcn_mfma_f32_32x32x16_bf16(pa2, VFK(6), o[1], 0, 0, 0);
    o[0] = __builtin_amdgcn_mfma_f32_32x32x16_bf16(pa3, VFK(3), o[0], 0, 0, 0);
    o[1] = __builtin_amdgcn_mfma_f32_32x32x16_bf16(pa3, VFK(7), o[1], 0, 0, 0);
#undef VFK
    n0 = c0; n1 = c1;
}
template <int THR>
__device__ __forceinline__ void softmax_pv(f32x16& p0, f32x16& p1, float& mhat, float& l, f32x16* o, int vb, LAS float* wsf, int r32, int hi) {
    float a = max3f(p0[0], p0[1], p1[0]), b = max3f(p0[2], p0[3], p1[1]); a = max3f(a, p1[2], p1[3]);
#pragma unroll
    for (int r = 4; r < 16; r += 4) { a = max3f(a, p0[r], p0[r + 1]); b = max3f(b, p0[r + 2], p0[r + 3]); a = max3f(a, p1[r], p1[r + 1]); b = max3f(b, p1[r + 2], p1[r + 3]); }
    float rm = fmaxf(a, b); rm = fmaxf(rm, __shfl_xor(rm, 32));
    if (__any(rm > mhat + (float)THR)) {
        const float mnew = fmaxf(mhat, rm), f = ex2(mhat - mnew);
        l *= f; mhat = mnew; scale_rows(o, f, wsf, r32, hi);
    }
    p0 = p0 - mhat; p1 = p1 - mhat;
#pragma unroll
    for (int r = 0; r < 16; ++r) { p0[r] = ex2(p0[r]); p1[r] = ex2(p1[r]); }
    const f32x16 t = p0 + p1;
    const f32x8 t8 = t.lo + t.hi; const f32x4 t4 = t8.lo + t8.hi; const f32x2 t2 = t4.lo + t4.hi;
    l += t2.x + t2.y;
    pv(o, vb, PACK8(p0, 0), PACK8(p0, 8), PACK8(p1, 0), PACK8(p1, 8));
}
__device__ __forceinline__ void store_o(const f32x16* o, float rinv, LAS float* wsf, LAS bf16_t* stg, bf16_t* Og, int pitch, int r32, int hi, int lane) {
    if (hi == 0) wsf[32 + r32] = rinv;
    LGKM_WAIT0();
#pragma unroll
    for (int r = 0; r < 16; ++r) { const int orow = crow(r, hi); const float rl = wsf[32 + orow];
#pragma unroll
        for (int d0 = 0; d0 < 2; ++d0) stg[orow * 64 + d0 * 32 + r32] = (bf16_t)f2bf(o[d0][r] * rl); }
    LGKM_WAIT0();
#pragma unroll
    for (int i = 0; i < 4; ++i) { const int row = i * 8 + (lane >> 3), ch = lane & 7; const u32x4 v = *(const LAS u32x4*)(stg + row * 64 + ch * 8); *(u32x4*)(Og + (size_t)row * pitch + ch * 8) = v; }
    LGKM_WAIT0();
}
__device__ __forceinline__ float log_sigmoid(float x) { return fminf(x, 0.f) - log1pf(__expf(-fabsf(x))); }

constexpr int MX_RING = 0, MX_F = 98304, MX_WSF = 114688, MX_WTOT = 116736, MX_STG_SWA = 65536, MX_STG_FOX = 40960;

struct MixCtx {
    const bf16_t* Z; const float* G; bf16_t* Y;
    const float* sinks; const float* fox_fb; const float* ml_ib; const float* ml_fb; const float* ml_norm;
    unsigned char* ws; const unsigned char* KT; const unsigned char* VT;
};

__device__ __forceinline__ void swa_item(const MixCtx& C, int item, LAS unsigned char* lds) {
    int tid_ = threadIdx.x; asm volatile("" : "+v"(tid_));
    const int tid = tid_, lane = tid & 63, w = __builtin_amdgcn_readfirstlane(tid >> 6), r32 = lane & 31, hi = lane >> 5;
    const int jp = item & 31, kvh = (item >> 5) & 1, b = item >> 6;
    const size_t rowbase = (size_t)b * 4096;
    const int cbase = jp >= 1 ? 2 * jp - 2 : 0, ntl = 2 * jp + 2 - cbase;
    const bf16_t* Kb = C.Z + rowbase * ZP + 512 + 64 * kvh; const bf16_t* Vb = C.Z + rowbase * ZP + 640 + 64 * kvh;
    for (int j = 0; j < ntl; ++j) { dma_k(lds + MX_RING + j * 16384, Kb + (size_t)(cbase + j) * 64 * ZP, ZP, w, lane); dma_v(lds + MX_RING + j * 16384 + 8192, Vb + (size_t)(cbase + j) * 64 * ZP, ZP, w, lane); }
    const int hq = 4 * kvh + (w >> 1);
    bf16x8 qra[4], qrb[4];
    { const bf16_t* Qa = C.Z + (rowbase + 128 * jp + 32 * (w & 1) + r32) * ZP + 64 * hq;
#pragma unroll
      for (int d0 = 0; d0 < 4; ++d0) { qra[d0] = *(const bf16x8*)(Qa + 16 * d0 + 8 * hi); qrb[d0] = *(const bf16x8*)(Qa + (size_t)64 * ZP + 16 * d0 + 8 * hi); } }
    LAS float* wsf = (LAS float*)(lds + MX_WSF) + w * 64; LAS bf16_t* stg = (LAS bf16_t*)(lds + MX_STG_SWA + w * 4096);
    const float sink = C.sinks[hq] * LOG2E;
    VM_WAIT0(); __syncthreads();
    const int vlo = vt_lane_off(lane);
#pragma unroll
    for (int cc = 0; cc < 2; ++cc) {
        const int c = 2 * jp + cc, c0 = c >= 2 ? c - 2 : 0, nt = c - c0 + 1, s0 = c0 - cbase, qw0 = 64 * c + 32 * (w & 1);
        const bf16x8* qr = cc == 0 ? qra : qrb;
        float mhat = sink, l = hi == 0 ? 1.f : 0.f; f32x16 o[2]; o[0] = f32x16{}; o[1] = f32x16{};
        f32x16 p0, p1; qkt(p0, p1, lds + MX_RING + s0 * 16384, qr, r32, hi);
        for (int j = 0; j < nt; ++j) {
            f32x16 n0 = p0, n1 = p1;
            if (j + 1 < nt) qkt(n0, n1, lds + MX_RING + (s0 + j + 1) * 16384, qr, r32, hi);
            softmax_pv<8>(p0, p1, mhat, l, o, (int)(uintptr_t)(lds + MX_RING + (s0 + j) * 16384 + 8192) + vlo, wsf, r32, hi);
            p0 = n0; p1 = n1;
        }
        l += __shfl_xor(l, 32);
        store_o(o, 1.0f / l, wsf, stg, C.Y + (rowbase + qw0) * 1024 + 64 * hq, 1024, r32, hi, lane);
    }
    __syncthreads();
}

__device__ __forceinline__ void fx0_item(const MixCtx& C, float* NF, unsigned* cntF, int bh, LAS unsigned char* lds) {
    int tid_ = threadIdx.x; asm volatile("" : "+v"(tid_));
    const int tid = tid_, lane = tid & 63, w = __builtin_amdgcn_readfirstlane(tid >> 6);
    const int b = bh >> 2, h = bh & 3; const size_t rowbase = (size_t)b * 4096;
    LAS float* wtot = (LAS float*)(lds + MX_WTOT);
    const float fb = C.fox_fb[h]; const int t0 = tid * 8; float v[8]; float run = 0.f;
    const f32x4 g0 = *(const f32x4*)(C.G + (size_t)h * 16384 + rowbase + t0), g1 = *(const f32x4*)(C.G + (size_t)h * 16384 + rowbase + t0 + 4);
#pragma unroll
    for (int i = 0; i < 8; ++i) { run += log_sigmoid((i < 4 ? g0[i & 3] : g1[i & 3]) + fb) * LOG2E; v[i] = run; }
    float inc = run;
#pragma unroll
    for (int o_ = 1; o_ < 64; o_ <<= 1) { const float y = __shfl_up(inc, o_); if (lane >= o_) inc += y; }
    if (lane == 63) wtot[w] = inc;
    __syncthreads();
    float off = inc - run;
    for (int j = 0; j < w; ++j) off += wtot[j];
    *(f32x4*)(NF + bh * 4096 + t0) = (f32x4){-(v[0] + off), -(v[1] + off), -(v[2] + off), -(v[3] + off)};
    *(f32x4*)(NF + bh * 4096 + t0 + 4) = (f32x4){-(v[4] + off), -(v[5] + off), -(v[6] + off), -(v[7] + off)};
    asm volatile("s_waitcnt vmcnt(0)" ::: "memory"); __syncthreads();
    if (tid == 0) { __builtin_amdgcn_fence(__ATOMIC_RELEASE, "agent"); asm volatile("s_waitcnt vmcnt(0)" ::: "memory"); __hip_atomic_fetch_add(cntF + bh, 1u, __ATOMIC_RELAXED, __HIP_MEMORY_SCOPE_AGENT); }
    __syncthreads();
}
__device__ __forceinline__ void fox_block(const MixCtx& C, const float* NF, unsigned* cntF, int bh, int qb, LAS unsigned char* lds, bool first) {
    int tid_ = threadIdx.x; asm volatile("" : "+v"(tid_));
    const int tid = tid_, lane = tid & 63, w = __builtin_amdgcn_readfirstlane(tid >> 6), r32 = lane & 31, hi = lane >> 5;
    const int b = bh >> 2, h = bh & 3; const size_t rowbase = (size_t)b * 4096; const int q0 = qb * 128, nkeys = q0 + 128, nst = qb + 1;
    const unsigned char* Kt = C.KT + (size_t)bh * 64 * 8192; const unsigned char* Vt = C.VT + (size_t)bh * 64 * 8192;
#define FOX_STAGE(st_) do { LAS unsigned char* sb_ = lds + MX_RING + ((st_) % 3) * 32768; \
        dma_lin(sb_, Kt + (size_t)(2 * (st_)) * 8192, w, lane); dma_lin(sb_ + 8192, Kt + (size_t)(2 * (st_) + 1) * 8192, w, lane); \
        dma_lin(sb_ + 16384, Vt + (size_t)(2 * (st_)) * 8192, w, lane); dma_lin(sb_ + 24576, Vt + (size_t)(2 * (st_) + 1) * 8192, w, lane); } while (0)
    FOX_STAGE(0); if (nst > 1) FOX_STAGE(1);
    LAS float* F2 = (LAS float*)(lds + MX_F);
    LAS float* wsf = (LAS float*)(lds + MX_WSF) + w * 64; LAS bf16_t* stg = (LAS bf16_t*)(lds + MX_STG_FOX + w * 4096);
    const int g = w >> 2, qw0 = q0 + 32 * (w & 3);
    const bf16_t* Qb = C.Z + (rowbase + qw0 + r32) * ZP + 768 + 64 * h;
    bf16x8 qr[4];
#pragma unroll
    for (int d0 = 0; d0 < 4; ++d0) qr[d0] = *(const bf16x8*)(Qb + 16 * d0 + 8 * hi);
    if (first) {
        if (tid == 0) { while (__hip_atomic_load(cntF + bh, __ATOMIC_RELAXED, __HIP_MEMORY_SCOPE_AGENT) < 1u) __builtin_amdgcn_s_sleep(2); }
        __syncthreads();
    }
    {
        const int t0 = tid * 8;
        if (first && t0 < nkeys) { const unsigned long long* np = (const unsigned long long*)(NF + bh * 4096 + t0); unsigned long long q[4];
#pragma unroll
            for (int i = 0; i < 4; ++i) q[i] = __hip_atomic_load(np + i, __ATOMIC_RELAXED, __HIP_MEMORY_SCOPE_AGENT);
#pragma unroll
            for (int i = 0; i < 4; ++i) *(LAS unsigned long long*)(F2 + t0 + 2 * i) = q[i]; }
    }
    float mhat = -1e30f, l = 0.f; f32x16 o[2]; o[0] = f32x16{}; o[1] = f32x16{};
    VM_WAIT0(); __syncthreads();
    const int vlo = vt_lane_off(lane), qpos = qw0 + r32;
#define FOX_SCORE(st_, P0, P1) do { const int kb_ = 64 * (2 * (st_) + g); const LAS unsigned char* sk_ = lds + MX_RING + ((st_) % 3) * 32768 + g * 8192; f32x16 c0_, c1_; \
        _Pragma("unroll") for (int rr = 0; rr < 4; ++rr) { const f32x4 f0 = *(const LAS f32x4*)(F2 + kb_ + 8 * rr + 4 * hi), f1 = *(const LAS f32x4*)(F2 + kb_ + 32 + 8 * rr + 4 * hi); \
            _Pragma("unroll") for (int e = 0; e < 4; ++e) { c0_[4 * rr + e] = f0[e]; c1_[4 * rr + e] = f1[e]; } } \
        qkt(P0, P1, sk_, qr, r32, hi, c0_, c1_); } while (0)
    f32x16 p0, p1, n0, n1; FOX_SCORE(0, p0, p1);
#define FOX_STEP(PA0, PA1, PB0, PB1, st_) do { if ((st_) + 2 < nst) FOX_STAGE((st_) + 2); \
        attn_step<24, true>(PA0, PA1, PB0, PB1, lds + MX_RING + (((st_) + 1) % 3) * 32768 + g * 8192, F2 + 64 * (2 * ((st_) + 1) + g) + 4 * hi, \
                           lds + MX_RING + ((st_) % 3) * 32768 + 16384 + g * 8192 + vlo, qr, mhat, l, o, wsf, r32, hi); \
        VM_WAIT0(); __syncthreads(); } while (0)
#define FOX_LAST(PA0, PA1) do { const int st = nst - 1, kbase = 64 * (2 * st + g); \
        if (kbase <= qw0 + 31) { \
            if (kbase + 63 > qw0) { _Pragma("unroll") for (int r = 0; r < 16; ++r) { const int kv = kbase + crow(r, hi); if (kv > qpos) PA0[r] = -INFINITY; if (kv + 32 > qpos) PA1[r] = -INFINITY; } } \
            softmax_pv<24>(PA0, PA1, mhat, l, o, (int)(uintptr_t)(lds + MX_RING + (st % 3) * 32768 + 16384 + g * 8192) + vlo, wsf, r32, hi); } } while (0)
    int st2 = 0;
    for (; st2 + 2 < nst; st2 += 2) { FOX_STEP(p0, p1, n0, n1, st2); FOX_STEP(n0, n1, p0, p1, st2 + 1); }
    if (st2 + 1 < nst) { FOX_STEP(p0, p1, n0, n1, st2); FOX_LAST(n0, n1); } else { FOX_LAST(p0, p1); }
#undef FOX_STEP
#undef FOX_LAST
    __syncthreads();
#undef FOX_SCORE
#undef FOX_STAGE
    l += __shfl_xor(l, 32);
    LAS float* mo = (LAS float*)(lds + MX_RING); LAS float* ml = (LAS float*)(lds + MX_RING + 32768);
    const int wq = w & 3;
    if (g == 1) {
#pragma unroll
        for (int d0 = 0; d0 < 2; ++d0)
#pragma unroll
            for (int r = 0; r < 16; ++r) mo[((wq * 2 + d0) * 16 + r) * 64 + lane] = o[d0][r];
        ml[(wq * 2 + 0) * 64 + lane] = mhat; ml[(wq * 2 + 1) * 64 + lane] = l;
    }
    __syncthreads();
    if (g == 0) {
        const float m1 = ml[(wq * 2 + 0) * 64 + lane], l1 = ml[(wq * 2 + 1) * 64 + lane];
        const float mn = fmaxf(mhat, m1), f0 = ex2(mhat - mn), f1 = ex2(m1 - mn), lt = l * f0 + l1 * f1;
        if (hi == 0) { wsf[r32] = f0; wsf[32 + r32] = f1; }
        LGKM_WAIT0();
#pragma unroll
        for (int r = 0; r < 16; ++r) { const float a0 = wsf[crow(r, hi)], a1 = wsf[32 + crow(r, hi)];
#pragma unroll
            for (int d0 = 0; d0 < 2; ++d0) o[d0][r] = o[d0][r] * a0 + mo[((wq * 2 + d0) * 16 + r) * 64 + lane] * a1; }
        LGKM_WAIT0();
        store_o(o, 1.0f / lt, wsf, stg, C.Y + (rowbase + qw0) * 1024 + 512 + 64 * h, 1024, r32, hi, lane);
    }
    __syncthreads();
}
__device__ __forceinline__ void fox_item(const MixCtx& C, const float* NF, unsigned* cntF, int bh, int i, LAS unsigned char* lds) {
    fox_block(C, NF, cntF, bh, 31 - i, lds, true);
    fox_block(C, NF, cntF, bh, i, lds, false);
}
constexpr int ML_WSF = 98304, ML_STG = 100352, ML_SM = 133120;
struct MlScratch { float* E; float* B; float* PM; float* CL; float* NL; bf16_t* CP; float* NP; float* GC; float* EM; float* MP; unsigned* cnt1; unsigned* cnt2; };
__device__ __forceinline__ void wait_count(unsigned* p, unsigned want, int tid) {
    if (tid == 0) { while (__hip_atomic_load(p, __ATOMIC_RELAXED, __HIP_MEMORY_SCOPE_AGENT) < want) __builtin_amdgcn_s_sleep(2);
        __builtin_amdgcn_fence(__ATOMIC_ACQUIRE, "agent"); asm volatile("s_waitcnt vmcnt(0)" ::: "memory"); }
    __syncthreads();
}
__device__ __forceinline__ void post_count(unsigned* p, int tid) {
    asm volatile("s_waitcnt vmcnt(0)" ::: "memory"); __syncthreads();
    if (tid == 0) { __builtin_amdgcn_fence(__ATOMIC_RELEASE, "agent"); asm volatile("s_waitcnt vmcnt(0)" ::: "memory");
        __hip_atomic_fetch_add(p, 1u, __ATOMIC_RELAXED, __HIP_MEMORY_SCOPE_AGENT); }
}
#define ML_COMMON \
    int tid_ = threadIdx.x; asm volatile("" : "+v"(tid_)); \
    const int tid = tid_, lane = tid & 63, w = __builtin_amdgcn_readfirstlane(tid >> 6), r32 = lane & 31, hi = lane >> 5; \
    const int b = bh >> 2, h = bh & 3; const size_t rowbase = (size_t)b * 4096; \
    float* E = S.E + bh * 4096; float* B = S.B + bh * 4096; float* PM = S.PM + bh * 4096; \
    float* CL = S.CL + (size_t)bh * 64 * 4096; float* NL = S.NL + bh * 4096; bf16_t* CP = S.CP + (size_t)bh * 64 * 4096; float* NP = S.NP + bh * 4096; \
    float* GC = S.GC + bh * 64; float* EM = S.EM + bh * 64; float* MP = S.MP + bh * 64; \
    (void)r32; (void)hi; (void)E; (void)B; (void)PM; (void)CL; (void)NL; (void)CP; (void)NP; (void)GC; (void)EM; (void)MP; (void)rowbase; (void)h;

__device__ __forceinline__ void ml1_item(const MixCtx& C, const MlScratch& S, int bh, int rd, LAS unsigned char* lds) {
    ML_COMMON
    LAS float* le = (LAS float*)(lds + ML_SM); LAS float* lem = le + 512;
    const bf16_t* Kg = C.Z + rowbase * ZP + 1792 + 64 * h; const bf16_t* Vg = C.Z + rowbase * ZP + 2048 + 64 * h;
    const int srow = 16 * (w & 3) + (lane >> 2), scol = (w >> 2) * 32 + (lane & 3) * 8;
    u32x4 kvr[8];
#pragma unroll
    for (int p = 0; p < 8; ++p) kvr[p] = *(const u32x4*)(Kg + (size_t)((8 * rd + p) * 64 + srow) * ZP + scol);
    {
        const int cc = 8 * rd + w, t = cc * 64 + lane;
        const float ig = C.G[(size_t)(4 + h) * 16384 + rowbase + t] + C.ml_ib[h];
        float bsum = log_sigmoid(C.G[(size_t)(8 + h) * 16384 + rowbase + t] + C.ml_fb[h]);
#pragma unroll
        for (int o_ = 1; o_ < 64; o_ <<= 1) { const float y = __shfl_up(bsum, o_); if (lane >= o_) bsum += y; }
        const float e = ig - bsum; float pm = e;
#pragma unroll
        for (int o_ = 1; o_ < 64; o_ <<= 1) { const float y = __shfl_up(pm, o_); if (lane >= o_) pm = fmaxf(pm, y); }
        E[t] = e; B[t] = bsum; PM[t] = pm; le[w * 64 + lane] = e;
        if (lane == 63) { GC[cc] = bsum; EM[cc] = pm; lem[w] = pm; }
    }
    __syncthreads();
    const int vlo = vt_lane_off(lane);
    const bf16x8 ones = (bf16x8){0x3F80, 0x3F80, 0x3F80, 0x3F80, 0x3F80, 0x3F80, 0x3F80, 0x3F80};
#pragma unroll
    for (int p = 0; p < 8; ++p) {
        const int cc = 8 * rd + p; LAS unsigned char* sl = lds + p * 16384;
        const float wa = __expf(le[p * 64 + srow] - lem[p]);
        u32x4 w2;
#pragma unroll
        for (int j = 0; j < 4; ++j) { const float lo = __builtin_bit_cast(float, kvr[p][j] << 16), hh = __builtin_bit_cast(float, kvr[p][j] & 0xffff0000u); w2[j] = cvtpk(lo * wa, hh * wa); }
        *(LAS u32x4*)(sl + w * 1024 + lane * 16) = w2;
        dma_v(sl + 8192, Vg + (size_t)cc * 64 * ZP, ZP, w, lane);
    }
    VM_WAIT0(); __syncthreads();
    {
        const int cc = 8 * rd + w; LAS unsigned char* sl = lds + w * 16384;
        const int ka = (int)(uintptr_t)sl + vlo, va = ka + 8192;
        float* cl = CL + (size_t)cc * 4096;
#pragma unroll
        for (int half = 0; half < 2; ++half) {
            f32x16 a0 = {}, a1 = {}, na = {};
#pragma unroll
            for (int ks = 0; ks < 4; ++ks) {
                const bf16x8 A = vfrag(ka, half, ks), B0 = vfrag(va, 0, ks), B1 = vfrag(va, 1, ks);
                a0 = __builtin_amdgcn_mfma_f32_32x32x16_bf16(A, B0, a0, 0, 0, 0);
                a1 = __builtin_amdgcn_mfma_f32_32x32x16_bf16(A, B1, a1, 0, 0, 0);
                na = __builtin_amdgcn_mfma_f32_32x32x16_bf16(A, ones, na, 0, 0, 0);
            }
#pragma unroll
            for (int r = 0; r < 16; ++r) { const int k = 32 * half + crow(r, hi); cl[k * 64 + r32] = a0[r]; cl[k * 64 + 32 + r32] = a1[r]; }
            if (r32 == 0) {
#pragma unroll
                for (int r = 0; r < 16; ++r) NL[cc * 64 + 32 * half + crow(r, hi)] = na[r];
            }
        }
    }
    post_count(S.cnt1 + bh, tid);
    __syncthreads();
}

__device__ __forceinline__ void ml2_item(const MixCtx& C, const MlScratch& S, int bh, int slice, LAS unsigned char* lds) {
    ML_COMMON
    LAS float* lg = (LAS float*)(lds + ML_SM); LAS float* lem = lg + 64; LAS float* lso = lg + 128; LAS float* lsl = lg + 192;
    wait_count(S.cnt1 + bh, 8u, tid);
    if (tid < 64) { lg[tid] = GC[tid]; lem[tid] = EM[tid]; }
    __syncthreads();
    if (tid == 0) { float mcur = 0.f; for (int c = 0; c < 64; ++c) { const float g = lg[c], em = lem[c], mx = fmaxf(mcur, em); if (slice == 0) MP[c] = mcur; lso[c] = __expf(mcur - mx); lsl[c] = __expf(em - mx); mcur = g + mx; } }
    __syncthreads();
    const int idx = slice * 2048 + tid * 4; const bool don = (slice == 0) && (tid < 64);
    f32x4 Cs = (f32x4){0.f, 0.f, 0.f, 0.f}; float ns = 0.f;
    for (int c0 = 0; c0 < 64; c0 += 16) {
        f32x4 lv[16]; float ln[16];
#pragma unroll
        for (int j = 0; j < 16; ++j) { lv[j] = *(const f32x4*)(CL + (size_t)(c0 + j) * 4096 + idx); ln[j] = don ? NL[(c0 + j) * 64 + tid] : 0.f; }
#pragma unroll
        for (int j = 0; j < 16; ++j) {
            const int c = c0 + j;
            u32x2 pk; pk.x = cvtpk(Cs[0], Cs[1]); pk.y = cvtpk(Cs[2], Cs[3]);
            *(u32x2*)(CP + (size_t)c * 4096 + idx) = pk;
            if (don) NP[c * 64 + tid] = ns;
            const float so = lso[c], sl = lsl[c];
            Cs = Cs * so + lv[j] * sl; ns = so * ns + sl * ln[j];
        }
    }
    post_count(S.cnt2 + bh, tid);
    __syncthreads();
}

__device__ __forceinline__ void ml3_item(const MixCtx& C, const MlScratch& S, int bh, int rd, LAS unsigned char* lds) {
    ML_COMMON
    wait_count(S.cnt2 + bh, 2u, tid);
    const int pair = w >> 1, half = w & 1;
    const bf16_t* Kg = C.Z + rowbase * ZP + 1792 + 64 * h; const bf16_t* Vg = C.Z + rowbase * ZP + 2048 + 64 * h; const bf16_t* Qg = C.Z + rowbase * ZP + 1536 + 64 * h;
    const int vlo = vt_lane_off(lane);
    LAS float* wsf = (LAS float*)(lds + ML_WSF) + w * 64; LAS bf16_t* stg = (LAS bf16_t*)(lds + ML_STG + w * 4096);
#pragma unroll
        for (int p = 0; p < 4; ++p) {
            const int cc = 4 * rd + p; LAS unsigned char* sl = lds + p * 24576;
            dma_k(sl, Kg + (size_t)cc * 64 * ZP, ZP, w, lane); dma_v(sl + 8192, Vg + (size_t)cc * 64 * ZP, ZP, w, lane); dma_v(sl + 16384, CP + (size_t)cc * 4096, 64, w, lane);
        }
        const int cc = 4 * rd + pair, lrow = 32 * half + r32, t = cc * 64 + lrow;
        const bf16_t* qp = Qg + (size_t)t * ZP;
        bf16x8 qr[4], qp2[4];
#pragma unroll
        for (int d0 = 0; d0 < 4; ++d0) qr[d0] = *(const bf16x8*)(qp + 16 * d0 + 8 * hi);
#pragma unroll
        for (int ks = 0; ks < 4; ++ks) { const u32x2 a = *(const u32x2*)(qp + 16 * ks + 4 * hi), b2 = *(const u32x2*)(qp + 16 * ks + 8 + 4 * hi); qp2[ks] = __builtin_bit_cast(bf16x8, ((u32x4){a.x, a.y, b2.x, b2.y})); }
        const float mprev = MP[cc], mm = fmaxf(mprev, PM[t]), winter = __expf(mprev - mm), bl = B[t];
        float nd = 0.f;
#pragma unroll
        for (int d0 = 0; d0 < 4; ++d0) { const float* np = NP + cc * 64 + 16 * d0 + 8 * hi; const f32x4 n0 = *(const f32x4*)np, n1 = *(const f32x4*)(np + 4);
            const u32x4 qq = __builtin_bit_cast(u32x4, qr[d0]);
#pragma unroll
            for (int j = 0; j < 4; ++j) { const float lo = __builtin_bit_cast(float, qq[j] << 16), hh = __builtin_bit_cast(float, qq[j] & 0xffff0000u);
                const float na_ = j < 2 ? n0[2 * j] : n1[2 * j - 4], nb_ = j < 2 ? n0[2 * j + 1] : n1[2 * j - 3]; nd += lo * na_ + hh * nb_; } }
        nd += __shfl_xor(nd, 32);
        VM_WAIT0(); __syncthreads();
        {
            LAS unsigned char* sl = lds + pair * 24576; const int base = (int)(uintptr_t)sl + vlo;
            f32x16 o[2]; o[0] = f32x16{}; o[1] = f32x16{};
            pv(o, base + 16384, qp2[0], qp2[1], qp2[2], qp2[3]);
            scale_rows(o, winter, wsf, r32, hi);
            f32x16 p0, p1; qkt(p0, p1, sl, qr, r32, hi);
            float rs = 0.f;
#pragma unroll
            for (int rr = 0; rr < 4; ++rr) { const f32x4 e0 = *(const f32x4*)(E + cc * 64 + 8 * rr + 4 * hi), e1 = *(const f32x4*)(E + cc * 64 + 32 + 8 * rr + 4 * hi);
#pragma unroll
                for (int e = 0; e < 4; ++e) { const int r = 4 * rr + e, s = 8 * rr + 4 * hi + e;
                    const float w0 = (s <= lrow) ? __expf(e0[e] - mm) : 0.f, w1 = (s + 32 <= lrow) ? __expf(e1[e] - mm) : 0.f;
                    p0[r] *= w0; p1[r] *= w1; rs += p0[r] + p1[r]; } }
            rs += __shfl_xor(rs, 32);
            pv(o, base + 8192, PACK8(p0, 0), PACK8(p0, 8), PACK8(p1, 0), PACK8(p1, 8));
            const float den = winter * nd + rs, dn = fmaxf(fabsf(den), __expf(-(bl + mm)));
            const float rinv = 1.0f / dn;
            if (hi == 0) wsf[32 + r32] = rinv;
            LGKM_WAIT0();
#pragma unroll
            for (int r = 0; r < 16; ++r) { const int orow = crow(r, hi); const float rl = wsf[32 + orow];
#pragma unroll
                for (int d0 = 0; d0 < 2; ++d0) stg[orow * 64 + d0 * 32 + r32] = (bf16_t)f2bf(o[d0][r] * rl); }
            LGKM_WAIT0();
#pragma unroll
            for (int i = 0; i < 4; ++i) {
                const int row = i * 8 + (lane >> 3), ch = lane & 7; const u32x4 v = *(const LAS u32x4*)(stg + row * 64 + ch * 8);
                float x[8]; float ss = 0.f;
#pragma unroll
                for (int j = 0; j < 4; ++j) { x[2 * j] = __builtin_bit_cast(float, v[j] << 16); x[2 * j + 1] = __builtin_bit_cast(float, v[j] & 0xffff0000u); ss += x[2 * j] * x[2 * j] + x[2 * j + 1] * x[2 * j + 1]; }
                ss += __shfl_xor(ss, 1); ss += __shfl_xor(ss, 2); ss += __shfl_xor(ss, 4);
                const float rn = rsqrtf(ss * (1.0f / 64.0f) + EPS);
                const size_t tok = rowbase + cc * 64 + 32 * half + row;
                const u32x4 og = *(const u32x4*)(C.Z + tok * ZP + 2304 + 64 * h + ch * 8);
                const f32x4 g0 = *(const f32x4*)(C.ml_norm + h * 64 + ch * 8), g1 = *(const f32x4*)(C.ml_norm + h * 64 + ch * 8 + 4);
                float y[8];
#pragma unroll
                for (int j = 0; j < 4; ++j) { const float o0 = __builtin_bit_cast(float, og[j] << 16), o1 = __builtin_bit_cast(float, og[j] & 0xffff0000u);
                    const float ga = j < 2 ? g0[2 * j] : g1[2 * j - 4], gb = j < 2 ? g0[2 * j + 1] : g1[2 * j - 3];
                    y[2 * j] = x[2 * j] * rn * ga * o0; y[2 * j + 1] = x[2 * j + 1] * rn * gb * o1; }
                u32x4 pk; pk.x = cvtpk(y[0], y[1]); pk.y = cvtpk(y[2], y[3]); pk.z = cvtpk(y[4], y[5]); pk.w = cvtpk(y[6], y[7]);
                *(u32x4*)(C.Y + tok * 1024 + 768 + 64 * h + ch * 8) = pk;
            }
            LGKM_WAIT0();
        }
        __syncthreads();
}
constexpr int MTOK = 16384, DMODEL = 1024, SEQL = 4096, DFF = 4096, NZT = 2816  , DEPTH = 2;
constexpr size_t MiB = 1u << 20;
constexpr size_t WS_CTL = 0, CTL_BYTES = 32768;
constexpr size_t WS_WIN = 2 * MiB, WIN_L = (size_t)NZT * DMODEL * 2;
constexpr size_t WS_WOUT = 13 * MiB, WOUT_L = (size_t)DMODEL * DMODEL * 2;
constexpr size_t WS_WFF1 = 17 * MiB, WFF_L = (size_t)DFF * DMODEL * 2;
constexpr size_t WS_WFF2 = 33 * MiB;
constexpr size_t WS_SSQ2 = 82 * MiB;
constexpr size_t WS_XG = 50 * MiB;
constexpr size_t WS_H = 84 * MiB;
constexpr size_t WS_Z = 84 * MiB, WS_Y = 164 * MiB;
constexpr size_t WS_KT = 196 * MiB, WS_VT = 204 * MiB;
constexpr size_t WS_SSQ = 212 * MiB, WS_ROPE = 214 * MiB, WS_G = 215 * MiB;
constexpr size_t WS_MLE = 216 * MiB, WS_MLB = WS_MLE + 262144, WS_MLPM = WS_MLB + 262144;
constexpr size_t WS_NL = 217 * MiB, WS_NP = WS_NL + 262144, WS_GC = WS_NP + 262144, WS_EM = WS_GC + 4096, WS_MP = WS_EM + 4096;
constexpr size_t WS_CL = 218 * MiB, WS_CP = 234 * MiB, WS_NFX = 242 * MiB, WS_RS = WS_NFX + 524288  , WS_END = 243 * MiB;
constexpr int LDS_BYTES = 147456;
constexpr int WGM_P1 = 2, WGM_P3 = 4, WGM_P4 = 4, WGM_P5 = 4;
constexpr int N_FOX = 256, N_SWA = 256, N_ML1 = 128, N_ML2 = 32, N_ML3 = 256, N_ML = N_ML1 + N_ML2 + N_ML3, N_FX0 = 16, N_ITEMS = N_FX0 + N_ML + N_FOX + N_SWA;

struct Params { const float* in[16]; float* out; unsigned char* ws; int ph_lo, ph_hi; };

__device__ __forceinline__ int win_src(int n) {
    const int pn = n >> 8, P = n & 255, L = 64 * ((P >> 5) & 3) + 32 * (P >> 7) + (P & 31), z = 256 * pn + L;
    if (z < 1536) return z;
    if (z < 2304) return z + 4;
    if (z < 2560) return z + 12;
    const int i = z - 2560;
    if (i < 4) return 1536 + i;
    if (i < 8) return 2308 + (i - 4);
    if (i < 12) return 2312 + (i - 8);
    return -1;
}
template <bool WIN>
__device__ __forceinline__ void tr_item(const float* W, const float* kgain, int K, int Nsrc, bf16_t* WT, int nblk, int item, LAS float* scr, int lane) {
    const int kb = item / nblk, nb = item % nblk, k0 = 64 * kb, n0 = 32 * nb;
    if (WIN && n0 >= 2560) {
        const int n = n0 + (lane & 31); const int src = win_src(n);
#pragma unroll 8
        for (int i = 0; i < 32; ++i) { const int kk = 2 * i + (lane >> 5); scr[kk * 33 + (lane & 31)] = src >= 0 ? W[(size_t)(k0 + kk) * Nsrc + src] * (kgain ? kgain[k0 + kk] : 1.f) : 0.f; }
    } else {
        const int n4 = (lane & 7) * 4; const int src = WIN ? win_src(n0 + n4) : n0 + n4;
        f32x4 v[8];
#pragma unroll
        for (int i = 0; i < 8; ++i) v[i] = *(const f32x4*)(W + (size_t)(k0 + 8 * i + (lane >> 3)) * Nsrc + src);
#pragma unroll
        for (int i = 0; i < 8; ++i) { const int kk = 8 * i + (lane >> 3); const float g = kgain ? kgain[k0 + kk] : 1.f; LAS float* d = scr + kk * 33 + n4;
            d[0] = v[i][0] * g; d[1] = v[i][1] * g; d[2] = v[i][2] * g; d[3] = v[i][3] * g; }
    }
    LGKM_WAIT0(); asm volatile("" ::: "memory");
    const int c = lane & 7;
#pragma unroll
    for (int j = 0; j < 4; ++j) { const int nn = (lane >> 3) + 8 * j; const LAS float* s = scr + (8 * c) * 33 + nn;
        u32x4 o; o.x = cvtpk(s[0 * 33], s[1 * 33]); o.y = cvtpk(s[2 * 33], s[3 * 33]); o.z = cvtpk(s[4 * 33], s[5 * 33]); o.w = cvtpk(s[6 * 33], s[7 * 33]);
        *(u32x4*)(WT + (size_t)(n0 + nn) * K + k0 + 8 * c) = o; }
    LGKM_WAIT0(); asm volatile("" ::: "memory");
}

#define RLX_AGENT __ATOMIC_RELAXED, __HIP_MEMORY_SCOPE_AGENT
#define XB_TMO      128
#define XB_XCNT(j)  (256  + 64 * (j))
#define XB_XSUB(j)  (1280 + 64 * (j))
#define XB_XGEN(j)  (2304 + 64 * (j))
#define XB_TOP      3328
#define XB_TOPGEN   3392
#define XCD_BAR_WORDS 3456
#define XB_SPIN_CAP (1u << 18)

__device__ __forceinline__ unsigned xb_ld(unsigned* p)              { return __hip_atomic_load(p, __ATOMIC_RELAXED, __HIP_MEMORY_SCOPE_AGENT); }
__device__ __forceinline__ unsigned xb_add(unsigned* p, unsigned v) { return __hip_atomic_fetch_add(p, v, __ATOMIC_RELAXED, __HIP_MEMORY_SCOPE_AGENT); }
__device__ __forceinline__ unsigned xb_xcc_id() { return (unsigned)__builtin_amdgcn_s_getreg((3 << 11) | 20) & 0xFu; }
#define XB_SPIN(cond, bar) do { unsigned _sp = 0; while (cond) { __builtin_amdgcn_s_sleep(1); \
    if ((++_sp & 255u) == 0u) { if (xb_ld(&(bar)[XB_TMO])) break; if (_sp > XB_SPIN_CAP) { atomicAdd(&(bar)[XB_TMO], 1u); break; } } } } while (0)

struct XcdBarrier {
    unsigned* bar; unsigned x;
    volatile LAS unsigned* st;
};

__device__ __forceinline__ XcdBarrier xcd_barrier_post(unsigned* bar, volatile LAS unsigned* st) {
    XcdBarrier b; b.bar = bar; b.x = xb_xcc_id(); b.st = st;
    if (threadIdx.x == 0) (void)xb_add(&bar[XB_XCNT(b.x)], 1u);
    return b;
}
__device__ __forceinline__ void xcd_barrier_complete(unsigned* bar, unsigned x, unsigned& nloc, unsigned& nx) {
    const unsigned G = gridDim.x * gridDim.y * gridDim.z;
    unsigned sum, cnt, mine, sp = 0u;
    for (;;) {
        sum = 0u; cnt = 0u; mine = 0u;
#pragma unroll
        for (unsigned j = 0; j < 16; ++j) { const unsigned c = xb_ld(&bar[XB_XCNT(j)]); sum += c; cnt += (c > 0u) ? 1u : 0u; mine = (j == x) ? c : mine; }
        if (sum == G) break;
        __builtin_amdgcn_s_sleep(1);
        if ((++sp & 255u) == 0u) { if (xb_ld(&bar[XB_TMO])) break; if (sp > XB_SPIN_CAP) { atomicAdd(&bar[XB_TMO], 1u); break; } }
    }
    nloc = mine > 0u ? mine : 1u; nx = cnt > 0u ? cnt : 1u;
}

__device__ __forceinline__ void xcd_barrier(const XcdBarrier& b) {
    asm volatile("s_waitcnt vmcnt(0)" ::: "memory");
    __syncthreads();
    if (threadIdx.x == 0) {
        unsigned* bar = b.bar;
        __builtin_amdgcn_s_waitcnt(0);
        unsigned nloc = b.st[0], nx = b.st[1];
        if (nloc == 0u) { xcd_barrier_complete(bar, b.x, nloc, nx); b.st[0] = nloc; b.st[1] = nx; }
        const unsigned old = xb_add(&bar[XB_XSUB(b.x)], 1u);
        const unsigned gen = old / nloc;
        if (old + 1u == (gen + 1u) * nloc) {
            __builtin_amdgcn_fence(__ATOMIC_RELEASE, "agent");
            asm volatile("s_waitcnt vmcnt(0)" ::: "memory");
            const unsigned og = xb_add(&bar[XB_TOP], 1u);
            const unsigned tg = og / nx;
            if (og + 1u == (tg + 1u) * nx) xb_add(&bar[XB_TOPGEN], 1u);
            else XB_SPIN(xb_ld(&bar[XB_TOPGEN]) == tg, bar);
            __builtin_amdgcn_fence(__ATOMIC_ACQUIRE, "agent");
            xb_add(&bar[XB_XGEN(b.x)], 1u);
            asm volatile("s_waitcnt vmcnt(0)" ::: "memory");
        } else {
            XB_SPIN(xb_ld(&bar[XB_XGEN(b.x)]) == gen, bar);
            __builtin_amdgcn_fence(__ATOMIC_ACQUIRE, "agent");
            asm volatile("s_waitcnt vmcnt(0)" ::: "memory");
        }
    }
    __syncthreads();
}

__global__ void __launch_bounds__(512, 2) fwd_megakernel(Params p) {
    extern __shared__ __attribute__((aligned(16))) unsigned char lds_raw[];
    LAS unsigned char* lds = (LAS unsigned char*)lds_raw;
    cg::grid_group grid = cg::this_grid();
    const int tid = threadIdx.x, lane = tid & 63, wave = __builtin_amdgcn_readfirstlane(tid >> 6);
    const int G = gridDim.x, bx = blockIdx.x;
    unsigned char* ws = p.ws;
    const float* x_in = p.in[0];
    bf16_t* XG = (bf16_t*)(ws + WS_XG); bf16_t* Zb = (bf16_t*)(ws + WS_Z); bf16_t* Yb = (bf16_t*)(ws + WS_Y); bf16_t* Hb = (bf16_t*)(ws + WS_H);
    float* SSQ = (float*)(ws + WS_SSQ); float* SSQ2 = (float*)(ws + WS_SSQ2); float* ROPEC = (float*)(ws + WS_ROPE); float* ROPES = ROPEC + SEQL * 32; float* Gt = (float*)(ws + WS_G);
    unsigned* ctl = (unsigned*)(ws + WS_CTL);
    const int lo = p.ph_lo, hi_ph = p.ph_hi;
    volatile LAS unsigned* bst = (volatile LAS unsigned*)(lds + 143360 + 16);
    if (tid < 2) bst[tid] = 0u;
    __syncthreads();
    XcdBarrier bar = xcd_barrier_post(ctl + 1024, bst);
    if (lo < 0) grid.sync();
#define IN_PH(k) (lo <= (k) && (k) < hi_ph)
#define SEAM(k) do { if (IN_PH(k) && IN_PH((k) + 1)) xcd_barrier(bar); } while (0)

    if (IN_PH(0)) {
        LAS float* scr = (LAS float*)(lds + wave * 16384);
        const int gw = bx * 8 + wave, NGW = G * 8;
        constexpr int I_IN = (DMODEL / 64) * (NZT / 32), I_OUT = (DMODEL / 64) * (DMODEL / 32), I_F1 = (DMODEL / 64) * (DFF / 32), I_F2 = (DFF / 64) * (DMODEL / 32);
        constexpr int I_LAYER = I_IN + I_OUT + I_F1 + I_F2;
        for (int it = gw; it < DEPTH * I_LAYER; it += NGW) {
            const int l = it / I_LAYER; int r = it % I_LAYER;
            if (r < I_IN) { tr_item<true>(p.in[2] + (size_t)l * DMODEL * 2572, p.in[1] + l * DMODEL, DMODEL, 2572, (bf16_t*)(ws + WS_WIN + l * WIN_L), NZT / 32, r, scr, lane); continue; } r -= I_IN;
            if (r < I_OUT) { tr_item<false>(p.in[12] + (size_t)l * DMODEL * DMODEL, nullptr, DMODEL, DMODEL, (bf16_t*)(ws + WS_WOUT + l * WOUT_L), DMODEL / 32, r, scr, lane); continue; } r -= I_OUT;
            if (r < I_F1) { tr_item<false>(p.in[14] + (size_t)l * DMODEL * DFF, p.in[13] + l * DMODEL, DMODEL, DFF, (bf16_t*)(ws + WS_WFF1 + l * WFF_L), DFF / 32, r, scr, lane); continue; } r -= I_F1;
            tr_item<false>(p.in[15] + (size_t)l * DFF * DMODEL, nullptr, DFF, DMODEL, (bf16_t*)(ws + WS_WFF2 + l * WFF_L), DMODEL / 32, r, scr, lane);
        }
        for (int i = bx * 512 + tid; i < SEQL * 32; i += G * 512) {
            const int pos = i >> 5, j = i & 31;
            double inv = 1.0; for (int q = 0; q < j; ++q) inv *= 0.7498942093324558;
            const float ang = (float)pos * (float)inv;
            double rev = (double)ang * 0.15915494309189535; rev -= __builtin_rint(rev);
            ROPEC[i] = __builtin_amdgcn_cosf((float)rev); ROPES[i] = __builtin_amdgcn_sinf((float)rev);
        }
        for (int m = gw; m < MTOK; m += 2 * NGW) {
            const int m2 = m + NGW;
            const bool has2 = m2 < MTOK;
            const f32x4* xr = (const f32x4*)(x_in + (size_t)m * DMODEL) + lane;
            const f32x4* xr2 = (const f32x4*)(x_in + (size_t)(has2 ? m2 : m) * DMODEL) + lane;
            f32x4 va[4], vb[4];
#pragma unroll
            for (int j = 0; j < 4; ++j) { va[j] = xr[64 * j]; vb[j] = xr2[64 * j]; }
#pragma unroll
            for (int rr = 0; rr < 2; ++rr) {
                if (rr == 1 && !has2) break;
                const int mm = rr == 0 ? m : m2;
                unsigned long long* o8 = (unsigned long long*)(XG + (size_t)mm * DMODEL) + lane;
#pragma unroll
                for (int j = 0; j < 4; ++j) {
                    const f32x4 v = rr == 0 ? va[j] : vb[j];
                    float s = (v[0] * v[0] + v[1] * v[1]) + (v[2] * v[2] + v[3] * v[3]);
                    s += __shfl_xor(s, 1); s += __shfl_xor(s, 2); s += __shfl_xor(s, 4);
                    if ((lane & 7) == 0) SSQ[(size_t)mm * 32 + 8 * j + (lane >> 3)] = s;
                    o8[64 * j] = (unsigned long long)cvtpk(v[0], v[1]) | ((unsigned long long)cvtpk(v[2], v[3]) << 32);
                }
            }
        }
    }
    SEAM(0);

    for (int l = 0; l < DEPTH; ++l) {
        const int pb = 1 + 5 * l;
        if (IN_PH(pb)) {
            pg8::Gemm g{XG, (const bf16_t*)(ws + WS_WIN + l * WIN_L), MTOK, NZT, DMODEL}; pg8::StaticOrder S; S.init(MTOK, NZT, G, bx, WGM_P1);
            float* RS = (float*)(ws + WS_RS);
            { int t3_ = threadIdx.x; asm volatile("" : "+v"(t3_)); pg8::Unit ux; int lastpm = -1;
              for (int i = 0; S.next(i, ux); ++i) { if (ux.pm == lastpm) continue; lastpm = ux.pm;
                  if (t3_ < 256) { const f32x4* sp = (const f32x4*)(SSQ + (size_t)(ux.pm * 256 + t3_) * 32); f32x4 a = sp[0];
#pragma unroll
                      for (int j = 1; j < 8; ++j) a = a + sp[j];
                      RS[ux.pm * 256 + t3_] = rsqrtf(((a[0] + a[1]) + (a[2] + a[3])) * (1.0f / 1024.0f) + pg8::EPS); } }
              asm volatile("s_waitcnt vmcnt(0)" ::: "memory"); }
            __syncthreads();
            pg8::EpiIn E{Zb, Gt, RS, ROPEC, ROPES, p.in[3] + l * 64, p.in[4] + l * 64, p.in[6] + l * 64, p.in[7] + l * 64, ws + WS_KT, ws + WS_VT};
            pg8::gemm_phase<pg8::EpiIn, pg8::StaticOrder, true, true>(lds, g, S, E);
        }
        SEAM(pb);
        if (IN_PH(pb + 1)) {
            MixCtx C{Zb, Gt, Yb, p.in[5] + l * 8, p.in[8] + l * 4, p.in[9] + l * 4, p.in[10] + l * 4, p.in[11] + l * 256, ws, ws + WS_KT, ws + WS_VT};
            MlScratch MS{(float*)(ws + WS_MLE), (float*)(ws + WS_MLB), (float*)(ws + WS_MLPM), (float*)(ws + WS_CL), (float*)(ws + WS_NL), (bf16_t*)(ws + WS_CP), (float*)(ws + WS_NP), (float*)(ws + WS_GC), (float*)(ws + WS_EM), (float*)(ws + WS_MP), ctl + 128 + 32 * l, ctl + 192 + 32 * l};
            LAS int* itm = (LAS int*)(lds + 143360);
            float* NF = (float*)(ws + WS_NFX); unsigned* cntF = ctl + 512 + 32 * l; unsigned* qctr = ctl + 64 * l;
            for (;;) {
                __syncthreads();
                if (tid == 0) *itm = (int)atomicAdd(qctr, 1u);
                __syncthreads();
                const int it = *itm;
                if (it >= N_ITEMS) break;
                constexpr int Q_ML1 = N_FX0, Q_ML2 = Q_ML1 + N_ML1, Q_FOXA = Q_ML2 + N_ML2, N_FOXA = 256, Q_ML3 = Q_FOXA + N_FOXA, Q_FOXB = Q_ML3 + N_ML3, Q_SWA = Q_FOXB + (N_FOX - N_FOXA);
                static_assert(Q_SWA + N_SWA == N_ITEMS, "queue map");
                if (it < Q_ML1) fx0_item(C, NF, cntF, it, lds);
                else if (it < Q_ML2) { const int k = it - Q_ML1; ml1_item(C, MS, k >> 3, k & 7, lds); }
                else if (it < Q_FOXA) { const int k = it - Q_ML2; ml2_item(C, MS, k >> 1, k & 1, lds); }
                else if (it < Q_ML3) {
                    if (tid == 0) { const unsigned x = xb_xcc_id() & 7u; int sel = 0;
                        for (unsigned t = 0; t < 8u; ++t) { const unsigned q = (x + t) & 7u; const unsigned j = atomicAdd(ctl + 640 + 16 * l + q, 1u); if (j < 32u) { sel = (int)(q * 32u + j); break; } }
                        itm[1] = sel; }
                    __syncthreads();
                    const int k = itm[1];
                    fox_item(C, NF, cntF, k >> 4, k & 15, lds); }
                else if (it < Q_FOXB) { const int k = it - Q_ML3; ml3_item(C, MS, k >> 4, k & 15, lds); }
                else if (it < Q_SWA) { const int k = it - Q_FOXB + N_FOXA; fox_item(C, NF, cntF, k & 15, k >> 4, lds); }
                else swa_item(C, it - Q_SWA, lds);
            }
        }
        SEAM(pb + 1);
        if (IN_PH(pb + 2)) {
            pg8::Gemm g{Yb, (const bf16_t*)(ws + WS_WOUT + l * WOUT_L), MTOK, DMODEL, DMODEL}; pg8::StaticOrder S; S.init(MTOK, DMODEL, G, bx, WGM_P3);
            pg8::EpiRes E{XG, SSQ2, nullptr, nullptr};
            pg8::gemm_phase<pg8::EpiRes, pg8::StaticOrder, true, true>(lds, g, S, E);
        }
        SEAM(pb + 2);
        if (IN_PH(pb + 3)) {
            pg8::Gemm g{XG, (const bf16_t*)(ws + WS_WFF1 + l * WFF_L), MTOK, DFF, DMODEL}; pg8::StaticOrder S; S.init(MTOK, DFF, G, bx, WGM_P4);
            pg8::EpiFF1 E{Hb};
            pg8::gemm_phase<pg8::EpiFF1, pg8::StaticOrder, true, true>(lds, g, S, E);
        }
        SEAM(pb + 3);
        if (IN_PH(pb + 4)) {
            pg8::Gemm g{Hb, (const bf16_t*)(ws + WS_WFF2 + l * WFF_L), MTOK, DMODEL, DFF}; pg8::StaticOrder S; S.init(MTOK, DMODEL, G, bx, WGM_P5);
            pg8::EpiRes E{XG, SSQ, l + 1 == DEPTH ? p.out : nullptr, SSQ2};
            pg8::gemm_phase<pg8::EpiRes, pg8::StaticOrder, true, true>(lds, g, S, E);
        }
        SEAM(pb + 4);
    }
#undef IN_PH
#undef SEAM
}

constexpr int N_PHASES = 1 + 5 * DEPTH;
#ifndef MK_MULTI
#define MK_MULTI 0
#endif
extern "C" void kernel_launch(void* const* d_in, const int* in_sizes, int n_in, void* d_out, int out_size, void* d_ws, size_t ws_size, hipStream_t stream) {
    static int grid = 0;
    if (grid == 0) {
        if (n_in != 16 || out_size != MTOK * DMODEL || ws_size < WS_END) { fprintf(stderr, "kernel_launch: unexpected shapes (n_in %d out %d ws %zu)\n", n_in, out_size, ws_size); grid = -1; return; }
        int dev = 0, cus = 0, per_cu = 0;
        hipGetDevice(&dev); hipDeviceGetAttribute(&cus, hipDeviceAttributeMultiprocessorCount, dev);
        if (hipFuncSetAttribute((const void*)fwd_megakernel, hipFuncAttributeMaxDynamicSharedMemorySize, LDS_BYTES) != hipSuccess) { fprintf(stderr, "kernel_launch: hipFuncSetAttribute failed\n"); grid = -1; return; }
        if (hipOccupancyMaxActiveBlocksPerMultiprocessor(&per_cu, (const void*)fwd_megakernel, 512, LDS_BYTES) != hipSuccess || per_cu < 1) { fprintf(stderr, "kernel_launch: occupancy query says %d\n", per_cu); per_cu = 1; }
        (void)hipGetLastError();
        grid = cus;
        if (grid != 256) fprintf(stderr, "kernel_launch: %d CUs (expected 256)\n", grid);
    }
    if (grid < 0) return;
    hipMemsetAsync((char*)d_ws + WS_CTL, 0, CTL_BYTES, stream);
    Params a{};
    for (int i = 0; i < 16; ++i) a.in[i] = (const float*)d_in[i];
    a.out = (float*)d_out; a.ws = (unsigned char*)d_ws;
#if MK_MULTI
    for (int ph = 0; ph < N_PHASES; ++ph) { a.ph_lo = ph; a.ph_hi = ph + 1; hipLaunchKernelGGL(fwd_megakernel, dim3(grid), dim3(512), LDS_BYTES, stream, a); }
#else
    a.ph_lo = 0; a.ph_hi = N_PHASES;
    void* args[] = {&a};
    hipError_t e = hipLaunchCooperativeKernel((const void*)fwd_megakernel, dim3(grid), dim3(512), args, LDS_BYTES, stream);
    if (e != hipSuccess) fprintf(stderr, "cooperative launch failed: %s (grid %d)\n", hipGetErrorString(e), grid);
#endif
}
```

```cpp
#include <hip/hip_runtime.h>
#include <hip/hip_cooperative_groups.h>
#include <cstdio>
#include <cstdint>
#include <cmath>
namespace cg = cooperative_groups;
namespace pg8 {
#define PG8_LAS __attribute__((address_space(3)))
typedef unsigned short bf16_t;
typedef short bf16x8 __attribute__((ext_vector_type(8)));
typedef float f32x4 __attribute__((ext_vector_type(4)));
typedef unsigned u32x4 __attribute__((ext_vector_type(4)));
constexpr int BM = 256, BK = 64, HALF = 128, HTB = HALF * BK * 2  , STAGE_BYTES = 8 * HTB, NXCD = 8;

__host__ __device__ __forceinline__ int lds_byte(int r, int c) { const int st = (r >> 4) * 2 + (c >> 5), rr = r & 15, cc = c & 31, ob = rr * 64 + cc * 2; return st * 1024 + (ob ^ (((ob >> 9) & 1) << 5)); }
__host__ __device__ __forceinline__ void stage_rc(int b, int& R, int& C) { const int st = b / 1024, sb = b % 1024, swz = sb ^ (((sb >> 9) & 1) << 5); R = (st >> 1) * 16 + swz / 64; C = (st & 1) * 32 + (swz % 64) / 2; }
__host__ __device__ __forceinline__ int perm32(int rho) { const int n = rho >> 4, i = rho & 15; return 8 * (i >> 2) + 4 * n + (i & 3); }

struct Unit { int pm, pn; };
struct Gemm { const bf16_t* A; const bf16_t* Bt; int M, N, K; };

struct StaticOrder {
    int nM, nN, nwg, G, c, WGM;
    __host__ __device__ void init(int M, int N, int G_, int c_, int wgm_ = 4) { nM = M / BM; nN = N / BM; nwg = nM * nN; G = G_; c = c_; WGM = wgm_; }
    __host__ __device__ bool next(int i, Unit& u) const {
        const long L = (long)i * G + c; if (L >= nwg) return false;
        int wgid = (int)L; { const int q = nwg / NXCD, r = nwg % NXCD, xcd = wgid % NXCD, off = wgid / NXCD; wgid = (xcd < r ? xcd * (q + 1) : r * (q + 1) + (xcd - r) * q) + off; }
        const int nig = WGM * nN, gid = wgid / nig, fm = gid * WGM, gsz = (nM - fm) < WGM ? (nM - fm) : WGM;
        u.pm = fm + ((wgid % nig) % gsz); u.pn = (wgid % nig) / gsz; return true;
    }
    __device__ __forceinline__ void a_ready(const Unit&) const {}
    __device__ __forceinline__ void done(const Unit&) const {}
};

__device__ __forceinline__ unsigned cvt_pk_bf16(float lo, float hi) { unsigned r; asm volatile("v_cvt_pk_bf16_f32 %0, %1, %2" : "=v"(r) : "v"(lo), "v"(hi)); return r; }
constexpr float EPS = 1e-6f;
constexpr float LOG2E = 1.4426950408889634f;
constexpr float C2 = 0.125f * LOG2E;
constexpr int ZP = 2560;

__device__ __forceinline__ float row_rstd(const float* ssq, int row, int fq) {
    const float* sp = ssq + (size_t)row * 32 + fq * 8;
    const f32x4 s0 = *(const f32x4*)sp, s1 = *(const f32x4*)(sp + 4);
    float t = ((s0[0] + s0[1]) + (s0[2] + s0[3])) + ((s1[0] + s1[1]) + (s1[2] + s1[3]));
    t += __shfl_xor(t, 16); t += __shfl_xor(t, 32);
    return rsqrtf(t * (1.0f / 1024.0f) + EPS);
}

struct EpiIn {
    static constexpr bool PERM = true, AFTER_DRAIN = false;
    bf16_t* Z; float* G; const float* ssq; const float* ropec; const float* ropes; const float* gqa; const float* gka; const float* gqb; const float* gkb;
    unsigned char* KT; unsigned char* VT;
    __device__ __forceinline__ void operator()(const f32x4 (&acc)[2][2][4][2], const Unit& u, int wr, int wc, int fr, int fq) const {
        const int pn = u.pn;
        int type = 0; const float* gsel = gqa; bool rp = false; float sc = 1.f;
        if (pn < 2) { type = 1; gsel = gqa; rp = true; sc = C2; }
        else if (pn == 2) { if (wc < 2) { type = 1; gsel = gka; rp = true; } }
        else if (pn == 3) { type = 1; gsel = gqb; sc = C2; }
        else if (pn == 4) { type = 1; gsel = gkb; }
        else if (pn == 7) { sc = 0.125f; }
        else if (pn == 9) { type = 2; }
        else if (pn == 10) { type = 3; }
        if (type == 3 && wc != 0) return;
        const int dcol = 8 * fq;
        unsigned char* tp = nullptr;
        if (pn == 4 || pn == 5) { const size_t tb0 = (size_t)((((u.pm * BM) >> 12) * 4 + wc) * 64 + (((u.pm * BM) & 4095) >> 6) + wr) * 8192;
            tp = pn == 4 ? KT + tb0 + fq * 1024 + fr * 16 : VT + tb0 + (fr * 4 + fq) * 16; }
        float gn[2][8];
#pragma unroll
        for (int bj = 0; bj < 2; ++bj)
#pragma unroll
            for (int i = 0; i < 8; ++i) gn[bj][i] = (type == 1) ? gsel[32 * bj + dcol + i] : 1.f;
#pragma unroll
        for (int ai = 0; ai < 2; ++ai)
#pragma unroll
            for (int m = 0; m < 4; ++m) {
                const int row = u.pm * BM + ai * HALF + wr * 64 + m * 16 + fr;
                const float rstd = ssq[row];
                float v[2][8];
#pragma unroll
                for (int bj = 0; bj < 2; ++bj)
#pragma unroll
                    for (int n = 0; n < 2; ++n)
#pragma unroll
                        for (int e = 0; e < 4; ++e) v[bj][4 * n + e] = acc[ai][bj][m][n][e] * rstd;
                if (type == 1) {
                    float ss = 0.f;
#pragma unroll
                    for (int bj = 0; bj < 2; ++bj)
#pragma unroll
                        for (int i = 0; i < 8; ++i) ss += v[bj][i] * v[bj][i];
                    ss += __shfl_xor(ss, 16); ss += __shfl_xor(ss, 32);
                    const float hr = rsqrtf(ss * (1.0f / 64.0f) + EPS);
#pragma unroll
                    for (int bj = 0; bj < 2; ++bj)
#pragma unroll
                        for (int i = 0; i < 8; ++i) v[bj][i] *= hr * gn[bj][i];
                    if (rp) {
                        const int pos = row & 4095;
                        const f32x4 c0 = *(const f32x4*)(ropec + pos * 32 + dcol), c1 = *(const f32x4*)(ropec + pos * 32 + dcol + 4);
                        const f32x4 s0 = *(const f32x4*)(ropes + pos * 32 + dcol), s1 = *(const f32x4*)(ropes + pos * 32 + dcol + 4);
#pragma unroll
                        for (int i = 0; i < 8; ++i) {
                            const float c = i < 4 ? c0[i & 3] : c1[i & 3], s = i < 4 ? s0[i & 3] : s1[i & 3];
                            const float x1 = v[0][i], x2 = v[1][i];
                            v[0][i] = x1 * c - x2 * s; v[1][i] = x2 * c + x1 * s;
                        }
                    }
#pragma unroll
                    for (int bj = 0; bj < 2; ++bj)
#pragma unroll
                        for (int i = 0; i < 8; ++i) v[bj][i] *= sc;
                } else if (type == 2) {
#pragma unroll
                    for (int bj = 0; bj < 2; ++bj)
#pragma unroll
                        for (int i = 0; i < 8; ++i) v[bj][i] = 1.0f / (1.0f + __expf(-v[bj][i]));
                } else if (type == 0) {
#pragma unroll
                    for (int bj = 0; bj < 2; ++bj)
#pragma unroll
                        for (int i = 0; i < 8; ++i) v[bj][i] *= sc;
                }
                if (type == 3) {
                    float* gp = G + row;
                    if (fq == 0) {
#pragma unroll
                        for (int i = 0; i < 8; ++i) gp[(size_t)i * 16384] = v[0][i]; }
                    else if (fq == 1) {
#pragma unroll
                        for (int i = 0; i < 4; ++i) gp[(size_t)(8 + i) * 16384] = v[0][i]; }
                } else {
#pragma unroll
                    for (int bj = 0; bj < 2; ++bj) {
                        u32x4 w; w.x = cvt_pk_bf16(v[bj][0], v[bj][1]); w.y = cvt_pk_bf16(v[bj][2], v[bj][3]); w.z = cvt_pk_bf16(v[bj][4], v[bj][5]); w.w = cvt_pk_bf16(v[bj][6], v[bj][7]);
                        if (pn == 4) *(u32x4*)(tp + ai * 16384 + bj * 4096 + m * 256) = w;
                        else if (pn == 5) *(u32x4*)(tp + ai * 16384 + bj * 4096 + m * 1024) = w;
                        else
                        *(u32x4*)(Z + (size_t)row * ZP + 256 * pn + 64 * wc + 32 * bj + dcol) = w;
                    }
                }
                if (m & 1) asm volatile("" ::: "memory");
            }
    }
};

struct EpiRes {
    static constexpr bool PERM = true, AFTER_DRAIN = false;
    bf16_t* XB; float* ssq; float* out; const float* rsq;
    __device__ __forceinline__ void operator()(const f32x4 (&acc)[2][2][4][2], const Unit& u, int wr, int wc, int fr, int fq) const {
        float r2[8];
#pragma unroll
        for (int j = 0; j < 8; ++j) r2[j] = 1.f;
        if (rsq) {
#pragma unroll
            for (int j = 0; j < 8; ++j) { const float r = row_rstd(rsq, u.pm * BM + (j >> 2) * HALF + wr * 64 + (j & 3) * 16 + fr, fq); r2[j] = r * r; }
        }
#pragma unroll
        for (int bj = 0; bj < 2; ++bj) {
            const int col0 = u.pn * BM + bj * HALF + wc * 32 + 8 * fq;
#pragma unroll
            for (int ai = 0; ai < 2; ++ai)
#pragma unroll
                for (int m = 0; m < 4; ++m) {
                    const int row = u.pm * BM + ai * HALF + wr * 64 + m * 16 + fr;
                    const size_t off = (size_t)row * 1024 + col0;
                    const u32x4 bw = *(const u32x4*)(XB + off);
                    f32x4 x0 = acc[ai][bj][m][0] * r2[ai * 4 + m], x1 = acc[ai][bj][m][1] * r2[ai * 4 + m];
                    x0[0] += __builtin_bit_cast(float, bw.x << 16); x0[1] += __builtin_bit_cast(float, bw.x & 0xffff0000u);
                    x0[2] += __builtin_bit_cast(float, bw.y << 16); x0[3] += __builtin_bit_cast(float, bw.y & 0xffff0000u);
                    x1[0] += __builtin_bit_cast(float, bw.z << 16); x1[1] += __builtin_bit_cast(float, bw.z & 0xffff0000u);
                    x1[2] += __builtin_bit_cast(float, bw.w << 16); x1[3] += __builtin_bit_cast(float, bw.w & 0xffff0000u);
                    if (out) { *(f32x4*)(out + off) = x0; *(f32x4*)(out + off + 4) = x1; }
                    else {
                        float ss = ((x0[0] * x0[0] + x0[1] * x0[1]) + (x0[2] * x0[2] + x0[3] * x0[3])) + ((x1[0] * x1[0] + x1[1] * x1[1]) + (x1[2] * x1[2] + x1[3] * x1[3]));
                        ss += __shfl_xor(ss, 16); ss += __shfl_xor(ss, 32);
                        if (fq == 0) ssq[(size_t)row * 32 + u.pn * 8 + bj * 4 + wc] = ss;
                        u32x4 w; w.x = cvt_pk_bf16(x0[0], x0[1]); w.y = cvt_pk_bf16(x0[2], x0[3]); w.z = cvt_pk_bf16(x1[0], x1[1]); w.w = cvt_pk_bf16(x1[2], x1[3]);
                        *(u32x4*)(XB + off) = w;
                    }
                }
        }
    }
};

struct EpiFF1 {
    static constexpr bool PERM = true, AFTER_DRAIN = false;
    bf16_t* H;
    __device__ __forceinline__ void operator()(const f32x4 (&acc)[2][2][4][2], const Unit& u, int wr, int wc, int fr, int fq) const {
#pragma unroll
        for (int ai = 0; ai < 2; ++ai)
#pragma unroll
            for (int m = 0; m < 4; ++m) {
                const int row = u.pm * BM + ai * HALF + wr * 64 + m * 16 + fr;
#pragma unroll
                for (int bj = 0; bj < 2; ++bj) {
                    const int col0 = u.pn * BM + bj * HALF + wc * 32 + 8 * fq;
                    f32x4 a = acc[ai][bj][m][0], b = acc[ai][bj][m][1];
#pragma unroll
                    for (int e = 0; e < 4; ++e) { a[e] = fmaxf(a[e], 0.f); a[e] *= a[e]; b[e] = fmaxf(b[e], 0.f); b[e] *= b[e]; }
                    u32x4 w; w.x = cvt_pk_bf16(a[0], a[1]); w.y = cvt_pk_bf16(a[2], a[3]); w.z = cvt_pk_bf16(b[0], b[1]); w.w = cvt_pk_bf16(b[2], b[3]);
                    *(u32x4*)(H + (size_t)row * 4096 + col0) = w;
                }
            }
    }
};

template <class Epi, class Sched, bool ALIGN_EPI = false, bool SP2 = false>
__device__ __forceinline__ void gemm_phase(PG8_LAS unsigned char* lds, const Gemm g, const Sched& S, const Epi& E) {
    int tid_ = threadIdx.x; asm volatile("" : "+v"(tid_));
    const int tid = tid_, wid = __builtin_amdgcn_readfirstlane(tid >> 6), lane = tid & 63, wr = wid >> 2, wc = wid & 3, fr = lane & 15, fq = lane >> 4;
    const int K = g.K, nt = K / BK;
    unsigned voffA[2], voffB[2];
#pragma unroll
    for (int i = 0; i < 2; ++i) { int R, C; stage_rc(tid * 16 + i * 8192, R, C); const int Rb = Epi::PERM ? ((R & ~31) + perm32(R & 31)) : R;
        voffA[i] = (unsigned)(R * K + C) * 2u; voffB[i] = (unsigned)(Rb * K + C) * 2u; }
    const size_t kstep = (size_t)(BK * 2);
    const size_t hstep = (size_t)HALF * K * 2;
    const size_t tstep = 2 * hstep;
    const unsigned ldsw = (unsigned)wid * 1024u;
    const int aoff = lds_byte(wr * 64 + fr, fq * 8), boff = lds_byte(wc * 32 + fr, fq * 8);
#define PG8_SA(b, h) (((b) * 2 + (h)) * HTB)
#define PG8_SB(b, h) ((4 + (b) * 2 + (h)) * HTB)
#define PG8_STAGE(bufoff, gbase, voff) do { _Pragma("unroll") for (int _i = 0; _i < 2; ++_i) \
        __builtin_amdgcn_global_load_lds((const unsigned*)((const char*)(gbase) + (voff)[_i]), (PG8_LAS unsigned*)(lds + (bufoff) + ldsw + _i * 8192), 16, 0, 0); } while (0)
#define PG8_LDA(dst, b, h) do { _Pragma("unroll") for (int m = 0; m < 4; ++m) _Pragma("unroll") for (int k = 0; k < 2; ++k) dst[m][k] = *(const PG8_LAS bf16x8*)(lds + PG8_SA(b, h) + aoff + m * 2048 + k * 1024); } while (0)
#define PG8_LDB(dst, b, h) do { _Pragma("unroll") for (int n = 0; n < 2; ++n) _Pragma("unroll") for (int k = 0; k < 2; ++k) dst[n][k] = *(const PG8_LAS bf16x8*)(lds + PG8_SB(b, h) + boff + n * 2048 + k * 1024); } while (0)
#define PG8_MMA(ai, bj, At, Bt) do { __builtin_amdgcn_s_setprio(1); _Pragma("unroll") for (int m = 0; m < 4; ++m) _Pragma("unroll") for (int n = 0; n < 2; ++n) _Pragma("unroll") for (int k = 0; k < 2; ++k) \
        acc[ai][bj][m][n] = __builtin_amdgcn_mfma_f32_16x16x32_bf16(Bt[n][k], At[m][k], acc[ai][bj][m][n], 0, 0, 0); __builtin_amdgcn_s_setprio(0); } while (0)
#define PG8_WAIT_V(n) asm volatile("s_waitcnt vmcnt(" #n ")" ::: "memory")
#define PG8_WAIT_L(n) asm volatile("s_waitcnt lgkmcnt(" #n ")" ::: "memory")
#define PG8_BAR __builtin_amdgcn_s_barrier()
#define PG8_SCHED __builtin_amdgcn_sched_barrier(0)
    Unit cur, nxt; int ui = 0;
    if (!S.next(0, cur)) return;
    f32x4 acc[2][2][4][2];
#pragma unroll
    for (int a = 0; a < 2; ++a)
#pragma unroll
        for (int b = 0; b < 2; ++b)
#pragma unroll
            for (int m = 0; m < 4; ++m)
#pragma unroll
                for (int n = 0; n < 2; ++n) acc[a][b][m][n] = (f32x4){0.f, 0.f, 0.f, 0.f};
    bf16x8 At[4][2], B0[2][2], B1[2][2];
    const char* cA = (const char*)g.A + (size_t)cur.pm * tstep; const char* cB = (const char*)g.Bt + (size_t)cur.pn * tstep;
    S.a_ready(cur);
    if constexpr (SP2) {
        PG8_STAGE(PG8_SB(0, 0), cB, voffB); PG8_STAGE(PG8_SB(0, 1), cB + hstep, voffB); PG8_STAGE(PG8_SA(0, 0), cA, voffA); PG8_STAGE(PG8_SA(0, 1), cA + hstep, voffA);
        if (wr == 1) PG8_BAR;
        PG8_WAIT_V(2); PG8_BAR;
        PG8_STAGE(PG8_SB(1, 0), cB + kstep, voffB); PG8_STAGE(PG8_SA(1, 0), cA + kstep, voffA); PG8_STAGE(PG8_SB(1, 1), cB + hstep + kstep, voffB);
        PG8_WAIT_V(6); PG8_BAR;
    } else {
        PG8_STAGE(PG8_SB(0, 0), cB, voffB); PG8_STAGE(PG8_SA(0, 0), cA, voffA); PG8_STAGE(PG8_SB(0, 1), cB + hstep, voffB); PG8_STAGE(PG8_SA(0, 1), cA + hstep, voffA);
        if (wr == 1) PG8_BAR;
        PG8_WAIT_V(4); PG8_BAR;
        PG8_STAGE(PG8_SB(1, 0), cB + kstep, voffB); PG8_STAGE(PG8_SA(1, 0), cA + kstep, voffA); PG8_STAGE(PG8_SB(1, 1), cB + hstep + kstep, voffB);
        PG8_WAIT_V(6); PG8_BAR;
    }
    for (;;) {
        const bool has_next = S.next(ui + 1, nxt);
        const char* nA = has_next ? (const char*)g.A + (size_t)nxt.pm * tstep : cA; const char* nB = has_next ? (const char*)g.Bt + (size_t)nxt.pn * tstep : cB;
        for (int t = 0; t < nt; t += 2) {
            const bool last = (t == nt - 2);
            const char* a1 = cA + (size_t)(t + 1) * kstep;
            const char* a2 = last ? nA : cA + (size_t)(t + 2) * kstep; const char* b2 = last ? nB : cB + (size_t)(t + 2) * kstep;
            const char* a3 = a2 + kstep; const char* b3 = b2 + kstep;
            if (last && has_next) S.a_ready(nxt);
            if constexpr (SP2) {
            PG8_LDB(B0, 0, 0); PG8_LDB(B1, 0, 1); PG8_SCHED; PG8_LDA(At, 0, 0); PG8_STAGE(PG8_SA(1, 1), a1 + hstep, voffA);
            PG8_WAIT_V(8); PG8_WAIT_L(0); PG8_BAR; PG8_MMA(0, 0, At, B0); PG8_MMA(0, 1, At, B1); PG8_BAR; PG8_SCHED;
            PG8_LDA(At, 0, 1); PG8_STAGE(PG8_SB(0, 0), b2, voffB); PG8_STAGE(PG8_SB(0, 1), b2 + hstep, voffB); PG8_STAGE(PG8_SA(0, 0), a2, voffA);
            PG8_WAIT_V(8); PG8_WAIT_L(0); PG8_BAR; PG8_MMA(1, 0, At, B0); PG8_MMA(1, 1, At, B1); PG8_BAR; PG8_SCHED;
            PG8_LDB(B0, 1, 0); PG8_LDB(B1, 1, 1); PG8_SCHED; PG8_LDA(At, 1, 0); PG8_STAGE(PG8_SA(0, 1), a2 + hstep, voffA);
            PG8_WAIT_V(8); PG8_WAIT_L(0); PG8_BAR; PG8_MMA(0, 0, At, B0); PG8_MMA(0, 1, At, B1); PG8_BAR; PG8_SCHED;
            PG8_LDA(At, 1, 1); PG8_STAGE(PG8_SB(1, 0), b3, voffB); PG8_STAGE(PG8_SB(1, 1), b3 + hstep, voffB); PG8_STAGE(PG8_SA(1, 0), a3, voffA);
            PG8_WAIT_V(8); PG8_WAIT_L(0); PG8_BAR; PG8_MMA(1, 0, At, B0); PG8_MMA(1, 1, At, B1); PG8_BAR; PG8_SCHED;
            } else {
            PG8_LDB(B0, 0, 0); PG8_SCHED; PG8_LDA(At, 0, 0); PG8_STAGE(PG8_SA(1, 1), a1 + hstep, voffA);
            PG8_WAIT_L(8); PG8_BAR; PG8_WAIT_L(0); PG8_MMA(0, 0, At, B0); PG8_BAR; PG8_SCHED;
            PG8_LDB(B1, 0, 1); PG8_STAGE(PG8_SB(0, 0), b2, voffB);
            PG8_BAR; PG8_WAIT_L(0); PG8_MMA(0, 1, At, B1); PG8_BAR;
            PG8_LDA(At, 0, 1); PG8_STAGE(PG8_SA(0, 0), a2, voffA);
            PG8_BAR; PG8_WAIT_L(0); PG8_MMA(1, 0, At, B0); PG8_BAR; PG8_SCHED;
            PG8_STAGE(PG8_SB(0, 1), b2 + hstep, voffB);
            PG8_WAIT_V(6); PG8_BAR; PG8_MMA(1, 1, At, B1); PG8_BAR;
            PG8_LDB(B0, 1, 0); PG8_SCHED; PG8_LDA(At, 1, 0); PG8_STAGE(PG8_SA(0, 1), a2 + hstep, voffA);
            PG8_WAIT_L(8); PG8_BAR; PG8_WAIT_L(0); PG8_MMA(0, 0, At, B0); PG8_BAR; PG8_SCHED;
            PG8_LDB(B1, 1, 1); PG8_STAGE(PG8_SB(1, 0), b3, voffB);
            PG8_BAR; PG8_WAIT_L(0); PG8_MMA(0, 1, At, B1); PG8_BAR;
            PG8_LDA(At, 1, 1); PG8_STAGE(PG8_SA(1, 0), a3, voffA);
            PG8_BAR; PG8_WAIT_L(0); PG8_MMA(1, 0, At, B0); PG8_BAR; PG8_SCHED;
            PG8_STAGE(PG8_SB(1, 1), b3 + hstep, voffB);
            PG8_WAIT_V(6); PG8_BAR; PG8_MMA(1, 1, At, B1); PG8_BAR;
            }
        }
        if constexpr (ALIGN_EPI) { if (wr == 0) PG8_BAR; }
        if constexpr (!Epi::AFTER_DRAIN) { E(acc, cur, wr, wc, fr, fq); S.done(cur); }
        if (!has_next) break;
#pragma unroll
        for (int a = 0; a < 2; ++a)
#pragma unroll
            for (int b = 0; b < 2; ++b)
#pragma unroll
                for (int m = 0; m < 4; ++m)
#pragma unroll
                    for (int n = 0; n < 2; ++n) acc[a][b][m][n] = (f32x4){0.f, 0.f, 0.f, 0.f};
        cur = nxt; cA = nA; cB = nB; ++ui;
        if constexpr (ALIGN_EPI) { if (wr == 1) PG8_BAR; }
    }
    PG8_WAIT_V(0);
    if constexpr (!ALIGN_EPI) { if (wr == 0) PG8_BAR; }
    PG8_BAR;
    if constexpr (Epi::AFTER_DRAIN) { E.fused(acc, cur, wr, wc, fr, fq, lds, wid, lane); S.done(cur); }
#undef PG8_SA
#undef PG8_SB
#undef PG8_STAGE
#undef PG8_LDA
#undef PG8_LDB
#undef PG8_MMA
#undef PG8_WAIT_V
#undef PG8_WAIT_L
#undef PG8_BAR
#undef PG8_SCHED
}
}
#define LAS __attribute__((address_space(3)))
typedef unsigned short bf16_t;
typedef short bf16x8 __attribute__((ext_vector_type(8)));
typedef short s16x4 __attribute__((ext_vector_type(4)));
typedef float f32x4 __attribute__((ext_vector_type(4)));
typedef float f32x16 __attribute__((ext_vector_type(16)));
typedef unsigned u32x4 __attribute__((ext_vector_type(4)));
typedef unsigned u32x2 __attribute__((ext_vector_type(2)));
using pg8::ZP; using pg8::LOG2E; using pg8::EPS;
__device__ __forceinline__ int crow(int r, int hi) { return (r & 3) + 8 * (r >> 2) + 4 * hi; }
__device__ __forceinline__ unsigned cvtpk(float lo, float hi) { unsigned r; asm volatile("v_cvt_pk_bf16_f32 %0, %1, %2" : "=v"(r) : "v"(lo), "v"(hi)); return r; }
__device__ __forceinline__ unsigned f2bf(float f) { unsigned u = __builtin_bit_cast(unsigned, f); return (u + 0x7fffu + ((u >> 16) & 1u)) >> 16; }
__device__ __forceinline__ float bf2f(unsigned short h) { return __builtin_bit_cast(float, (unsigned)h << 16); }
__device__ __forceinline__ float ex2(float x) { return __builtin_amdgcn_exp2f(x); }
#define VM_WAIT0() asm volatile("s_waitcnt vmcnt(0)" ::: "memory")
#define LGKM_WAIT0() asm volatile("s_waitcnt lgkmcnt(0)" ::: "memory")

__device__ __forceinline__ void dma_k(LAS unsigned char* slot, const bf16_t* src, int pitch, int w, int lane) {
    const bf16_t* s = src + (size_t)lane * pitch + w * 8;
    __builtin_amdgcn_global_load_lds((const unsigned*)s, (LAS unsigned*)(slot + w * 1024), 16, 0, 0);
}
__device__ __forceinline__ void dma_v(LAS unsigned char* slot, const bf16_t* src, int pitch, int w, int lane) {
    const bf16_t* s = src + (size_t)(16 * (w & 3) + (lane >> 2)) * pitch + (w >> 2) * 32 + (lane & 3) * 8;
    __builtin_amdgcn_global_load_lds((const unsigned*)s, (LAS unsigned*)(slot + w * 1024), 16, 0, 0);
}
__device__ __forceinline__ void dma_lin(LAS unsigned char* slot, const unsigned char* src, int w, int lane) {
    __builtin_amdgcn_global_load_lds((const unsigned*)(src + w * 1024 + lane * 16), (LAS unsigned*)(slot + w * 1024), 16, 0, 0);
}
__device__ __forceinline__ void qkt(f32x16& p0, f32x16& p1, const LAS unsigned char* Kslot, const bf16x8* qr, int r32, int hi, f32x16 z0 = f32x16{}, f32x16 z1 = f32x16{}) {
    const LAS unsigned char* kb = Kslot + hi * 1024 + r32 * 16;
#pragma unroll
    for (int d0 = 0; d0 < 4; ++d0) {
        const bf16x8 b0 = *(const LAS bf16x8*)(kb + d0 * 2048);
        const bf16x8 b1 = *(const LAS bf16x8*)(kb + d0 * 2048 + 512);
        z0 = __builtin_amdgcn_mfma_f32_32x32x16_bf16(b0, qr[d0], z0, 0, 0, 0);
        z1 = __builtin_amdgcn_mfma_f32_32x32x16_bf16(b1, qr[d0], z1, 0, 0, 0);
    }
    p0 = z0; p1 = z1;
}
__device__ __forceinline__ int vt_lane_off(int lane) { const int hi = lane >> 5; return ((lane >> 4) & 1) * 32 + (lane & 3) * 8 + (4 * hi + ((lane & 15) >> 2)) * 64; }
__device__ __forceinline__ bf16x8 vfrag(int vb, int d0, int ks) {
    s16x4 lo, hh;
    asm volatile("ds_read_b64_tr_b16 %0, %1" : "=v"(lo) : "v"(vb + d0 * 4096 + ks * 1024) : "memory");
    asm volatile("ds_read_b64_tr_b16 %0, %1" : "=v"(hh) : "v"(vb + d0 * 4096 + ks * 1024 + 512) : "memory");
    asm volatile("s_waitcnt lgkmcnt(0)" : "+v"(lo), "+v"(hh) :: "memory");
    return (bf16x8){lo[0], lo[1], lo[2], lo[3], hh[0], hh[1], hh[2], hh[3]};
}
__device__ __forceinline__ void pv(f32x16* o, int vb, bf16x8 pa0, bf16x8 pa1, bf16x8 pa2, bf16x8 pa3) {
    s16x4 lo[8], hh[8];
#pragma unroll
    for (int i = 0; i < 8; ++i) {
        asm volatile("ds_read_b64_tr_b16 %0, %1 offset:%c2" : "=&v"(lo[i]) : "v"(vb), "i"((i >> 2) * 4096 + (i & 3) * 1024) : "memory");
        asm volatile("ds_read_b64_tr_b16 %0, %1 offset:%c2" : "=&v"(hh[i]) : "v"(vb), "i"((i >> 2) * 4096 + (i & 3) * 1024 + 512) : "memory");
    }
    asm volatile("s_waitcnt lgkmcnt(0)" : "+v"(lo[0]), "+v"(lo[1]), "+v"(lo[2]), "+v"(lo[3]), "+v"(lo[4]), "+v"(lo[5]), "+v"(lo[6]), "+v"(lo[7]),
                 "+v"(hh[0]), "+v"(hh[1]), "+v"(hh[2]), "+v"(hh[3]), "+v"(hh[4]), "+v"(hh[5]), "+v"(hh[6]), "+v"(hh[7]) :: "memory");
#define PVK(k) (bf16x8){lo[k][0], lo[k][1], lo[k][2], lo[k][3], hh[k][0], hh[k][1], hh[k][2], hh[k][3]}
    o[0] = __builtin_amdgcn_mfma_f32_32x32x16_bf16(pa0, PVK(0), o[0], 0, 0, 0);
    o[1] = __builtin_amdgcn_mfma_f32_32x32x16_bf16(pa0, PVK(4), o[1], 0, 0, 0);
    o[0] = __builtin_amdgcn_mfma_f32_32x32x16_bf16(pa1, PVK(1), o[0], 0, 0, 0);
    o[1] = __builtin_amdgcn_mfma_f32_32x32x16_bf16(pa1, PVK(5), o[1], 0, 0, 0);
    o[0] = __builtin_amdgcn_mfma_f32_32x32x16_bf16(pa2, PVK(2), o[0], 0, 0, 0);
    o[1] = __builtin_amdgcn_mfma_f32_32x32x16_bf16(pa2, PVK(6), o[1], 0, 0, 0);
    o[0] = __builtin_amdgcn_mfma_f32_32x32x16_bf16(pa3, PVK(3), o[0], 0, 0, 0);
    o[1] = __builtin_amdgcn_mfma_f32_32x32x16_bf16(pa3, PVK(7), o[1], 0, 0, 0);
#undef PVK
}
#define PACK8(P, B) __builtin_bit_cast(bf16x8, ((u32x4){cvtpk(P[B], P[B + 1]), cvtpk(P[B + 2], P[B + 3]), cvtpk(P[B + 4], P[B + 5]), cvtpk(P[B + 6], P[B + 7])}))
__device__ __forceinline__ void scale_rows(f32x16* o, float f, LAS float* wsf, int r32, int hi) {
    if (hi == 0) wsf[r32] = f;
    LGKM_WAIT0();
#pragma unroll
    for (int r = 0; r < 16; ++r) { const float fr = wsf[crow(r, hi)]; o[0][r] *= fr; o[1][r] *= fr; }
    LGKM_WAIT0();
}
__device__ __forceinline__ float max3f(float x, float y, float z) { return __builtin_fmaxf(__builtin_fmaxf(x, y), z); }
typedef float f32x8 __attribute__((ext_vector_type(8)));
typedef float f32x2 __attribute__((ext_vector_type(2)));
typedef short v4i16_t __attribute__((ext_vector_type(4)));
__device__ __forceinline__ s16x4 vtr(const LAS unsigned char* p) { return __builtin_bit_cast(s16x4, __builtin_amdgcn_ds_read_tr16_b64_v4i16((LAS v4i16_t*)p)); }
__device__ __forceinline__ float rowmax32(const f32x16& p0, const f32x16& p1) {
    float a = max3f(p0[0], p0[1], p1[0]), b = max3f(p0[2], p0[3], p1[1]); a = max3f(a, p1[2], p1[3]);
#pragma unroll
    for (int r = 4; r < 16; r += 4) { a = max3f(a, p0[r], p0[r + 1]); b = max3f(b, p0[r + 2], p0[r + 3]); a = max3f(a, p1[r], p1[r + 1]); b = max3f(b, p1[r + 2], p1[r + 3]); }
    const float m = fmaxf(a, b);
    auto rr = __builtin_amdgcn_permlane32_swap(__builtin_bit_cast(unsigned, m), __builtin_bit_cast(unsigned, m), false, false);
    return fmaxf(__builtin_bit_cast(float, (unsigned)rr[0]), __builtin_bit_cast(float, (unsigned)rr[1]));
}
template <int THR, bool HASF>
__device__ __forceinline__ void attn_step(f32x16& p0, f32x16& p1, f32x16& n0, f32x16& n1, const LAS unsigned char* Knext, const LAS float* Fnext, const LAS unsigned char* Vcur,
                                          const bf16x8* qr, float& mhat, float& l, f32x16* o, LAS float* wsf, int r32, int hi) {
    f32x16 c0 = f32x16{}, c1 = f32x16{};
    if (HASF) {
#pragma unroll
        for (int rr = 0; rr < 4; ++rr) { const f32x4 f0 = *(const LAS f32x4*)(Fnext + 8 * rr), f1 = *(const LAS f32x4*)(Fnext + 32 + 8 * rr);
#pragma unroll
            for (int e = 0; e < 4; ++e) { c0[4 * rr + e] = f0[e]; c1[4 * rr + e] = f1[e]; } }
    }
    bf16x8 kf[8];
    { const LAS unsigned char* kb = Knext + hi * 1024 + r32 * 16;
#pragma unroll
      for (int d0 = 0; d0 < 4; ++d0) { kf[2 * d0] = *(const LAS bf16x8*)(kb + d0 * 2048); kf[2 * d0 + 1] = *(const LAS bf16x8*)(kb + d0 * 2048 + 512); } }
    __builtin_amdgcn_sched_barrier(0);
    const float rm = rowmax32(p0, p1);
    if (__any(rm > mhat + (float)THR)) {
        const float mnew = fmaxf(mhat, rm), f = ex2(mhat - mnew);
        l *= f; mhat = mnew; scale_rows(o, f, wsf, r32, hi);
    }
#pragma unroll
    for (int d0 = 0; d0 < 4; ++d0) {
        c0 = __builtin_amdgcn_mfma_f32_32x32x16_bf16(kf[2 * d0], qr[d0], c0, 0, 0, 0);
        c1 = __builtin_amdgcn_mfma_f32_32x32x16_bf16(kf[2 * d0 + 1], qr[d0], c1, 0, 0, 0);
    }
    __builtin_amdgcn_sched_barrier(0);
    s16x4 vl[8], vh[8];
#pragma unroll
    for (int i = 0; i < 8; ++i) { vl[i] = vtr(Vcur + (i >> 2) * 4096 + (i & 3) * 1024); vh[i] = vtr(Vcur + (i >> 2) * 4096 + (i & 3) * 1024 + 512); }
    __builtin_amdgcn_sched_barrier(0);
    p0 = p0 - mhat; p1 = p1 - mhat;
#pragma unroll
    for (int r = 0; r < 16; ++r) { p0[r] = ex2(p0[r]); p1[r] = ex2(p1[r]); }
    const f32x16 t = p0 + p1;
    const f32x8 t8 = t.lo + t.hi; const f32x4 t4 = t8.lo + t8.hi; const f32x2 t2 = t4.lo + t4.hi;
    l += t2.x + t2.y;
    const bf16x8 pa0 = PACK8(p0, 0), pa1 = PACK8(p0, 8), pa2 = PACK8(p1, 0), pa3 = PACK8(p1, 8);
#define VFK(k) (bf16x8){vl[k][0], vl[k][1], vl[k][2], vl[k][3], vh[k][0], vh[k][1], vh[k][2], vh[k][3]}
    o[0] = __builtin_amdgcn_mfma_f32_32x32x16_bf16(pa0, VFK(0), o[0], 0, 0, 0);
    o[1] = __builtin_amdgcn_mfma_f32_32x32x16_bf16(pa0, VFK(4), o[1], 0, 0, 0);
    o[0] = __builtin_amdgcn_mfma_f32_32x32x16_bf16(pa1, VFK(1), o[0], 0, 0, 0);
    o[1] = __builtin_amdgcn_mfma_f32_32x32x16_bf16(pa1, VFK(5), o[1], 0, 0, 0);
    o[0] = __builtin_amdgcn_mfma_f32_32x32x16_bf16(pa2, VFK(2), o[0], 0, 0, 0);
    o[1] = __builtin_amdgcn_mfma_f32_32x32x16_bf16(pa2, VFK(6), o[1], 0, 0, 0);
    o[0] = __builtin_amdgcn_mfma_f32_32x32x16_bf16(pa3, VFK(3), o[0], 0, 0, 0);
    o[1] = __builtin_amdgcn_mfma_f32_32x32x16_bf16(pa3, VFK(7), o[1], 0, 0, 0);
#undef VFK
    n0 = c0; n1 = c1;
}
template <int THR>
__device__ __forceinline__ void softmax_pv(f32x16& p0, f32x16& p1, float& mhat, float& l, f32x16* o, int vb, LAS float* wsf, int r32, int hi) {
    float a = max3f(p0[0], p0[1], p1[0]), b = max3f(p0[2], p0[3], p1[1]); a = max3f(a, p1[2], p1[3]);
#pragma unroll
    for (int r = 4; r < 16; r += 4) { a = max3f(a, p0[r], p0[r + 1]); b = max3f(b, p0[r + 2], p0[r + 3]); a = max3f(a, p1[r], p1[r + 1]); b = max3f(b, p1[r + 2], p1[r + 3]); }
    float rm = fmaxf(a, b); rm = fmaxf(rm, __shfl_xor(rm, 32));
    if (__any(rm > mhat + (float)THR)) {
        const float mnew = fmaxf(mhat, rm), f = ex2(mhat - mnew);
        l *= f; mhat = mnew; scale_rows(o, f, wsf, r32, hi);
    }
    p0 = p0 - mhat; p1 = p1 - mhat;
#pragma unroll
    for (int r = 0; r < 16; ++r) { p0[r] = ex2(p0[r]); p1[r] = ex2(p1[r]); }
    const f32x16 t = p0 + p1;
    const f32x8 t8 = t.lo + t.hi; const f32x4 t4 = t8.lo + t8.hi; const f32x2 t2 = t4.lo + t4.hi;
    l += t2.x + t2.y;
    pv(o, vb, PACK8(p0, 0), PACK8(p0, 8), PACK8(p1, 0), PACK8(p1, 8));
}
__device__ __forceinline__ void store_o(const f32x16* o, float rinv, LAS float* wsf, LAS bf16_t* stg, bf16_t* Og, int pitch, int r32, int hi, int lane) {
    if (hi == 0) wsf[32 + r32] = rinv;
    LGKM_WAIT0();
#pragma unroll
    for (int r = 0; r < 16; ++r) { const int orow = crow(r, hi); const float rl = wsf[32 + orow];
#pragma unroll
        for (int d0 = 0; d0 < 2; ++d0) stg[orow * 64 + d0 * 32 + r32] = (bf16_t)f2bf(o[d0][r] * rl); }
    LGKM_WAIT0();
#pragma unroll
    for (int i = 0; i < 4; ++i) { const int row = i * 8 + (lane >> 3), ch = lane & 7; const u32x4 v = *(const LAS u32x4*)(stg + row * 64 + ch * 8); *(u32x4*)(Og + (size_t)row * pitch + ch * 8) = v; }
    LGKM_WAIT0();
}
__device__ __forceinline__ float log_sigmoid(float x) { const float y = __expf(-fabsf(x)); return fminf(x, 0.f) - (y < 0.03125f ? y * (1.0f - y * (0.5f - y * (1.0f / 3.0f))) : __logf(1.0f + y)); }

constexpr int MX_RING = 0, MX_F = 98304, MX_WSF = 114688, MX_WTOT = 116736, MX_STG_SWA = 65536, MX_STG_FOX = 40960;

struct MixCtx {
    const bf16_t* Z; const float* G; bf16_t* Y;
    const float* sinks; const float* fox_fb; const float* ml_ib; const float* ml_fb; const float* ml_norm;
    unsigned char* ws; const unsigned char* KT; const unsigned char* VT;
};

__device__ __forceinline__ void swa_item(const MixCtx& C, int item, LAS unsigned char* lds) {
    int tid_ = threadIdx.x; asm volatile("" : "+v"(tid_));
    const int tid = tid_, lane = tid & 63, w = __builtin_amdgcn_readfirstlane(tid >> 6), r32 = lane & 31, hi = lane >> 5;
    const int jp = item & 31, kvh = (item >> 5) & 1, b = item >> 6;
    const size_t rowbase = (size_t)b * 4096;
    const int cbase = jp >= 1 ? 2 * jp - 2 : 0, ntl = 2 * jp + 2 - cbase;
    const bf16_t* Kb = C.Z + rowbase * ZP + 512 + 64 * kvh; const bf16_t* Vb = C.Z + rowbase * ZP + 640 + 64 * kvh;
    for (int j = 0; j < ntl; ++j) { dma_k(lds + MX_RING + j * 16384, Kb + (size_t)(cbase + j) * 64 * ZP, ZP, w, lane); dma_v(lds + MX_RING + j * 16384 + 8192, Vb + (size_t)(cbase + j) * 64 * ZP, ZP, w, lane); }
    const int hq = 4 * kvh + (w >> 1);
    bf16x8 qra[4], qrb[4];
    { const bf16_t* Qa = C.Z + (rowbase + 128 * jp + 32 * (w & 1) + r32) * ZP + 64 * hq;
#pragma unroll
      for (int d0 = 0; d0 < 4; ++d0) { qra[d0] = *(const bf16x8*)(Qa + 16 * d0 + 8 * hi); qrb[d0] = *(const bf16x8*)(Qa + (size_t)64 * ZP + 16 * d0 + 8 * hi); } }
    LAS float* wsf = (LAS float*)(lds + MX_WSF) + w * 64; LAS bf16_t* stg = (LAS bf16_t*)(lds + MX_STG_SWA + w * 4096);
    const float sink = C.sinks[hq] * LOG2E;
    VM_WAIT0(); __syncthreads();
    const int vlo = vt_lane_off(lane);
#pragma unroll
    for (int cc = 0; cc < 2; ++cc) {
        const int c = 2 * jp + cc, c0 = c >= 2 ? c - 2 : 0, nt = c - c0 + 1, s0 = c0 - cbase, qw0 = 64 * c + 32 * (w & 1);
        const bf16x8* qr = cc == 0 ? qra : qrb;
        float mhat = sink, l = hi == 0 ? 1.f : 0.f; f32x16 o[2]; o[0] = f32x16{}; o[1] = f32x16{};
        f32x16 p0, p1; qkt(p0, p1, lds + MX_RING + s0 * 16384, qr, r32, hi);
        for (int j = 0; j < nt; ++j) {
            f32x16 n0 = p0, n1 = p1;
            if (j + 1 < nt) qkt(n0, n1, lds + MX_RING + (s0 + j + 1) * 16384, qr, r32, hi);
            softmax_pv<8>(p0, p1, mhat, l, o, (int)(uintptr_t)(lds + MX_RING + (s0 + j) * 16384 + 8192) + vlo, wsf, r32, hi);
            p0 = n0; p1 = n1;
        }
        l += __shfl_xor(l, 32);
        store_o(o, 1.0f / l, wsf, stg, C.Y + (rowbase + qw0) * 1024 + 64 * hq, 1024, r32, hi, lane);
    }
    __syncthreads();
}

__device__ __forceinline__ void fx0_item(const MixCtx& C, float* NF, unsigned* cntF, int bh, LAS unsigned char* lds) {
    int tid_ = threadIdx.x; asm volatile("" : "+v"(tid_));
    const int tid = tid_, lane = tid & 63, w = __builtin_amdgcn_readfirstlane(tid >> 6);
    const int b = bh >> 2, h = bh & 3; const size_t rowbase = (size_t)b * 4096;
    LAS float* wtot = (LAS float*)(lds + MX_WTOT);
    const float fb = C.fox_fb[h]; const int t0 = tid * 8; float v[8]; float run = 0.f;
    const f32x4 g0 = *(const f32x4*)(C.G + (size_t)h * 16384 + rowbase + t0), g1 = *(const f32x4*)(C.G + (size_t)h * 16384 + rowbase + t0 + 4);
#pragma unroll
    for (int i = 0; i < 8; ++i) { run += log_sigmoid((i < 4 ? g0[i & 3] : g1[i & 3]) + fb) * LOG2E; v[i] = run; }
    float inc = run;
#pragma unroll
    for (int o_ = 1; o_ < 64; o_ <<= 1) { const float y = __shfl_up(inc, o_); if (lane >= o_) inc += y; }
    if (lane == 63) wtot[w] = inc;
    __syncthreads();
    float off = inc - run;
    for (int j = 0; j < w; ++j) off += wtot[j];
    *(f32x4*)(NF + bh * 4096 + t0) = (f32x4){-(v[0] + off), -(v[1] + off), -(v[2] + off), -(v[3] + off)};
    *(f32x4*)(NF + bh * 4096 + t0 + 4) = (f32x4){-(v[4] + off), -(v[5] + off), -(v[6] + off), -(v[7] + off)};
    asm volatile("s_waitcnt vmcnt(0)" ::: "memory"); __syncthreads();
    if (tid == 0) { __builtin_amdgcn_fence(__ATOMIC_RELEASE, "agent"); asm volatile("s_waitcnt vmcnt(0)" ::: "memory"); __hip_atomic_fetch_add(cntF + bh, 1u, __ATOMIC_RELAXED, __HIP_MEMORY_SCOPE_AGENT); }
    __syncthreads();
}
__device__ __forceinline__ void fox_block(const MixCtx& C, const float* NF, unsigned* cntF, int bh, int qb, LAS unsigned char* lds, bool first) {
    int tid_ = threadIdx.x; asm volatile("" : "+v"(tid_));
    const int tid = tid_, lane = tid & 63, w = __builtin_amdgcn_readfirstlane(tid >> 6), r32 = lane & 31, hi = lane >> 5;
    const int b = bh >> 2, h = bh & 3; const size_t rowbase = (size_t)b * 4096; const int q0 = qb * 128, nkeys = q0 + 128, nst = qb + 1;
    const unsigned char* Kt = C.KT + (size_t)bh * 64 * 8192; const unsigned char* Vt = C.VT + (size_t)bh * 64 * 8192;
#define FOX_STAGE(st_) do { LAS unsigned char* sb_ = lds + MX_RING + ((st_) % 3) * 32768; \
        dma_lin(sb_, Kt + (size_t)(2 * (st_)) * 8192, w, lane); dma_lin(sb_ + 8192, Kt + (size_t)(2 * (st_) + 1) * 8192, w, lane); \
        dma_lin(sb_ + 16384, Vt + (size_t)(2 * (st_)) * 8192, w, lane); dma_lin(sb_ + 24576, Vt + (size_t)(2 * (st_) + 1) * 8192, w, lane); } while (0)
    FOX_STAGE(0); if (nst > 1) FOX_STAGE(1);
    LAS float* F2 = (LAS float*)(lds + MX_F);
    LAS float* wsf = (LAS float*)(lds + MX_WSF) + w * 64; LAS bf16_t* stg = (LAS bf16_t*)(lds + MX_STG_FOX + w * 4096);
    const int g = w >> 2, qw0 = q0 + 32 * (w & 3);
    const bf16_t* Qb = C.Z + (rowbase + qw0 + r32) * ZP + 768 + 64 * h;
    bf16x8 qr[4];
#pragma unroll
    for (int d0 = 0; d0 < 4; ++d0) qr[d0] = *(const bf16x8*)(Qb + 16 * d0 + 8 * hi);
    if (first) {
        if (tid == 0) { while (__hip_atomic_load(cntF + bh, __ATOMIC_RELAXED, __HIP_MEMORY_SCOPE_AGENT) < 1u) __builtin_amdgcn_s_sleep(2); }
        __syncthreads();
    }
    {
        const int t0 = tid * 8;
        if (first && t0 < nkeys) { const unsigned long long* np = (const unsigned long long*)(NF + bh * 4096 + t0); unsigned long long q[4];
#pragma unroll
            for (int i = 0; i < 4; ++i) q[i] = __hip_atomic_load(np + i, __ATOMIC_RELAXED, __HIP_MEMORY_SCOPE_AGENT);
#pragma unroll
            for (int i = 0; i < 4; ++i) *(LAS unsigned long long*)(F2 + t0 + 2 * i) = q[i]; }
    }
    float mhat = -1e30f, l = 0.f; f32x16 o[2]; o[0] = f32x16{}; o[1] = f32x16{};
    VM_WAIT0(); __syncthreads();
    const int vlo = vt_lane_off(lane), qpos = qw0 + r32;
#define FOX_SCORE(st_, P0, P1) do { const int kb_ = 64 * (2 * (st_) + g); const LAS unsigned char* sk_ = lds + MX_RING + ((st_) % 3) * 32768 + g * 8192; f32x16 c0_, c1_; \
        _Pragma("unroll") for (int rr = 0; rr < 4; ++rr) { const f32x4 f0 = *(const LAS f32x4*)(F2 + kb_ + 8 * rr + 4 * hi), f1 = *(const LAS f32x4*)(F2 + kb_ + 32 + 8 * rr + 4 * hi); \
            _Pragma("unroll") for (int e = 0; e < 4; ++e) { c0_[4 * rr + e] = f0[e]; c1_[4 * rr + e] = f1[e]; } } \
        qkt(P0, P1, sk_, qr, r32, hi, c0_, c1_); } while (0)
    f32x16 p0, p1, n0, n1; FOX_SCORE(0, p0, p1);
#define FOX_STEP(PA0, PA1, PB0, PB1, st_) do { if ((st_) + 2 < nst) FOX_STAGE((st_) + 2); \
        attn_step<24, true>(PA0, PA1, PB0, PB1, lds + MX_RING + (((st_) + 1) % 3) * 32768 + g * 8192, F2 + 64 * (2 * ((st_) + 1) + g) + 4 * hi, \
                           lds + MX_RING + ((st_) % 3) * 32768 + 16384 + g * 8192 + vlo, qr, mhat, l, o, wsf, r32, hi); \
        VM_WAIT0(); __syncthreads(); } while (0)
#define FOX_LAST(PA0, PA1) do { const int st = nst - 1, kbase = 64 * (2 * st + g); \
        if (kbase <= qw0 + 31) { \
            if (kbase + 63 > qw0) { _Pragma("unroll") for (int r = 0; r < 16; ++r) { const int kv = kbase + crow(r, hi); if (kv > qpos) PA0[r] = -INFINITY; if (kv + 32 > qpos) PA1[r] = -INFINITY; } } \
            softmax_pv<24>(PA0, PA1, mhat, l, o, (int)(uintptr_t)(lds + MX_RING + (st % 3) * 32768 + 16384 + g * 8192) + vlo, wsf, r32, hi); } } while (0)
    int st2 = 0;
    for (; st2 + 2 < nst; st2 += 2) { FOX_STEP(p0, p1, n0, n1, st2); FOX_STEP(n0, n1, p0, p1, st2 + 1); }
    if (st2 + 1 < nst) { FOX_STEP(p0, p1, n0, n1, st2); FOX_LAST(n0, n1); } else { FOX_LAST(p0, p1); }
#undef FOX_STEP
#undef FOX_LAST
    __syncthreads();
#undef FOX_SCORE
#undef FOX_STAGE
    l += __shfl_xor(l, 32);
    LAS float* mo = (LAS float*)(lds + MX_RING); LAS float* ml = (LAS float*)(lds + MX_RING + 32768);
    const int wq = w & 3;
    if (g == 1) {
#pragma unroll
        for (int d0 = 0; d0 < 2; ++d0)
#pragma unroll
            for (int r = 0; r < 16; ++r) mo[((wq * 2 + d0) * 16 + r) * 64 + lane] = o[d0][r];
        ml[(wq * 2 + 0) * 64 + lane] = mhat; ml[(wq * 2 + 1) * 64 + lane] = l;
    }
    __syncthreads();
    if (g == 0) {
        const float m1 = ml[(wq * 2 + 0) * 64 + lane], l1 = ml[(wq * 2 + 1) * 64 + lane];
        const float mn = fmaxf(mhat, m1), f0 = ex2(mhat - mn), f1 = ex2(m1 - mn), lt = l * f0 + l1 * f1;
        if (hi == 0) { wsf[r32] = f0; wsf[32 + r32] = f1; }
        LGKM_WAIT0();
#pragma unroll
        for (int r = 0; r < 16; ++r) { const float a0 = wsf[crow(r, hi)], a1 = wsf[32 + crow(r, hi)];
#pragma unroll
            for (int d0 = 0; d0 < 2; ++d0) o[d0][r] = o[d0][r] * a0 + mo[((wq * 2 + d0) * 16 + r) * 64 + lane] * a1; }
        LGKM_WAIT0();
        store_o(o, 1.0f / lt, wsf, stg, C.Y + (rowbase + qw0) * 1024 + 512 + 64 * h, 1024, r32, hi, lane);
    }
    __syncthreads();
}
__device__ __forceinline__ void fox_item(const MixCtx& C, const float* NF, unsigned* cntF, int bh, int i, LAS unsigned char* lds) {
    fox_block(C, NF, cntF, bh, 31 - i, lds, true);
    fox_block(C, NF, cntF, bh, i, lds, false);
}
constexpr int ML_WSF = 98304, ML_STG = 100352, ML_SM = 133120;
struct MlScratch { float* E; float* B; float* PM; float* CL; float* NL; bf16_t* CP; float* NP; float* GC; float* EM; float* MP; unsigned* cnt1; unsigned* cnt2; };
__device__ __forceinline__ void wait_count(unsigned* p, unsigned want, int tid) {
    if (tid == 0) { while (__hip_atomic_load(p, __ATOMIC_RELAXED, __HIP_MEMORY_SCOPE_AGENT) < want) __builtin_amdgcn_s_sleep(2);
        __builtin_amdgcn_fence(__ATOMIC_ACQUIRE, "agent"); asm volatile("s_waitcnt vmcnt(0)" ::: "memory"); }
    __syncthreads();
}
__device__ __forceinline__ void post_count(unsigned* p, int tid) {
    asm volatile("s_waitcnt vmcnt(0)" ::: "memory"); __syncthreads();
    if (tid == 0) { __builtin_amdgcn_fence(__ATOMIC_RELEASE, "agent"); asm volatile("s_waitcnt vmcnt(0)" ::: "memory");
        __hip_atomic_fetch_add(p, 1u, __ATOMIC_RELAXED, __HIP_MEMORY_SCOPE_AGENT); }
}
#define ML_COMMON \
    int tid_ = threadIdx.x; asm volatile("" : "+v"(tid_)); \
    const int tid = tid_, lane = tid & 63, w = __builtin_amdgcn_readfirstlane(tid >> 6), r32 = lane & 31, hi = lane >> 5; \
    const int b = bh >> 2, h = bh & 3; const size_t rowbase = (size_t)b * 4096; \
    float* E = S.E + bh * 4096; float* B = S.B + bh * 4096; float* PM = S.PM + bh * 4096; \
    float* CL = S.CL + (size_t)bh * 64 * 4096; float* NL = S.NL + bh * 4096; bf16_t* CP = S.CP + (size_t)bh * 64 * 4096; float* NP = S.NP + bh * 4096; \
    float* GC = S.GC + bh * 64; float* EM = S.EM + bh * 64; float* MP = S.MP + bh * 64; \
    (void)r32; (void)hi; (void)E; (void)B; (void)PM; (void)CL; (void)NL; (void)CP; (void)NP; (void)GC; (void)EM; (void)MP; (void)rowbase; (void)h;

__device__ __forceinline__ void ml1_item(const MixCtx& C, const MlScratch& S, int bh, int rd, LAS unsigned char* lds) {
    ML_COMMON
    LAS float* le = (LAS float*)(lds + ML_SM); LAS float* lem = le + 512;
    const bf16_t* Kg = C.Z + rowbase * ZP + 1792 + 64 * h; const bf16_t* Vg = C.Z + rowbase * ZP + 2048 + 64 * h;
    const int srow = 16 * (w & 3) + (lane >> 2), scol = (w >> 2) * 32 + (lane & 3) * 8;
    u32x4 kvr[8];
#pragma unroll
    for (int p = 0; p < 8; ++p) kvr[p] = *(const u32x4*)(Kg + (size_t)((8 * rd + p) * 64 + srow) * ZP + scol);
    {
        const int cc = 8 * rd + w, t = cc * 64 + lane;
        const float ig = C.G[(size_t)(4 + h) * 16384 + rowbase + t] + C.ml_ib[h];
        float bsum = log_sigmoid(C.G[(size_t)(8 + h) * 16384 + rowbase + t] + C.ml_fb[h]);
#pragma unroll
        for (int o_ = 1; o_ < 64; o_ <<= 1) { const float y = __shfl_up(bsum, o_); if (lane >= o_) bsum += y; }
        const float e = ig - bsum; float pm = e;
#pragma unroll
        for (int o_ = 1; o_ < 64; o_ <<= 1) { const float y = __shfl_up(pm, o_); if (lane >= o_) pm = fmaxf(pm, y); }
        E[t] = e; B[t] = bsum; PM[t] = pm; le[w * 64 + lane] = e;
        if (lane == 63) { GC[cc] = bsum; EM[cc] = pm; lem[w] = pm; }
    }
    __syncthreads();
    const int vlo = vt_lane_off(lane);
    const bf16x8 ones = (bf16x8){0x3F80, 0x3F80, 0x3F80, 0x3F80, 0x3F80, 0x3F80, 0x3F80, 0x3F80};
#pragma unroll
    for (int p = 0; p < 8; ++p) {
        const int cc = 8 * rd + p; LAS unsigned char* sl = lds + p * 16384;
        const float wa = __expf(le[p * 64 + srow] - lem[p]);
        u32x4 w2;
#pragma unroll
        for (int j = 0; j < 4; ++j) { const float lo = __builtin_bit_cast(float, kvr[p][j] << 16), hh = __builtin_bit_cast(float, kvr[p][j] & 0xffff0000u); w2[j] = cvtpk(lo * wa, hh * wa); }
        *(LAS u32x4*)(sl + w * 1024 + lane * 16) = w2;
        dma_v(sl + 8192, Vg + (size_t)cc * 64 * ZP, ZP, w, lane);
    }
    VM_WAIT0(); __syncthreads();
    {
        const int cc = 8 * rd + w; LAS unsigned char* sl = lds + w * 16384;
        const int ka = (int)(uintptr_t)sl + vlo, va = ka + 8192;
        float* cl = CL + (size_t)cc * 4096;
#pragma unroll
        for (int half = 0; half < 2; ++half) {
            f32x16 a0 = {}, a1 = {}, na = {};
#pragma unroll
            for (int ks = 0; ks < 4; ++ks) {
                const bf16x8 A = vfrag(ka, half, ks), B0 = vfrag(va, 0, ks), B1 = vfrag(va, 1, ks);
                a0 = __builtin_amdgcn_mfma_f32_32x32x16_bf16(A, B0, a0, 0, 0, 0);
                a1 = __builtin_amdgcn_mfma_f32_32x32x16_bf16(A, B1, a1, 0, 0, 0);
                na = __builtin_amdgcn_mfma_f32_32x32x16_bf16(A, ones, na, 0, 0, 0);
            }
#pragma unroll
            for (int r = 0; r < 16; ++r) { const int k = 32 * half + crow(r, hi); cl[k * 64 + r32] = a0[r]; cl[k * 64 + 32 + r32] = a1[r]; }
            if (r32 == 0) {
#pragma unroll
                for (int r = 0; r < 16; ++r) NL[cc * 64 + 32 * half + crow(r, hi)] = na[r];
            }
        }
    }
    post_count(S.cnt1 + bh, tid);
    __syncthreads();
}

__device__ __forceinline__ void ml2_item(const MixCtx& C, const MlScratch& S, int bh, int slice, LAS unsigned char* lds) {
    ML_COMMON
    LAS float* lg = (LAS float*)(lds + ML_SM); LAS float* lem = lg + 64; LAS float* lso = lg + 128; LAS float* lsl = lg + 192;
    wait_count(S.cnt1 + bh, 8u, tid);
    if (tid < 64) { lg[tid] = GC[tid]; lem[tid] = EM[tid]; }
    __syncthreads();
    if (tid == 0) { float mcur = 0.f; for (int c = 0; c < 64; ++c) { const float g = lg[c], em = lem[c], mx = fmaxf(mcur, em); if (slice == 0) MP[c] = mcur; lso[c] = __expf(mcur - mx); lsl[c] = __expf(em - mx); mcur = g + mx; } }
    __syncthreads();
    const int idx = slice * 2048 + tid * 4; const bool don = (slice == 0) && (tid < 64);
    f32x4 Cs = (f32x4){0.f, 0.f, 0.f, 0.f}; float ns = 0.f;
    for (int c0 = 0; c0 < 64; c0 += 16) {
        f32x4 lv[16]; float ln[16];
#pragma unroll
        for (int j = 0; j < 16; ++j) { lv[j] = *(const f32x4*)(CL + (size_t)(c0 + j) * 4096 + idx); ln[j] = don ? NL[(c0 + j) * 64 + tid] : 0.f; }
#pragma unroll
        for (int j = 0; j < 16; ++j) {
            const int c = c0 + j;
            u32x2 pk; pk.x = cvtpk(Cs[0], Cs[1]); pk.y = cvtpk(Cs[2], Cs[3]);
            *(u32x2*)(CP + (size_t)c * 4096 + idx) = pk;
            if (don) NP[c * 64 + tid] = ns;
            const float so = lso[c], sl = lsl[c];
            Cs = Cs * so + lv[j] * sl; ns = so * ns + sl * ln[j];
        }
    }
    post_count(S.cnt2 + bh, tid);
    __syncthreads();
}

__device__ __forceinline__ void ml3_item(const MixCtx& C, const MlScratch& S, int bh, int rd, LAS unsigned char* lds) {
    ML_COMMON
    wait_count(S.cnt2 + bh, 2u, tid);
    const int pair = w >> 1, half = w & 1;
    const bf16_t* Kg = C.Z + rowbase * ZP + 1792 + 64 * h; const bf16_t* Vg = C.Z + rowbase * ZP + 2048 + 64 * h; const bf16_t* Qg = C.Z + rowbase * ZP + 1536 + 64 * h;
    const int vlo = vt_lane_off(lane);
    LAS float* wsf = (LAS float*)(lds + ML_WSF) + w * 64; LAS bf16_t* stg = (LAS bf16_t*)(lds + ML_STG + w * 4096);
#pragma unroll
        for (int p = 0; p < 4; ++p) {
            const int cc = 4 * rd + p; LAS unsigned char* sl = lds + p * 24576;
            dma_k(sl, Kg + (size_t)cc * 64 * ZP, ZP, w, lane); dma_v(sl + 8192, Vg + (size_t)cc * 64 * ZP, ZP, w, lane); dma_v(sl + 16384, CP + (size_t)cc * 4096, 64, w, lane);
        }
        const int cc = 4 * rd + pair, lrow = 32 * half + r32, t = cc * 64 + lrow;
        const bf16_t* qp = Qg + (size_t)t * ZP;
        bf16x8 qr[4], qp2[4];
#pragma unroll
        for (int d0 = 0; d0 < 4; ++d0) qr[d0] = *(const bf16x8*)(qp + 16 * d0 + 8 * hi);
#pragma unroll
        for (int ks = 0; ks < 4; ++ks) { const u32x2 a = *(const u32x2*)(qp + 16 * ks + 4 * hi), b2 = *(const u32x2*)(qp + 16 * ks + 8 + 4 * hi); qp2[ks] = __builtin_bit_cast(bf16x8, ((u32x4){a.x, a.y, b2.x, b2.y})); }
        const float mprev = MP[cc], mm = fmaxf(mprev, PM[t]), winter = __expf(mprev - mm), bl = B[t];
        float nd = 0.f;
#pragma unroll
        for (int d0 = 0; d0 < 4; ++d0) { const float* np = NP + cc * 64 + 16 * d0 + 8 * hi; const f32x4 n0 = *(const f32x4*)np, n1 = *(const f32x4*)(np + 4);
            const u32x4 qq = __builtin_bit_cast(u32x4, qr[d0]);
#pragma unroll
            for (int j = 0; j < 4; ++j) { const float lo = __builtin_bit_cast(float, qq[j] << 16), hh = __builtin_bit_cast(float, qq[j] & 0xffff0000u);
                const float na_ = j < 2 ? n0[2 * j] : n1[2 * j - 4], nb_ = j < 2 ? n0[2 * j + 1] : n1[2 * j - 3]; nd += lo * na_ + hh * nb_; } }
        nd += __shfl_xor(nd, 32);
        VM_WAIT0(); __syncthreads();
        {
            LAS unsigned char* sl = lds + pair * 24576; const int base = (int)(uintptr_t)sl + vlo;
            f32x16 o[2]; o[0] = f32x16{}; o[1] = f32x16{};
            pv(o, base + 16384, qp2[0], qp2[1], qp2[2], qp2[3]);
            scale_rows(o, winter, wsf, r32, hi);
            f32x16 p0, p1; qkt(p0, p1, sl, qr, r32, hi);
            float rs = 0.f;
#pragma unroll
            for (int rr = 0; rr < 4; ++rr) { const f32x4 e0 = *(const f32x4*)(E + cc * 64 + 8 * rr + 4 * hi), e1 = *(const f32x4*)(E + cc * 64 + 32 + 8 * rr + 4 * hi);
#pragma unroll
                for (int e = 0; e < 4; ++e) { const int r = 4 * rr + e, s = 8 * rr + 4 * hi + e;
                    const float w0 = (s <= lrow) ? __expf(e0[e] - mm) : 0.f, w1 = (s + 32 <= lrow) ? __expf(e1[e] - mm) : 0.f;
                    p0[r] *= w0; p1[r] *= w1; rs += p0[r] + p1[r]; } }
            rs += __shfl_xor(rs, 32);
            pv(o, base + 8192, PACK8(p0, 0), PACK8(p0, 8), PACK8(p1, 0), PACK8(p1, 8));
            const float den = winter * nd + rs, dn = fmaxf(fabsf(den), __expf(-(bl + mm)));
            const float rinv = 1.0f / dn;
            if (hi == 0) wsf[32 + r32] = rinv;
            LGKM_WAIT0();
#pragma unroll
            for (int r = 0; r < 16; ++r) { const int orow = crow(r, hi); const float rl = wsf[32 + orow];
#pragma unroll
                for (int d0 = 0; d0 < 2; ++d0) stg[orow * 64 + d0 * 32 + r32] = (bf16_t)f2bf(o[d0][r] * rl); }
            LGKM_WAIT0();
#pragma unroll
            for (int i = 0; i < 4; ++i) {
                const int row = i * 8 + (lane >> 3), ch = lane & 7; const u32x4 v = *(const LAS u32x4*)(stg + row * 64 + ch * 8);
                float x[8]; float ss = 0.f;
#pragma unroll
                for (int j = 0; j < 4; ++j) { x[2 * j] = __builtin_bit_cast(float, v[j] << 16); x[2 * j + 1] = __builtin_bit_cast(float, v[j] & 0xffff0000u); ss += x[2 * j] * x[2 * j] + x[2 * j + 1] * x[2 * j + 1]; }
                ss += __shfl_xor(ss, 1); ss += __shfl_xor(ss, 2); ss += __shfl_xor(ss, 4);
                const float rn = rsqrtf(ss * (1.0f / 64.0f) + EPS);
                const size_t tok = rowbase + cc * 64 + 32 * half + row;
                const u32x4 og = *(const u32x4*)(C.Z + tok * ZP + 2304 + 64 * h + ch * 8);
                const f32x4 g0 = *(const f32x4*)(C.ml_norm + h * 64 + ch * 8), g1 = *(const f32x4*)(C.ml_norm + h * 64 + ch * 8 + 4);
                float y[8];
#pragma unroll
                for (int j = 0; j < 4; ++j) { const float o0 = __builtin_bit_cast(float, og[j] << 16), o1 = __builtin_bit_cast(float, og[j] & 0xffff0000u);
                    const float ga = j < 2 ? g0[2 * j] : g1[2 * j - 4], gb = j < 2 ? g0[2 * j + 1] : g1[2 * j - 3];
                    y[2 * j] = x[2 * j] * rn * ga * o0; y[2 * j + 1] = x[2 * j + 1] * rn * gb * o1; }
                u32x4 pk; pk.x = cvtpk(y[0], y[1]); pk.y = cvtpk(y[2], y[3]); pk.z = cvtpk(y[4], y[5]); pk.w = cvtpk(y[6], y[7]);
                *(u32x4*)(C.Y + tok * 1024 + 768 + 64 * h + ch * 8) = pk;
            }
            LGKM_WAIT0();
        }
        __syncthreads();
}
constexpr int MTOK = 16384, DMODEL = 1024, SEQL = 4096, DFF = 4096, NZT = 2816  , DEPTH = 2;
constexpr size_t MiB = 1u << 20;
constexpr size_t WS_CTL = 0, CTL_BYTES = 32768;
constexpr size_t WS_WIN = 2 * MiB, WIN_L = (size_t)NZT * DMODEL * 2;
constexpr size_t WS_WOUT = 13 * MiB, WOUT_L = (size_t)DMODEL * DMODEL * 2;
constexpr size_t WS_WFF1 = 17 * MiB, WFF_L = (size_t)DFF * DMODEL * 2;
constexpr size_t WS_WFF2 = 33 * MiB;
constexpr size_t WS_SSQ2 = 82 * MiB;
constexpr size_t WS_XG = 50 * MiB;
constexpr size_t WS_H = 84 * MiB;
constexpr size_t WS_Z = 84 * MiB, WS_Y = 164 * MiB;
constexpr size_t WS_KT = 196 * MiB, WS_VT = 204 * MiB;
constexpr size_t WS_SSQ = 212 * MiB, WS_ROPE = 214 * MiB, WS_G = 215 * MiB;
constexpr size_t WS_MLE = 216 * MiB, WS_MLB = WS_MLE + 262144, WS_MLPM = WS_MLB + 262144;
constexpr size_t WS_NL = 217 * MiB, WS_NP = WS_NL + 262144, WS_GC = WS_NP + 262144, WS_EM = WS_GC + 4096, WS_MP = WS_EM + 4096;
constexpr size_t WS_CL = 218 * MiB, WS_CP = 234 * MiB, WS_NFX = 242 * MiB, WS_RS = WS_NFX + 524288  , WS_END = 243 * MiB;
constexpr int LDS_BYTES = 147456;
constexpr int WGM_P1 = 2, WGM_P3 = 4, WGM_P4 = 4, WGM_P5 = 4;
constexpr int N_FOX = 256, N_SWA = 256, N_ML1 = 128, N_ML2 = 32, N_ML3 = 256, N_ML = N_ML1 + N_ML2 + N_ML3, N_FX0 = 16, N_ITEMS = N_FX0 + N_ML + N_FOX + N_SWA;

struct Params { const float* in[16]; float* out; unsigned char* ws; int ph_lo, ph_hi; };

__device__ __forceinline__ int win_src(int n) {
    const int pn = n >> 8, P = n & 255, L = 64 * ((P >> 5) & 3) + 32 * (P >> 7) + (P & 31), z = 256 * pn + L;
    if (z < 1536) return z;
    if (z < 2304) return z + 4;
    if (z < 2560) return z + 12;
    const int i = z - 2560;
    if (i < 4) return 1536 + i;
    if (i < 8) return 2308 + (i - 4);
    if (i < 12) return 2312 + (i - 8);
    return -1;
}
template <bool WIN>
__device__ __forceinline__ void tr_item(const float* W, const float* kgain, int K, int Nsrc, bf16_t* WT, int nblk, int item, LAS float* scr, int lane) {
    const int kb = item / nblk, nb = item % nblk, k0 = 64 * kb, n0 = 32 * nb;
    if (WIN && n0 >= 2560) {
        const int n = n0 + (lane & 31); const int src = win_src(n);
#pragma unroll 8
        for (int i = 0; i < 32; ++i) { const int kk = 2 * i + (lane >> 5); scr[kk * 33 + (lane & 31)] = src >= 0 ? W[(size_t)(k0 + kk) * Nsrc + src] * (kgain ? kgain[k0 + kk] : 1.f) : 0.f; }
    } else {
        const int n4 = (lane & 7) * 4; const int src = WIN ? win_src(n0 + n4) : n0 + n4;
        f32x4 v[8];
#pragma unroll
        for (int i = 0; i < 8; ++i) v[i] = *(const f32x4*)(W + (size_t)(k0 + 8 * i + (lane >> 3)) * Nsrc + src);
#pragma unroll
        for (int i = 0; i < 8; ++i) { const int kk = 8 * i + (lane >> 3); const float g = kgain ? kgain[k0 + kk] : 1.f; LAS float* d = scr + kk * 33 + n4;
            d[0] = v[i][0] * g; d[1] = v[i][1] * g; d[2] = v[i][2] * g; d[3] = v[i][3] * g; }
    }
    LGKM_WAIT0(); asm volatile("" ::: "memory");
    const int c = lane & 7;
#pragma unroll
    for (int j = 0; j < 4; ++j) { const int nn = (lane >> 3) + 8 * j; const LAS float* s = scr + (8 * c) * 33 + nn;
        u32x4 o; o.x = cvtpk(s[0 * 33], s[1 * 33]); o.y = cvtpk(s[2 * 33], s[3 * 33]); o.z = cvtpk(s[4 * 33], s[5 * 33]); o.w = cvtpk(s[6 * 33], s[7 * 33]);
        *(u32x4*)(WT + (size_t)(n0 + nn) * K + k0 + 8 * c) = o; }
    LGKM_WAIT0(); asm volatile("" ::: "memory");
}

#define RLX_AGENT __ATOMIC_RELAXED, __HIP_MEMORY_SCOPE_AGENT
#define XB_TMO      128
#define XB_XCNT(j)  (256  + 64 * (j))
#define XB_XSUB(j)  (1280 + 64 * (j))
#define XB_XGEN(j)  (2304 + 64 * (j))
#define XB_TOP      3328
#define XB_TOPGEN   3392
#define XCD_BAR_WORDS 3456
#define XB_SPIN_CAP (1u << 18)

__device__ __forceinline__ unsigned xb_ld(unsigned* p)              { return __hip_atomic_load(p, __ATOMIC_RELAXED, __HIP_MEMORY_SCOPE_AGENT); }
__device__ __forceinline__ unsigned xb_add(unsigned* p, unsigned v) { return __hip_atomic_fetch_add(p, v, __ATOMIC_RELAXED, __HIP_MEMORY_SCOPE_AGENT); }
__device__ __forceinline__ unsigned xb_xcc_id() { return (unsigned)__builtin_amdgcn_s_getreg((3 << 11) | 20) & 0xFu; }
#define XB_SPIN(cond, bar) do { unsigned _sp = 0; while (cond) { __builtin_amdgcn_s_sleep(1); \
    if ((++_sp & 255u) == 0u) { if (xb_ld(&(bar)[XB_TMO])) break; if (_sp > XB_SPIN_CAP) { atomicAdd(&(bar)[XB_TMO], 1u); break; } } } } while (0)

struct XcdBarrier {
    unsigned* bar; unsigned x;
    volatile LAS unsigned* st;
};

__device__ __forceinline__ XcdBarrier xcd_barrier_post(unsigned* bar, volatile LAS unsigned* st) {
    XcdBarrier b; b.bar = bar; b.x = xb_xcc_id(); b.st = st;
    if (threadIdx.x == 0) (void)xb_add(&bar[XB_XCNT(b.x)], 1u);
    return b;
}
__device__ __forceinline__ void xcd_barrier_complete(unsigned* bar, unsigned x, unsigned& nloc, unsigned& nx) {
    const unsigned G = gridDim.x * gridDim.y * gridDim.z;
    unsigned sum, cnt, mine, sp = 0u;
    for (;;) {
        sum = 0u; cnt = 0u; mine = 0u;
#pragma unroll
        for (unsigned j = 0; j < 16; ++j) { const unsigned c = xb_ld(&bar[XB_XCNT(j)]); sum += c; cnt += (c > 0u) ? 1u : 0u; mine = (j == x) ? c : mine; }
        if (sum == G) break;
        __builtin_amdgcn_s_sleep(1);
        if ((++sp & 255u) == 0u) { if (xb_ld(&bar[XB_TMO])) break; if (sp > XB_SPIN_CAP) { atomicAdd(&bar[XB_TMO], 1u); break; } }
    }
    nloc = mine > 0u ? mine : 1u; nx = cnt > 0u ? cnt : 1u;
}

__device__ __forceinline__ void xcd_barrier(const XcdBarrier& b) {
    asm volatile("s_waitcnt vmcnt(0)" ::: "memory");
    __syncthreads();
    if (threadIdx.x == 0) {
        unsigned* bar = b.bar;
        __builtin_amdgcn_s_waitcnt(0);
        unsigned nloc = b.st[0], nx = b.st[1];
        if (nloc == 0u) { xcd_barrier_complete(bar, b.x, nloc, nx); b.st[0] = nloc; b.st[1] = nx; }
        const unsigned old = xb_add(&bar[XB_XSUB(b.x)], 1u);
        const unsigned gen = old / nloc;
        if (old + 1u == (gen + 1u) * nloc) {
            __builtin_amdgcn_fence(__ATOMIC_RELEASE, "agent");
            asm volatile("s_waitcnt vmcnt(0)" ::: "memory");
            const unsigned og = xb_add(&bar[XB_TOP], 1u);
            const unsigned tg = og / nx;
            if (og + 1u == (tg + 1u) * nx) xb_add(&bar[XB_TOPGEN], 1u);
            else XB_SPIN(xb_ld(&bar[XB_TOPGEN]) == tg, bar);
            __builtin_amdgcn_fence(__ATOMIC_ACQUIRE, "agent");
            xb_add(&bar[XB_XGEN(b.x)], 1u);
            asm volatile("s_waitcnt vmcnt(0)" ::: "memory");
        } else {
            XB_SPIN(xb_ld(&bar[XB_XGEN(b.x)]) == gen, bar);
            __builtin_amdgcn_fence(__ATOMIC_ACQUIRE, "agent");
            asm volatile("s_waitcnt vmcnt(0)" ::: "memory");
        }
    }
    __syncthreads();
}

__global__ void __launch_bounds__(512, 2) fwd_megakernel(Params p) {
    extern __shared__ __attribute__((aligned(16))) unsigned char lds_raw[];
    LAS unsigned char* lds = (LAS unsigned char*)lds_raw;
    cg::grid_group grid = cg::this_grid();
    const int tid = threadIdx.x, lane = tid & 63, wave = __builtin_amdgcn_readfirstlane(tid >> 6);
    const int G = gridDim.x, bx = blockIdx.x;
    unsigned char* ws = p.ws;
    const float* x_in = p.in[0];
    bf16_t* XG = (bf16_t*)(ws + WS_XG); bf16_t* Zb = (bf16_t*)(ws + WS_Z); bf16_t* Yb = (bf16_t*)(ws + WS_Y); bf16_t* Hb = (bf16_t*)(ws + WS_H);
    float* SSQ = (float*)(ws + WS_SSQ); float* SSQ2 = (float*)(ws + WS_SSQ2); float* ROPEC = (float*)(ws + WS_ROPE); float* ROPES = ROPEC + SEQL * 32; float* Gt = (float*)(ws + WS_G);
    unsigned* ctl = (unsigned*)(ws + WS_CTL);
    const int lo = p.ph_lo, hi_ph = p.ph_hi;
    volatile LAS unsigned* bst = (volatile LAS unsigned*)(lds + 143360 + 16);
    if (tid < 2) bst[tid] = 0u;
    __syncthreads();
    XcdBarrier bar = xcd_barrier_post(ctl + 1024, bst);
    if (lo < 0) grid.sync();
#define IN_PH(k) (lo <= (k) && (k) < hi_ph)
#define SEAM(k) do { if (IN_PH(k) && IN_PH((k) + 1)) xcd_barrier(bar); } while (0)

    if (IN_PH(0)) {
        LAS float* scr = (LAS float*)(lds + wave * 16384);
        const int gw = bx * 8 + wave, NGW = G * 8;
        constexpr int I_IN = (DMODEL / 64) * (NZT / 32), I_OUT = (DMODEL / 64) * (DMODEL / 32), I_F1 = (DMODEL / 64) * (DFF / 32), I_F2 = (DFF / 64) * (DMODEL / 32);
        constexpr int I_LAYER = I_IN + I_OUT + I_F1 + I_F2;
        for (int it = gw; it < DEPTH * I_LAYER; it += NGW) {
            const int l = it / I_LAYER; int r = it % I_LAYER;
            if (r < I_IN) { tr_item<true>(p.in[2] + (size_t)l * DMODEL * 2572, p.in[1] + l * DMODEL, DMODEL, 2572, (bf16_t*)(ws + WS_WIN + l * WIN_L), NZT / 32, r, scr, lane); continue; } r -= I_IN;
            if (r < I_OUT) { tr_item<false>(p.in[12] + (size_t)l * DMODEL * DMODEL, nullptr, DMODEL, DMODEL, (bf16_t*)(ws + WS_WOUT + l * WOUT_L), DMODEL / 32, r, scr, lane); continue; } r -= I_OUT;
            if (r < I_F1) { tr_item<false>(p.in[14] + (size_t)l * DMODEL * DFF, p.in[13] + l * DMODEL, DMODEL, DFF, (bf16_t*)(ws + WS_WFF1 + l * WFF_L), DFF / 32, r, scr, lane); continue; } r -= I_F1;
            tr_item<false>(p.in[15] + (size_t)l * DFF * DMODEL, nullptr, DFF, DMODEL, (bf16_t*)(ws + WS_WFF2 + l * WFF_L), DMODEL / 32, r, scr, lane);
        }
        for (int i = bx * 512 + tid; i < SEQL * 32; i += G * 512) {
            const int pos = i >> 5, j = i & 31;
            double inv = 1.0; for (int q = 0; q < j; ++q) inv *= 0.7498942093324558;
            const float ang = (float)pos * (float)inv;
            double rev = (double)ang * 0.15915494309189535; rev -= __builtin_rint(rev);
            ROPEC[i] = __builtin_amdgcn_cosf((float)rev); ROPES[i] = __builtin_amdgcn_sinf((float)rev);
        }
        for (int m = gw; m < MTOK; m += 2 * NGW) {
            const int m2 = m + NGW;
            const bool has2 = m2 < MTOK;
            const f32x4* xr = (const f32x4*)(x_in + (size_t)m * DMODEL) + lane;
            const f32x4* xr2 = (const f32x4*)(x_in + (size_t)(has2 ? m2 : m) * DMODEL) + lane;
            f32x4 va[4], vb[4];
#pragma unroll
            for (int j = 0; j < 4; ++j) { va[j] = xr[64 * j]; vb[j] = xr2[64 * j]; }
#pragma unroll
            for (int rr = 0; rr < 2; ++rr) {
                if (rr == 1 && !has2) break;
                const int mm = rr == 0 ? m : m2;
                unsigned long long* o8 = (unsigned long long*)(XG + (size_t)mm * DMODEL) + lane;
#pragma unroll
                for (int j = 0; j < 4; ++j) {
                    const f32x4 v = rr == 0 ? va[j] : vb[j];
                    float s = (v[0] * v[0] + v[1] * v[1]) + (v[2] * v[2] + v[3] * v[3]);
                    s += __shfl_xor(s, 1); s += __shfl_xor(s, 2); s += __shfl_xor(s, 4);
                    if ((lane & 7) == 0) SSQ[(size_t)mm * 32 + 8 * j + (lane >> 3)] = s;
                    o8[64 * j] = (unsigned long long)cvtpk(v[0], v[1]) | ((unsigned long long)cvtpk(v[2], v[3]) << 32);
                }
            }
        }
    }
    SEAM(0);

    for (int l = 0; l < DEPTH; ++l) {
        const int pb = 1 + 5 * l;
        if (IN_PH(pb)) {
            pg8::Gemm g{XG, (const bf16_t*)(ws + WS_WIN + l * WIN_L), MTOK, NZT, DMODEL}; pg8::StaticOrder S; S.init(MTOK, NZT, G, bx, WGM_P1);
            float* RS = (float*)(ws + WS_RS);
            { int t3_ = threadIdx.x; asm volatile("" : "+v"(t3_)); pg8::Unit ux; int lastpm = -1;
              for (int i = 0; S.next(i, ux); ++i) { if (ux.pm == lastpm) continue; lastpm = ux.pm;
                  if (t3_ < 256) { const f32x4* sp = (const f32x4*)(SSQ + (size_t)(ux.pm * 256 + t3_) * 32); f32x4 a = sp[0];
#pragma unroll
                      for (int j = 1; j < 8; ++j) a = a + sp[j];
                      RS[ux.pm * 256 + t3_] = rsqrtf(((a[0] + a[1]) + (a[2] + a[3])) * (1.0f / 1024.0f) + pg8::EPS); } }
              asm volatile("s_waitcnt vmcnt(0)" ::: "memory"); }
            __syncthreads();
            pg8::EpiIn E{Zb, Gt, RS, ROPEC, ROPES, p.in[3] + l * 64, p.in[4] + l * 64, p.in[6] + l * 64, p.in[7] + l * 64, ws + WS_KT, ws + WS_VT};
            pg8::gemm_phase<pg8::EpiIn, pg8::StaticOrder, true, true>(lds, g, S, E);
        }
        SEAM(pb);
        if (IN_PH(pb + 1)) {
            MixCtx C{Zb, Gt, Yb, p.in[5] + l * 8, p.in[8] + l * 4, p.in[9] + l * 4, p.in[10] + l * 4, p.in[11] + l * 256, ws, ws + WS_KT, ws + WS_VT};
            MlScratch MS{(float*)(ws + WS_MLE), (float*)(ws + WS_MLB), (float*)(ws + WS_MLPM), (float*)(ws + WS_CL), (float*)(ws + WS_NL), (bf16_t*)(ws + WS_CP), (float*)(ws + WS_NP), (float*)(ws + WS_GC), (float*)(ws + WS_EM), (float*)(ws + WS_MP), ctl + 128 + 32 * l, ctl + 192 + 32 * l};
            LAS int* itm = (LAS int*)(lds + 143360);
            float* NF = (float*)(ws + WS_NFX); unsigned* cntF = ctl + 512 + 32 * l; unsigned* qctr = ctl + 64 * l;
            for (;;) {
                __syncthreads();
                if (tid == 0) *itm = (int)atomicAdd(qctr, 1u);
                __syncthreads();
                const int it = *itm;
                if (it >= N_ITEMS) break;
                constexpr int Q_ML1 = N_FX0, Q_ML2 = Q_ML1 + N_ML1, Q_FOXA = Q_ML2 + N_ML2, N_FOXA = 256, Q_ML3 = Q_FOXA + N_FOXA, Q_FOXB = Q_ML3 + N_ML3, Q_SWA = Q_FOXB + (N_FOX - N_FOXA);
                static_assert(Q_SWA + N_SWA == N_ITEMS, "queue map");
                if (it < Q_ML1) fx0_item(C, NF, cntF, it, lds);
                else if (it < Q_ML2) { const int k = it - Q_ML1; ml1_item(C, MS, k >> 3, k & 7, lds); }
                else if (it < Q_FOXA) { const int k = it - Q_ML2; ml2_item(C, MS, k >> 1, k & 1, lds); }
                else if (it < Q_ML3) {
                    if (tid == 0) { const unsigned x = xb_xcc_id() & 7u; int sel = 0;
                        for (unsigned t = 0; t < 8u; ++t) { const unsigned q = (x + t) & 7u; const unsigned j = atomicAdd(ctl + 640 + 16 * l + q, 1u); if (j < 32u) { sel = (int)(q * 32u + j); break; } }
                        itm[1] = sel; }
                    __syncthreads();
                    const int k = itm[1];
                    fox_item(C, NF, cntF, k >> 4, k & 15, lds); }
                else if (it < Q_FOXB) { const int k = it - Q_ML3; ml3_item(C, MS, k >> 4, k & 15, lds); }
                else if (it < Q_SWA) { const int k = it - Q_FOXB + N_FOXA; fox_item(C, NF, cntF, k & 15, k >> 4, lds); }
                else swa_item(C, it - Q_SWA, lds);
            }
        }
        SEAM(pb + 1);
        if (IN_PH(pb + 2)) {
            pg8::Gemm g{Yb, (const bf16_t*)(ws + WS_WOUT + l * WOUT_L), MTOK, DMODEL, DMODEL}; pg8::StaticOrder S; S.init(MTOK, DMODEL, G, bx, WGM_P3);
            pg8::EpiRes E{XG, SSQ2, nullptr, nullptr};
            pg8::gemm_phase<pg8::EpiRes, pg8::StaticOrder, true, true>(lds, g, S, E);
        }
        SEAM(pb + 2);
        if (IN_PH(pb + 3)) {
            pg8::Gemm g{XG, (const bf16_t*)(ws + WS_WFF1 + l * WFF_L), MTOK, DFF, DMODEL}; pg8::StaticOrder S; S.init(MTOK, DFF, G, bx, WGM_P4);
            pg8::EpiFF1 E{Hb};
            pg8::gemm_phase<pg8::EpiFF1, pg8::StaticOrder, true, true>(lds, g, S, E);
        }
        SEAM(pb + 3);
        if (IN_PH(pb + 4)) {
            pg8::Gemm g{Hb, (const bf16_t*)(ws + WS_WFF2 + l * WFF_L), MTOK, DMODEL, DFF}; pg8::StaticOrder S; S.init(MTOK, DMODEL, G, bx, WGM_P5);
            pg8::EpiRes E{XG, SSQ, l + 1 == DEPTH ? p.out : nullptr, SSQ2};
            pg8::gemm_phase<pg8::EpiRes, pg8::StaticOrder, true, true>(lds, g, S, E);
        }
        SEAM(pb + 4);
    }
#undef IN_PH
#undef SEAM
}

constexpr int N_PHASES = 1 + 5 * DEPTH;
#ifndef MK_MULTI
#define MK_MULTI 0
#endif
extern "C" void kernel_launch(void* const* d_in, const int* in_sizes, int n_in, void* d_out, int out_size, void* d_ws, size_t ws_size, hipStream_t stream) {
    static int grid = 0;
    if (grid == 0) {
        if (n_in != 16 || out_size != MTOK * DMODEL || ws_size < WS_END) { fprintf(stderr, "kernel_launch: unexpected shapes (n_in %d out %d ws %zu)\n", n_in, out_size, ws_size); grid = -1; return; }
        int dev = 0, cus = 0, per_cu = 0;
        hipGetDevice(&dev); hipDeviceGetAttribute(&cus, hipDeviceAttributeMultiprocessorCount, dev);
        if (hipFuncSetAttribute((const void*)fwd_megakernel, hipFuncAttributeMaxDynamicSharedMemorySize, LDS_BYTES) != hipSuccess) { fprintf(stderr, "kernel_launch: hipFuncSetAttribute failed\n"); grid = -1; return; }
        if (hipOccupancyMaxActiveBlocksPerMultiprocessor(&per_cu, (const void*)fwd_megakernel, 512, LDS_BYTES) != hipSuccess || per_cu < 1) { fprintf(stderr, "kernel_launch: occupancy query says %d\n", per_cu); per_cu = 1; }
        (void)hipGetLastError();
        grid = cus;
        if (grid != 256) fprintf(stderr, "kernel_launch: %d CUs (expected 256)\n", grid);
    }
    if (grid < 0) return;
    hipMemsetAsync((char*)d_ws + WS_CTL, 0, CTL_BYTES, stream);
    Params a{};
    for (int i = 0; i < 16; ++i) a.in[i] = (const float*)d_in[i];
    a.out = (float*)d_out; a.ws = (unsigned char*)d_ws;
#if MK_MULTI
    for (int ph = 0; ph < N_PHASES; ++ph) { a.ph_lo = ph; a.ph_hi = ph + 1; hipLaunchKernelGGL(fwd_megakernel, dim3(grid), dim3(512), LDS_BYTES, stream, a); }
#else
    a.ph_lo = 0; a.ph_hi = N_PHASES;
    void* args[] = {&a};
    hipError_t e = hipLaunchCooperativeKernel((const void*)fwd_megakernel, dim3(grid), dim3(512), args, LDS_BYTES, stream);
    if (e != hipSuccess) fprintf(stderr, "cooperative launch failed: %s (grid %d)\n", hipGetErrorString(e), grid);
#endif
}
```
